# Optimizing an MI355X kernel written in HIP

```python
import math
import jax, jax.numpy as jnp
from jax import lax
import numpy as np

D_MODEL = 1024
BATCH = 8
SEQ = 8192
DEPTH = 1

GRID_W = 64
CTX_LEN = 256
DA_HEADS = 8
DA_DH = 64
DA_DV = 2 * DA_DH
Q_BLOCK = 128
GLA_HEADS = 4
GLA_DK = D_MODEL // (2 * GLA_HEADS)
GLA_DV = D_MODEL // GLA_HEADS
GLA_GATE_RANK = 16
GLA_GATE_NORM = 16.0
GLA_CHUNK = 64
D_FF = 4 * D_MODEL
ROPE_THETA = 10000.0
ROPE_AXIS_DIM = DA_DH // 2
N_BRANCH = 2
N_MOD = 6
EPS = 1e-6
IN_WIDTHS = (DA_HEADS * 2 * DA_DH,
             DA_HEADS * 2 * DA_DH,
             DA_HEADS * DA_DV,
             GLA_HEADS * GLA_DK,
             GLA_HEADS * GLA_DK,
             GLA_HEADS * GLA_DV,
             2 * GLA_GATE_RANK,
             GLA_HEADS * GLA_DV,
             N_BRANCH * D_MODEL)
D_IN = sum(IN_WIDTHS)

kernel_name = 'hybrid_diffattn_gla_dit_block'


def rms_norm(x, gain):
    xf = x.astype(jnp.float32)
    y = xf * lax.rsqrt(jnp.mean(xf * xf, axis=-1, keepdims=True) + EPS)
    return (y * gain.astype(jnp.float32)).astype(x.dtype)


def modulate(x, shift, scale):
    return x * (1.0 + scale) + shift


def axial_angles(T):
    rows = T // GRID_W
    r, col = jnp.meshgrid(jnp.arange(rows), jnp.arange(GRID_W), indexing='ij')
    inv = ROPE_THETA ** (-jnp.arange(0, ROPE_AXIS_DIM, 2, dtype=jnp.float32) / ROPE_AXIS_DIM)
    ang_r = r.reshape(-1, 1).astype(jnp.float32) * inv
    ang_c = col.reshape(-1, 1).astype(jnp.float32) * inv
    return ang_r, ang_c


def rotate_half_pairs(x, ang):
    cos = jnp.cos(ang)[:, None, None, :].astype(x.dtype)
    sin = jnp.sin(ang)[:, None, None, :].astype(x.dtype)
    x1, x2 = jnp.split(x, 2, axis=-1)
    return jnp.concatenate([x1 * cos - x2 * sin, x2 * cos + x1 * sin], axis=-1)


def axial_rope(x, ang_r, ang_c):
    return jnp.concatenate([rotate_half_pairs(x[..., :ROPE_AXIS_DIM], ang_r),
                            rotate_half_pairs(x[..., ROPE_AXIS_DIM:], ang_c)], axis=-1)


def diff_attend(q, k, v, lam):
    B, Tq = q.shape[:2]
    nblk = Tq // Q_BLOCK
    qb = q.reshape(B, nblk, Q_BLOCK, DA_HEADS, 2, DA_DH).swapaxes(0, 1)
    scale = DA_DH ** -0.5

    def block(qi):
        s = jnp.einsum('bqhcd,bkhcd->bhcqk', qi, k).astype(jnp.float32) * scale
        p = jax.nn.softmax(s, axis=-1)
        p = p[:, :, 0] - lam * p[:, :, 1]
        return jnp.einsum('bhqk,bkhe->bqhe', p.astype(v.dtype), v)

    o = lax.map(block, qb)
    return o.swapaxes(0, 1).reshape(B, Tq, DA_HEADS, DA_DV)


def gla_chunk_scan(q, k, v, g, state):
    B, H, T, _ = q.shape
    dv = v.shape[-1]
    n = T // GLA_CHUNK

    def chunks(a):
        return jnp.moveaxis(a.astype(jnp.float32).reshape(B, H, n, GLA_CHUNK, a.shape[-1]), 2, 0)

    tri = jnp.tril(jnp.ones((GLA_CHUNK, GLA_CHUNK), dtype=bool))[:, :, None]

    def step(S, inp):
        qc, kc, vc, gc = inp
        b = jnp.cumsum(gc, axis=2)
        o_inter = jnp.einsum('bhik,bhkv->bhiv', qc * jnp.exp(b), S)
        diff = b[:, :, :, None, :] - b[:, :, None, :, :]
        decay = jnp.where(tri, jnp.exp(jnp.where(tri, diff, 0.0)), 0.0)
        A = jnp.einsum('bhik,bhjk,bhijk->bhij', qc, kc, decay)
        o_intra = jnp.einsum('bhij,bhjv->bhiv', A, vc)
        b_last = b[:, :, -1:]
        S = jnp.exp(b_last)[:, :, 0, :, None] * S + jnp.einsum(
            'bhjk,bhjv->bhkv', kc * jnp.exp(b_last - b), vc)
        return S, o_inter + o_intra

    S, o = lax.scan(step, state.astype(jnp.float32), (chunks(q), chunks(k), chunks(v), chunks(g)))
    return jnp.moveaxis(o, 0, 2).reshape(B, H, T, dv), S


def gla_final_state(k, v, g):
    b = jnp.cumsum(g.astype(jnp.float32), axis=2)
    w = jnp.exp(b[:, :, -1:] - b)
    return jnp.einsum('bhtk,bhtv->bhkv', k.astype(jnp.float32) * w, v.astype(jnp.float32))


def flip_t(a):
    return jnp.flip(a, axis=2)


def gla_bidir(q, k, v, g_f, g_b, S_f, S_b):
    o_f, _ = gla_chunk_scan(q, k, v, g_f, S_f)
    o_b, _ = gla_chunk_scan(flip_t(q), flip_t(k), flip_t(v), flip_t(g_b), S_b)
    return o_f + flip_t(o_b)


def project(h, w_in, w_gate_up, b_gate_up):
    B, T = h.shape[:2]
    parts = jnp.split(h @ w_in, np.cumsum(IN_WIDTHS)[:-1].tolist(), axis=-1)
    da_q, da_k, da_v, gq, gk, gv, g_low, g_out, merge = parts
    da_q = da_q.reshape(B, T, DA_HEADS, 2, DA_DH)
    da_k = da_k.reshape(B, T, DA_HEADS, 2, DA_DH)
    da_v = da_v.reshape(B, T, DA_HEADS, DA_DV)

    def heads(a, d):
        return a.reshape(B, T, GLA_HEADS, d).transpose(0, 2, 1, 3)

    gq = heads(gq, GLA_DK) * (GLA_DK ** -0.5)
    gk = heads(gk, GLA_DK)
    gv = heads(gv, GLA_DV)
    gate = jnp.einsum('btzr,zrk->btzk', g_low.reshape(B, T, 2, GLA_GATE_RANK), w_gate_up) + b_gate_up
    gate = jax.nn.log_sigmoid(gate.astype(jnp.float32)) / GLA_GATE_NORM
    g_f = heads(gate[:, :, 0], GLA_DK)
    g_b = heads(gate[:, :, 1], GLA_DK)
    return da_q, da_k, da_v, gq, gk, gv, g_f, g_b, g_out, merge


def finish_and_merge(o_da, o_gla, g_out, merge, p, lam_init):
    B, T = o_da.shape[:2]
    y_da = (rms_norm(o_da, p['da_head_norm']) * (1.0 - lam_init)).reshape(B, T, DA_HEADS * DA_DV)
    o_gla = jnp.swapaxes(o_gla, 1, 2).astype(g_out.dtype)
    y_gla = (rms_norm(o_gla, p['gla_head_norm'])
             * jax.nn.silu(g_out.reshape(B, T, GLA_HEADS, GLA_DV))).reshape(B, T, GLA_HEADS * GLA_DV)
    gates = jax.nn.sigmoid(merge).reshape(B, T, N_BRANCH, D_MODEL)
    y = gates[:, :, 0] * (y_da @ p['w_branch_da']) + gates[:, :, 1] * (y_gla @ p['w_branch_gla'])
    return y @ p['w_out']


def sq_relu_mlp(h, w_ff1, w_ff2):
    return jnp.square(jax.nn.relu(h @ w_ff1)) @ w_ff2


def trunk_layer(x, ctx, mod_lat, mod_ctx, p, layer_idx, update_ctx):
    T = x.shape[1]
    lam_init = 0.8 - 0.6 * math.exp(-0.3 * layer_idx)
    f32 = jnp.float32
    lam = (jnp.exp(jnp.sum(p['lambda_q1'].astype(f32) * p['lambda_k1'].astype(f32)))
           - jnp.exp(jnp.sum(p['lambda_q2'].astype(f32) * p['lambda_k2'].astype(f32))) + lam_init)
    sh1, sc1, gt1, sh2, sc2, gt2 = jnp.split(mod_lat, N_MOD, axis=-1)
    csh1, csc1, cgt1, csh2, csc2, cgt2 = jnp.split(mod_ctx, N_MOD, axis=-1)

    h = modulate(rms_norm(x, p['pre_norm1']), sh1, sc1)
    hc = modulate(rms_norm(ctx, p['pre_norm1']), csh1, csc1)
    da_q, da_k, da_v, gq, gk, gv, g_f, g_b, g_out, merge = project(h, p['w_in'], p['w_gate_up'], p['b_gate_up'])
    cda_q, cda_k, cda_v, cgq, cgk, cgv, cg_f, cg_b, cg_out, cmerge = project(hc, p['w_in'], p['w_gate_up'], p['b_gate_up'])

    ang_r, ang_c = axial_angles(T)
    q_lat = axial_rope(da_q, ang_r, ang_c)
    k_lat = axial_rope(da_k, ang_r, ang_c)
    k_all = jnp.concatenate([k_lat, cda_k], axis=1)
    v_all = jnp.concatenate([da_v, cda_v], axis=1)
    o_da = diff_attend(q_lat, k_all, v_all, lam)

    S_f = gla_final_state(cgk, cgv, cg_f)
    S_b = gla_final_state(flip_t(cgk), flip_t(cgv), flip_t(cg_b))
    o_gla = gla_bidir(gq, gk, gv, g_f, g_b, S_f, S_b)

    y = finish_and_merge(o_da, o_gla, g_out, merge, p, lam_init)
    x_new = x + gt1 * rms_norm(y, p['post_norm1'])

    h2 = modulate(rms_norm(x_new, p['pre_norm2']), sh2, sc2)
    x_new = x_new + gt2 * rms_norm(sq_relu_mlp(h2, p['w_ff1'], p['w_ff2']), p['post_norm2'])

    if update_ctx:
        o_da_c = diff_attend(cda_q, cda_k, cda_v, lam)
        zero_state = jnp.zeros_like(S_f)
        o_gla_c = gla_bidir(cgq, cgk, cgv, cg_f, cg_b, zero_state, zero_state)
        yc = finish_and_merge(o_da_c, o_gla_c, cg_out, cmerge, p, lam_init)
        ctx = ctx + cgt1 * rms_norm(yc, p['post_norm1'])
        hc2 = modulate(rms_norm(ctx, p['pre_norm2']), csh2, csc2)
        ctx = ctx + cgt2 * rms_norm(sq_relu_mlp(hc2, p['w_ff1'], p['w_ff2']), p['post_norm2'])
    return x_new, ctx


def setup_inputs(seed: int = 0) -> dict:
    key = jax.random.key(seed)
    ks = jax.random.split(key, 26)
    D = D_MODEL
    nrm = jax.random.normal
    f32 = jnp.float32

    def gain(k, d):
        return 1.0 + 0.05 * nrm(k, (DEPTH, d), f32)

    return {
        'x': nrm(ks[0], (BATCH, SEQ, D), f32),
        'c': nrm(ks[1], (BATCH, D), f32),
        'ctx': nrm(ks[2], (BATCH, CTX_LEN, D), f32),
        'c_ctx': nrm(ks[3], (D,), f32),
        'w_mod': nrm(ks[4], (DEPTH, D, N_MOD * D), f32) * (0.5 * D ** -0.5),
        'b_mod': 0.01 * nrm(ks[5], (DEPTH, N_MOD * D), f32),
        'pre_norm1': gain(ks[6], D),
        'w_in': nrm(ks[7], (DEPTH, D, D_IN), f32) * D ** -0.5,
        'w_gate_up': nrm(ks[8], (DEPTH, 2, GLA_GATE_RANK, GLA_HEADS * GLA_DK), f32) * GLA_GATE_RANK ** -0.5,
        'b_gate_up': 0.1 * nrm(ks[9], (DEPTH, 2, GLA_HEADS * GLA_DK), f32),
        'lambda_q1': 0.1 * nrm(ks[10], (DEPTH, DA_DH), f32),
        'lambda_k1': 0.1 * nrm(ks[11], (DEPTH, DA_DH), f32),
        'lambda_q2': 0.1 * nrm(ks[12], (DEPTH, DA_DH), f32),
        'lambda_k2': 0.1 * nrm(ks[13], (DEPTH, DA_DH), f32),
        'da_head_norm': gain(ks[14], DA_DV),
        'gla_head_norm': gain(ks[15], GLA_DV),
        'w_branch_da': nrm(ks[16], (DEPTH, DA_HEADS * DA_DV, D), f32) * (DA_HEADS * DA_DV) ** -0.5,
        'w_branch_gla': nrm(ks[17], (DEPTH, GLA_HEADS * GLA_DV, D), f32) * (GLA_HEADS * GLA_DV) ** -0.5,
        'w_out': nrm(ks[18], (DEPTH, D, D), f32) * D ** -0.5,
        'post_norm1': gain(ks[19], D),
        'pre_norm2': gain(ks[20], D),
        'w_ff1': nrm(ks[21], (DEPTH, D, D_FF), f32) * D ** -0.5,
        'w_ff2': nrm(ks[22], (DEPTH, D_FF, D), f32) * D_FF ** -0.5,
        'post_norm2': gain(ks[23], D),
    }


def reference(x, c, ctx, c_ctx, w_mod, b_mod, pre_norm1, w_in, w_gate_up, b_gate_up,
              lambda_q1, lambda_k1, lambda_q2, lambda_k2, da_head_norm, gla_head_norm,
              w_branch_da, w_branch_gla, w_out, post_norm1, pre_norm2, w_ff1, w_ff2, post_norm2):
    for layer in range(DEPTH):
        mod_lat = (jax.nn.silu(c) @ w_mod[layer] + b_mod[layer])[:, None, :]
        mod_ctx = (jax.nn.silu(c_ctx) @ w_mod[layer] + b_mod[layer])[None, None, :]
        p = {
            'pre_norm1': pre_norm1[layer], 'w_in': w_in[layer],
            'w_gate_up': w_gate_up[layer], 'b_gate_up': b_gate_up[layer],
            'lambda_q1': lambda_q1[layer], 'lambda_k1': lambda_k1[layer],
            'lambda_q2': lambda_q2[layer], 'lambda_k2': lambda_k2[layer],
            'da_head_norm': da_head_norm[layer], 'gla_head_norm': gla_head_norm[layer],
            'w_branch_da': w_branch_da[layer], 'w_branch_gla': w_branch_gla[layer],
            'w_out': w_out[layer], 'post_norm1': post_norm1[layer],
            'pre_norm2': pre_norm2[layer], 'w_ff1': w_ff1[layer], 'w_ff2': w_ff2[layer],
            'post_norm2': post_norm2[layer],
        }
        x, ctx = trunk_layer(x, ctx, mod_lat, mod_ctx, p, layer, layer + 1 < DEPTH)
    return x
```

```cpp
#include <hip/hip_runtime.h>
#include <hip/hip_cooperative_groups.h>
#include <cstdio>
namespace cg = cooperative_groups;

typedef unsigned short bf16_t;
typedef short bf16x8 __attribute__((ext_vector_type(8)));
typedef float f32x16 __attribute__((ext_vector_type(16)));
typedef float f32x4 __attribute__((ext_vector_type(4)));
typedef float f32x2 __attribute__((ext_vector_type(2)));
typedef __bf16 bf2_t __attribute__((ext_vector_type(2)));
typedef _Float16 h4_t __attribute__((ext_vector_type(4)));

#define DI __device__ __forceinline__
#define MFMA32(a, b, c) __builtin_amdgcn_mfma_f32_32x32x16_bf16((a), (b), (c), 0, 0, 0)

constexpr int NT = 512;
constexpr int TLAT = 8192, NB = 8, NLAT = 65536, NROW = 67584, TKV = 8448;
constexpr float EPS = 1e-6f;
constexpr size_t MiB = 1048576;
constexpr size_t OFF_WIN = 0;
constexpr size_t OFF_WDA = OFF_WIN + 8448ull * 1024 * 2;
constexpr size_t OFF_WGLA = OFF_WDA + 2 * MiB;
constexpr size_t OFF_WOUT = OFF_WGLA + 2 * MiB;
constexpr size_t OFF_WFF1 = OFF_WOUT + 2 * MiB;
constexpr size_t OFF_WFF2 = OFF_WFF1 + 8 * MiB;
constexpr size_t OFF_MODP = OFF_WFF2 + 8 * MiB;
constexpr size_t OFF_ROPE = OFF_MODP + 16ull * 9 * 6144 * 4;
constexpr size_t OFF_GLOW = OFF_ROPE + 16384;
constexpr size_t R_H = 64 * MiB;
constexpr size_t R_Q = R_H + 132 * MiB;
constexpr size_t R_K = R_Q + 128 * MiB;
constexpr size_t R_VT = R_K + 132 * MiB;
constexpr size_t R_GQ = R_VT + 132 * MiB;
constexpr size_t R_GK = R_GQ + 64 * MiB;
constexpr size_t R_GVT = R_GK + 66 * MiB;
constexpr size_t R_SG = R_GVT + 132 * MiB;
constexpr size_t WS_END = R_SG + 128 * MiB;
static_assert(OFF_GLOW + 67584ull * 32 * 4 <= R_H, "small region overflow");
static_assert(WS_END <= 1024 * MiB, "workspace overflow");
constexpr size_t R_BF = R_Q;
constexpr size_t R_BB = R_Q + 66 * MiB;
constexpr size_t R_OF = R_K + 4 * MiB;
constexpr size_t R_OB = R_VT;
constexpr size_t R_YGLA = R_GQ;
constexpr size_t R_Y = R_GVT;
constexpr size_t R_Y2 = R_SG;
constexpr size_t R_H2 = R_H;
constexpr size_t R_U = R_Q;
constexpr size_t R_Y3 = R_GVT;

struct Params {
    const float *x, *c, *ctx, *c_ctx, *w_mod, *b_mod, *pre_norm1, *w_in, *w_gate_up, *b_gate_up;
    const float *lq1, *lk1, *lq2, *lk2, *da_hn, *gla_hn, *w_bda, *w_bgla, *w_out, *post_norm1, *pre_norm2, *w_ff1, *w_ff2, *post_norm2;
    float* out;
    char* ws;
};

DI unsigned pk2(float a, float b) { f32x2 v = {a, b}; bf2_t r = __builtin_convertvector(v, bf2_t); return __builtin_bit_cast(unsigned, r); }
DI bf16_t bf1(float a) { __bf16 r = (__bf16)a; return __builtin_bit_cast(unsigned short, r); }
DI float bflo(unsigned v) { return __uint_as_float(v << 16); }
DI float bfhi(unsigned v) { return __uint_as_float(v & 0xffff0000u); }
DI float wave_sum(float v) {
#pragma unroll
    for (int o = 32; o >= 1; o >>= 1) v += __shfl_xor(v, o);
    return v;
}
DI float sigmoidf_(float x) { return 1.0f / (1.0f + __expf(-x)); }

template <int MODE>
DI void repack(const float* __restrict__ src, int K, int Nsrc, bf16_t* __restrict__ dst, int Nd, long gtid, long gsz) {
    const long total = (long)Nd * (K / 8);
    for (long it = gtid; it < total; it += gsz) {
        const int n = (int)(it % Nd), kc = (int)(it / Nd);
        int col = n; bool valid = true;
        if (MODE == 1) { if (n < 5120) col = n; else if (n < 8192) col = n + 32; else if (n < 8224) col = n - 8192 + 5120; else valid = false; }
        float v[8];
#pragma unroll
        for (int j = 0; j < 8; ++j) v[j] = valid ? src[(size_t)(kc * 8 + j) * Nsrc + col] : 0.f;
        uint4 o; o.x = pk2(v[0], v[1]); o.y = pk2(v[2], v[3]); o.z = pk2(v[4], v[5]); o.w = pk2(v[6], v[7]);
        *(uint4*)(dst + (size_t)n * K + kc * 8) = o;
    }
}

DI void sincos_acc(float a, float& s, float& c) {
    const float q = rintf(a * 0.63661977236758134f);
    float r = fmaf(-q, 1.5703125f, a); r = fmaf(-q, 4.837512969970703125e-4f, r); r = fmaf(-q, 7.54978995489188216e-8f, r);
    const float r2 = r * r;
    const float sp = r + r * r2 * (-1.6666666666e-1f + r2 * (8.3333333333e-3f + r2 * (-1.98412698e-4f + r2 * 2.7557319e-6f)));
    const float cp = 1.0f + r2 * (-0.5f + r2 * (4.16666666667e-2f + r2 * (-1.38888888889e-3f + r2 * (2.48015873e-5f + r2 * -2.75573192e-7f))));
    const int qi = ((int)q) & 3;
    s = (qi == 0) ? sp : (qi == 1) ? cp : (qi == 2) ? -sp : -cp;
    c = (qi == 0) ? cp : (qi == 1) ? -sp : (qi == 2) ? -cp : sp;
}

DI void phase_prep(const Params& p, char* smem) {
    const int tid = threadIdx.x;
    const long gsz = (long)gridDim.x * NT, gtid = (long)blockIdx.x * NT + tid;
    char* ws = p.ws;
    repack<1>(p.w_in, 1024, 8224, (bf16_t*)(ws + OFF_WIN), 8448, gtid, gsz);
    repack<0>(p.w_bda, 1024, 1024, (bf16_t*)(ws + OFF_WDA), 1024, gtid, gsz);
    repack<0>(p.w_bgla, 1024, 1024, (bf16_t*)(ws + OFF_WGLA), 1024, gtid, gsz);
    repack<0>(p.w_out, 1024, 1024, (bf16_t*)(ws + OFF_WOUT), 1024, gtid, gsz);
    repack<0>(p.w_ff1, 1024, 4096, (bf16_t*)(ws + OFF_WFF1), 4096, gtid, gsz);
    repack<0>(p.w_ff2, 4096, 1024, (bf16_t*)(ws + OFF_WFF2), 1024, gtid, gsz);
    if (gtid < 2048) {
        const int pos = (int)gtid >> 4, f = (int)gtid & 15;
        const float inv = exp2f(-(float)f * (13.287712379549449f / 16.0f));
        float s, c; sincos_acc((float)pos * inv, s, c);
        float* rt = (float*)(ws + OFF_ROPE);
        rt[gtid] = c; rt[2048 + gtid] = s;
    }
    float* sil = (float*)smem;
    float* modp = (float*)(ws + OFF_MODP);
    for (int item = blockIdx.x; item < 192; item += gridDim.x) {
        const int cb = item % 12, ks = item / 12;
        __syncthreads();
        for (int i = tid; i < 9 * 64; i += NT) {
            const int r = i >> 6, kk = i & 63;
            const float v = (r < 8) ? p.c[r * 1024 + ks * 64 + kk] : p.c_ctx[ks * 64 + kk];
            sil[i] = v * sigmoidf_(v);
        }
        __syncthreads();
        const int n = cb * 512 + tid;
        float acc[9];
#pragma unroll
        for (int r = 0; r < 9; ++r) acc[r] = 0.f;
        for (int kk = 0; kk < 64; ++kk) {
            const float w = p.w_mod[(size_t)(ks * 64 + kk) * 6144 + n];
#pragma unroll
            for (int r = 0; r < 9; ++r) acc[r] = fmaf(sil[r * 64 + kk], w, acc[r]);
        }
#pragma unroll
        for (int r = 0; r < 9; ++r) modp[(size_t)(ks * 9 + r) * 6144 + n] = acc[r];
    }
}

DI void load_mod(const Params& p, int r, int which, float* dst) {
    const float* modp = (const float*)(p.ws + OFF_MODP);
    for (int n = threadIdx.x; n < 1024; n += NT) {
        float a = p.b_mod[which * 1024 + n];
#pragma unroll
        for (int ks = 0; ks < 16; ++ks) a += modp[(size_t)(ks * 9 + r) * 6144 + which * 1024 + n];
        dst[n] = a;
    }
}

DI void phase_h(const Params& p, char* smem) {
    float* md = (float*)smem;
    const int tid = threadIdx.x, lane = tid & 63, w = tid >> 6;
    bf16_t* H = (bf16_t*)(p.ws + R_H);
    for (int tile = blockIdx.x; tile < 264; tile += gridDim.x) {
        const int r = tile < 256 ? (tile >> 5) : 8;
        __syncthreads();
        load_mod(p, r, 0, md); load_mod(p, r, 1, md + 1024);
        __syncthreads();
        for (int i = 0; i < 32; ++i) {
            const int row = tile * 256 + w * 32 + i;
            const float* src = row < NLAT ? p.x + (size_t)row * 1024 : p.ctx + (size_t)(row - NLAT) * 1024;
            f32x4 v[4]; float ss = 0.f;
#pragma unroll
            for (int j = 0; j < 4; ++j) { v[j] = *(const f32x4*)(src + lane * 4 + 256 * j); ss += v[j].x * v[j].x + v[j].y * v[j].y + v[j].z * v[j].z + v[j].w * v[j].w; }
            ss = wave_sum(ss);
            const float rs = rsqrtf(ss * (1.0f / 1024.0f) + EPS);
#pragma unroll
            for (int j = 0; j < 4; ++j) {
                const int col = lane * 4 + 256 * j;
                const f32x4 g = *(const f32x4*)(p.pre_norm1 + col);
                const f32x4 sh = *(const f32x4*)(md + col), sc = *(const f32x4*)(md + 1024 + col);
                const float o0 = v[j].x * rs * g.x * (1.f + sc.x) + sh.x, o1 = v[j].y * rs * g.y * (1.f + sc.y) + sh.y;
                const float o2 = v[j].z * rs * g.z * (1.f + sc.z) + sh.z, o3 = v[j].w * rs * g.w * (1.f + sc.w) + sh.w;
                uint2 o; o.x = pk2(o0, o1); o.y = pk2(o2, o3);
                *(uint2*)(H + (size_t)row * 1024 + col) = o;
            }
        }
    }
}

template <class Epi>
DI void gemm_tile(const bf16_t* __restrict__ A, int lda, const bf16_t* __restrict__ B, int ldb, int K, int m0, int n0, char* smem, Epi& epi) {
    const int tid = threadIdx.x, lane = tid & 63, w = tid >> 6, wm = w >> 2, wn = w & 3, l31 = lane & 31, hh = lane >> 5;
    f32x16 acc[4][2];
#pragma unroll
    for (int i = 0; i < 4; ++i)
#pragma unroll
        for (int j = 0; j < 2; ++j)
#pragma unroll
            for (int e = 0; e < 16; ++e) acc[i][j][e] = 0.f;
    const int sc = tid & 7, sr = tid >> 3;
    const bf16_t* ga = A + (size_t)(m0 + sr) * lda + sc * 8;
    const bf16_t* gb = B + (size_t)(n0 + sr) * ldb + sc * 8;
    const int wofs = sr * 128 + ((sc ^ ((sr >> 1) & 7)) << 4);
    const int sw = (l31 >> 1) & 7;
    const int aofs = (128 * wm + l31) * 128, bofs = 32768 + (64 * wn + l31) * 128;
    uint4 ra[4], rb[4];
#pragma unroll
    for (int i = 0; i < 4; ++i) { ra[i] = *(const uint4*)(ga + (size_t)i * 64 * lda); rb[i] = *(const uint4*)(gb + (size_t)i * 64 * ldb); }
#pragma unroll
    for (int i = 0; i < 4; ++i) { *(uint4*)(smem + wofs + i * 8192) = ra[i]; *(uint4*)(smem + 32768 + wofs + i * 8192) = rb[i]; }
    __syncthreads();
    const int KT = K >> 6;
    for (int kt = 0; kt < KT; ++kt) {
        const bool more = kt + 1 < KT;
        if (more) {
#pragma unroll
            for (int i = 0; i < 4; ++i) { ra[i] = *(const uint4*)(ga + (size_t)i * 64 * lda + (kt + 1) * 64); rb[i] = *(const uint4*)(gb + (size_t)i * 64 * ldb + (kt + 1) * 64); }
        }
        const char* sb = smem + (kt & 1) * 65536;
#pragma unroll
        for (int ks = 0; ks < 4; ++ks) {
            const int co = ((2 * ks + hh) ^ sw) << 4;
            bf16x8 af[4], bf[2];
#pragma unroll
            for (int mi = 0; mi < 4; ++mi) af[mi] = *(const bf16x8*)(sb + aofs + mi * 4096 + co);
#pragma unroll
            for (int ni = 0; ni < 2; ++ni) bf[ni] = *(const bf16x8*)(sb + bofs + ni * 4096 + co);
#pragma unroll
            for (int mi = 0; mi < 4; ++mi)
#pragma unroll
                for (int ni = 0; ni < 2; ++ni) acc[mi][ni] = MFMA32(bf[ni], af[mi], acc[mi][ni]);
        }
        if (more) {
            char* so = smem + ((kt + 1) & 1) * 65536;
#pragma unroll
            for (int i = 0; i < 4; ++i) { *(uint4*)(so + wofs + i * 8192) = ra[i]; *(uint4*)(so + 32768 + wofs + i * 8192) = rb[i]; }
        }
        __syncthreads();
    }
#pragma unroll
    for (int mi = 0; mi < 4; ++mi)
#pragma unroll
        for (int ni = 0; ni < 2; ++ni) epi(m0 + 128 * wm + 32 * mi + l31, n0 + 64 * wn + 32 * ni, acc[mi][ni], hh);
}

DI void tile_map(int id, int MT, int NTl, int& mt, int& nt) {
    const int x = id & 7, local = id >> 3, mtx = MT >> 3;
    const int full = mtx >> 2, per = 4 * NTl;
    int patch = local / per, wv = local - patch * per, pm = 4;
    if (patch >= full) { patch = full; wv = local - full * per; pm = mtx - full * 4; }
    const int mo = wv % pm; nt = wv / pm;
    mt = (patch * 4 + mo) * 8 + x;
}

template <class Epi>
DI void gemm_phase(const bf16_t* A, int lda, const bf16_t* B, int ldb, int K, int MT, int NTl, char* smem, Epi& epi) {
    const int total = MT * NTl;
    for (int id = blockIdx.x; id < total; id += gridDim.x) {
        int mt, nt; tile_map(id, MT, NTl, mt, nt);
        gemm_tile(A, lda, B, ldb, K, mt * 256, nt * 256, smem, epi);
    }
}

struct EpiIn {
    bf16_t *Q, *Kk, *Vt, *gq, *gk, *gvT, *sg, *mg; float* glow; const float* rope;
    DI void operator()(int row, int cb, const f32x16& v, int hh) const {
        if (cb >= 8224) return;
        const bool lat = row < NLAT;
        int b, t;
        if (lat) { b = row >> 13; t = row & 8191; } else { const int r2 = row - NLAT; b = r2 >> 8; t = TLAT + (r2 & 255); }
        if (cb < 2048) {
            const bool isq = cb < 1024;
            if (isq && !lat) return;
            const int c = cb & 1023, head = c >> 7, comp = (c >> 6) & 1, half = (c >> 5) & 1;
            float o[16];
            if (lat) {
                const int pos = half ? (t & 63) : (t >> 6);
                const float* cs = rope + pos * 16; const float* sn = rope + 2048 + pos * 16;
#pragma unroll
                for (int g = 0; g < 2; ++g) {
                    const f32x4 c4 = *(const f32x4*)(cs + 8 * g + 4 * hh), s4 = *(const f32x4*)(sn + 8 * g + 4 * hh);
#pragma unroll
                    for (int j = 0; j < 4; ++j) {
                        const float x1 = v[4 * g + j], x2 = v[4 * (g + 2) + j];
                        o[4 * g + j] = x1 * c4[j] - x2 * s4[j];
                        o[4 * (g + 2) + j] = x2 * c4[j] + x1 * s4[j];
                    }
                }
            } else {
#pragma unroll
                for (int e = 0; e < 16; ++e) o[e] = v[e];
            }
            const float scl = isq ? 0.125f * 1.4426950408889634f : 1.0f;
            bf16_t* dst = isq ? Q + ((size_t)((b * 8 + head) * 2 + comp) * TLAT + t) * 64 : Kk + ((size_t)((b * 8 + head) * 2 + comp) * TKV + t) * 64;
#pragma unroll
            for (int g = 0; g < 4; ++g) {
                uint2 u; u.x = pk2(o[4 * g] * scl, o[4 * g + 1] * scl); u.y = pk2(o[4 * g + 2] * scl, o[4 * g + 3] * scl);
                *(uint2*)(dst + 32 * half + 8 * g + 4 * hh) = u;
            }
        } else if (cb < 3072) {
            const int c = cb - 2048, head = c >> 7, dv0 = c & 127;
            bf16_t* dst = Vt + (size_t)((b * 8 + head) * 128 + dv0) * TKV + t;
#pragma unroll
            for (int e = 0; e < 16; ++e) dst[(size_t)(8 * (e >> 2) + 4 * hh + (e & 3)) * TKV] = bf1(v[e]);
        } else if (cb < 4096) {
            const bool isq = cb < 3584;
            if (isq && !lat) return;
            const int c = (cb - 3072) & 511;
            const float scl = isq ? 0.08838834764831845f : 1.0f;
            bf16_t* dst = (isq ? gq : gk) + (size_t)row * 512 + c;
#pragma unroll
            for (int g = 0; g < 4; ++g) {
                uint2 u; u.x = pk2(v[4 * g] * scl, v[4 * g + 1] * scl); u.y = pk2(v[4 * g + 2] * scl, v[4 * g + 3] * scl);
                *(uint2*)(dst + 8 * g + 4 * hh) = u;
            }
        } else if (cb < 5120) {
            const int c = cb - 4096, head = c >> 8, dv0 = c & 255;
            bf16_t* dst = gvT + (size_t)((b * 4 + head) * 256 + dv0) * TKV + t;
#pragma unroll
            for (int e = 0; e < 16; ++e) dst[(size_t)(8 * (e >> 2) + 4 * hh + (e & 3)) * TKV] = bf1(v[e]);
        } else if (cb < 6144) {
            if (!lat) return;
            bf16_t* dst = sg + (size_t)row * 1024 + (cb - 5120);
#pragma unroll
            for (int g = 0; g < 4; ++g) {
                float s[4];
#pragma unroll
                for (int j = 0; j < 4; ++j) { const float xx = v[4 * g + j]; s[j] = xx * sigmoidf_(xx); }
                uint2 u; u.x = pk2(s[0], s[1]); u.y = pk2(s[2], s[3]);
                *(uint2*)(dst + 8 * g + 4 * hh) = u;
            }
        } else if (cb < 8192) {
            if (!lat) return;
            bf16_t* dst = mg + (size_t)row * 2048 + (cb - 6144);
#pragma unroll
            for (int g = 0; g < 4; ++g) {
                uint2 u; u.x = pk2(sigmoidf_(v[4 * g]), sigmoidf_(v[4 * g + 1])); u.y = pk2(sigmoidf_(v[4 * g + 2]), sigmoidf_(v[4 * g + 3]));
                *(uint2*)(dst + 8 * g + 4 * hh) = u;
            }
        } else {
            float* dst = glow + (size_t)row * 32;
#pragma unroll
            for (int g = 0; g < 4; ++g) { f32x4 u = {v[4 * g], v[4 * g + 1], v[4 * g + 2], v[4 * g + 3]}; *(f32x4*)(dst + 8 * g + 4 * hh) = u; }
        }
    }
};

struct EpiGate0 {
    bf16_t* Y; const bf16_t* mg;
    DI void operator()(int row, int cb, const f32x16& v, int hh) const {
#pragma unroll
        for (int g = 0; g < 4; ++g) {
            const int col = cb + 8 * g + 4 * hh;
            const uint2 m = *(const uint2*)(mg + (size_t)row * 2048 + col);
            uint2 u; u.x = pk2(v[4 * g] * bflo(m.x), v[4 * g + 1] * bfhi(m.x)); u.y = pk2(v[4 * g + 2] * bflo(m.y), v[4 * g + 3] * bfhi(m.y));
            *(uint2*)(Y + (size_t)row * 1024 + col) = u;
        }
    }
};
struct EpiGate1 {
    bf16_t* Y; const bf16_t* mg;
    DI void operator()(int row, int cb, const f32x16& v, int hh) const {
#pragma unroll
        for (int g = 0; g < 4; ++g) {
            const int col = cb + 8 * g + 4 * hh;
            const uint2 m = *(const uint2*)(mg + (size_t)row * 2048 + 1024 + col);
            const uint2 pr = *(const uint2*)(Y + (size_t)row * 1024 + col);
            uint2 u; u.x = pk2(bflo(pr.x) + v[4 * g] * bflo(m.x), bfhi(pr.x) + v[4 * g + 1] * bfhi(m.x));
            u.y = pk2(bflo(pr.y) + v[4 * g + 2] * bflo(m.y), bfhi(pr.y) + v[4 * g + 3] * bfhi(m.y));
            *(uint2*)(Y + (size_t)row * 1024 + col) = u;
        }
    }
};
template <int ACT>
struct EpiStore {
    bf16_t* O; int ldo;
    DI void operator()(int row, int cb, const f32x16& v, int hh) const {
#pragma unroll
        for (int g = 0; g < 4; ++g) {
            float s[4];
#pragma unroll
            for (int j = 0; j < 4; ++j) { float xx = v[4 * g + j]; if (ACT == 1) { xx = fmaxf(xx, 0.f); xx = xx * xx; } s[j] = xx; }
            uint2 u; u.x = pk2(s[0], s[1]); u.y = pk2(s[2], s[3]);
            *(uint2*)(O + (size_t)row * ldo + cb + 8 * g + 4 * hh) = u;
        }
    }
};

DI int kappa(int r) { return (r & ~12) | ((r & 4) << 1) | ((r & 8) >> 1); }

DI void attn_softmax(f32x16& s, float& m, float& l, f32x16 (&O)[4], bf16x8 (&pb)[2]) {
    float mt = fmaxf(fmaxf(fmaxf(s[0], s[1]), fmaxf(s[2], s[3])), fmaxf(fmaxf(s[4], s[5]), fmaxf(s[6], s[7])));
    mt = fmaxf(mt, fmaxf(fmaxf(fmaxf(s[8], s[9]), fmaxf(s[10], s[11])), fmaxf(fmaxf(s[12], s[13]), fmaxf(s[14], s[15]))));
    mt = fmaxf(mt, __shfl_xor(mt, 32));
    if (__any(mt > m + 8.0f)) {
        const float mn = fmaxf(m, mt);
        const float al = exp2f(m - mn);
        l *= al;
#pragma unroll
        for (int d = 0; d < 4; ++d)
#pragma unroll
            for (int e = 0; e < 16; ++e) O[d][e] *= al;
        m = mn;
    }
    float pv[16]; float ls = 0.f;
#pragma unroll
    for (int e = 0; e < 16; ++e) { pv[e] = __builtin_amdgcn_exp2f(s[e] - m); ls += pv[e]; }
    l += ls;
    unsigned u[8];
#pragma unroll
    for (int e = 0; e < 8; ++e) u[e] = pk2(pv[2 * e], pv[2 * e + 1]);
    typedef unsigned u32x4 __attribute__((ext_vector_type(4)));
    u32x4 a = {u[0], u[1], u[2], u[3]}, b = {u[4], u[5], u[6], u[7]};
    pb[0] = __builtin_bit_cast(bf16x8, a); pb[1] = __builtin_bit_cast(bf16x8, b);
}

DI void phase_attn(const Params& p, char* smem) {
    const int tid = threadIdx.x, lane = tid & 63, w = tid >> 6, l31 = lane & 31, hh = lane >> 5;
    const int g = w >> 1, comp = w & 1;
    const bf16_t* Q = (const bf16_t*)(p.ws + R_Q);
    const bf16_t* Kk = (const bf16_t*)(p.ws + R_K);
    const bf16_t* Vt = (const bf16_t*)(p.ws + R_VT);
    bf16_t* YDA = (bf16_t*)(p.ws + R_H);
    float d1 = 0.f, d2 = 0.f;
    for (int i = 0; i < 64; ++i) { d1 += p.lq1[i] * p.lk1[i]; d2 += p.lq2[i] * p.lk2[i]; }
    const float lam = __expf(d1) - __expf(d2) + 0.2f;
    const int sc = tid & 7, sr = tid >> 3;
    const int wofs = sr * 128 + ((sc ^ ((sr >> 1) & 7)) << 4);
    const int sw = (l31 >> 1) & 7;
    const int krow = kappa(l31);
    const int ksw = (krow >> 1) & 7;
    float* xbuf = (float*)smem + g * 4096;
    for (int id = blockIdx.x; id < 4096; id += gridDim.x) {
        const int x = id & 7, j = id >> 3, bh = (j >> 6) * 8 + x, qt = j & 63;
        const int b = bh >> 3, h = bh & 7;
        const bf16_t* qp = Q + ((size_t)(bh * 2 + comp) * TLAT + qt * 128 + g * 32 + l31) * 64 + hh * 8;
        bf16x8 qf[4];
#pragma unroll
        for (int ks = 0; ks < 4; ++ks) qf[ks] = *(const bf16x8*)(qp + ks * 16);
        const bf16_t* gk0 = Kk + ((size_t)(bh * 2 + 0) * TKV + sr) * 64 + sc * 8;
        const bf16_t* gk1 = gk0 + (size_t)TKV * 64;
        const bf16_t* gv0 = Vt + ((size_t)bh * 128 + sr) * TKV + sc * 8;
        const bf16_t* gv1 = gv0 + (size_t)64 * TKV;
        f32x16 O[4];
#pragma unroll
        for (int d = 0; d < 4; ++d)
#pragma unroll
            for (int e = 0; e < 16; ++e) O[d][e] = 0.f;
        float m = -INFINITY, l = 0.f;
        uint4 r0, r1, r2, r3;
        r0 = *(const uint4*)gk0; r1 = *(const uint4*)gk1; r2 = *(const uint4*)gv0; r3 = *(const uint4*)gv1;
        __syncthreads();
        *(uint4*)(smem + wofs) = r0; *(uint4*)(smem + 8192 + wofs) = r1; *(uint4*)(smem + 16384 + wofs) = r2; *(uint4*)(smem + 24576 + wofs) = r3;
        __syncthreads();
        constexpr int NKT = TKV / 64;
        for (int kt = 0; kt < NKT; ++kt) {
            const bool more = kt + 1 < NKT;
            if (more) {
                r0 = *(const uint4*)(gk0 + (size_t)(kt + 1) * 64 * 64); r1 = *(const uint4*)(gk1 + (size_t)(kt + 1) * 64 * 64);
                r2 = *(const uint4*)(gv0 + (kt + 1) * 64); r3 = *(const uint4*)(gv1 + (kt + 1) * 64);
            }
            const char* sb = smem + (kt & 1) * 32768;
            const char* skc = sb + comp * 8192;
#pragma unroll
            for (int sub = 0; sub < 2; ++sub) {
                bf16x8 pb[2];
                f32x16 s;
#pragma unroll
                for (int e = 0; e < 16; ++e) s[e] = 0.f;
#pragma unroll
                for (int ks = 0; ks < 4; ++ks) {
                    const bf16x8 kf = *(const bf16x8*)(skc + (32 * sub + krow) * 128 + (((2 * ks + hh) ^ ksw) << 4));
                    s = MFMA32(kf, qf[ks], s);
                }
                attn_softmax(s, m, l, O, pb);
#pragma unroll
                for (int dt = 0; dt < 4; ++dt)
#pragma unroll
                    for (int s2 = 0; s2 < 2; ++s2) {
                        const bf16x8 vf = *(const bf16x8*)(sb + 16384 + (32 * dt + l31) * 128 + (((4 * sub + 2 * s2 + hh) ^ sw) << 4));
                        O[dt] = MFMA32(vf, pb[s2], O[dt]);
                    }
            }
            if (more) {
                char* so = smem + ((kt + 1) & 1) * 32768;
                *(uint4*)(so + wofs) = r0; *(uint4*)(so + 8192 + wofs) = r1; *(uint4*)(so + 16384 + wofs) = r2; *(uint4*)(so + 24576 + wofs) = r3;
            }
            __syncthreads();
        }
        l += __shfl_xor(l, 32);
        if (comp == 1) {
            const float i1 = lam / l;
#pragma unroll
            for (int d = 0; d < 4; ++d)
#pragma unroll
                for (int e = 0; e < 16; ++e) xbuf[(d * 16 + e) * 64 + lane] = O[d][e] * i1;
        }
        __syncthreads();
        if (comp == 0) {
            const float i0 = 1.0f / l;
            float ss = 0.f;
#pragma unroll
            for (int d = 0; d < 4; ++d)
#pragma unroll
                for (int e = 0; e < 16; ++e) { const float o = O[d][e] * i0 - xbuf[(d * 16 + e) * 64 + lane]; O[d][e] = o; ss += o * o; }
            ss += __shfl_xor(ss, 32);
            const float rs = rsqrtf(ss * (1.0f / 128.0f) + EPS) * 0.8f;
            const int t = qt * 128 + g * 32 + l31;
            bf16_t* dst = YDA + ((size_t)b * TLAT + t) * 1024 + h * 128;
#pragma unroll
            for (int d = 0; d < 4; ++d)
#pragma unroll
                for (int gg = 0; gg < 4; ++gg) {
                    const int dv = 32 * d + 8 * gg + 4 * hh;
                    const f32x4 hn = *(const f32x4*)(p.da_hn + dv);
                    uint2 u; u.x = pk2(O[d][4 * gg] * rs * hn.x, O[d][4 * gg + 1] * rs * hn.y); u.y = pk2(O[d][4 * gg + 2] * rs * hn.z, O[d][4 * gg + 3] * rs * hn.w);
                    *(uint2*)(dst + dv) = u;
                }
        }
    }
}

DI void phase_gate(const Params& p) {
    const int tid = threadIdx.x;
    const float* glow = (const float*)(p.ws + OFF_GLOW);
    for (int item = blockIdx.x; item < 2112; item += gridDim.x) {
        const int z = item & 1, ch = item >> 1;
        _Float16* B = (_Float16*)(p.ws + (z ? R_BB : R_BF));
        float wv[16];
#pragma unroll
        for (int r = 0; r < 16; ++r) wv[r] = p.w_gate_up[(size_t)(z * 16 + r) * 512 + tid];
        const float bias = p.b_gate_up[z * 512 + tid];
        float run = 0.f;
        for (int i = 0; i < 64; ++i) {
            const int row = ch * 64 + (z ? 63 - i : i);
            const float* gl = glow + (size_t)row * 32 + z * 16;
            float a = bias;
#pragma unroll
            for (int r = 0; r < 16; ++r) a = fmaf(gl[r], wv[r], a);
            const float ls = fminf(a, 0.f) - __logf(1.0f + __expf(-fabsf(a)));
            run += ls * (1.0f / 16.0f);
            B[(size_t)row * 512 + tid] = (_Float16)run;
        }
    }
}

struct GlaRegs { uint2 k[2][2], q[2][2], bb[2][2], bl[2][2]; uint4 v[4]; };

DI void phase_gla(const Params& p, char* smem) {
    if (blockIdx.x >= 64) return;
    const int tid = threadIdx.x, lane = tid & 63, w = tid >> 6, l31 = lane & 31, hh = lane >> 5;
    const int unit = blockIdx.x, dir = unit & 1, bh = unit >> 1, b = bh >> 2, h = bh & 3;
    const bf16_t* gq = (const bf16_t*)(p.ws + R_GQ);
    const bf16_t* gk = (const bf16_t*)(p.ws + R_GK);
    const bf16_t* gvT = (const bf16_t*)(p.ws + R_GVT) + (size_t)bh * 256 * TKV;
    const _Float16* B16 = (const _Float16*)(p.ws + (dir ? R_BB : R_BF));
    bf16_t* Oo = (bf16_t*)(p.ws + (dir ? R_OB : R_OF));
    char* sQt = smem;
    char* sKt = smem + 16384;
    char* sKh = smem + 32768;
    char* sVT = smem + 49152;
    char* sA = smem + 81920;
    float* sD = (float*)(smem + 90112);
    f32x16 S[4];
#pragma unroll
    for (int k = 0; k < 4; ++k)
#pragma unroll
        for (int e = 0; e < 16; ++e) S[k][e] = 0.f;
    const int sw = (l31 >> 1) & 7;
    GlaRegs R;
    auto chunk_info = [&](int step, int& rowbase, int& tcol, bool& emit) {
        if (step < 4) { const int cc = dir ? 3 - step : step; rowbase = NLAT + b * 256 + cc * 64; tcol = TLAT + cc * 64; emit = false; }
        else { const int cc = dir ? 127 - (step - 4) : step - 4; rowbase = b * TLAT + cc * 64; tcol = cc * 64; emit = true; }
    };
    auto load_chunk = [&](int step) {
        int rowbase, tcol; bool emit; chunk_info(step, rowbase, tcol, emit);
        const int rl = rowbase + (dir ? 0 : 63);
#pragma unroll
        for (int i = 0; i < 2; ++i) {
            const int item = tid + NT * i, tok = item >> 4, c = item & 15, d0 = 16 * (c >> 1) + 4 * (c & 1);
            const size_t ro = (size_t)(rowbase + tok) * 512 + h * 128 + d0;
            R.k[i][0] = *(const uint2*)(gk + ro); R.k[i][1] = *(const uint2*)(gk + ro + 8);
            if (emit) { R.q[i][0] = *(const uint2*)(gq + ro); R.q[i][1] = *(const uint2*)(gq + ro + 8); }
            else { R.q[i][0] = make_uint2(0, 0); R.q[i][1] = make_uint2(0, 0); }
            R.bb[i][0] = *(const uint2*)(B16 + ro); R.bb[i][1] = *(const uint2*)(B16 + ro + 8);
            const size_t rlo = (size_t)rl * 512 + h * 128 + d0;
            R.bl[i][0] = *(const uint2*)(B16 + rlo); R.bl[i][1] = *(const uint2*)(B16 + rlo + 8);
        }
#pragma unroll
        for (int i = 0; i < 4; ++i) R.v[i] = *(const uint4*)(gvT + (size_t)((tid >> 3) + 64 * i) * TKV + tcol + (tid & 7) * 8);
    };
    auto stage_chunk = [&]() {
#pragma unroll
        for (int i = 0; i < 2; ++i) {
            const int item = tid + NT * i, tok = item >> 4, c = item & 15, d0 = 16 * (c >> 1) + 4 * (c & 1);
            float qo[8], ko[8];
#pragma unroll
            for (int g = 0; g < 2; ++g) {
                const h4_t bv = __builtin_bit_cast(h4_t, R.bb[i][g]), lv = __builtin_bit_cast(h4_t, R.bl[i][g]);
                const float kk[4] = {bflo(R.k[i][g].x), bfhi(R.k[i][g].x), bflo(R.k[i][g].y), bfhi(R.k[i][g].y)};
                const float qq[4] = {bflo(R.q[i][g].x), bfhi(R.q[i][g].x), bflo(R.q[i][g].y), bfhi(R.q[i][g].y)};
#pragma unroll
                for (int j = 0; j < 4; ++j) {
                    const float bb = (float)bv[j], bl = (float)lv[j];
                    qo[4 * g + j] = qq[j] * __expf(bb);
                    ko[4 * g + j] = kk[j] * __expf(-bb);
                    const float kh = kk[j] * __expf(bl - bb);
                    const int dk = d0 + 8 * g + j;
                    *(bf16_t*)(sKh + dk * 128 + ((((tok >> 3) ^ ((dk >> 1) & 7))) << 4) + (tok & 7) * 2) = bf1(kh);
                    if (tok == 0) sD[dk] = __expf(bl);
                }
            }
            const int po = tok * 256 + ((c ^ (tok & 15)) << 4);
            uint4 uq, uk;
            uq.x = pk2(qo[0], qo[1]); uq.y = pk2(qo[2], qo[3]); uq.z = pk2(qo[4], qo[5]); uq.w = pk2(qo[6], qo[7]);
            uk.x = pk2(ko[0], ko[1]); uk.y = pk2(ko[2], ko[3]); uk.z = pk2(ko[4], ko[5]); uk.w = pk2(ko[6], ko[7]);
            *(uint4*)(sQt + po) = uq; *(uint4*)(sKt + po) = uk;
        }
#pragma unroll
        for (int i = 0; i < 4; ++i) {
            const int row = (tid >> 3) + 64 * i, scn = tid & 7;
            *(uint4*)(sVT + row * 128 + ((scn ^ ((row >> 1) & 7)) << 4)) = R.v[i];
        }
    };
    load_chunk(0);
    for (int step = 0; step < 132; ++step) {
        int rowbase, tcol; bool emit; chunk_info(step, rowbase, tcol, emit);
        stage_chunk();
        __syncthreads();
        if (step + 1 < 132) load_chunk(step + 1);
        const int dvb = 32 * w;
        if (emit) {
            if (w < 4) {
                const int ti = w >> 1, tj = w & 1;
                f32x16 a;
#pragma unroll
                for (int e = 0; e < 16; ++e) a[e] = 0.f;
                const bool dead = dir ? (tj < ti) : (tj > ti);
                if (!dead) {
#pragma unroll
                    for (int ks = 0; ks < 8; ++ks) {
                        const int ri = 32 * ti + l31, rj = 32 * tj + l31, c = 2 * ks + hh;
                        const bf16x8 af = *(const bf16x8*)(sQt + ri * 256 + ((c ^ (ri & 15)) << 4));
                        const bf16x8 bf = *(const bf16x8*)(sKt + rj * 256 + ((c ^ (rj & 15)) << 4));
                        a = MFMA32(af, bf, a);
                    }
                }
                const int jj = 32 * tj + l31;
#pragma unroll
                for (int e = 0; e < 16; ++e) {
                    const int ii = 32 * ti + (e & 3) + 8 * (e >> 2) + 4 * hh;
                    const bool keep = dir ? (jj >= ii) : (jj <= ii);
                    *(bf16_t*)(sA + ii * 128 + ((((jj >> 3) ^ ((ii >> 1) & 7))) << 4) + (jj & 7) * 2) = bf1(keep ? a[e] : 0.f);
                }
            }
            f32x16 o[2];
#pragma unroll
            for (int mt = 0; mt < 2; ++mt)
#pragma unroll
                for (int e = 0; e < 16; ++e) o[mt][e] = 0.f;
#pragma unroll
            for (int kt = 0; kt < 4; ++kt)
#pragma unroll
                for (int s = 0; s < 2; ++s) {
                    typedef unsigned u32x4 __attribute__((ext_vector_type(4)));
                    u32x4 pu = {pk2(S[kt][8 * s], S[kt][8 * s + 1]), pk2(S[kt][8 * s + 2], S[kt][8 * s + 3]), pk2(S[kt][8 * s + 4], S[kt][8 * s + 5]), pk2(S[kt][8 * s + 6], S[kt][8 * s + 7])};
                    const bf16x8 sf = __builtin_bit_cast(bf16x8, pu);
#pragma unroll
                    for (int mt = 0; mt < 2; ++mt) {
                        const int ri = 32 * mt + l31, c = 4 * kt + 2 * s + hh;
                        const bf16x8 af = *(const bf16x8*)(sQt + ri * 256 + ((c ^ (ri & 15)) << 4));
                        o[mt] = MFMA32(af, sf, o[mt]);
                    }
                }
            __syncthreads();
#pragma unroll
            for (int s2 = 0; s2 < 4; ++s2) {
                const int c = 2 * s2 + hh;
                const bf16x8 vf = *(const bf16x8*)(sVT + (dvb + l31) * 128 + ((c ^ sw) << 4));
#pragma unroll
                for (int mt = 0; mt < 2; ++mt) {
                    const bf16x8 af = *(const bf16x8*)(sA + (32 * mt + l31) * 128 + ((c ^ sw) << 4));
                    o[mt] = MFMA32(af, vf, o[mt]);
                }
            }
            bf16_t* od = Oo + (size_t)rowbase * 1024 + h * 256 + dvb + l31;
#pragma unroll
            for (int mt = 0; mt < 2; ++mt)
#pragma unroll
                for (int e = 0; e < 16; ++e) od[(size_t)(32 * mt + (e & 3) + 8 * (e >> 2) + 4 * hh) * 1024] = bf1(o[mt][e]);
        }
#pragma unroll
        for (int kt = 0; kt < 4; ++kt)
#pragma unroll
            for (int e = 0; e < 16; ++e) S[kt][e] *= sD[32 * kt + (e & 3) + 8 * (e >> 2) + 4 * hh];
#pragma unroll
        for (int s2 = 0; s2 < 4; ++s2) {
            const int c = 2 * s2 + hh;
            const bf16x8 vf = *(const bf16x8*)(sVT + (dvb + l31) * 128 + ((c ^ sw) << 4));
#pragma unroll
            for (int kt = 0; kt < 4; ++kt) {
                const bf16x8 af = *(const bf16x8*)(sKh + (32 * kt + l31) * 128 + ((c ^ sw) << 4));
                S[kt] = MFMA32(af, vf, S[kt]);
            }
        }
        __syncthreads();
    }
}

DI void phase_combine(const Params& p) {
    const int tid = threadIdx.x, lane = tid & 63, w = tid >> 6;
    const bf16_t* OF = (const bf16_t*)(p.ws + R_OF);
    const bf16_t* OB = (const bf16_t*)(p.ws + R_OB);
    const bf16_t* SG = (const bf16_t*)(p.ws + R_SG);
    bf16_t* Y = (bf16_t*)(p.ws + R_YGLA);
    for (int row = blockIdx.x * 8 + w; row < NLAT; row += gridDim.x * 8) {
        const size_t o = (size_t)row * 1024 + lane * 16;
        const uint4 a0 = *(const uint4*)(OF + o), a1 = *(const uint4*)(OF + o + 8);
        const uint4 b0 = *(const uint4*)(OB + o), b1 = *(const uint4*)(OB + o + 8);
        const uint4 g0 = *(const uint4*)(SG + o), g1 = *(const uint4*)(SG + o + 8);
        const unsigned au[8] = {a0.x, a0.y, a0.z, a0.w, a1.x, a1.y, a1.z, a1.w};
        const unsigned bu[8] = {b0.x, b0.y, b0.z, b0.w, b1.x, b1.y, b1.z, b1.w};
        const unsigned gu[8] = {g0.x, g0.y, g0.z, g0.w, g1.x, g1.y, g1.z, g1.w};
        float v[16]; float ss = 0.f;
#pragma unroll
        for (int e = 0; e < 8; ++e) { v[2 * e] = bflo(au[e]) + bflo(bu[e]); v[2 * e + 1] = bfhi(au[e]) + bfhi(bu[e]); ss += v[2 * e] * v[2 * e] + v[2 * e + 1] * v[2 * e + 1]; }
#pragma unroll
        for (int of = 8; of >= 1; of >>= 1) ss += __shfl_xor(ss, of);
        const float rs = rsqrtf(ss * (1.0f / 256.0f) + EPS);
        const float* gn = p.gla_hn + ((lane * 16) & 255);
        unsigned ou[8];
#pragma unroll
        for (int e = 0; e < 8; ++e) ou[e] = pk2(v[2 * e] * rs * gn[2 * e] * bflo(gu[e]), v[2 * e + 1] * rs * gn[2 * e + 1] * bfhi(gu[e]));
        *(uint4*)(Y + o) = make_uint4(ou[0], ou[1], ou[2], ou[3]);
        *(uint4*)(Y + o + 8) = make_uint4(ou[4], ou[5], ou[6], ou[7]);
    }
}

template <int MODE>
DI void phase_rows(const Params& p, char* smem) {
    float* md = (float*)smem;
    const int tid = threadIdx.x, lane = tid & 63, w = tid >> 6;
    const bf16_t* Yin = (const bf16_t*)(p.ws + (MODE == 0 ? R_Y2 : R_Y3));
    bf16_t* H2 = (bf16_t*)(p.ws + R_H2);
    const float* pn = MODE == 0 ? p.post_norm1 : p.post_norm2;
    for (int tile = blockIdx.x; tile < 256; tile += gridDim.x) {
        const int r = tile >> 5;
        __syncthreads();
        if (MODE == 0) { load_mod(p, r, 2, md); load_mod(p, r, 3, md + 1024); load_mod(p, r, 4, md + 2048); }
        else load_mod(p, r, 5, md);
        __syncthreads();
        for (int i = 0; i < 32; ++i) {
            const int row = tile * 256 + w * 32 + i;
            float y[16]; float ss = 0.f;
#pragma unroll
            for (int j = 0; j < 4; ++j) {
                const uint2 u = *(const uint2*)(Yin + (size_t)row * 1024 + lane * 4 + 256 * j);
                y[4 * j] = bflo(u.x); y[4 * j + 1] = bfhi(u.x); y[4 * j + 2] = bflo(u.y); y[4 * j + 3] = bfhi(u.y);
                ss += y[4 * j] * y[4 * j] + y[4 * j + 1] * y[4 * j + 1] + y[4 * j + 2] * y[4 * j + 2] + y[4 * j + 3] * y[4 * j + 3];
            }
            ss = wave_sum(ss);
            const float rs = rsqrtf(ss * (1.0f / 1024.0f) + EPS);
            float xn[16]; float s2 = 0.f;
#pragma unroll
            for (int j = 0; j < 4; ++j) {
                const int col = lane * 4 + 256 * j;
                const float* xs = (MODE == 0 ? p.x : (const float*)p.out) + (size_t)row * 1024 + col;
                const f32x4 xv = *(const f32x4*)xs, g = *(const f32x4*)(pn + col), gt = *(const f32x4*)(md + col);
#pragma unroll
                for (int e = 0; e < 4; ++e) { xn[4 * j + e] = xv[e] + gt[e] * (y[4 * j + e] * rs * g[e]); s2 += xn[4 * j + e] * xn[4 * j + e]; }
                f32x4 ov = {xn[4 * j], xn[4 * j + 1], xn[4 * j + 2], xn[4 * j + 3]};
                *(f32x4*)(p.out + (size_t)row * 1024 + col) = ov;
            }
            if (MODE == 0) {
                s2 = wave_sum(s2);
                const float rs2 = rsqrtf(s2 * (1.0f / 1024.0f) + EPS);
#pragma unroll
                for (int j = 0; j < 4; ++j) {
                    const int col = lane * 4 + 256 * j;
                    const f32x4 g = *(const f32x4*)(p.pre_norm2 + col), sh = *(const f32x4*)(md + 1024 + col), sc = *(const f32x4*)(md + 2048 + col);
                    float o[4];
#pragma unroll
                    for (int e = 0; e < 4; ++e) o[e] = xn[4 * j + e] * rs2 * g[e] * (1.f + sc[e]) + sh[e];
                    uint2 u; u.x = pk2(o[0], o[1]); u.y = pk2(o[2], o[3]);
                    *(uint2*)(H2 + (size_t)row * 1024 + col) = u;
                }
            }
        }
    }
}

__global__ void __launch_bounds__(NT) fwd_megakernel(Params p) {
    __shared__ __attribute__((aligned(16))) char smem[131072];
    cg::grid_group grid = cg::this_grid();
    char* ws = p.ws;
    phase_prep(p, smem);
    grid.sync();
    phase_h(p, smem);
    grid.sync();
    {
        EpiIn e; e.Q = (bf16_t*)(ws + R_Q); e.Kk = (bf16_t*)(ws + R_K); e.Vt = (bf16_t*)(ws + R_VT); e.gq = (bf16_t*)(ws + R_GQ); e.gk = (bf16_t*)(ws + R_GK);
        e.gvT = (bf16_t*)(ws + R_GVT); e.sg = (bf16_t*)(ws + R_SG); e.mg = (bf16_t*)p.out; e.glow = (float*)(ws + OFF_GLOW); e.rope = (const float*)(ws + OFF_ROPE);
        gemm_phase((const bf16_t*)(ws + R_H), 1024, (const bf16_t*)(ws + OFF_WIN), 1024, 1024, 264, 33, smem, e);
    }
    grid.sync();
    phase_attn(p, smem);
    grid.sync();
    phase_gate(p);
    grid.sync();
    phase_gla(p, smem);
    grid.sync();
    phase_combine(p);
    grid.sync();
    {
        EpiGate0 e0; e0.Y = (bf16_t*)(ws + R_Y); e0.mg = (const bf16_t*)p.out;
        gemm_phase((const bf16_t*)(ws + R_H), 1024, (const bf16_t*)(ws + OFF_WDA), 1024, 1024, 256, 4, smem, e0);
        EpiGate1 e1; e1.Y = (bf16_t*)(ws + R_Y); e1.mg = (const bf16_t*)p.out;
        gemm_phase((const bf16_t*)(ws + R_YGLA), 1024, (const bf16_t*)(ws + OFF_WGLA), 1024, 1024, 256, 4, smem, e1);
    }
    grid.sync();
    {
        EpiStore<0> e; e.O = (bf16_t*)(ws + R_Y2); e.ldo = 1024;
        gemm_phase((const bf16_t*)(ws + R_Y), 1024, (const bf16_t*)(ws + OFF_WOUT), 1024, 1024, 256, 4, smem, e);
    }
    grid.sync();
    phase_rows<0>(p, smem);
    grid.sync();
    {
        EpiStore<1> e; e.O = (bf16_t*)(ws + R_U); e.ldo = 4096;
        gemm_phase((const bf16_t*)(ws + R_H2), 1024, (const bf16_t*)(ws + OFF_WFF1), 1024, 1024, 256, 16, smem, e);
    }
    grid.sync();
    {
        EpiStore<0> e; e.O = (bf16_t*)(ws + R_Y3); e.ldo = 1024;
        gemm_phase((const bf16_t*)(ws + R_U), 4096, (const bf16_t*)(ws + OFF_WFF2), 4096, 4096, 256, 4, smem, e);
    }
    grid.sync();
    phase_rows<1>(p, smem);
}

extern "C" void kernel_launch(void* const* d_in, const int* in_sizes, int n_in, void* d_out, int out_size, void* d_ws, size_t ws_size, hipStream_t stream) {
    static int grid_blocks = 0;
    if (!grid_blocks) {
        int dev = 0, cus = 0, per_cu = 0;
        hipGetDevice(&dev);
        hipDeviceGetAttribute(&cus, hipDeviceAttributeMultiprocessorCount, dev);
        hipOccupancyMaxActiveBlocksPerMultiprocessor(&per_cu, fwd_megakernel, NT, 0);
        if (per_cu < 1) per_cu = 1;
        grid_blocks = cus * per_cu;
        if (grid_blocks > 256) grid_blocks = 256;
    }
    Params p{};
    const float* const* in = (const float* const*)d_in;
    p.x = in[0]; p.c = in[1]; p.ctx = in[2]; p.c_ctx = in[3]; p.w_mod = in[4]; p.b_mod = in[5]; p.pre_norm1 = in[6]; p.w_in = in[7];
    p.w_gate_up = in[8]; p.b_gate_up = in[9]; p.lq1 = in[10]; p.lk1 = in[11]; p.lq2 = in[12]; p.lk2 = in[13]; p.da_hn = in[14]; p.gla_hn = in[15];
    p.w_bda = in[16]; p.w_bgla = in[17]; p.w_out = in[18]; p.post_norm1 = in[19]; p.pre_norm2 = in[20]; p.w_ff1 = in[21]; p.w_ff2 = in[22]; p.post_norm2 = in[23];
    p.out = (float*)d_out; p.ws = (char*)d_ws;
    void* args[] = {&p};
    hipError_t e = hipLaunchCooperativeKernel((void*)fwd_megakernel, dim3(grid_blocks), dim3(NT), args, 0, stream);
    if (e != hipSuccess) fprintf(stderr, "cooperative launch failed: %s (grid %d)\n", hipGetErrorString(e), grid_blocks);
}
```

```cpp
#include <hip/hip_runtime.h>
#include <hip/hip_cooperative_groups.h>
#include <cstdio>
namespace cg = cooperative_groups;

typedef unsigned short bf16_t;
typedef short bf16x8 __attribute__((ext_vector_type(8)));
typedef float f32x16 __attribute__((ext_vector_type(16)));
typedef float f32x4 __attribute__((ext_vector_type(4)));
typedef float f32x2 __attribute__((ext_vector_type(2)));
typedef __bf16 bf2_t __attribute__((ext_vector_type(2)));
typedef _Float16 h4_t __attribute__((ext_vector_type(4)));

#define DI __device__ __forceinline__
#define MFMA32(a, b, c) __builtin_amdgcn_mfma_f32_32x32x16_bf16((a), (b), (c), 0, 0, 0)

constexpr int NT = 512;
constexpr int TLAT = 8192, NB = 8, NLAT = 65536, NROW = 67584, TKV = 8448;
constexpr float EPS = 1e-6f;
constexpr size_t MiB = 1048576;
constexpr size_t OFF_WIN = 0;
constexpr size_t OFF_WDA = OFF_WIN + 8448ull * 1024 * 2;
constexpr size_t OFF_WGLA = OFF_WDA + 2 * MiB;
constexpr size_t OFF_WOUT = OFF_WGLA + 2 * MiB;
constexpr size_t OFF_WFF1 = OFF_WOUT + 2 * MiB;
constexpr size_t OFF_WFF2 = OFF_WFF1 + 8 * MiB;
constexpr size_t OFF_MODP = OFF_WFF2 + 8 * MiB;
constexpr size_t OFF_ROPE = OFF_MODP + 16ull * 9 * 6144 * 4;
constexpr size_t OFF_GLOW = OFF_ROPE + 16384;
constexpr size_t R_H = 64 * MiB;
constexpr size_t R_Q = R_H + 132 * MiB;
constexpr size_t R_K = R_Q + 128 * MiB;
constexpr size_t R_VT = R_K + 132 * MiB;
constexpr size_t R_GQ = R_VT + 132 * MiB;
constexpr size_t R_GK = R_GQ + 64 * MiB;
constexpr size_t R_GVT = R_GK + 66 * MiB;
constexpr size_t R_SG = R_GVT + 132 * MiB;
constexpr size_t WS_END = R_SG + 128 * MiB;
static_assert(OFF_GLOW + 67584ull * 32 * 4 <= R_H, "small region overflow");
static_assert(WS_END <= 1024 * MiB, "workspace overflow");
constexpr size_t R_BF = R_Q;
constexpr size_t R_BB = R_Q + 66 * MiB;
constexpr size_t R_OF = R_K + 4 * MiB;
constexpr size_t R_OB = R_VT;
constexpr size_t R_YGLA = R_GQ;
constexpr size_t R_Y = R_GVT;
constexpr size_t R_Y2 = R_SG;
constexpr size_t R_H2 = R_H;
constexpr size_t R_U = R_Q;
constexpr size_t R_Y3 = R_GVT;

struct Params {
    const float *x, *c, *ctx, *c_ctx, *w_mod, *b_mod, *pre_norm1, *w_in, *w_gate_up, *b_gate_up;
    const float *lq1, *lk1, *lq2, *lk2, *da_hn, *gla_hn, *w_bda, *w_bgla, *w_out, *post_norm1, *pre_norm2, *w_ff1, *w_ff2, *post_norm2;
    float* out;
    char* ws;
};

DI unsigned pk2(float a, float b) { f32x2 v = {a, b}; bf2_t r = __builtin_convertvector(v, bf2_t); return __builtin_bit_cast(unsigned, r); }
DI bf16_t bf1(float a) { __bf16 r = (__bf16)a; return __builtin_bit_cast(unsigned short, r); }
DI float bflo(unsigned v) { return __uint_as_float(v << 16); }
DI float bfhi(unsigned v) { return __uint_as_float(v & 0xffff0000u); }
DI float wave_sum(float v) {
#pragma unroll
    for (int o = 32; o >= 1; o >>= 1) v += __shfl_xor(v, o);
    return v;
}
DI int get_tid() { int t = threadIdx.x; asm volatile("" : "+v"(t)); return t; }
DI float sigmoidf_(float x) { return 1.0f / (1.0f + __expf(-x)); }

template <int MODE>
DI void repack(const float* __restrict__ src, int K, int Nsrc, bf16_t* __restrict__ dst, int Nd, long gtid, long gsz) {
    const long total = (long)Nd * (K / 8);
    for (long it = gtid; it < total; it += gsz) {
        const int n = (int)(it % Nd), kc = (int)(it / Nd);
        int col = n; bool valid = true;
        if (MODE == 1) { if (n < 5120) col = n; else if (n < 8192) col = n + 32; else if (n < 8224) col = n - 8192 + 5120; else valid = false; }
        float v[8];
#pragma unroll
        for (int j = 0; j < 8; ++j) v[j] = valid ? src[(size_t)(kc * 8 + j) * Nsrc + col] : 0.f;
        uint4 o; o.x = pk2(v[0], v[1]); o.y = pk2(v[2], v[3]); o.z = pk2(v[4], v[5]); o.w = pk2(v[6], v[7]);
        *(uint4*)(dst + (size_t)n * K + kc * 8) = o;
    }
}

DI void sincos_acc(float a, float& s, float& c) {
    const float q = rintf(a * 0.63661977236758134f);
    float r = fmaf(-q, 1.5703125f, a); r = fmaf(-q, 4.837512969970703125e-4f, r); r = fmaf(-q, 7.54978995489188216e-8f, r);
    const float r2 = r * r;
    const float sp = r + r * r2 * (-1.6666666666e-1f + r2 * (8.3333333333e-3f + r2 * (-1.98412698e-4f + r2 * 2.7557319e-6f)));
    const float cp = 1.0f + r2 * (-0.5f + r2 * (4.16666666667e-2f + r2 * (-1.38888888889e-3f + r2 * (2.48015873e-5f + r2 * -2.75573192e-7f))));
    const int qi = ((int)q) & 3;
    s = (qi == 0) ? sp : (qi == 1) ? cp : (qi == 2) ? -sp : -cp;
    c = (qi == 0) ? cp : (qi == 1) ? -sp : (qi == 2) ? -cp : sp;
}

DI void phase_prep(const Params& p, char* smem) {
    const int tid = get_tid();
    const long gsz = (long)gridDim.x * NT, gtid = (long)blockIdx.x * NT + tid;
    char* ws = p.ws;
    repack<1>(p.w_in, 1024, 8224, (bf16_t*)(ws + OFF_WIN), 8448, gtid, gsz);
    repack<0>(p.w_bda, 1024, 1024, (bf16_t*)(ws + OFF_WDA), 1024, gtid, gsz);
    repack<0>(p.w_bgla, 1024, 1024, (bf16_t*)(ws + OFF_WGLA), 1024, gtid, gsz);
    repack<0>(p.w_out, 1024, 1024, (bf16_t*)(ws + OFF_WOUT), 1024, gtid, gsz);
    repack<0>(p.w_ff1, 1024, 4096, (bf16_t*)(ws + OFF_WFF1), 4096, gtid, gsz);
    repack<0>(p.w_ff2, 4096, 1024, (bf16_t*)(ws + OFF_WFF2), 1024, gtid, gsz);
    if (gtid < 2048) {
        const int pos = (int)gtid >> 4, f = (int)gtid & 15;
        const float inv = exp2f(-(float)f * (13.287712379549449f / 16.0f));
        float s, c; sincos_acc((float)pos * inv, s, c);
        float* rt = (float*)(ws + OFF_ROPE);
        rt[gtid] = c; rt[2048 + gtid] = s;
    }
    float* sil = (float*)smem;
    float* modp = (float*)(ws + OFF_MODP);
    for (int item = blockIdx.x; item < 192; item += gridDim.x) {
        const int cb = item % 12, ks = item / 12;
        __syncthreads();
        for (int i = tid; i < 9 * 64; i += NT) {
            const int r = i >> 6, kk = i & 63;
            const float v = (r < 8) ? p.c[r * 1024 + ks * 64 + kk] : p.c_ctx[ks * 64 + kk];
            sil[i] = v * sigmoidf_(v);
        }
        __syncthreads();
        const int n = cb * 512 + tid;
        float acc[9];
#pragma unroll
        for (int r = 0; r < 9; ++r) acc[r] = 0.f;
        for (int kk = 0; kk < 64; ++kk) {
            const float w = p.w_mod[(size_t)(ks * 64 + kk) * 6144 + n];
#pragma unroll
            for (int r = 0; r < 9; ++r) acc[r] = fmaf(sil[r * 64 + kk], w, acc[r]);
        }
#pragma unroll
        for (int r = 0; r < 9; ++r) modp[(size_t)(ks * 9 + r) * 6144 + n] = acc[r];
    }
}

DI void load_mod(const Params& p, int r, int which, float* dst) {
    const float* modp = (const float*)(p.ws + OFF_MODP);
    for (int n = threadIdx.x; n < 1024; n += NT) {
        float a = p.b_mod[which * 1024 + n];
#pragma unroll
        for (int ks = 0; ks < 16; ++ks) a += modp[(size_t)(ks * 9 + r) * 6144 + which * 1024 + n];
        dst[n] = a;
    }
}

DI void phase_h(const Params& p, char* smem) {
    float* md = (float*)smem;
    const int tid = get_tid(), lane = tid & 63, w = tid >> 6;
    bf16_t* H = (bf16_t*)(p.ws + R_H);
    for (int tile = blockIdx.x; tile < 264; tile += gridDim.x) {
        const int r = tile < 256 ? (tile >> 5) : 8;
        __syncthreads();
        load_mod(p, r, 0, md); load_mod(p, r, 1, md + 1024);
        __syncthreads();
        for (int i = 0; i < 32; ++i) {
            const int row = tile * 256 + w * 32 + i;
            const float* src = row < NLAT ? p.x + (size_t)row * 1024 : p.ctx + (size_t)(row - NLAT) * 1024;
            f32x4 v[4]; float ss = 0.f;
#pragma unroll
            for (int j = 0; j < 4; ++j) { v[j] = *(const f32x4*)(src + lane * 4 + 256 * j); ss += v[j].x * v[j].x + v[j].y * v[j].y + v[j].z * v[j].z + v[j].w * v[j].w; }
            ss = wave_sum(ss);
            const float rs = rsqrtf(ss * (1.0f / 1024.0f) + EPS);
#pragma unroll
            for (int j = 0; j < 4; ++j) {
                const int col = lane * 4 + 256 * j;
                const f32x4 g = *(const f32x4*)(p.pre_norm1 + col);
                const f32x4 sh = *(const f32x4*)(md + col), sc = *(const f32x4*)(md + 1024 + col);
                const float o0 = v[j].x * rs * g.x * (1.f + sc.x) + sh.x, o1 = v[j].y * rs * g.y * (1.f + sc.y) + sh.y;
                const float o2 = v[j].z * rs * g.z * (1.f + sc.z) + sh.z, o3 = v[j].w * rs * g.w * (1.f + sc.w) + sh.w;
                uint2 o; o.x = pk2(o0, o1); o.y = pk2(o2, o3);
                *(uint2*)(H + (size_t)row * 1024 + col) = o;
            }
        }
    }
}

typedef __attribute__((address_space(3))) unsigned lds_u32;
DI lds_u32* to_lds(const void* p) { return (lds_u32*)(unsigned)(size_t)p; }
#define GLDS16(src, dst) __builtin_amdgcn_global_load_lds((const unsigned*)(src), to_lds(dst), 16, 0, 0)

template <class Epi>
DI void gemm_tile(const bf16_t* A, int lda, const bf16_t* B, int ldb, int K, int m0, int n0, char* smem, Epi& epi) {
    const int tid = get_tid(), lane = tid & 63, w = tid >> 6, wm = w >> 2, wn = w & 3, l31 = lane & 31, hh = lane >> 5;
    f32x16 acc[4][2];
#pragma unroll
    for (int i = 0; i < 4; ++i)
#pragma unroll
        for (int j = 0; j < 2; ++j)
#pragma unroll
            for (int e = 0; e < 16; ++e) acc[i][j][e] = 0.f;
    const int srow = 8 * w + (lane >> 3), schunk = (lane & 7) ^ (4 * (w & 1) + (lane >> 4));
    const bf16_t* ga = A + (size_t)(m0 + srow) * lda + schunk * 8;
    const bf16_t* gb = B + (size_t)(n0 + srow) * ldb + schunk * 8;
    const int sw = (l31 >> 1) & 7;
    const int aofs = (128 * wm + l31) * 128, bofs = 32768 + (64 * wn + l31) * 128;
    char* sdst = smem + w * 1024;
#define GEMM_STAGE(buf, kt_) do { _Pragma("unroll") for (int i = 0; i < 4; ++i) { \
        GLDS16(ga + (size_t)i * 64 * lda + (kt_) * 64, sdst + (buf) * 65536 + i * 8192); \
        GLDS16(gb + (size_t)i * 64 * ldb + (kt_) * 64, sdst + (buf) * 65536 + 32768 + i * 8192); } } while (0)
    GEMM_STAGE(0, 0);
    asm volatile("s_waitcnt vmcnt(0)" ::: "memory");
    __syncthreads();
    const int KT = K >> 6;
    for (int kt = 0; kt < KT; ++kt) {
        const int cur = kt & 1;
        if (kt + 1 < KT) GEMM_STAGE(cur ^ 1, kt + 1);
        const char* sb = smem + cur * 65536;
#pragma unroll
        for (int ks = 0; ks < 4; ++ks) {
            const int co = ((2 * ks + hh) ^ sw) << 4;
            bf16x8 af[4], bf[2];
#pragma unroll
            for (int mi = 0; mi < 4; ++mi) af[mi] = *(const bf16x8*)(sb + aofs + mi * 4096 + co);
#pragma unroll
            for (int ni = 0; ni < 2; ++ni) bf[ni] = *(const bf16x8*)(sb + bofs + ni * 4096 + co);
#pragma unroll
            for (int mi = 0; mi < 4; ++mi)
#pragma unroll
                for (int ni = 0; ni < 2; ++ni) acc[mi][ni] = MFMA32(bf[ni], af[mi], acc[mi][ni]);
        }
        asm volatile("s_waitcnt vmcnt(0)" ::: "memory");
        __syncthreads();
    }
#undef GEMM_STAGE
#pragma unroll
    for (int mi = 0; mi < 4; ++mi)
#pragma unroll
        for (int ni = 0; ni < 2; ++ni) { epi(m0 + 128 * wm + 32 * mi + l31, n0 + 64 * wn + 32 * ni, acc[mi][ni], hh); asm volatile("" ::: "memory"); }
}

DI void tile_map(int id, int MT, int NTl, int& mt, int& nt) {
    const int x = id & 7, local = id >> 3, mtx = MT >> 3;
    const int full = mtx >> 2, per = 4 * NTl;
    int patch = local / per, wv = local - patch * per, pm = 4;
    if (patch >= full) { patch = full; wv = local - full * per; pm = mtx - full * 4; }
    const int mo = wv % pm; nt = wv / pm;
    mt = (patch * 4 + mo) * 8 + x;
}

template <class Epi>
DI void gemm_phase(const bf16_t* A, int lda, const bf16_t* B, int ldb, int K, int MT, int NTl, char* smem, Epi& epi) {
    const int total = MT * NTl;
    for (int id = blockIdx.x; id < total; id += gridDim.x) {
        int mt, nt; tile_map(id, MT, NTl, mt, nt);
        gemm_tile(A, lda, B, ldb, K, mt * 256, nt * 256, smem, epi);
    }
}

struct EpiIn {
    bf16_t *Q, *Kk, *Vt, *gq, *gk, *gvT, *sg, *mg; float* glow; const float* rope;
    DI void operator()(int row, int cb, const f32x16& v, int hh) const {
        if (cb >= 8224) return;
        const bool lat = row < NLAT;
        int b, t;
        if (lat) { b = row >> 13; t = row & 8191; } else { const int r2 = row - NLAT; b = r2 >> 8; t = TLAT + (r2 & 255); }
        if (cb < 2048) {
            const bool isq = cb < 1024;
            if (isq && !lat) return;
            const int c = cb & 1023, head = c >> 7, comp = (c >> 6) & 1, half = (c >> 5) & 1;
            float o[16];
            if (lat) {
                const int pos = half ? (t & 63) : (t >> 6);
                const float* cs = rope + pos * 16; const float* sn = rope + 2048 + pos * 16;
#pragma unroll
                for (int g = 0; g < 2; ++g) {
                    const f32x4 c4 = *(const f32x4*)(cs + 8 * g + 4 * hh), s4 = *(const f32x4*)(sn + 8 * g + 4 * hh);
#pragma unroll
                    for (int j = 0; j < 4; ++j) {
                        const float x1 = v[4 * g + j], x2 = v[4 * (g + 2) + j];
                        o[4 * g + j] = x1 * c4[j] - x2 * s4[j];
                        o[4 * (g + 2) + j] = x2 * c4[j] + x1 * s4[j];
                    }
                }
            } else {
#pragma unroll
                for (int e = 0; e < 16; ++e) o[e] = v[e];
            }
            const float scl = isq ? 0.125f * 1.4426950408889634f : 1.0f;
            bf16_t* dst = isq ? Q + ((size_t)((b * 8 + head) * 2 + comp) * TLAT + t) * 64 : Kk + ((size_t)((b * 8 + head) * 2 + comp) * TKV + t) * 64;
#pragma unroll
            for (int g = 0; g < 4; ++g) {
                uint2 u; u.x = pk2(o[4 * g] * scl, o[4 * g + 1] * scl); u.y = pk2(o[4 * g + 2] * scl, o[4 * g + 3] * scl);
                *(uint2*)(dst + 32 * half + 8 * g + 4 * hh) = u;
            }
        } else if (cb < 3072) {
            const int c = cb - 2048, head = c >> 7, dv0 = c & 127;
            bf16_t* dst = Vt + (size_t)((b * 8 + head) * 128 + dv0) * TKV + t;
#pragma unroll
            for (int e = 0; e < 16; ++e) dst[(size_t)(8 * (e >> 2) + 4 * hh + (e & 3)) * TKV] = bf1(v[e]);
        } else if (cb < 4096) {
            const bool isq = cb < 3584;
            if (isq && !lat) return;
            const int c = (cb - 3072) & 511;
            const float scl = isq ? 0.08838834764831845f : 1.0f;
            bf16_t* dst = (isq ? gq : gk) + (size_t)row * 512 + c;
#pragma unroll
            for (int g = 0; g < 4; ++g) {
                uint2 u; u.x = pk2(v[4 * g] * scl, v[4 * g + 1] * scl); u.y = pk2(v[4 * g + 2] * scl, v[4 * g + 3] * scl);
                *(uint2*)(dst + 8 * g + 4 * hh) = u;
            }
        } else if (cb < 5120) {
            const int c = cb - 4096, head = c >> 8, dv0 = c & 255;
            bf16_t* dst = gvT + (size_t)((b * 4 + head) * 256 + dv0) * TKV + t;
#pragma unroll
            for (int e = 0; e < 16; ++e) dst[(size_t)(8 * (e >> 2) + 4 * hh + (e & 3)) * TKV] = bf1(v[e]);
        } else if (cb < 6144) {
            if (!lat) return;
            bf16_t* dst = sg + (size_t)row * 1024 + (cb - 5120);
#pragma unroll
            for (int g = 0; g < 4; ++g) {
                float s[4];
#pragma unroll
                for (int j = 0; j < 4; ++j) { const float xx = v[4 * g + j]; s[j] = xx * sigmoidf_(xx); }
                uint2 u; u.x = pk2(s[0], s[1]); u.y = pk2(s[2], s[3]);
                *(uint2*)(dst + 8 * g + 4 * hh) = u;
            }
        } else if (cb < 8192) {
            if (!lat) return;
            bf16_t* dst = mg + (size_t)row * 2048 + (cb - 6144);
#pragma unroll
            for (int g = 0; g < 4; ++g) {
                uint2 u; u.x = pk2(sigmoidf_(v[4 * g]), sigmoidf_(v[4 * g + 1])); u.y = pk2(sigmoidf_(v[4 * g + 2]), sigmoidf_(v[4 * g + 3]));
                *(uint2*)(dst + 8 * g + 4 * hh) = u;
            }
        } else {
            float* dst = glow + (size_t)row * 32;
#pragma unroll
            for (int g = 0; g < 4; ++g) { f32x4 u = {v[4 * g], v[4 * g + 1], v[4 * g + 2], v[4 * g + 3]}; *(f32x4*)(dst + 8 * g + 4 * hh) = u; }
        }
    }
};

struct EpiGate0 {
    bf16_t* Y; const bf16_t* mg;
    DI void operator()(int row, int cb, const f32x16& v, int hh) const {
#pragma unroll
        for (int g = 0; g < 4; ++g) {
            const int col = cb + 8 * g + 4 * hh;
            const uint2 m = *(const uint2*)(mg + (size_t)row * 2048 + col);
            uint2 u; u.x = pk2(v[4 * g] * bflo(m.x), v[4 * g + 1] * bfhi(m.x)); u.y = pk2(v[4 * g + 2] * bflo(m.y), v[4 * g + 3] * bfhi(m.y));
            *(uint2*)(Y + (size_t)row * 1024 + col) = u;
        }
    }
};
struct EpiGate1 {
    bf16_t* Y; const bf16_t* mg;
    DI void operator()(int row, int cb, const f32x16& v, int hh) const {
#pragma unroll
        for (int g = 0; g < 4; ++g) {
            const int col = cb + 8 * g + 4 * hh;
            const uint2 m = *(const uint2*)(mg + (size_t)row * 2048 + 1024 + col);
            const uint2 pr = *(const uint2*)(Y + (size_t)row * 1024 + col);
            uint2 u; u.x = pk2(bflo(pr.x) + v[4 * g] * bflo(m.x), bfhi(pr.x) + v[4 * g + 1] * bfhi(m.x));
            u.y = pk2(bflo(pr.y) + v[4 * g + 2] * bflo(m.y), bfhi(pr.y) + v[4 * g + 3] * bfhi(m.y));
            *(uint2*)(Y + (size_t)row * 1024 + col) = u;
        }
    }
};
template <int ACT>
struct EpiStore {
    bf16_t* O; int ldo;
    DI void operator()(int row, int cb, const f32x16& v, int hh) const {
#pragma unroll
        for (int g = 0; g < 4; ++g) {
            float s[4];
#pragma unroll
            for (int j = 0; j < 4; ++j) { float xx = v[4 * g + j]; if (ACT == 1) { xx = fmaxf(xx, 0.f); xx = xx * xx; } s[j] = xx; }
            uint2 u; u.x = pk2(s[0], s[1]); u.y = pk2(s[2], s[3]);
            *(uint2*)(O + (size_t)row * ldo + cb + 8 * g + 4 * hh) = u;
        }
    }
};

DI int kappa(int r) { return (r & ~12) | ((r & 4) << 1) | ((r & 8) >> 1); }

DI float xhalf_max(float v) {
    typedef unsigned u32x2 __attribute__((ext_vector_type(2)));
    const unsigned u = __float_as_uint(v);
    const u32x2 r = __builtin_amdgcn_permlane32_swap(u, u, false, false);
    return fmaxf(__uint_as_float(r[0]), __uint_as_float(r[1]));
}
DI float xhalf_sum(float v) {
    typedef unsigned u32x2 __attribute__((ext_vector_type(2)));
    const unsigned u = __float_as_uint(v);
    const u32x2 r = __builtin_amdgcn_permlane32_swap(u, u, false, false);
    return __uint_as_float(r[0]) + __uint_as_float(r[1]);
}
DI float max16(const f32x16& s) {
    const float a = fmaxf(fmaxf(fmaxf(s[0], s[1]), fmaxf(s[2], s[3])), fmaxf(fmaxf(s[4], s[5]), fmaxf(s[6], s[7])));
    const float b = fmaxf(fmaxf(fmaxf(s[8], s[9]), fmaxf(s[10], s[11])), fmaxf(fmaxf(s[12], s[13]), fmaxf(s[14], s[15])));
    return fmaxf(a, b);
}

DI void phase_attn(const Params& p, char* smem) {
    const int tid = get_tid(), lane = tid & 63, w = tid >> 6, l31 = lane & 31, hh = lane >> 5;
    const int g = w >> 1, comp = w & 1;
    const bf16_t* Q = (const bf16_t*)(p.ws + R_Q);
    const bf16_t* Kk = (const bf16_t*)(p.ws + R_K);
    const bf16_t* Vt = (const bf16_t*)(p.ws + R_VT);
    bf16_t* YDA = (bf16_t*)(p.ws + R_H);
    float d1 = 0.f, d2 = 0.f;
    for (int i = 0; i < 64; ++i) { d1 += p.lq1[i] * p.lk1[i]; d2 += p.lq2[i] * p.lk2[i]; }
    const float lam = __expf(d1) - __expf(d2) + 0.2f;
    const int krs = 8 * w + (lane >> 3), kcs = (lane & 7) ^ (4 * (w & 1) + (lane >> 4));
    const int vrs = 4 * w + (lane >> 4), vcs = (lane & 15) ^ ((4 * w + (lane >> 4)) & 15);
    const int krow = kappa(l31);
    const int ksw = (krow >> 1) & 7, vsw = l31 & 15;
    float* xbuf = (float*)smem + g * 4096;
    char* sdst = smem + w * 1024;
    for (int id = blockIdx.x; id < 4096; id += gridDim.x) {
        const int x = id & 7, j = id >> 3, bh = (j >> 6) * 8 + x, qt = j & 63;
        const int b = bh >> 3, h = bh & 7;
        const bf16_t* qp = Q + ((size_t)(bh * 2 + comp) * TLAT + qt * 128 + g * 32 + l31) * 64 + hh * 8;
        bf16x8 qf[4];
#pragma unroll
        for (int ks = 0; ks < 4; ++ks) qf[ks] = *(const bf16x8*)(qp + ks * 16);
        const bf16_t* gk0 = Kk + ((size_t)(bh * 2 + 0) * TKV + krs) * 64 + kcs * 8;
        const bf16_t* gk1 = gk0 + (size_t)TKV * 64;
        const bf16_t* gv = Vt + ((size_t)bh * 128 + vrs) * TKV + vcs * 8;
#define ATT_STAGE(buf, kt_) do { _Pragma("unroll") for (int jj = 0; jj < 2; ++jj) { \
            GLDS16(gk0 + (size_t)((kt_) * 128 + 64 * jj) * 64, sdst + (buf) * 65536 + jj * 8192); \
            GLDS16(gk1 + (size_t)((kt_) * 128 + 64 * jj) * 64, sdst + (buf) * 65536 + 16384 + jj * 8192); } \
            _Pragma("unroll") for (int jj = 0; jj < 4; ++jj) GLDS16(gv + (size_t)(32 * jj) * TKV + (kt_) * 128, sdst + (buf) * 65536 + 32768 + jj * 8192); } while (0)
        f32x16 O[4];
#pragma unroll
        for (int d = 0; d < 4; ++d)
#pragma unroll
            for (int e = 0; e < 16; ++e) O[d][e] = 0.f;
        float m = -INFINITY, l = 0.f;
        __syncthreads();
        ATT_STAGE(0, 0);
        asm volatile("s_waitcnt vmcnt(0)" ::: "memory");
        __syncthreads();
        constexpr int NKT = TKV / 128;
        for (int kt = 0; kt < NKT; ++kt) {
            const int cur = kt & 1;
            if (kt + 1 < NKT) ATT_STAGE(cur ^ 1, kt + 1);
            const char* sb = smem + cur * 65536;
            const char* skc = sb + comp * 16384;
            f32x16 S[4];
#pragma unroll
            for (int sub = 0; sub < 4; ++sub) {
#pragma unroll
                for (int e = 0; e < 16; ++e) S[sub][e] = 0.f;
#pragma unroll
                for (int ks = 0; ks < 4; ++ks) {
                    const bf16x8 kf = *(const bf16x8*)(skc + (32 * sub + krow) * 128 + (((2 * ks + hh) ^ ksw) << 4));
                    S[sub] = MFMA32(kf, qf[ks], S[sub]);
                }
            }
            float mt = fmaxf(fmaxf(max16(S[0]), max16(S[1])), fmaxf(max16(S[2]), max16(S[3])));
            mt = xhalf_max(mt);
            if (__any(mt > m + 8.0f)) {
                const float mn = fmaxf(m, mt);
                const float al = __builtin_amdgcn_exp2f(m - mn);
                l *= al;
#pragma unroll
                for (int d = 0; d < 4; ++d)
#pragma unroll
                    for (int e = 0; e < 16; ++e) O[d][e] *= al;
                m = mn;
            }
#pragma unroll
            for (int sub = 0; sub < 4; ++sub) {
                float pv[16];
#pragma unroll
                for (int e = 0; e < 16; ++e) { pv[e] = __builtin_amdgcn_exp2f(S[sub][e] - m); l += pv[e]; }
                typedef unsigned u32x4 __attribute__((ext_vector_type(4)));
                const u32x4 ua = {pk2(pv[0], pv[1]), pk2(pv[2], pv[3]), pk2(pv[4], pv[5]), pk2(pv[6], pv[7])};
                const u32x4 ub = {pk2(pv[8], pv[9]), pk2(pv[10], pv[11]), pk2(pv[12], pv[13]), pk2(pv[14], pv[15])};
                const bf16x8 pb0 = __builtin_bit_cast(bf16x8, ua), pb1 = __builtin_bit_cast(bf16x8, ub);
#pragma unroll
                for (int dt = 0; dt < 4; ++dt) {
                    const char* vr = sb + 32768 + (32 * dt + l31) * 256;
                    const bf16x8 v0 = *(const bf16x8*)(vr + (((4 * sub + hh) ^ vsw) << 4));
                    const bf16x8 v1 = *(const bf16x8*)(vr + (((4 * sub + 2 + hh) ^ vsw) << 4));
                    O[dt] = MFMA32(v0, pb0, O[dt]);
                    O[dt] = MFMA32(v1, pb1, O[dt]);
                }
            }
            asm volatile("s_waitcnt vmcnt(0)" ::: "memory");
            __syncthreads();
        }
#undef ATT_STAGE
        l = xhalf_sum(l);
        if (comp == 1) {
            const float i1 = lam / l;
#pragma unroll
            for (int d = 0; d < 4; ++d)
#pragma unroll
                for (int e = 0; e < 16; ++e) xbuf[(d * 16 + e) * 64 + lane] = O[d][e] * i1;
        }
        __syncthreads();
        if (comp == 0) {
            const float i0 = 1.0f / l;
            float ss = 0.f;
#pragma unroll
            for (int d = 0; d < 4; ++d)
#pragma unroll
                for (int e = 0; e < 16; ++e) { const float o = O[d][e] * i0 - xbuf[(d * 16 + e) * 64 + lane]; O[d][e] = o; ss += o * o; }
            ss = xhalf_sum(ss);
            const float rs = rsqrtf(ss * (1.0f / 128.0f) + EPS) * 0.8f;
            const int t = qt * 128 + g * 32 + l31;
            bf16_t* dst = YDA + ((size_t)b * TLAT + t) * 1024 + h * 128;
#pragma unroll
            for (int d = 0; d < 4; ++d)
#pragma unroll
                for (int gg = 0; gg < 4; ++gg) {
                    const int dv = 32 * d + 8 * gg + 4 * hh;
                    const f32x4 hn = *(const f32x4*)(p.da_hn + dv);
                    uint2 u; u.x = pk2(O[d][4 * gg] * rs * hn.x, O[d][4 * gg + 1] * rs * hn.y); u.y = pk2(O[d][4 * gg + 2] * rs * hn.z, O[d][4 * gg + 3] * rs * hn.w);
                    *(uint2*)(dst + dv) = u;
                }
        }
    }
}

DI void phase_gate(const Params& p, char* smem) {
    const int tid = get_tid();
    const float* glow = (const float*)(p.ws + OFF_GLOW);
    float* sg = (float*)smem;
    float wf[16], wb[16];
#pragma unroll
    for (int r = 0; r < 16; ++r) { wf[r] = p.w_gate_up[(size_t)r * 512 + tid]; wb[r] = p.w_gate_up[(size_t)(16 + r) * 512 + tid]; }
    const float biasf = p.b_gate_up[tid], biasb = p.b_gate_up[512 + tid];
    _Float16* BF = (_Float16*)(p.ws + R_BF);
    _Float16* BB = (_Float16*)(p.ws + R_BB);
    for (int ch = blockIdx.x; ch < 1056; ch += gridDim.x) {
        __syncthreads();
        *(f32x4*)(sg + tid * 4) = *(const f32x4*)(glow + (size_t)ch * 2048 + tid * 4);
        __syncthreads();
        float run = 0.f;
#pragma unroll 4
        for (int i = 0; i < 64; ++i) {
            const float* gl = sg + i * 32;
            float a = biasf;
#pragma unroll
            for (int r = 0; r < 16; ++r) a = fmaf(gl[r], wf[r], a);
            const float ls = fminf(a, 0.f) - __logf(1.0f + __expf(-fabsf(a)));
            run += ls * (1.0f / 16.0f);
            BF[(size_t)(ch * 64 + i) * 512 + tid] = (_Float16)run;
        }
        run = 0.f;
#pragma unroll 4
        for (int i = 63; i >= 0; --i) {
            const float* gl = sg + i * 32 + 16;
            float a = biasb;
#pragma unroll
            for (int r = 0; r < 16; ++r) a = fmaf(gl[r], wb[r], a);
            const float ls = fminf(a, 0.f) - __logf(1.0f + __expf(-fabsf(a)));
            run += ls * (1.0f / 16.0f);
            BB[(size_t)(ch * 64 + i) * 512 + tid] = (_Float16)run;
        }
    }
}

struct GlaRegs { uint2 k[2][2], q[2][2], bb[2][2], bl[2][2]; uint4 v[4]; };

DI void phase_gla(const Params& p, char* smem) {
    if (blockIdx.x >= 64) return;
    const int tid = get_tid(), lane = tid & 63, w = tid >> 6, l31 = lane & 31, hh = lane >> 5;
    const int unit = blockIdx.x, dir = unit & 1, bh = unit >> 1, b = bh >> 2, h = bh & 3;
    const bf16_t* gq = (const bf16_t*)(p.ws + R_GQ);
    const bf16_t* gk = (const bf16_t*)(p.ws + R_GK);
    const bf16_t* gvT = (const bf16_t*)(p.ws + R_GVT) + (size_t)bh * 256 * TKV;
    const _Float16* B16 = (const _Float16*)(p.ws + (dir ? R_BB : R_BF));
    bf16_t* Oo = (bf16_t*)(p.ws + (dir ? R_OB : R_OF));
    char* sQt = smem;
    char* sKt = smem + 16384;
    char* sKh = smem + 32768;
    char* sVT = smem + 49152;
    char* sA = smem + 81920;
    float* sD = (float*)(smem + 90112);
    f32x16 S[4];
#pragma unroll
    for (int k = 0; k < 4; ++k)
#pragma unroll
        for (int e = 0; e < 16; ++e) S[k][e] = 0.f;
    const int sw = (l31 >> 1) & 7;
    GlaRegs R;
    auto chunk_info = [&](int step, int& rowbase, int& tcol, bool& emit) {
        if (step < 4) { const int cc = dir ? 3 - step : step; rowbase = NLAT + b * 256 + cc * 64; tcol = TLAT + cc * 64; emit = false; }
        else { const int cc = dir ? 127 - (step - 4) : step - 4; rowbase = b * TLAT + cc * 64; tcol = cc * 64; emit = true; }
    };
    auto load_chunk = [&](int step) {
        int rowbase, tcol; bool emit; chunk_info(step, rowbase, tcol, emit);
        const int rl = rowbase + (dir ? 0 : 63);
#pragma unroll
        for (int i = 0; i < 2; ++i) {
            const int item = tid + NT * i, tok = item >> 4, c = item & 15, d0 = 16 * (c >> 1) + 4 * (c & 1);
            const size_t ro = (size_t)(rowbase + tok) * 512 + h * 128 + d0;
            R.k[i][0] = *(const uint2*)(gk + ro); R.k[i][1] = *(const uint2*)(gk + ro + 8);
            if (emit) { R.q[i][0] = *(const uint2*)(gq + ro); R.q[i][1] = *(const uint2*)(gq + ro + 8); }
            else { R.q[i][0] = make_uint2(0, 0); R.q[i][1] = make_uint2(0, 0); }
            R.bb[i][0] = *(const uint2*)(B16 + ro); R.bb[i][1] = *(const uint2*)(B16 + ro + 8);
            const size_t rlo = (size_t)rl * 512 + h * 128 + d0;
            R.bl[i][0] = *(const uint2*)(B16 + rlo); R.bl[i][1] = *(const uint2*)(B16 + rlo + 8);
        }
#pragma unroll
        for (int i = 0; i < 4; ++i) R.v[i] = *(const uint4*)(gvT + (size_t)((tid >> 3) + 64 * i) * TKV + tcol + (tid & 7) * 8);
    };
    auto stage_chunk = [&]() {
#pragma unroll
        for (int i = 0; i < 2; ++i) {
            const int item = tid + NT * i, tok = item >> 4, c = item & 15, d0 = 16 * (c >> 1) + 4 * (c & 1);
            float qo[8], ko[8];
#pragma unroll
            for (int g = 0; g < 2; ++g) {
                const h4_t bv = __builtin_bit_cast(h4_t, R.bb[i][g]), lv = __builtin_bit_cast(h4_t, R.bl[i][g]);
                const float kk[4] = {bflo(R.k[i][g].x), bfhi(R.k[i][g].x), bflo(R.k[i][g].y), bfhi(R.k[i][g].y)};
                const float qq[4] = {bflo(R.q[i][g].x), bfhi(R.q[i][g].x), bflo(R.q[i][g].y), bfhi(R.q[i][g].y)};
#pragma unroll
                for (int j = 0; j < 4; ++j) {
                    const float bb = (float)bv[j], bl = (float)lv[j];
                    qo[4 * g + j] = qq[j] * __expf(bb);
                    ko[4 * g + j] = kk[j] * __expf(-bb);
                    const float kh = kk[j] * __expf(bl - bb);
                    const int dk = d0 + 8 * g + j;
                    *(bf16_t*)(sKh + dk * 128 + ((((tok >> 3) ^ ((dk >> 1) & 7))) << 4) + (tok & 7) * 2) = bf1(kh);
                    if (tok == 0) sD[dk] = __expf(bl);
                }
            }
            const int po = tok * 256 + ((c ^ (tok & 15)) << 4);
            uint4 uq, uk;
            uq.x = pk2(qo[0], qo[1]); uq.y = pk2(qo[2], qo[3]); uq.z = pk2(qo[4], qo[5]); uq.w = pk2(qo[6], qo[7]);
            uk.x = pk2(ko[0], ko[1]); uk.y = pk2(ko[2], ko[3]); uk.z = pk2(ko[4], ko[5]); uk.w = pk2(ko[6], ko[7]);
            *(uint4*)(sQt + po) = uq; *(uint4*)(sKt + po) = uk;
        }
#pragma unroll
        for (int i = 0; i < 4; ++i) {
            const int row = (tid >> 3) + 64 * i, scn = tid & 7;
            *(uint4*)(sVT + row * 128 + ((scn ^ ((row >> 1) & 7)) << 4)) = R.v[i];
        }
    };
    load_chunk(0);
    for (int step = 0; step < 132; ++step) {
        int rowbase, tcol; bool emit; chunk_info(step, rowbase, tcol, emit);
        stage_chunk();
        __syncthreads();
        if (step + 1 < 132) load_chunk(step + 1);
        const int dvb = 32 * w;
        if (emit) {
            if (w < 4) {
                const int ti = w >> 1, tj = w & 1;
                f32x16 a;
#pragma unroll
                for (int e = 0; e < 16; ++e) a[e] = 0.f;
                const bool dead = dir ? (tj < ti) : (tj > ti);
                if (!dead) {
#pragma unroll
                    for (int ks = 0; ks < 8; ++ks) {
                        const int ri = 32 * ti + l31, rj = 32 * tj + l31, c = 2 * ks + hh;
                        const bf16x8 af = *(const bf16x8*)(sQt + ri * 256 + ((c ^ (ri & 15)) << 4));
                        const bf16x8 bf = *(const bf16x8*)(sKt + rj * 256 + ((c ^ (rj & 15)) << 4));
                        a = MFMA32(af, bf, a);
                    }
                }
                const int jj = 32 * tj + l31;
#pragma unroll
                for (int e = 0; e < 16; ++e) {
                    const int ii = 32 * ti + (e & 3) + 8 * (e >> 2) + 4 * hh;
                    const bool keep = dir ? (jj >= ii) : (jj <= ii);
                    *(bf16_t*)(sA + ii * 128 + ((((jj >> 3) ^ ((ii >> 1) & 7))) << 4) + (jj & 7) * 2) = bf1(keep ? a[e] : 0.f);
                }
            }
            f32x16 o[2];
#pragma unroll
            for (int mt = 0; mt < 2; ++mt)
#pragma unroll
                for (int e = 0; e < 16; ++e) o[mt][e] = 0.f;
#pragma unroll
            for (int kt = 0; kt < 4; ++kt)
#pragma unroll
                for (int s = 0; s < 2; ++s) {
                    typedef unsigned u32x4 __attribute__((ext_vector_type(4)));
                    u32x4 pu = {pk2(S[kt][8 * s], S[kt][8 * s + 1]), pk2(S[kt][8 * s + 2], S[kt][8 * s + 3]), pk2(S[kt][8 * s + 4], S[kt][8 * s + 5]), pk2(S[kt][8 * s + 6], S[kt][8 * s + 7])};
                    const bf16x8 sf = __builtin_bit_cast(bf16x8, pu);
#pragma unroll
                    for (int mt = 0; mt < 2; ++mt) {
                        const int ri = 32 * mt + l31, c = 4 * kt + 2 * s + hh;
                        const bf16x8 af = *(const bf16x8*)(sQt + ri * 256 + ((c ^ (ri & 15)) << 4));
                        o[mt] = MFMA32(af, sf, o[mt]);
                    }
                }
            __syncthreads();
#pragma unroll
            for (int s2 = 0; s2 < 4; ++s2) {
                const int c = 2 * s2 + hh;
                const bf16x8 vf = *(const bf16x8*)(sVT + (dvb + l31) * 128 + ((c ^ sw) << 4));
#pragma unroll
                for (int mt = 0; mt < 2; ++mt) {
                    const bf16x8 af = *(const bf16x8*)(sA + (32 * mt + l31) * 128 + ((c ^ sw) << 4));
                    o[mt] = MFMA32(af, vf, o[mt]);
                }
            }
            bf16_t* od = Oo + (size_t)rowbase * 1024 + h * 256 + dvb + l31;
#pragma unroll
            for (int mt = 0; mt < 2; ++mt)
#pragma unroll
                for (int e = 0; e < 16; ++e) od[(size_t)(32 * mt + (e & 3) + 8 * (e >> 2) + 4 * hh) * 1024] = bf1(o[mt][e]);
        }
#pragma unroll
        for (int kt = 0; kt < 4; ++kt)
#pragma unroll
            for (int e = 0; e < 16; ++e) S[kt][e] *= sD[32 * kt + (e & 3) + 8 * (e >> 2) + 4 * hh];
#pragma unroll
        for (int s2 = 0; s2 < 4; ++s2) {
            const int c = 2 * s2 + hh;
            const bf16x8 vf = *(const bf16x8*)(sVT + (dvb + l31) * 128 + ((c ^ sw) << 4));
#pragma unroll
            for (int kt = 0; kt < 4; ++kt) {
                const bf16x8 af = *(const bf16x8*)(sKh + (32 * kt + l31) * 128 + ((c ^ sw) << 4));
                S[kt] = MFMA32(af, vf, S[kt]);
            }
        }
        __syncthreads();
    }
}

DI void phase_combine(const Params& p) {
    const int tid = get_tid(), lane = tid & 63, w = tid >> 6;
    const bf16_t* OF = (const bf16_t*)(p.ws + R_OF);
    const bf16_t* OB = (const bf16_t*)(p.ws + R_OB);
    const bf16_t* SG = (const bf16_t*)(p.ws + R_SG);
    bf16_t* Y = (bf16_t*)(p.ws + R_YGLA);
    for (int row = blockIdx.x * 8 + w; row < NLAT; row += gridDim.x * 8) {
        const size_t o = (size_t)row * 1024 + lane * 16;
        const uint4 a0 = *(const uint4*)(OF + o), a1 = *(const uint4*)(OF + o + 8);
        const uint4 b0 = *(const uint4*)(OB + o), b1 = *(const uint4*)(OB + o + 8);
        const uint4 g0 = *(const uint4*)(SG + o), g1 = *(const uint4*)(SG + o + 8);
        const unsigned au[8] = {a0.x, a0.y, a0.z, a0.w, a1.x, a1.y, a1.z, a1.w};
        const unsigned bu[8] = {b0.x, b0.y, b0.z, b0.w, b1.x, b1.y, b1.z, b1.w};
        const unsigned gu[8] = {g0.x, g0.y, g0.z, g0.w, g1.x, g1.y, g1.z, g1.w};
        float v[16]; float ss = 0.f;
#pragma unroll
        for (int e = 0; e < 8; ++e) { v[2 * e] = bflo(au[e]) + bflo(bu[e]); v[2 * e + 1] = bfhi(au[e]) + bfhi(bu[e]); ss += v[2 * e] * v[2 * e] + v[2 * e + 1] * v[2 * e + 1]; }
#pragma unroll
        for (int of = 8; of >= 1; of >>= 1) ss += __shfl_xor(ss, of);
        const float rs = rsqrtf(ss * (1.0f / 256.0f) + EPS);
        const float* gn = p.gla_hn + ((lane * 16) & 255);
        unsigned ou[8];
#pragma unroll
        for (int e = 0; e < 8; ++e) ou[e] = pk2(v[2 * e] * rs * gn[2 * e] * bflo(gu[e]), v[2 * e + 1] * rs * gn[2 * e + 1] * bfhi(gu[e]));
        *(uint4*)(Y + o) = make_uint4(ou[0], ou[1], ou[2], ou[3]);
        *(uint4*)(Y + o + 8) = make_uint4(ou[4], ou[5], ou[6], ou[7]);
    }
}

template <int MODE>
DI void phase_rows(const Params& p, char* smem) {
    float* md = (float*)smem;
    const int tid = get_tid(), lane = tid & 63, w = tid >> 6;
    const bf16_t* Yin = (const bf16_t*)(p.ws + (MODE == 0 ? R_Y2 : R_Y3));
    bf16_t* H2 = (bf16_t*)(p.ws + R_H2);
    const float* pn = MODE == 0 ? p.post_norm1 : p.post_norm2;
    for (int tile = blockIdx.x; tile < 256; tile += gridDim.x) {
        const int r = tile >> 5;
        __syncthreads();
        if (MODE == 0) { load_mod(p, r, 2, md); load_mod(p, r, 3, md + 1024); load_mod(p, r, 4, md + 2048); }
        else load_mod(p, r, 5, md);
        __syncthreads();
        for (int i = 0; i < 32; ++i) {
            const int row = tile * 256 + w * 32 + i;
            float y[16]; float ss = 0.f;
#pragma unroll
            for (int j = 0; j < 4; ++j) {
                const uint2 u = *(const uint2*)(Yin + (size_t)row * 1024 + lane * 4 + 256 * j);
                y[4 * j] = bflo(u.x); y[4 * j + 1] = bfhi(u.x); y[4 * j + 2] = bflo(u.y); y[4 * j + 3] = bfhi(u.y);
                ss += y[4 * j] * y[4 * j] + y[4 * j + 1] * y[4 * j + 1] + y[4 * j + 2] * y[4 * j + 2] + y[4 * j + 3] * y[4 * j + 3];
            }
            ss = wave_sum(ss);
            const float rs = rsqrtf(ss * (1.0f / 1024.0f) + EPS);
            float xn[16]; float s2 = 0.f;
#pragma unroll
            for (int j = 0; j < 4; ++j) {
                const int col = lane * 4 + 256 * j;
                const float* xs = (MODE == 0 ? p.x : (const float*)p.out) + (size_t)row * 1024 + col;
                const f32x4 xv = *(const f32x4*)xs, g = *(const f32x4*)(pn + col), gt = *(const f32x4*)(md + col);
#pragma unroll
                for (int e = 0; e < 4; ++e) { xn[4 * j + e] = xv[e] + gt[e] * (y[4 * j + e] * rs * g[e]); s2 += xn[4 * j + e] * xn[4 * j + e]; }
                f32x4 ov = {xn[4 * j], xn[4 * j + 1], xn[4 * j + 2], xn[4 * j + 3]};
                *(f32x4*)(p.out + (size_t)row * 1024 + col) = ov;
            }
            if (MODE == 0) {
                s2 = wave_sum(s2);
                const float rs2 = rsqrtf(s2 * (1.0f / 1024.0f) + EPS);
#pragma unroll
                for (int j = 0; j < 4; ++j) {
                    const int col = lane * 4 + 256 * j;
                    const f32x4 g = *(const f32x4*)(p.pre_norm2 + col), sh = *(const f32x4*)(md + 1024 + col), sc = *(const f32x4*)(md + 2048 + col);
                    float o[4];
#pragma unroll
                    for (int e = 0; e < 4; ++e) o[e] = xn[4 * j + e] * rs2 * g[e] * (1.f + sc[e]) + sh[e];
                    uint2 u; u.x = pk2(o[0], o[1]); u.y = pk2(o[2], o[3]);
                    *(uint2*)(H2 + (size_t)row * 1024 + col) = u;
                }
            }
        }
    }
}

__global__ void __launch_bounds__(NT) fwd_megakernel(Params p) {
    __shared__ __attribute__((aligned(16))) char smem[131072];
    cg::grid_group grid = cg::this_grid();
    char* ws = p.ws;
    phase_prep(p, smem);
    grid.sync();
    phase_h(p, smem);
    grid.sync();
    {
        EpiIn e; e.Q = (bf16_t*)(ws + R_Q); e.Kk = (bf16_t*)(ws + R_K); e.Vt = (bf16_t*)(ws + R_VT); e.gq = (bf16_t*)(ws + R_GQ); e.gk = (bf16_t*)(ws + R_GK);
        e.gvT = (bf16_t*)(ws + R_GVT); e.sg = (bf16_t*)(ws + R_SG); e.mg = (bf16_t*)p.out; e.glow = (float*)(ws + OFF_GLOW); e.rope = (const float*)(ws + OFF_ROPE);
        gemm_phase((const bf16_t*)(ws + R_H), 1024, (const bf16_t*)(ws + OFF_WIN), 1024, 1024, 264, 33, smem, e);
    }
    grid.sync();
    phase_attn(p, smem);
    grid.sync();
    phase_gate(p, smem);
    grid.sync();
    phase_gla(p, smem);
    grid.sync();
    phase_combine(p);
    grid.sync();
    {
        EpiGate0 e0; e0.Y = (bf16_t*)(ws + R_Y); e0.mg = (const bf16_t*)p.out;
        gemm_phase((const bf16_t*)(ws + R_H), 1024, (const bf16_t*)(ws + OFF_WDA), 1024, 1024, 256, 4, smem, e0);
        EpiGate1 e1; e1.Y = (bf16_t*)(ws + R_Y); e1.mg = (const bf16_t*)p.out;
        gemm_phase((const bf16_t*)(ws + R_YGLA), 1024, (const bf16_t*)(ws + OFF_WGLA), 1024, 1024, 256, 4, smem, e1);
    }
    grid.sync();
    {
        EpiStore<0> e; e.O = (bf16_t*)(ws + R_Y2); e.ldo = 1024;
        gemm_phase((const bf16_t*)(ws + R_Y), 1024, (const bf16_t*)(ws + OFF_WOUT), 1024, 1024, 256, 4, smem, e);
    }
    grid.sync();
    phase_rows<0>(p, smem);
    grid.sync();
    {
        EpiStore<1> e; e.O = (bf16_t*)(ws + R_U); e.ldo = 4096;
        gemm_phase((const bf16_t*)(ws + R_H2), 1024, (const bf16_t*)(ws + OFF_WFF1), 1024, 1024, 256, 16, smem, e);
    }
    grid.sync();
    {
        EpiStore<0> e; e.O = (bf16_t*)(ws + R_Y3); e.ldo = 1024;
        gemm_phase((const bf16_t*)(ws + R_U), 4096, (const bf16_t*)(ws + OFF_WFF2), 4096, 4096, 256, 4, smem, e);
    }
    grid.sync();
    phase_rows<1>(p, smem);
}

extern "C" void kernel_launch(void* const* d_in, const int* in_sizes, int n_in, void* d_out, int out_size, void* d_ws, size_t ws_size, hipStream_t stream) {
    static int grid_blocks = 0;
    if (!grid_blocks) {
        int dev = 0, cus = 0, per_cu = 0;
        hipGetDevice(&dev);
        hipDeviceGetAttribute(&cus, hipDeviceAttributeMultiprocessorCount, dev);
        hipOccupancyMaxActiveBlocksPerMultiprocessor(&per_cu, fwd_megakernel, NT, 0);
        if (per_cu < 1) per_cu = 1;
        grid_blocks = cus * per_cu;
        if (grid_blocks > 256) grid_blocks = 256;
    }
    Params p{};
    const float* const* in = (const float* const*)d_in;
    p.x = in[0]; p.c = in[1]; p.ctx = in[2]; p.c_ctx = in[3]; p.w_mod = in[4]; p.b_mod = in[5]; p.pre_norm1 = in[6]; p.w_in = in[7];
    p.w_gate_up = in[8]; p.b_gate_up = in[9]; p.lq1 = in[10]; p.lk1 = in[11]; p.lq2 = in[12]; p.lk2 = in[13]; p.da_hn = in[14]; p.gla_hn = in[15];
    p.w_bda = in[16]; p.w_bgla = in[17]; p.w_out = in[18]; p.post_norm1 = in[19]; p.pre_norm2 = in[20]; p.w_ff1 = in[21]; p.w_ff2 = in[22]; p.post_norm2 = in[23];
    p.out = (float*)d_out; p.ws = (char*)d_ws;
    void* args[] = {&p};
    hipError_t e = hipLaunchCooperativeKernel((void*)fwd_megakernel, dim3(grid_blocks), dim3(NT), args, 0, stream);
    if (e != hipSuccess) fprintf(stderr, "cooperative launch failed: %s (grid %d)\n", hipGetErrorString(e), grid_blocks);
}
```

```cpp
#include <hip/hip_runtime.h>
#include <hip/hip_cooperative_groups.h>
#include <cstdio>
namespace cg = cooperative_groups;

typedef unsigned short bf16_t;
typedef short bf16x8 __attribute__((ext_vector_type(8)));
typedef float f32x16 __attribute__((ext_vector_type(16)));
typedef float f32x4 __attribute__((ext_vector_type(4)));
typedef float f32x2 __attribute__((ext_vector_type(2)));
typedef __bf16 bf2_t __attribute__((ext_vector_type(2)));
typedef _Float16 h4_t __attribute__((ext_vector_type(4)));

#define DI __device__ __forceinline__
#define MFMA32(a, b, c) __builtin_amdgcn_mfma_f32_32x32x16_bf16((a), (b), (c), 0, 0, 0)

constexpr int NT = 512;
constexpr int TLAT = 8192, NB = 8, NLAT = 65536, NROW = 67584, TKV = 8448;
constexpr float EPS = 1e-6f;
constexpr size_t MiB = 1048576;
constexpr size_t OFF_WIN = 0;
constexpr size_t OFF_WDA = OFF_WIN + 8448ull * 1024 * 2;
constexpr size_t OFF_WGLA = OFF_WDA + 2 * MiB;
constexpr size_t OFF_WOUT = OFF_WGLA + 2 * MiB;
constexpr size_t OFF_WFF1 = OFF_WOUT + 2 * MiB;
constexpr size_t OFF_WFF2 = OFF_WFF1 + 8 * MiB;
constexpr size_t OFF_MODP = OFF_WFF2 + 8 * MiB;
constexpr size_t OFF_ROPE = OFF_MODP + 16ull * 9 * 6144 * 4;
constexpr size_t OFF_GLOW = OFF_ROPE + 16384;
constexpr size_t OFF_KMAX = OFF_GLOW + 67584ull * 32 * 4;
constexpr size_t OFF_BAR = OFF_KMAX + 1024;
constexpr size_t R_H = 64 * MiB;
constexpr size_t R_Q = R_H + 132 * MiB;
constexpr size_t R_K = R_Q + 128 * MiB;
constexpr size_t R_VT = R_K + 132 * MiB;
constexpr size_t R_GQ = R_VT + 132 * MiB;
constexpr size_t R_GK = R_GQ + 64 * MiB;
constexpr size_t R_GVT = R_GK + 66 * MiB;
constexpr size_t R_SG = R_GVT + 132 * MiB;
constexpr size_t WS_END = R_SG + 128 * MiB;
static_assert(OFF_BAR + 1024 <= R_H, "small region overflow");
static_assert(WS_END <= 1024 * MiB, "workspace overflow");
constexpr size_t R_BF = R_Q;
constexpr size_t R_BB = R_Q + 66 * MiB;
constexpr size_t R_OF = R_K + 4 * MiB;
constexpr size_t R_OB = R_VT;
constexpr size_t R_YGLA = R_GQ;
constexpr size_t R_Y = R_GVT;
constexpr size_t R_Y2 = R_SG;
constexpr size_t R_H2 = R_H;
constexpr size_t R_U = R_Q;
constexpr size_t R_Y3 = R_GVT;

struct Params {
    const float *x, *c, *ctx, *c_ctx, *w_mod, *b_mod, *pre_norm1, *w_in, *w_gate_up, *b_gate_up;
    const float *lq1, *lk1, *lq2, *lk2, *da_hn, *gla_hn, *w_bda, *w_bgla, *w_out, *post_norm1, *pre_norm2, *w_ff1, *w_ff2, *post_norm2;
    float* out;
    char* ws;
};

DI unsigned pk2(float a, float b) { f32x2 v = {a, b}; bf2_t r = __builtin_convertvector(v, bf2_t); return __builtin_bit_cast(unsigned, r); }
DI bf16_t bf1(float a) { __bf16 r = (__bf16)a; return __builtin_bit_cast(unsigned short, r); }
DI float bflo(unsigned v) { return __uint_as_float(v << 16); }
DI float bfhi(unsigned v) { return __uint_as_float(v & 0xffff0000u); }
DI float wave_sum(float v) {
#pragma unroll
    for (int o = 32; o >= 1; o >>= 1) v += __shfl_xor(v, o);
    return v;
}
DI int get_tid() { int t = threadIdx.x; asm volatile("" : "+v"(t)); return t; }
DI float sigmoidf_(float x) { return 1.0f / (1.0f + __expf(-x)); }

template <int MODE>
DI void repack(const float* __restrict__ src, int K, int Nsrc, bf16_t* __restrict__ dst, int Nd, long gtid, long gsz) {
    const long total = (long)Nd * (K / 8);
    for (long it = gtid; it < total; it += gsz) {
        const int n = (int)(it % Nd), kc = (int)(it / Nd);
        int col = n; bool valid = true;
        if (MODE == 1) { if (n < 5120) col = n; else if (n < 8192) col = n + 32; else if (n < 8224) col = n - 8192 + 5120; else valid = false; }
        float v[8];
#pragma unroll
        for (int j = 0; j < 8; ++j) v[j] = valid ? src[(size_t)(kc * 8 + j) * Nsrc + col] : 0.f;
        uint4 o; o.x = pk2(v[0], v[1]); o.y = pk2(v[2], v[3]); o.z = pk2(v[4], v[5]); o.w = pk2(v[6], v[7]);
        *(uint4*)(dst + (size_t)n * K + kc * 8) = o;
    }
}

DI void sincos_acc(float a, float& s, float& c) {
    const float q = rintf(a * 0.63661977236758134f);
    float r = fmaf(-q, 1.5703125f, a); r = fmaf(-q, 4.837512969970703125e-4f, r); r = fmaf(-q, 7.54978995489188216e-8f, r);
    const float r2 = r * r;
    const float sp = r + r * r2 * (-1.6666666666e-1f + r2 * (8.3333333333e-3f + r2 * (-1.98412698e-4f + r2 * 2.7557319e-6f)));
    const float cp = 1.0f + r2 * (-0.5f + r2 * (4.16666666667e-2f + r2 * (-1.38888888889e-3f + r2 * (2.48015873e-5f + r2 * -2.75573192e-7f))));
    const int qi = ((int)q) & 3;
    s = (qi == 0) ? sp : (qi == 1) ? cp : (qi == 2) ? -sp : -cp;
    c = (qi == 0) ? cp : (qi == 1) ? -sp : (qi == 2) ? -cp : sp;
}

DI void phase_prep(const Params& p, char* smem) {
    const int tid = get_tid();
    const long gsz = (long)gridDim.x * NT, gtid = (long)blockIdx.x * NT + tid;
    char* ws = p.ws;
    repack<1>(p.w_in, 1024, 8224, (bf16_t*)(ws + OFF_WIN), 8448, gtid, gsz);
    repack<0>(p.w_bda, 1024, 1024, (bf16_t*)(ws + OFF_WDA), 1024, gtid, gsz);
    repack<0>(p.w_bgla, 1024, 1024, (bf16_t*)(ws + OFF_WGLA), 1024, gtid, gsz);
    repack<0>(p.w_out, 1024, 1024, (bf16_t*)(ws + OFF_WOUT), 1024, gtid, gsz);
    repack<0>(p.w_ff1, 1024, 4096, (bf16_t*)(ws + OFF_WFF1), 4096, gtid, gsz);
    repack<0>(p.w_ff2, 4096, 1024, (bf16_t*)(ws + OFF_WFF2), 1024, gtid, gsz);
    if (gtid < 256) ((float*)(ws + OFF_KMAX))[gtid] = 0.f;
    if (gtid < 2048) {
        const int pos = (int)gtid >> 4, f = (int)gtid & 15;
        const float inv = exp2f(-(float)f * (13.287712379549449f / 16.0f));
        float s, c; sincos_acc((float)pos * inv, s, c);
        float* rt = (float*)(ws + OFF_ROPE);
        rt[gtid] = c; rt[2048 + gtid] = s;
    }
    float* sil = (float*)smem;
    float* modp = (float*)(ws + OFF_MODP);
    for (int item = blockIdx.x; item < 192; item += gridDim.x) {
        const int cb = item % 12, ks = item / 12;
        __syncthreads();
        for (int i = tid; i < 9 * 64; i += NT) {
            const int r = i >> 6, kk = i & 63;
            const float v = (r < 8) ? p.c[r * 1024 + ks * 64 + kk] : p.c_ctx[ks * 64 + kk];
            sil[i] = v * sigmoidf_(v);
        }
        __syncthreads();
        const int n = cb * 512 + tid;
        float acc[9];
#pragma unroll
        for (int r = 0; r < 9; ++r) acc[r] = 0.f;
        for (int kk = 0; kk < 64; ++kk) {
            const float w = p.w_mod[(size_t)(ks * 64 + kk) * 6144 + n];
#pragma unroll
            for (int r = 0; r < 9; ++r) acc[r] = fmaf(sil[r * 64 + kk], w, acc[r]);
        }
#pragma unroll
        for (int r = 0; r < 9; ++r) modp[(size_t)(ks * 9 + r) * 6144 + n] = acc[r];
    }
}

DI void load_mod(const Params& p, int r, int which, float* dst) {
    const float* modp = (const float*)(p.ws + OFF_MODP);
    for (int n = threadIdx.x; n < 1024; n += NT) {
        float a = p.b_mod[which * 1024 + n];
#pragma unroll
        for (int ks = 0; ks < 16; ++ks) a += modp[(size_t)(ks * 9 + r) * 6144 + which * 1024 + n];
        dst[n] = a;
    }
}

DI void phase_h(const Params& p, char* smem) {
    float* md = (float*)smem;
    const int tid = get_tid(), lane = tid & 63, w = tid >> 6;
    bf16_t* H = (bf16_t*)(p.ws + R_H);
    for (int tile = blockIdx.x; tile < 264; tile += gridDim.x) {
        const int r = tile < 256 ? (tile >> 5) : 8;
        __syncthreads();
        load_mod(p, r, 0, md); load_mod(p, r, 1, md + 1024);
        __syncthreads();
        for (int i = 0; i < 32; ++i) {
            const int row = tile * 256 + w * 32 + i;
            const float* src = row < NLAT ? p.x + (size_t)row * 1024 : p.ctx + (size_t)(row - NLAT) * 1024;
            f32x4 v[4]; float ss = 0.f;
#pragma unroll
            for (int j = 0; j < 4; ++j) { v[j] = *(const f32x4*)(src + lane * 4 + 256 * j); ss += v[j].x * v[j].x + v[j].y * v[j].y + v[j].z * v[j].z + v[j].w * v[j].w; }
            ss = wave_sum(ss);
            const float rs = rsqrtf(ss * (1.0f / 1024.0f) + EPS);
#pragma unroll
            for (int j = 0; j < 4; ++j) {
                const int col = lane * 4 + 256 * j;
                const f32x4 g = *(const f32x4*)(p.pre_norm1 + col);
                const f32x4 sh = *(const f32x4*)(md + col), sc = *(const f32x4*)(md + 1024 + col);
                const float o0 = v[j].x * rs * g.x * (1.f + sc.x) + sh.x, o1 = v[j].y * rs * g.y * (1.f + sc.y) + sh.y;
                const float o2 = v[j].z * rs * g.z * (1.f + sc.z) + sh.z, o3 = v[j].w * rs * g.w * (1.f + sc.w) + sh.w;
                uint2 o; o.x = pk2(o0, o1); o.y = pk2(o2, o3);
                *(uint2*)(H + (size_t)row * 1024 + col) = o;
            }
        }
    }
}

typedef __attribute__((address_space(3))) unsigned lds_u32;
DI lds_u32* to_lds(const void* p) { return (lds_u32*)(unsigned)(size_t)p; }
#define GLDS16(src, dst) __builtin_amdgcn_global_load_lds((const unsigned*)(src), to_lds(dst), 16, 0, 0)

template <bool SWAP, class Epi>
DI void gemm_tile(const bf16_t* A, int lda, const bf16_t* B, int ldb, int K, int m0, int n0, bool first, bool has_next, int nm0, int nn0, char* smem, Epi& epi) {
    const int tid = get_tid(), lane = tid & 63, w = tid >> 6, wm = w >> 2, wn = w & 3, l31 = lane & 31, hh = lane >> 5;
    f32x16 acc[4][2];
#pragma unroll
    for (int i = 0; i < 4; ++i)
#pragma unroll
        for (int j = 0; j < 2; ++j)
#pragma unroll
            for (int e = 0; e < 16; ++e) acc[i][j][e] = 0.f;
    const int srow = 8 * w + (lane >> 3), schunk = (lane & 7) ^ (4 * (w & 1) + (lane >> 4));
    const bf16_t* ga = A + (size_t)(m0 + srow) * lda + schunk * 8;
    const bf16_t* gb = B + (size_t)(n0 + srow) * ldb + schunk * 8;
    const bf16_t* nga = A + (size_t)(nm0 + srow) * lda + schunk * 8;
    const bf16_t* ngb = B + (size_t)(nn0 + srow) * ldb + schunk * 8;
    const int sw = (l31 >> 1) & 7;
    const int aofs = (128 * wm + l31) * 128, bofs = 32768 + (64 * wn + l31) * 128;
    char* sdst = smem + w * 1024;
#define GEMM_STAGE(pa, pb, buf, kt_) do { _Pragma("unroll") for (int i = 0; i < 4; ++i) { \
        GLDS16(pa + (size_t)i * 64 * lda + (kt_) * 64, sdst + (buf) * 65536 + i * 8192); \
        GLDS16(pb + (size_t)i * 64 * ldb + (kt_) * 64, sdst + (buf) * 65536 + 32768 + i * 8192); } } while (0)
    if (first) {
        GEMM_STAGE(ga, gb, 0, 0);
        asm volatile("s_waitcnt vmcnt(0)" ::: "memory");
        __syncthreads();
    }
    const int KT = K >> 6;
    for (int kt = 0; kt < KT; ++kt) {
        const int cur = kt & 1;
        if (kt + 1 < KT) GEMM_STAGE(ga, gb, cur ^ 1, kt + 1);
        else if (has_next) GEMM_STAGE(nga, ngb, cur ^ 1, 0);
        const char* sb = smem + cur * 65536;
#pragma unroll
        for (int ks = 0; ks < 4; ++ks) {
            const int co = ((2 * ks + hh) ^ sw) << 4;
            bf16x8 af[4], bf[2];
#pragma unroll
            for (int mi = 0; mi < 4; ++mi) af[mi] = *(const bf16x8*)(sb + aofs + mi * 4096 + co);
#pragma unroll
            for (int ni = 0; ni < 2; ++ni) bf[ni] = *(const bf16x8*)(sb + bofs + ni * 4096 + co);
#pragma unroll
            for (int mi = 0; mi < 4; ++mi)
#pragma unroll
                for (int ni = 0; ni < 2; ++ni) acc[mi][ni] = SWAP ? MFMA32(af[mi], bf[ni], acc[mi][ni]) : MFMA32(bf[ni], af[mi], acc[mi][ni]);
        }
        asm volatile("s_waitcnt vmcnt(0)" ::: "memory");
        __syncthreads();
    }
#undef GEMM_STAGE
#pragma unroll
    for (int mi = 0; mi < 4; ++mi)
#pragma unroll
        for (int ni = 0; ni < 2; ++ni) {
            if constexpr (SWAP) epi.vt(m0 + 128 * wm + 32 * mi + 4 * hh, n0 + 64 * wn + 32 * ni + l31, acc[mi][ni]);
            else epi(m0 + 128 * wm + 32 * mi + l31, n0 + 64 * wn + 32 * ni, acc[mi][ni], hh);
            asm volatile("" ::: "memory");
        }
}

DI void tile_map(int id, int MT, int NTl, int& mt, int& nt) {
    const int x = id & 7, local = id >> 3, mtx = MT >> 3;
    const int full = mtx >> 2, per = 4 * NTl;
    int patch = local / per, wv = local - patch * per, pm = 4;
    if (patch >= full) { patch = full; wv = local - full * per; pm = mtx - full * 4; }
    const int mo = wv % pm; nt = wv / pm;
    mt = (patch * 4 + mo) * 8 + x;
}

template <bool VSWAP, class Epi>
DI void gemm_phase_ex(const bf16_t* A, int lda, const bf16_t* B, int ldb, int K, int MT, int NTl, char* smem, Epi& epi, int bid, int nblk) {
    const int total = MT * NTl;
    bool first = true;
    for (int id = bid; id < total; id += nblk) {
        int mt, nt, mt2 = 0, nt2 = 0; tile_map(id, MT, NTl, mt, nt);
        const bool has_next = id + nblk < total;
        if (has_next) tile_map(id + nblk, MT, NTl, mt2, nt2);
        if constexpr (VSWAP) { if (Epi::is_vt(nt)) { gemm_tile<true>(A, lda, B, ldb, K, mt * 256, nt * 256, first, has_next, mt2 * 256, nt2 * 256, smem, epi); first = false; continue; } }
        gemm_tile<false>(A, lda, B, ldb, K, mt * 256, nt * 256, first, has_next, mt2 * 256, nt2 * 256, smem, epi);
        first = false;
    }
}
template <class Epi>
DI void gemm_phase(const bf16_t* A, int lda, const bf16_t* B, int ldb, int K, int MT, int NTl, char* smem, Epi& epi) {
    gemm_phase_ex<false>(A, lda, B, ldb, K, MT, NTl, smem, epi, blockIdx.x, gridDim.x);
}

DI float xhalf_max(float v) {
    typedef unsigned u32x2 __attribute__((ext_vector_type(2)));
    const unsigned u = __float_as_uint(v);
    const u32x2 r = __builtin_amdgcn_permlane32_swap(u, u, false, false);
    return fmaxf(__uint_as_float(r[0]), __uint_as_float(r[1]));
}
DI float xhalf_sum(float v) {
    typedef unsigned u32x2 __attribute__((ext_vector_type(2)));
    const unsigned u = __float_as_uint(v);
    const u32x2 r = __builtin_amdgcn_permlane32_swap(u, u, false, false);
    return __uint_as_float(r[0]) + __uint_as_float(r[1]);
}
struct EpiIn {
    bf16_t *Q, *Kk, *Vt, *gq, *gk, *gvT, *sg, *mg; float* glow; const float* rope; float* kmax;
    static DI bool is_vt(int nt) { return (nt >= 8 && nt < 12) || (nt >= 16 && nt < 20); }
    DI void vt(int row0, int col, const f32x16& v) const {
        int b, t;
        if (row0 < NLAT) { b = row0 >> 13; t = row0 & 8191; } else { const int r2 = row0 - NLAT; b = r2 >> 8; t = TLAT + (r2 & 255); }
        bf16_t* dst;
        if (col < 3072) { const int c = col - 2048; dst = Vt + (size_t)((b * 8 + (c >> 7)) * 128 + (c & 127)) * TKV + t; }
        else { const int c = col - 4096; dst = gvT + (size_t)((b * 4 + (c >> 8)) * 256 + (c & 255)) * TKV + t; }
#pragma unroll
        for (int g = 0; g < 4; ++g) { uint2 u; u.x = pk2(v[4 * g], v[4 * g + 1]); u.y = pk2(v[4 * g + 2], v[4 * g + 3]); *(uint2*)(dst + 8 * g) = u; }
    }
    DI void operator()(int row, int cb, const f32x16& v, int hh) const {
        if (cb >= 8224) return;
        const bool lat = row < NLAT;
        int b, t;
        if (lat) { b = row >> 13; t = row & 8191; } else { const int r2 = row - NLAT; b = r2 >> 8; t = TLAT + (r2 & 255); }
        if (cb < 2048) {
            const bool isq = cb < 1024;
            if (isq && !lat) return;
            const int c = cb & 1023, head = c >> 7, comp = (c >> 6) & 1, half = (c >> 5) & 1;
            float o[16];
            if (lat) {
                const int pos = half ? (t & 63) : (t >> 6);
                const float* cs = rope + pos * 16; const float* sn = rope + 2048 + pos * 16;
#pragma unroll
                for (int g = 0; g < 2; ++g) {
                    const f32x4 c4 = *(const f32x4*)(cs + 8 * g + 4 * hh), s4 = *(const f32x4*)(sn + 8 * g + 4 * hh);
#pragma unroll
                    for (int j = 0; j < 4; ++j) {
                        const float x1 = v[4 * g + j], x2 = v[4 * (g + 2) + j];
                        o[4 * g + j] = x1 * c4[j] - x2 * s4[j];
                        o[4 * (g + 2) + j] = x2 * c4[j] + x1 * s4[j];
                    }
                }
            } else {
#pragma unroll
                for (int e = 0; e < 16; ++e) o[e] = v[e];
            }
            if (!isq) {
                float ssq = 0.f;
#pragma unroll
                for (int e = 0; e < 16; ++e) ssq += o[e] * o[e];
                ssq = xhalf_sum(ssq);
#pragma unroll
                for (int of = 16; of >= 1; of >>= 1) ssq = fmaxf(ssq, __shfl_xor(ssq, of));
                if ((threadIdx.x & 63) == 0) atomicMax((unsigned*)(kmax + ((b * 8 + head) * 2 + comp) * 2 + half), __float_as_uint(ssq));
            }
            const float scl = isq ? 0.125f * 1.4426950408889634f : 1.0f;
            bf16_t* dst = isq ? Q + ((size_t)((b * 8 + head) * 2 + comp) * TLAT + t) * 64 : Kk + ((size_t)((b * 8 + head) * 2 + comp) * TKV + t) * 64;
#pragma unroll
            for (int g = 0; g < 4; ++g) {
                uint2 u; u.x = pk2(o[4 * g] * scl, o[4 * g + 1] * scl); u.y = pk2(o[4 * g + 2] * scl, o[4 * g + 3] * scl);
                *(uint2*)(dst + 32 * half + 8 * g + 4 * hh) = u;
            }
        } else if (cb < 3072) {
            const int c = cb - 2048, head = c >> 7, dv0 = c & 127;
            bf16_t* dst = Vt + (size_t)((b * 8 + head) * 128 + dv0) * TKV + t;
#pragma unroll
            for (int e = 0; e < 16; ++e) dst[(size_t)(8 * (e >> 2) + 4 * hh + (e & 3)) * TKV] = bf1(v[e]);
        } else if (cb < 4096) {
            const bool isq = cb < 3584;
            if (isq && !lat) return;
            const int c = (cb - 3072) & 511;
            const float scl = isq ? 0.08838834764831845f : 1.0f;
            bf16_t* dst = (isq ? gq : gk) + (size_t)row * 512 + c;
#pragma unroll
            for (int g = 0; g < 4; ++g) {
                uint2 u; u.x = pk2(v[4 * g] * scl, v[4 * g + 1] * scl); u.y = pk2(v[4 * g + 2] * scl, v[4 * g + 3] * scl);
                *(uint2*)(dst + 8 * g + 4 * hh) = u;
            }
        } else if (cb < 5120) {
            const int c = cb - 4096, head = c >> 8, dv0 = c & 255;
            bf16_t* dst = gvT + (size_t)((b * 4 + head) * 256 + dv0) * TKV + t;
#pragma unroll
            for (int e = 0; e < 16; ++e) dst[(size_t)(8 * (e >> 2) + 4 * hh + (e & 3)) * TKV] = bf1(v[e]);
        } else if (cb < 6144) {
            if (!lat) return;
            bf16_t* dst = sg + (size_t)row * 1024 + (cb - 5120);
#pragma unroll
            for (int g = 0; g < 4; ++g) {
                float s[4];
#pragma unroll
                for (int j = 0; j < 4; ++j) { const float xx = v[4 * g + j]; s[j] = xx * sigmoidf_(xx); }
                uint2 u; u.x = pk2(s[0], s[1]); u.y = pk2(s[2], s[3]);
                *(uint2*)(dst + 8 * g + 4 * hh) = u;
            }
        } else if (cb < 8192) {
            if (!lat) return;
            bf16_t* dst = mg + (size_t)row * 2048 + (cb - 6144);
#pragma unroll
            for (int g = 0; g < 4; ++g) {
                uint2 u; u.x = pk2(sigmoidf_(v[4 * g]), sigmoidf_(v[4 * g + 1])); u.y = pk2(sigmoidf_(v[4 * g + 2]), sigmoidf_(v[4 * g + 3]));
                *(uint2*)(dst + 8 * g + 4 * hh) = u;
            }
        } else {
            float* dst = glow + (size_t)row * 32;
#pragma unroll
            for (int g = 0; g < 4; ++g) { f32x4 u = {v[4 * g], v[4 * g + 1], v[4 * g + 2], v[4 * g + 3]}; *(f32x4*)(dst + 8 * g + 4 * hh) = u; }
        }
    }
};

struct EpiGate0 {
    bf16_t* mg;
    DI void operator()(int row, int cb, const f32x16& v, int hh) const {
#pragma unroll
        for (int g = 0; g < 4; ++g) {
            const int col = cb + 8 * g + 4 * hh;
            const uint2 m = *(const uint2*)(mg + (size_t)row * 2048 + col);
            uint2 u; u.x = pk2(v[4 * g] * bflo(m.x), v[4 * g + 1] * bfhi(m.x)); u.y = pk2(v[4 * g + 2] * bflo(m.y), v[4 * g + 3] * bfhi(m.y));
            *(uint2*)(mg + (size_t)row * 2048 + col) = u;
        }
    }
};
struct EpiGate1 {
    bf16_t* Y; const bf16_t* mg;
    DI void operator()(int row, int cb, const f32x16& v, int hh) const {
#pragma unroll
        for (int g = 0; g < 4; ++g) {
            const int col = cb + 8 * g + 4 * hh;
            const uint2 m = *(const uint2*)(mg + (size_t)row * 2048 + 1024 + col);
            const uint2 pr = *(const uint2*)(mg + (size_t)row * 2048 + col);
            uint2 u; u.x = pk2(bflo(pr.x) + v[4 * g] * bflo(m.x), bfhi(pr.x) + v[4 * g + 1] * bfhi(m.x));
            u.y = pk2(bflo(pr.y) + v[4 * g + 2] * bflo(m.y), bfhi(pr.y) + v[4 * g + 3] * bfhi(m.y));
            *(uint2*)(Y + (size_t)row * 1024 + col) = u;
        }
    }
};
template <int ACT>
struct EpiStore {
    bf16_t* O; int ldo;
    DI void operator()(int row, int cb, const f32x16& v, int hh) const {
#pragma unroll
        for (int g = 0; g < 4; ++g) {
            float s[4];
#pragma unroll
            for (int j = 0; j < 4; ++j) { float xx = v[4 * g + j]; if (ACT == 1) { xx = fmaxf(xx, 0.f); xx = xx * xx; } s[j] = xx; }
            uint2 u; u.x = pk2(s[0], s[1]); u.y = pk2(s[2], s[3]);
            *(uint2*)(O + (size_t)row * ldo + cb + 8 * g + 4 * hh) = u;
        }
    }
};

DI int kappa(int r) { return (r & ~12) | ((r & 4) << 1) | ((r & 8) >> 1); }

DI float max16(const f32x16& s) {
    const float a = fmaxf(fmaxf(fmaxf(s[0], s[1]), fmaxf(s[2], s[3])), fmaxf(fmaxf(s[4], s[5]), fmaxf(s[6], s[7])));
    const float b = fmaxf(fmaxf(fmaxf(s[8], s[9]), fmaxf(s[10], s[11])), fmaxf(fmaxf(s[12], s[13]), fmaxf(s[14], s[15])));
    return fmaxf(a, b);
}

template <bool FAST>
DI void attn_kloop(char* smem, char* sdst, const bf16_t* gk0, const bf16_t* gk1, const bf16_t* gv, int comp, int krow, int ksw, int vsw, int l31, int hh,
                   const bf16x8 (&qf)[4], f32x16 (&O)[4], float& m, float& l) {
#define ATT_STAGE(buf, kt_) do { _Pragma("unroll") for (int jj = 0; jj < 2; ++jj) { \
            GLDS16(gk0 + (size_t)((kt_) * 128 + 64 * jj) * 64, sdst + (buf) * 65536 + jj * 8192); \
            GLDS16(gk1 + (size_t)((kt_) * 128 + 64 * jj) * 64, sdst + (buf) * 65536 + 16384 + jj * 8192); } \
            _Pragma("unroll") for (int jj = 0; jj < 4; ++jj) GLDS16(gv + (size_t)(32 * jj) * TKV + (kt_) * 128, sdst + (buf) * 65536 + 32768 + jj * 8192); } while (0)
    ATT_STAGE(0, 0);
    asm volatile("s_waitcnt vmcnt(0)" ::: "memory");
    __syncthreads();
    f32x16 sinit;
#pragma unroll
    for (int e = 0; e < 16; ++e) sinit[e] = FAST ? -m : 0.f;
    constexpr int NKT = TKV / 128;
    for (int kt = 0; kt < NKT; ++kt) {
        const int cur = kt & 1;
        if (kt + 1 < NKT) ATT_STAGE(cur ^ 1, kt + 1);
        const char* sb = smem + cur * 65536;
        const char* skc = sb + comp * 16384;
        if (FAST) {
            bf16x8 kf[4];
#pragma unroll
            for (int ks = 0; ks < 4; ++ks) kf[ks] = *(const bf16x8*)(skc + krow * 128 + (((2 * ks + hh) ^ ksw) << 4));
            f32x16 Sn = MFMA32(kf[0], qf[0], sinit);
            Sn = MFMA32(kf[1], qf[1], Sn); Sn = MFMA32(kf[2], qf[2], Sn); Sn = MFMA32(kf[3], qf[3], Sn);
#pragma unroll
            for (int sub = 0; sub < 4; ++sub) {
                const f32x16 Sc = Sn;
                bf16x8 va[4], vb[4];
#pragma unroll
                for (int dt = 0; dt < 4; ++dt) {
                    const char* vr = sb + 32768 + (32 * dt + l31) * 256;
                    va[dt] = *(const bf16x8*)(vr + (((4 * sub + hh) ^ vsw) << 4));
                    vb[dt] = *(const bf16x8*)(vr + (((4 * sub + 2 + hh) ^ vsw) << 4));
                }
                if (sub < 3) {
#pragma unroll
                    for (int ks = 0; ks < 4; ++ks) kf[ks] = *(const bf16x8*)(skc + (32 * (sub + 1) + krow) * 128 + (((2 * ks + hh) ^ ksw) << 4));
                }
                __builtin_amdgcn_sched_barrier(0);
                float pv[16];
#pragma unroll
                for (int e = 0; e < 16; ++e) { pv[e] = __builtin_amdgcn_exp2f(Sc[e]); l += pv[e]; }
                typedef unsigned u32x4 __attribute__((ext_vector_type(4)));
                const u32x4 ua = {pk2(pv[0], pv[1]), pk2(pv[2], pv[3]), pk2(pv[4], pv[5]), pk2(pv[6], pv[7])};
                const u32x4 ub = {pk2(pv[8], pv[9]), pk2(pv[10], pv[11]), pk2(pv[12], pv[13]), pk2(pv[14], pv[15])};
                const bf16x8 pb0 = __builtin_bit_cast(bf16x8, ua), pb1 = __builtin_bit_cast(bf16x8, ub);
                if (sub < 3) {
                    O[0] = MFMA32(va[0], pb0, O[0]); Sn = MFMA32(kf[0], qf[0], sinit);
                    O[1] = MFMA32(va[1], pb0, O[1]); Sn = MFMA32(kf[1], qf[1], Sn);
                    O[2] = MFMA32(va[2], pb0, O[2]); Sn = MFMA32(kf[2], qf[2], Sn);
                    O[3] = MFMA32(va[3], pb0, O[3]); Sn = MFMA32(kf[3], qf[3], Sn);
                } else {
                    O[0] = MFMA32(va[0], pb0, O[0]); O[1] = MFMA32(va[1], pb0, O[1]); O[2] = MFMA32(va[2], pb0, O[2]); O[3] = MFMA32(va[3], pb0, O[3]);
                }
                O[0] = MFMA32(vb[0], pb1, O[0]); O[1] = MFMA32(vb[1], pb1, O[1]); O[2] = MFMA32(vb[2], pb1, O[2]); O[3] = MFMA32(vb[3], pb1, O[3]);
            }
        } else {
        f32x16 S[4];
#pragma unroll
        for (int sub = 0; sub < 4; ++sub) {
#pragma unroll
            for (int ks = 0; ks < 4; ++ks) {
                const bf16x8 kf = *(const bf16x8*)(skc + (32 * sub + krow) * 128 + (((2 * ks + hh) ^ ksw) << 4));
                S[sub] = MFMA32(kf, qf[ks], ks == 0 ? sinit : S[sub]);
            }
        }
        {
            float mt = fmaxf(fmaxf(max16(S[0]), max16(S[1])), fmaxf(max16(S[2]), max16(S[3])));
            mt = xhalf_max(mt);
            if (__any(mt > m + 8.0f)) {
                const float mn = fmaxf(m, mt);
                const float al = __builtin_amdgcn_exp2f(m - mn);
                l *= al;
#pragma unroll
                for (int d = 0; d < 4; ++d)
#pragma unroll
                    for (int e = 0; e < 16; ++e) O[d][e] *= al;
                m = mn;
            }
        }
#pragma unroll
        for (int sub = 0; sub < 4; ++sub) {
            float pv[16];
#pragma unroll
            for (int e = 0; e < 16; ++e) { pv[e] = __builtin_amdgcn_exp2f(S[sub][e] - m); l += pv[e]; }
            typedef unsigned u32x4 __attribute__((ext_vector_type(4)));
            const u32x4 ua = {pk2(pv[0], pv[1]), pk2(pv[2], pv[3]), pk2(pv[4], pv[5]), pk2(pv[6], pv[7])};
            const u32x4 ub = {pk2(pv[8], pv[9]), pk2(pv[10], pv[11]), pk2(pv[12], pv[13]), pk2(pv[14], pv[15])};
            const bf16x8 pb0 = __builtin_bit_cast(bf16x8, ua), pb1 = __builtin_bit_cast(bf16x8, ub);
#pragma unroll
            for (int dt = 0; dt < 4; ++dt) {
                const char* vr = sb + 32768 + (32 * dt + l31) * 256;
                const bf16x8 v0 = *(const bf16x8*)(vr + (((4 * sub + hh) ^ vsw) << 4));
                const bf16x8 v1 = *(const bf16x8*)(vr + (((4 * sub + 2 + hh) ^ vsw) << 4));
                O[dt] = MFMA32(v0, pb0, O[dt]);
                O[dt] = MFMA32(v1, pb1, O[dt]);
            }
        }
        }
        asm volatile("s_waitcnt vmcnt(0)" ::: "memory");
        __syncthreads();
    }
#undef ATT_STAGE
}

DI void phase_attn(const Params& p, char* smem) {
    const int tid = get_tid(), lane = tid & 63, w = tid >> 6, l31 = lane & 31, hh = lane >> 5;
    const int g = w >> 1, comp = w & 1;
    const bf16_t* Q = (const bf16_t*)(p.ws + R_Q);
    const bf16_t* Kk = (const bf16_t*)(p.ws + R_K);
    const bf16_t* Vt = (const bf16_t*)(p.ws + R_VT);
    const float* kmax = (const float*)(p.ws + OFF_KMAX);
    bf16_t* YDA = (bf16_t*)(p.ws + R_H);
    float d1 = 0.f, d2 = 0.f;
    for (int i = 0; i < 64; ++i) { d1 += p.lq1[i] * p.lk1[i]; d2 += p.lq2[i] * p.lk2[i]; }
    const float lam = __expf(d1) - __expf(d2) + 0.2f;
    const int krs = 8 * w + (lane >> 3), kcs = (lane & 7) ^ (4 * (w & 1) + (lane >> 4));
    const int vrs = 4 * w + (lane >> 4), vcs = (lane & 15) ^ ((4 * w + (lane >> 4)) & 15);
    const int krow = kappa(l31);
    const int ksw = (krow >> 1) & 7, vsw = l31 & 15;
    float* xbuf = (float*)smem + g * 4096;
    char* sdst = smem + w * 1024;
    for (int id = blockIdx.x; id < 4096; id += gridDim.x) {
        const int x = id & 7, j = id >> 3, bh = (j >> 6) * 8 + x, qt = j & 63;
        const int b = bh >> 3, h = bh & 7;
        const bf16_t* qp = Q + ((size_t)(bh * 2 + comp) * TLAT + qt * 128 + g * 32 + l31) * 64 + hh * 8;
        bf16x8 qf[4];
#pragma unroll
        for (int ks = 0; ks < 4; ++ks) qf[ks] = *(const bf16x8*)(qp + ks * 16);
        float qn = 0.f;
#pragma unroll
        for (int ks = 0; ks < 4; ++ks)
#pragma unroll
            for (int e = 0; e < 8; ++e) { const float qv = __uint_as_float(((unsigned)(unsigned short)qf[ks][e]) << 16); qn += qv * qv; }
        qn = xhalf_sum(qn);
        const float kb = sqrtf(kmax[(bh * 2 + comp) * 2] + kmax[(bh * 2 + comp) * 2 + 1]);
        const float mb = sqrtf(qn) * kb * 1.01f + 1e-3f;
        const bf16_t* gk0 = Kk + ((size_t)(bh * 2 + 0) * TKV + krs) * 64 + kcs * 8;
        const bf16_t* gk1 = gk0 + (size_t)TKV * 64;
        const bf16_t* gv = Vt + ((size_t)bh * 128 + vrs) * TKV + vcs * 8;
        f32x16 O[4];
#pragma unroll
        for (int d = 0; d < 4; ++d)
#pragma unroll
            for (int e = 0; e < 16; ++e) O[d][e] = 0.f;
        float m, l = 0.f;
        const int slow = __syncthreads_or(!(mb <= 60.0f));
        if (!slow) { m = mb; attn_kloop<true>(smem, sdst, gk0, gk1, gv, comp, krow, ksw, vsw, l31, hh, qf, O, m, l); }
        else { m = -INFINITY; attn_kloop<false>(smem, sdst, gk0, gk1, gv, comp, krow, ksw, vsw, l31, hh, qf, O, m, l); }
        l = xhalf_sum(l);
        if (comp == 1) {
            const float i1 = lam / l;
#pragma unroll
            for (int d = 0; d < 4; ++d)
#pragma unroll
                for (int e = 0; e < 16; ++e) xbuf[(d * 16 + e) * 64 + lane] = O[d][e] * i1;
        }
        __syncthreads();
        if (comp == 0) {
            const float i0 = 1.0f / l;
            float ss = 0.f;
#pragma unroll
            for (int d = 0; d < 4; ++d)
#pragma unroll
                for (int e = 0; e < 16; ++e) { const float o = O[d][e] * i0 - xbuf[(d * 16 + e) * 64 + lane]; O[d][e] = o; ss += o * o; }
            ss = xhalf_sum(ss);
            const float rs = rsqrtf(ss * (1.0f / 128.0f) + EPS) * 0.8f;
            const int t = qt * 128 + g * 32 + l31;
            bf16_t* dst = YDA + ((size_t)b * TLAT + t) * 1024 + h * 128;
#pragma unroll
            for (int d = 0; d < 4; ++d)
#pragma unroll
                for (int gg = 0; gg < 4; ++gg) {
                    const int dv = 32 * d + 8 * gg + 4 * hh;
                    const f32x4 hn = *(const f32x4*)(p.da_hn + dv);
                    uint2 u; u.x = pk2(O[d][4 * gg] * rs * hn.x, O[d][4 * gg + 1] * rs * hn.y); u.y = pk2(O[d][4 * gg + 2] * rs * hn.z, O[d][4 * gg + 3] * rs * hn.w);
                    *(uint2*)(dst + dv) = u;
                }
        }
    }
}

DI void phase_gate(const Params& p, char* smem) {
    const int tid = get_tid();
    const float* glow = (const float*)(p.ws + OFF_GLOW);
    float* sg = (float*)smem;
    float wf[16], wb[16];
#pragma unroll
    for (int r = 0; r < 16; ++r) { wf[r] = p.w_gate_up[(size_t)r * 512 + tid]; wb[r] = p.w_gate_up[(size_t)(16 + r) * 512 + tid]; }
    const float biasf = p.b_gate_up[tid], biasb = p.b_gate_up[512 + tid];
    _Float16* BF = (_Float16*)(p.ws + R_BF);
    _Float16* BB = (_Float16*)(p.ws + R_BB);
    for (int ch = blockIdx.x; ch < 1056; ch += gridDim.x) {
        __syncthreads();
        *(f32x4*)(sg + tid * 4) = *(const f32x4*)(glow + (size_t)ch * 2048 + tid * 4);
        __syncthreads();
        float run = 0.f;
#pragma unroll 4
        for (int i = 0; i < 64; ++i) {
            const float* gl = sg + i * 32;
            float a = biasf;
#pragma unroll
            for (int r = 0; r < 16; ++r) a = fmaf(gl[r], wf[r], a);
            const float ls = fminf(a, 0.f) - __logf(1.0f + __expf(-fabsf(a)));
            run += ls * (1.0f / 16.0f);
            BF[(size_t)(ch * 64 + i) * 512 + tid] = (_Float16)run;
        }
        run = 0.f;
#pragma unroll 4
        for (int i = 63; i >= 0; --i) {
            const float* gl = sg + i * 32 + 16;
            float a = biasb;
#pragma unroll
            for (int r = 0; r < 16; ++r) a = fmaf(gl[r], wb[r], a);
            const float ls = fminf(a, 0.f) - __logf(1.0f + __expf(-fabsf(a)));
            run += ls * (1.0f / 16.0f);
            BB[(size_t)(ch * 64 + i) * 512 + tid] = (_Float16)run;
        }
    }
}

struct GlaRegs { uint2 k[2][2], q[2][2], bb[2][2], bl[2][2]; uint4 v[4]; };

DI void phase_gla(const Params& p, char* smem) {
    const int tid = get_tid(), lane = tid & 63, w = tid >> 6, l31 = lane & 31, hh = lane >> 5;
    const int unit = blockIdx.x, dir = unit & 1, bh = unit >> 1, b = bh >> 2, h = bh & 3;
    const bf16_t* gq = (const bf16_t*)(p.ws + R_GQ);
    const bf16_t* gk = (const bf16_t*)(p.ws + R_GK);
    const bf16_t* gvT = (const bf16_t*)(p.ws + R_GVT) + (size_t)bh * 256 * TKV;
    const _Float16* B16 = (const _Float16*)(p.ws + (dir ? R_BB : R_BF));
    bf16_t* Oo = (bf16_t*)(p.ws + (dir ? R_OB : R_OF));
    char* sQt = smem;
    char* sKt = smem + 16384;
    char* sKh = smem + 32768;
    char* sVT = smem + 49152;
    char* sA = smem + 81920;
    float* sD = (float*)(smem + 90112);
    f32x16 S[4];
#pragma unroll
    for (int k = 0; k < 4; ++k)
#pragma unroll
        for (int e = 0; e < 16; ++e) S[k][e] = 0.f;
    const int sw = (l31 >> 1) & 7;
    GlaRegs R;
    auto chunk_info = [&](int step, int& rowbase, int& tcol, bool& emit) {
        if (step < 4) { const int cc = dir ? 3 - step : step; rowbase = NLAT + b * 256 + cc * 64; tcol = TLAT + cc * 64; emit = false; }
        else { const int cc = dir ? 127 - (step - 4) : step - 4; rowbase = b * TLAT + cc * 64; tcol = cc * 64; emit = true; }
    };
    auto load_chunk = [&](int step) {
        int rowbase, tcol; bool emit; chunk_info(step, rowbase, tcol, emit);
        const int rl = rowbase + (dir ? 0 : 63);
#pragma unroll
        for (int i = 0; i < 2; ++i) {
            const int item = tid + NT * i, tok = item >> 4, c = item & 15, d0 = 16 * (c >> 1) + 4 * (c & 1);
            const size_t ro = (size_t)(rowbase + tok) * 512 + h * 128 + d0;
            R.k[i][0] = *(const uint2*)(gk + ro); R.k[i][1] = *(const uint2*)(gk + ro + 8);
            if (emit) { R.q[i][0] = *(const uint2*)(gq + ro); R.q[i][1] = *(const uint2*)(gq + ro + 8); }
            else { R.q[i][0] = make_uint2(0, 0); R.q[i][1] = make_uint2(0, 0); }
            R.bb[i][0] = *(const uint2*)(B16 + ro); R.bb[i][1] = *(const uint2*)(B16 + ro + 8);
            const size_t rlo = (size_t)rl * 512 + h * 128 + d0;
            R.bl[i][0] = *(const uint2*)(B16 + rlo); R.bl[i][1] = *(const uint2*)(B16 + rlo + 8);
        }
#pragma unroll
        for (int i = 0; i < 4; ++i) R.v[i] = *(const uint4*)(gvT + (size_t)((tid >> 3) + 64 * i) * TKV + tcol + (tid & 7) * 8);
    };
    auto stage_chunk = [&]() {
#pragma unroll
        for (int i = 0; i < 2; ++i) {
            const int item = tid + NT * i, tok = item >> 4, c = item & 15, d0 = 16 * (c >> 1) + 4 * (c & 1);
            float qo[8], ko[8];
#pragma unroll
            for (int g = 0; g < 2; ++g) {
                const h4_t bv = __builtin_bit_cast(h4_t, R.bb[i][g]), lv = __builtin_bit_cast(h4_t, R.bl[i][g]);
                const float kk[4] = {bflo(R.k[i][g].x), bfhi(R.k[i][g].x), bflo(R.k[i][g].y), bfhi(R.k[i][g].y)};
                const float qq[4] = {bflo(R.q[i][g].x), bfhi(R.q[i][g].x), bflo(R.q[i][g].y), bfhi(R.q[i][g].y)};
#pragma unroll
                for (int j = 0; j < 4; ++j) {
                    const float bb = (float)bv[j], bl = (float)lv[j];
                    qo[4 * g + j] = qq[j] * __expf(bb);
                    ko[4 * g + j] = kk[j] * __expf(-bb);
                    const float kh = kk[j] * __expf(bl - bb);
                    const int dk = d0 + 8 * g + j;
                    *(bf16_t*)(sKh + dk * 128 + ((((tok >> 3) ^ ((dk >> 1) & 7))) << 4) + (tok & 7) * 2) = bf1(kh);
                    if (tok == 0) sD[dk] = __expf(bl);
                }
            }
            const int po = tok * 256 + ((c ^ (tok & 15)) << 4);
            uint4 uq, uk;
            uq.x = pk2(qo[0], qo[1]); uq.y = pk2(qo[2], qo[3]); uq.z = pk2(qo[4], qo[5]); uq.w = pk2(qo[6], qo[7]);
            uk.x = pk2(ko[0], ko[1]); uk.y = pk2(ko[2], ko[3]); uk.z = pk2(ko[4], ko[5]); uk.w = pk2(ko[6], ko[7]);
            *(uint4*)(sQt + po) = uq; *(uint4*)(sKt + po) = uk;
        }
#pragma unroll
        for (int i = 0; i < 4; ++i) {
            const int row = (tid >> 3) + 64 * i, scn = tid & 7;
            *(uint4*)(sVT + row * 128 + ((scn ^ ((row >> 1) & 7)) << 4)) = R.v[i];
        }
    };
    load_chunk(0);
    for (int step = 0; step < 132; ++step) {
        int rowbase, tcol; bool emit; chunk_info(step, rowbase, tcol, emit);
        stage_chunk();
        __syncthreads();
        if (step + 1 < 132) load_chunk(step + 1);
        const int dvb = 32 * w;
        if (emit) {
            if (w < 4) {
                const int ti = w >> 1, tj = w & 1;
                f32x16 a;
#pragma unroll
                for (int e = 0; e < 16; ++e) a[e] = 0.f;
                const bool dead = dir ? (tj < ti) : (tj > ti);
                if (!dead) {
#pragma unroll
                    for (int ks = 0; ks < 8; ++ks) {
                        const int ri = 32 * ti + l31, rj = 32 * tj + l31, c = 2 * ks + hh;
                        const bf16x8 af = *(const bf16x8*)(sQt + ri * 256 + ((c ^ (ri & 15)) << 4));
                        const bf16x8 bf = *(const bf16x8*)(sKt + rj * 256 + ((c ^ (rj & 15)) << 4));
                        a = MFMA32(af, bf, a);
                    }
                }
                const int jj = 32 * tj + l31;
#pragma unroll
                for (int e = 0; e < 16; ++e) {
                    const int ii = 32 * ti + (e & 3) + 8 * (e >> 2) + 4 * hh;
                    const bool keep = dir ? (jj >= ii) : (jj <= ii);
                    *(bf16_t*)(sA + ii * 128 + ((((jj >> 3) ^ ((ii >> 1) & 7))) << 4) + (jj & 7) * 2) = bf1(keep ? a[e] : 0.f);
                }
            }
            f32x16 o[2];
#pragma unroll
            for (int mt = 0; mt < 2; ++mt)
#pragma unroll
                for (int e = 0; e < 16; ++e) o[mt][e] = 0.f;
#pragma unroll
            for (int kt = 0; kt < 4; ++kt)
#pragma unroll
                for (int s = 0; s < 2; ++s) {
                    typedef unsigned u32x4 __attribute__((ext_vector_type(4)));
                    u32x4 pu = {pk2(S[kt][8 * s], S[kt][8 * s + 1]), pk2(S[kt][8 * s + 2], S[kt][8 * s + 3]), pk2(S[kt][8 * s + 4], S[kt][8 * s + 5]), pk2(S[kt][8 * s + 6], S[kt][8 * s + 7])};
                    const bf16x8 sf = __builtin_bit_cast(bf16x8, pu);
#pragma unroll
                    for (int mt = 0; mt < 2; ++mt) {
                        const int ri = 32 * mt + l31, c = 4 * kt + 2 * s + hh;
                        const bf16x8 af = *(const bf16x8*)(sQt + ri * 256 + ((c ^ (ri & 15)) << 4));
                        o[mt] = MFMA32(af, sf, o[mt]);
                    }
                }
            __syncthreads();
#pragma unroll
            for (int s2 = 0; s2 < 4; ++s2) {
                const int c = 2 * s2 + hh;
                const bf16x8 vf = *(const bf16x8*)(sVT + (dvb + l31) * 128 + ((c ^ sw) << 4));
#pragma unroll
                for (int mt = 0; mt < 2; ++mt) {
                    const bf16x8 af = *(const bf16x8*)(sA + (32 * mt + l31) * 128 + ((c ^ sw) << 4));
                    o[mt] = MFMA32(af, vf, o[mt]);
                }
            }
            bf16_t* od = Oo + (size_t)rowbase * 1024 + h * 256 + dvb + l31;
#pragma unroll
            for (int mt = 0; mt < 2; ++mt)
#pragma unroll
                for (int e = 0; e < 16; ++e) od[(size_t)(32 * mt + (e & 3) + 8 * (e >> 2) + 4 * hh) * 1024] = bf1(o[mt][e]);
        }
#pragma unroll
        for (int kt = 0; kt < 4; ++kt)
#pragma unroll
            for (int g4 = 0; g4 < 4; ++g4) {
                const f32x4 dd = *(const f32x4*)(sD + 32 * kt + 8 * g4 + 4 * hh);
#pragma unroll
                for (int jq = 0; jq < 4; ++jq) S[kt][4 * g4 + jq] *= dd[jq];
            }
#pragma unroll
        for (int s2 = 0; s2 < 4; ++s2) {
            const int c = 2 * s2 + hh;
            const bf16x8 vf = *(const bf16x8*)(sVT + (dvb + l31) * 128 + ((c ^ sw) << 4));
#pragma unroll
            for (int kt = 0; kt < 4; ++kt) {
                const bf16x8 af = *(const bf16x8*)(sKh + (32 * kt + l31) * 128 + ((c ^ sw) << 4));
                S[kt] = MFMA32(af, vf, S[kt]);
            }
        }
        __syncthreads();
    }
}

DI void phase_combine(const Params& p) {
    const int tid = get_tid(), lane = tid & 63, w = tid >> 6;
    const bf16_t* OF = (const bf16_t*)(p.ws + R_OF);
    const bf16_t* OB = (const bf16_t*)(p.ws + R_OB);
    const bf16_t* SG = (const bf16_t*)(p.ws + R_SG);
    bf16_t* Y = (bf16_t*)(p.ws + R_YGLA);
    for (int row = blockIdx.x * 8 + w; row < NLAT; row += gridDim.x * 8) {
        const size_t o = (size_t)row * 1024 + lane * 16;
        const uint4 a0 = *(const uint4*)(OF + o), a1 = *(const uint4*)(OF + o + 8);
        const uint4 b0 = *(const uint4*)(OB + o), b1 = *(const uint4*)(OB + o + 8);
        const uint4 g0 = *(const uint4*)(SG + o), g1 = *(const uint4*)(SG + o + 8);
        const unsigned au[8] = {a0.x, a0.y, a0.z, a0.w, a1.x, a1.y, a1.z, a1.w};
        const unsigned bu[8] = {b0.x, b0.y, b0.z, b0.w, b1.x, b1.y, b1.z, b1.w};
        const unsigned gu[8] = {g0.x, g0.y, g0.z, g0.w, g1.x, g1.y, g1.z, g1.w};
        float v[16]; float ss = 0.f;
#pragma unroll
        for (int e = 0; e < 8; ++e) { v[2 * e] = bflo(au[e]) + bflo(bu[e]); v[2 * e + 1] = bfhi(au[e]) + bfhi(bu[e]); ss += v[2 * e] * v[2 * e] + v[2 * e + 1] * v[2 * e + 1]; }
#pragma unroll
        for (int of = 8; of >= 1; of >>= 1) ss += __shfl_xor(ss, of);
        const float rs = rsqrtf(ss * (1.0f / 256.0f) + EPS);
        const float* gn = p.gla_hn + ((lane * 16) & 255);
        unsigned ou[8];
#pragma unroll
        for (int e = 0; e < 8; ++e) ou[e] = pk2(v[2 * e] * rs * gn[2 * e] * bflo(gu[e]), v[2 * e + 1] * rs * gn[2 * e + 1] * bfhi(gu[e]));
        *(uint4*)(Y + o) = make_uint4(ou[0], ou[1], ou[2], ou[3]);
        *(uint4*)(Y + o + 8) = make_uint4(ou[4], ou[5], ou[6], ou[7]);
    }
}

template <int MODE>
DI void phase_rows(const Params& p, char* smem) {
    float* md = (float*)smem;
    const int tid = get_tid(), lane = tid & 63, w = tid >> 6;
    const bf16_t* Yin = (const bf16_t*)(p.ws + (MODE == 0 ? R_Y2 : R_Y3));
    bf16_t* H2 = (bf16_t*)(p.ws + R_H2);
    const float* pn = MODE == 0 ? p.post_norm1 : p.post_norm2;
    for (int tile = blockIdx.x; tile < 256; tile += gridDim.x) {
        const int r = tile >> 5;
        __syncthreads();
        if (MODE == 0) { load_mod(p, r, 2, md); load_mod(p, r, 3, md + 1024); load_mod(p, r, 4, md + 2048); }
        else load_mod(p, r, 5, md);
        __syncthreads();
        for (int i = 0; i < 32; ++i) {
            const int row = tile * 256 + w * 32 + i;
            float y[16]; float ss = 0.f;
#pragma unroll
            for (int j = 0; j < 4; ++j) {
                const uint2 u = *(const uint2*)(Yin + (size_t)row * 1024 + lane * 4 + 256 * j);
                y[4 * j] = bflo(u.x); y[4 * j + 1] = bfhi(u.x); y[4 * j + 2] = bflo(u.y); y[4 * j + 3] = bfhi(u.y);
                ss += y[4 * j] * y[4 * j] + y[4 * j + 1] * y[4 * j + 1] + y[4 * j + 2] * y[4 * j + 2] + y[4 * j + 3] * y[4 * j + 3];
            }
            ss = wave_sum(ss);
            const float rs = rsqrtf(ss * (1.0f / 1024.0f) + EPS);
            float xn[16]; float s2 = 0.f;
#pragma unroll
            for (int j = 0; j < 4; ++j) {
                const int col = lane * 4 + 256 * j;
                const float* xs = (MODE == 0 ? p.x : (const float*)p.out) + (size_t)row * 1024 + col;
                const f32x4 xv = *(const f32x4*)xs, g = *(const f32x4*)(pn + col), gt = *(const f32x4*)(md + col);
#pragma unroll
                for (int e = 0; e < 4; ++e) { xn[4 * j + e] = xv[e] + gt[e] * (y[4 * j + e] * rs * g[e]); s2 += xn[4 * j + e] * xn[4 * j + e]; }
                f32x4 ov = {xn[4 * j], xn[4 * j + 1], xn[4 * j + 2], xn[4 * j + 3]};
                *(f32x4*)(p.out + (size_t)row * 1024 + col) = ov;
            }
            if (MODE == 0) {
                s2 = wave_sum(s2);
                const float rs2 = rsqrtf(s2 * (1.0f / 1024.0f) + EPS);
#pragma unroll
                for (int j = 0; j < 4; ++j) {
                    const int col = lane * 4 + 256 * j;
                    const f32x4 g = *(const f32x4*)(p.pre_norm2 + col), sh = *(const f32x4*)(md + 1024 + col), sc = *(const f32x4*)(md + 2048 + col);
                    float o[4];
#pragma unroll
                    for (int e = 0; e < 4; ++e) o[e] = xn[4 * j + e] * rs2 * g[e] * (1.f + sc[e]) + sh[e];
                    uint2 u; u.x = pk2(o[0], o[1]); u.y = pk2(o[2], o[3]);
                    *(uint2*)(H2 + (size_t)row * 1024 + col) = u;
                }
            }
        }
    }
}

DI void gsync(unsigned* bar, unsigned& epoch) {
    __syncthreads();
    epoch += gridDim.x;
    if (threadIdx.x == 0) {
        __threadfence();
        atomicAdd(bar, 1u);
        while (__hip_atomic_load(bar, __ATOMIC_RELAXED, __HIP_MEMORY_SCOPE_AGENT) < epoch) __builtin_amdgcn_s_sleep(1);
        __threadfence();
    }
    __syncthreads();
}

__global__ void __launch_bounds__(NT) fwd_megakernel(Params p) {
    __shared__ __attribute__((aligned(16))) char smem[131072];
    cg::grid_group grid = cg::this_grid();
    char* ws = p.ws;
    unsigned* bar = (unsigned*)(ws + OFF_BAR);
    unsigned epoch = 0;
    phase_prep(p, smem);
    grid.sync();
    phase_h(p, smem);
    gsync(bar, epoch);
    {
        EpiIn e; e.Q = (bf16_t*)(ws + R_Q); e.Kk = (bf16_t*)(ws + R_K); e.Vt = (bf16_t*)(ws + R_VT); e.gq = (bf16_t*)(ws + R_GQ); e.gk = (bf16_t*)(ws + R_GK);
        e.gvT = (bf16_t*)(ws + R_GVT); e.sg = (bf16_t*)(ws + R_SG); e.mg = (bf16_t*)p.out; e.glow = (float*)(ws + OFF_GLOW); e.rope = (const float*)(ws + OFF_ROPE); e.kmax = (float*)(ws + OFF_KMAX);
        gemm_phase_ex<true>((const bf16_t*)(ws + R_H), 1024, (const bf16_t*)(ws + OFF_WIN), 1024, 1024, 264, 33, smem, e, blockIdx.x, gridDim.x);
    }
    gsync(bar, epoch);
    phase_attn(p, smem);
    gsync(bar, epoch);
    phase_gate(p, smem);
    gsync(bar, epoch);
    if (blockIdx.x < 64) phase_gla(p, smem);
    else {
        EpiGate0 e0; e0.mg = (bf16_t*)p.out;
        gemm_phase_ex<false>((const bf16_t*)(ws + R_H), 1024, (const bf16_t*)(ws + OFF_WDA), 1024, 1024, 256, 4, smem, e0, blockIdx.x - 64, gridDim.x - 64);
    }
    gsync(bar, epoch);
    phase_combine(p);
    gsync(bar, epoch);
    {
        EpiGate1 e1; e1.Y = (bf16_t*)(ws + R_Y); e1.mg = (const bf16_t*)p.out;
        gemm_phase((const bf16_t*)(ws + R_YGLA), 1024, (const bf16_t*)(ws + OFF_WGLA), 1024, 1024, 256, 4, smem, e1);
    }
    gsync(bar, epoch);
    {
        EpiStore<0> e; e.O = (bf16_t*)(ws + R_Y2); e.ldo = 1024;
        gemm_phase((const bf16_t*)(ws + R_Y), 1024, (const bf16_t*)(ws + OFF_WOUT), 1024, 1024, 256, 4, smem, e);
    }
    gsync(bar, epoch);
    phase_rows<0>(p, smem);
    gsync(bar, epoch);
    {
        EpiStore<1> e; e.O = (bf16_t*)(ws + R_U); e.ldo = 4096;
        gemm_phase((const bf16_t*)(ws + R_H2), 1024, (const bf16_t*)(ws + OFF_WFF1), 1024, 1024, 256, 16, smem, e);
    }
    gsync(bar, epoch);
    {
        EpiStore<0> e; e.O = (bf16_t*)(ws + R_Y3); e.ldo = 1024;
        gemm_phase((const bf16_t*)(ws + R_U), 4096, (const bf16_t*)(ws + OFF_WFF2), 4096, 4096, 256, 4, smem, e);
    }
    gsync(bar, epoch);
    phase_rows<1>(p, smem);
}

extern "C" void kernel_launch(void* const* d_in, const int* in_sizes, int n_in, void* d_out, int out_size, void* d_ws, size_t ws_size, hipStream_t stream) {
    static int grid_blocks = 0;
    if (!grid_blocks) {
        int dev = 0, cus = 0, per_cu = 0;
        hipGetDevice(&dev);
        hipDeviceGetAttribute(&cus, hipDeviceAttributeMultiprocessorCount, dev);
        hipOccupancyMaxActiveBlocksPerMultiprocessor(&per_cu, fwd_megakernel, NT, 0);
        if (per_cu < 1) per_cu = 1;
        grid_blocks = cus * per_cu;
        if (grid_blocks > 256) grid_blocks = 256;
    }
    Params p{};
    const float* const* in = (const float* const*)d_in;
    p.x = in[0]; p.c = in[1]; p.ctx = in[2]; p.c_ctx = in[3]; p.w_mod = in[4]; p.b_mod = in[5]; p.pre_norm1 = in[6]; p.w_in = in[7];
    p.w_gate_up = in[8]; p.b_gate_up = in[9]; p.lq1 = in[10]; p.lk1 = in[11]; p.lq2 = in[12]; p.lk2 = in[13]; p.da_hn = in[14]; p.gla_hn = in[15];
    p.w_bda = in[16]; p.w_bgla = in[17]; p.w_out = in[18]; p.post_norm1 = in[19]; p.pre_norm2 = in[20]; p.w_ff1 = in[21]; p.w_ff2 = in[22]; p.post_norm2 = in[23];
    p.out = (float*)d_out; p.ws = (char*)d_ws;
    hipMemsetAsync((char*)d_ws + OFF_BAR, 0, 256, stream);
    void* args[] = {&p};
    hipError_t e = hipLaunchCooperativeKernel((void*)fwd_megakernel, dim3(grid_blocks), dim3(NT), args, 0, stream);
    if (e != hipSuccess) fprintf(stderr, "cooperative launch failed: %s (grid %d)\n", hipGetErrorString(e), grid_blocks);
}
```

```cpp
#include <hip/hip_runtime.h>
#include <hip/hip_cooperative_groups.h>
#include <cstdio>
namespace cg = cooperative_groups;

typedef unsigned short bf16_t;
typedef short bf16x8 __attribute__((ext_vector_type(8)));
typedef float f32x16 __attribute__((ext_vector_type(16)));
typedef float f32x4 __attribute__((ext_vector_type(4)));
typedef float f32x2 __attribute__((ext_vector_type(2)));
typedef __bf16 bf2_t __attribute__((ext_vector_type(2)));
typedef _Float16 h4_t __attribute__((ext_vector_type(4)));

#define DI __device__ __forceinline__
#define MFMA32(a, b, c) __builtin_amdgcn_mfma_f32_32x32x16_bf16((a), (b), (c), 0, 0, 0)

constexpr int NT = 512;
constexpr int TLAT = 8192, NB = 8, NLAT = 65536, NROW = 67584, TKV = 8448;
constexpr float EPS = 1e-6f;
constexpr size_t MiB = 1048576;
constexpr size_t OFF_WIN = 0;
constexpr size_t OFF_WDA = OFF_WIN + 8448ull * 1024 * 2;
constexpr size_t OFF_WGLA = OFF_WDA + 2 * MiB;
constexpr size_t OFF_WOUT = OFF_WGLA + 2 * MiB;
constexpr size_t OFF_WFF1 = OFF_WOUT + 2 * MiB;
constexpr size_t OFF_WFF2 = OFF_WFF1 + 8 * MiB;
constexpr size_t OFF_MODP = OFF_WFF2 + 8 * MiB;
constexpr size_t OFF_ROPE = OFF_MODP + 16ull * 9 * 6144 * 4;
constexpr size_t OFF_GLOW = OFF_ROPE + 16384;
constexpr size_t OFF_KMAX = OFF_GLOW + 67584ull * 32 * 4;
constexpr size_t OFF_BAR = OFF_KMAX + 1024;
constexpr size_t R_H = 64 * MiB;
constexpr size_t R_Q = R_H + 132 * MiB;
constexpr size_t R_K = R_Q + 128 * MiB;
constexpr size_t R_VT = R_K + 132 * MiB;
constexpr size_t R_GQ = R_VT + 132 * MiB;
constexpr size_t R_GK = R_GQ + 64 * MiB;
constexpr size_t R_GVT = R_GK + 66 * MiB;
constexpr size_t R_SG = R_GVT + 132 * MiB;
constexpr size_t WS_END = R_SG + 128 * MiB;
static_assert(OFF_BAR + 1024 <= R_H, "small region overflow");
static_assert(WS_END <= 1024 * MiB, "workspace overflow");
constexpr size_t R_BF = R_Q;
constexpr size_t R_BB = R_Q + 66 * MiB;
constexpr size_t R_OF = R_K + 4 * MiB;
constexpr size_t R_OB = R_VT;
constexpr size_t R_YGLA = R_SG;
constexpr size_t R_Y = R_GVT;
constexpr size_t R_Y2 = R_SG;
constexpr size_t R_H2 = R_H;
constexpr size_t R_U = R_Q;
constexpr size_t R_Y3 = R_GVT;

struct Params {
    const float *x, *c, *ctx, *c_ctx, *w_mod, *b_mod, *pre_norm1, *w_in, *w_gate_up, *b_gate_up;
    const float *lq1, *lk1, *lq2, *lk2, *da_hn, *gla_hn, *w_bda, *w_bgla, *w_out, *post_norm1, *pre_norm2, *w_ff1, *w_ff2, *post_norm2;
    float* out;
    char* ws;
};

DI unsigned pk2(float a, float b) { f32x2 v = {a, b}; bf2_t r = __builtin_convertvector(v, bf2_t); return __builtin_bit_cast(unsigned, r); }
DI bf16_t bf1(float a) { __bf16 r = (__bf16)a; return __builtin_bit_cast(unsigned short, r); }
DI float bflo(unsigned v) { return __uint_as_float(v << 16); }
DI float bfhi(unsigned v) { return __uint_as_float(v & 0xffff0000u); }
DI float wave_sum(float v) {
#pragma unroll
    for (int o = 32; o >= 1; o >>= 1) v += __shfl_xor(v, o);
    return v;
}
DI int get_tid() { int t = threadIdx.x; asm volatile("" : "+v"(t)); return t; }
DI float sigmoidf_(float x) { return 1.0f / (1.0f + __expf(-x)); }

template <int MODE>
DI void repack(const float* __restrict__ src, int K, int Nsrc, bf16_t* __restrict__ dst, int Nd, long gtid, long gsz) {
    const long total = (long)Nd * (K / 8);
    for (long it = gtid; it < total; it += gsz) {
        const int n = (int)(it % Nd), kc = (int)(it / Nd);
        int col = n; bool valid = true;
        if (MODE == 1) { if (n < 5120) col = n; else if (n < 8192) col = n + 32; else if (n < 8224) col = n - 8192 + 5120; else valid = false; }
        float v[8];
#pragma unroll
        for (int j = 0; j < 8; ++j) v[j] = valid ? src[(size_t)(kc * 8 + j) * Nsrc + col] : 0.f;
        uint4 o; o.x = pk2(v[0], v[1]); o.y = pk2(v[2], v[3]); o.z = pk2(v[4], v[5]); o.w = pk2(v[6], v[7]);
        *(uint4*)(dst + (size_t)n * K + kc * 8) = o;
    }
}

DI void sincos_acc(float a, float& s, float& c) {
    const float q = rintf(a * 0.63661977236758134f);
    float r = fmaf(-q, 1.5703125f, a); r = fmaf(-q, 4.837512969970703125e-4f, r); r = fmaf(-q, 7.54978995489188216e-8f, r);
    const float r2 = r * r;
    const float sp = r + r * r2 * (-1.6666666666e-1f + r2 * (8.3333333333e-3f + r2 * (-1.98412698e-4f + r2 * 2.7557319e-6f)));
    const float cp = 1.0f + r2 * (-0.5f + r2 * (4.16666666667e-2f + r2 * (-1.38888888889e-3f + r2 * (2.48015873e-5f + r2 * -2.75573192e-7f))));
    const int qi = ((int)q) & 3;
    s = (qi == 0) ? sp : (qi == 1) ? cp : (qi == 2) ? -sp : -cp;
    c = (qi == 0) ? cp : (qi == 1) ? -sp : (qi == 2) ? -cp : sp;
}

DI void phase_prep(const Params& p, char* smem) {
    const int tid = get_tid();
    const long gsz = (long)gridDim.x * NT, gtid = (long)blockIdx.x * NT + tid;
    char* ws = p.ws;
    repack<1>(p.w_in, 1024, 8224, (bf16_t*)(ws + OFF_WIN), 8448, gtid, gsz);
    repack<0>(p.w_bda, 1024, 1024, (bf16_t*)(ws + OFF_WDA), 1024, gtid, gsz);
    if (gtid < 256) ((float*)(ws + OFF_KMAX))[gtid] = 0.f;
    if (gtid < 2048) {
        const int pos = (int)gtid >> 4, f = (int)gtid & 15;
        const float inv = exp2f(-(float)f * (13.287712379549449f / 16.0f));
        float s, c; sincos_acc((float)pos * inv, s, c);
        float* rt = (float*)(ws + OFF_ROPE);
        rt[gtid] = c; rt[2048 + gtid] = s;
    }
    float* sil = (float*)smem;
    float* modp = (float*)(ws + OFF_MODP);
    for (int item = blockIdx.x; item < 192; item += gridDim.x) {
        const int cb = item % 12, ks = item / 12;
        __syncthreads();
        for (int i = tid; i < 9 * 64; i += NT) {
            const int r = i >> 6, kk = i & 63;
            const float v = (r < 8) ? p.c[r * 1024 + ks * 64 + kk] : p.c_ctx[ks * 64 + kk];
            sil[i] = v * sigmoidf_(v);
        }
        __syncthreads();
        const int n = cb * 512 + tid;
        float acc[9];
#pragma unroll
        for (int r = 0; r < 9; ++r) acc[r] = 0.f;
        for (int kk = 0; kk < 64; ++kk) {
            const float w = p.w_mod[(size_t)(ks * 64 + kk) * 6144 + n];
#pragma unroll
            for (int r = 0; r < 9; ++r) acc[r] = fmaf(sil[r * 64 + kk], w, acc[r]);
        }
#pragma unroll
        for (int r = 0; r < 9; ++r) modp[(size_t)(ks * 9 + r) * 6144 + n] = acc[r];
    }
}

DI void load_mod(const Params& p, int r, int which, float* dst) {
    const float* modp = (const float*)(p.ws + OFF_MODP);
    for (int n = threadIdx.x; n < 1024; n += NT) {
        float a = p.b_mod[which * 1024 + n];
#pragma unroll
        for (int ks = 0; ks < 16; ++ks) a += modp[(size_t)(ks * 9 + r) * 6144 + which * 1024 + n];
        dst[n] = a;
    }
}

DI void h_row2(const Params& p, const float* md, bf16_t* H, int rowA, int rowB, int lane) {
    const float* sa = rowA < NLAT ? p.x + (size_t)rowA * 1024 : p.ctx + (size_t)(rowA - NLAT) * 1024;
    const float* sbp = rowB < NLAT ? p.x + (size_t)rowB * 1024 : p.ctx + (size_t)(rowB - NLAT) * 1024;
    f32x4 va[4], vb[4]; float sa2 = 0.f, sb2 = 0.f;
#pragma unroll
    for (int j = 0; j < 4; ++j) { va[j] = *(const f32x4*)(sa + lane * 4 + 256 * j); vb[j] = *(const f32x4*)(sbp + lane * 4 + 256 * j); }
#pragma unroll
    for (int j = 0; j < 4; ++j) {
        sa2 += va[j].x * va[j].x + va[j].y * va[j].y + va[j].z * va[j].z + va[j].w * va[j].w;
        sb2 += vb[j].x * vb[j].x + vb[j].y * vb[j].y + vb[j].z * vb[j].z + vb[j].w * vb[j].w;
    }
    sa2 = wave_sum(sa2); sb2 = wave_sum(sb2);
    const float ra = rsqrtf(sa2 * (1.0f / 1024.0f) + EPS), rb = rsqrtf(sb2 * (1.0f / 1024.0f) + EPS);
#pragma unroll
    for (int j = 0; j < 4; ++j) {
        const int col = lane * 4 + 256 * j;
        const f32x4 g = *(const f32x4*)(p.pre_norm1 + col);
        const f32x4 sh = *(const f32x4*)(md + col), sc = *(const f32x4*)(md + 1024 + col);
        float oa[4], ob[4];
#pragma unroll
        for (int e = 0; e < 4; ++e) { const float gm = g[e] * (1.f + sc[e]); oa[e] = va[j][e] * ra * gm + sh[e]; ob[e] = vb[j][e] * rb * gm + sh[e]; }
        uint2 o; o.x = pk2(oa[0], oa[1]); o.y = pk2(oa[2], oa[3]);
        *(uint2*)(H + (size_t)rowA * 1024 + col) = o;
        o.x = pk2(ob[0], ob[1]); o.y = pk2(ob[2], ob[3]);
        *(uint2*)(H + (size_t)rowB * 1024 + col) = o;
    }
}

DI void phase_h(const Params& p, char* smem) {
    float* md = (float*)smem;
    const int tid = get_tid(), lane = tid & 63, w = tid >> 6;
    bf16_t* H = (bf16_t*)(p.ws + R_H);
    for (int tile = blockIdx.x; tile < 256; tile += gridDim.x) {
        __syncthreads();
        load_mod(p, tile >> 5, 0, md); load_mod(p, tile >> 5, 1, md + 1024);
        __syncthreads();
        for (int i = 0; i < 16; ++i) h_row2(p, md, H, tile * 256 + w * 32 + i, tile * 256 + w * 32 + 16 + i, lane);
    }
    __syncthreads();
    load_mod(p, 8, 0, md); load_mod(p, 8, 1, md + 1024);
    __syncthreads();
    for (int r2 = blockIdx.x * 8 + w; r2 < 1024; r2 += gridDim.x * 8) h_row2(p, md, H, NLAT + 2 * r2, NLAT + 2 * r2 + 1, lane);
}

typedef __attribute__((address_space(3))) unsigned lds_u32;
DI lds_u32* to_lds(const void* p) { return (lds_u32*)(unsigned)(size_t)p; }
#define GLDS16(src, dst) __builtin_amdgcn_global_load_lds((const unsigned*)(src), to_lds(dst), 16, 0, 0)

#define MFMA16(a, b, c) __builtin_amdgcn_mfma_f32_16x16x32_bf16((a), (b), (c), 0, 0, 0)
template <bool SWAP, class Epi>
DI void gemm_tile(const bf16_t* A, int lda, const bf16_t* B, int ldb, int K, int m0, int n0, bool first, bool has_next, int nm0, int nn0, char* smem, Epi& epi) {
    const int tid = get_tid(), lane = tid & 63, w = tid >> 6, wm = w >> 2, wn = w & 3, l15 = lane & 15, q = lane >> 4;
    f32x4 acc[8][4];
#pragma unroll
    for (int i = 0; i < 8; ++i)
#pragma unroll
        for (int j = 0; j < 4; ++j) acc[i][j] = (f32x4){0.f, 0.f, 0.f, 0.f};
    const int srow = 8 * w + (lane >> 3), schunk = (lane & 7) ^ (4 * (w & 1) + (lane >> 4));
    const bf16_t* ga = A + (size_t)(m0 + srow) * lda + schunk * 8;
    const bf16_t* gb = B + (size_t)(n0 + srow) * ldb + schunk * 8;
    const bf16_t* nga = A + (size_t)(nm0 + srow) * lda + schunk * 8;
    const bf16_t* ngb = B + (size_t)(nn0 + srow) * ldb + schunk * 8;
    const int sw = (l15 >> 1) & 7;
    const int aofs = (128 * wm + l15) * 128, bofs = 32768 + (64 * wn + l15) * 128;
    char* sdst = smem + w * 1024;
#define GEMM_STAGE(pa, pb, buf, kt_) do { _Pragma("unroll") for (int i = 0; i < 4; ++i) { \
        GLDS16(pa + (size_t)i * 64 * lda + (kt_) * 64, sdst + (buf) * 65536 + i * 8192); \
        GLDS16(pb + (size_t)i * 64 * ldb + (kt_) * 64, sdst + (buf) * 65536 + 32768 + i * 8192); } } while (0)
    if (first) {
        GEMM_STAGE(ga, gb, 0, 0);
        asm volatile("s_waitcnt vmcnt(0)" ::: "memory");
        __syncthreads();
    }
    const int KT = K >> 6;
    for (int kt = 0; kt < KT; ++kt) {
        const int cur = kt & 1;
        if (kt + 1 < KT) GEMM_STAGE(ga, gb, cur ^ 1, kt + 1);
        else if (has_next) GEMM_STAGE(nga, ngb, cur ^ 1, 0);
        const char* sb = smem + cur * 65536;
#pragma unroll
        for (int kk = 0; kk < 2; ++kk) {
            const int co = ((4 * kk + q) ^ sw) << 4;
            bf16x8 af[8], bf[4];
#pragma unroll
            for (int mi = 0; mi < 8; ++mi) af[mi] = *(const bf16x8*)(sb + aofs + mi * 2048 + co);
#pragma unroll
            for (int ni = 0; ni < 4; ++ni) bf[ni] = *(const bf16x8*)(sb + bofs + ni * 2048 + co);
#pragma unroll
            for (int mi = 0; mi < 8; ++mi)
#pragma unroll
                for (int ni = 0; ni < 4; ++ni) acc[mi][ni] = SWAP ? MFMA16(af[mi], bf[ni], acc[mi][ni]) : MFMA16(bf[ni], af[mi], acc[mi][ni]);
        }
        asm volatile("s_waitcnt vmcnt(0)" ::: "memory");
        __syncthreads();
    }
#undef GEMM_STAGE
#pragma unroll
    for (int mi = 0; mi < 8; ++mi) {
        if constexpr (SWAP) {
#pragma unroll
            for (int ni = 0; ni < 4; ++ni) epi.vt(m0 + 128 * wm + 16 * mi + 4 * q, n0 + 64 * wn + 16 * ni + l15, acc[mi][ni]);
        } else epi(m0 + 128 * wm + 16 * mi + l15, n0 + 64 * wn, acc[mi], q);
        asm volatile("" ::: "memory");
    }
}

DI void tile_map(int id, int MT, int NTl, int& mt, int& nt) {
    const int x = id & 7, local = id >> 3, mtx = MT >> 3;
    const int full = mtx >> 2, per = 4 * NTl;
    int patch = local / per, wv = local - patch * per, pm = 4;
    if (patch >= full) { patch = full; wv = local - full * per; pm = mtx - full * 4; }
    const int mo = wv % pm; nt = wv / pm;
    mt = (patch * 4 + mo) * 8 + x;
}

DI void tile_map_in(int id, int& mt, int& nt) {
    if (id < 8448) { tile_map(id, 256, 33, mt, nt); return; }
    const int id2 = id - 8448, k = id2 >> 3;
    mt = 256 + (id2 & 7);
    nt = k < 8 ? 4 + k : k < 10 ? 14 + (k - 8) : k < 14 ? 16 + (k - 10) : 32;
}
template <bool VSWAP, class Epi>
DI void gemm_phase_ex(const bf16_t* A, int lda, const bf16_t* B, int ldb, int K, int MT, int NTl, char* smem, Epi& epi, int bid, int nblk) {
    const int total = VSWAP ? 8448 + 120 : MT * NTl;
    bool first = true;
    for (int id = bid; id < total; id += nblk) {
        int mt, nt, mt2 = 0, nt2 = 0;
        if (VSWAP) tile_map_in(id, mt, nt); else tile_map(id, MT, NTl, mt, nt);
        const bool has_next = id + nblk < total;
        if (has_next) { if (VSWAP) tile_map_in(id + nblk, mt2, nt2); else tile_map(id + nblk, MT, NTl, mt2, nt2); }
        if constexpr (VSWAP) { if (Epi::is_vt(nt)) { gemm_tile<true>(A, lda, B, ldb, K, mt * 256, nt * 256, first, has_next, mt2 * 256, nt2 * 256, smem, epi); first = false; continue; } }
        gemm_tile<false>(A, lda, B, ldb, K, mt * 256, nt * 256, first, has_next, mt2 * 256, nt2 * 256, smem, epi);
        first = false;
    }
}
template <class Epi>
DI void gemm_phase(const bf16_t* A, int lda, const bf16_t* B, int ldb, int K, int MT, int NTl, char* smem, Epi& epi) {
    gemm_phase_ex<false>(A, lda, B, ldb, K, MT, NTl, smem, epi, blockIdx.x, gridDim.x);
}

DI float xhalf_max(float v) {
    typedef unsigned u32x2 __attribute__((ext_vector_type(2)));
    const unsigned u = __float_as_uint(v);
    const u32x2 r = __builtin_amdgcn_permlane32_swap(u, u, false, false);
    return fmaxf(__uint_as_float(r[0]), __uint_as_float(r[1]));
}
DI float xhalf_sum(float v) {
    typedef unsigned u32x2 __attribute__((ext_vector_type(2)));
    const unsigned u = __float_as_uint(v);
    const u32x2 r = __builtin_amdgcn_permlane32_swap(u, u, false, false);
    return __uint_as_float(r[0]) + __uint_as_float(r[1]);
}
template <class Epi>
DI void gemm_panel(const bf16_t* A, int lda, const bf16_t* B, int ldb, int K, int panel, int NTl, char* smem, Epi& epi) {
    for (int nt = 0; nt < NTl; ++nt)
        gemm_tile<false>(A, lda, B, ldb, K, panel * 256, nt * 256, nt == 0, nt + 1 < NTl, panel * 256, (nt + 1) * 256, smem, epi);
}

DI float quad_sum(float v) { v += __shfl_xor(v, 16); v += __shfl_xor(v, 32); return v; }
struct EpiIn {
    bf16_t *Q, *Kk, *Vt, *gq, *gk, *gvT, *sg, *mg; float* glow; const float* rope; float* kmax;
    static DI bool is_vt(int nt) { return (nt >= 8 && nt < 12) || (nt >= 16 && nt < 20); }
    DI void vt(int row0, int col, const f32x4& v) const {
        int b, t;
        if (row0 < NLAT) { b = row0 >> 13; t = row0 & 8191; } else { const int r2 = row0 - NLAT; b = r2 >> 8; t = TLAT + (r2 & 255); }
        bf16_t* dst;
        if (col < 3072) { const int c = col - 2048; dst = Vt + (size_t)((b * 8 + (c >> 7)) * 128 + (c & 127)) * TKV + t; }
        else { const int c = col - 4096; dst = gvT + (size_t)((b * 4 + (c >> 8)) * 256 + (c & 255)) * TKV + t; }
        uint2 u; u.x = pk2(v[0], v[1]); u.y = pk2(v[2], v[3]);
        *(uint2*)dst = u;
    }
    DI void operator()(int row, int cb, const f32x4 (&v)[4], int q) const {
        if (cb >= 8224) return;
        const bool lat = row < NLAT;
        int b, t;
        if (lat) { b = row >> 13; t = row & 8191; } else { const int r2 = row - NLAT; b = r2 >> 8; t = TLAT + (r2 & 255); }
        if (cb < 2048) {
            const bool isq = cb < 1024;
            if (isq && !lat) return;
            const int c = cb & 1023, head = c >> 7, comp = (c >> 6) & 1;
            f32x4 o[4];
            if (lat) {
#pragma unroll
                for (int half = 0; half < 2; ++half) {
                    const int pos = half ? (t & 63) : (t >> 6);
                    const f32x4 c4 = *(const f32x4*)(rope + pos * 16 + 4 * q), s4 = *(const f32x4*)(rope + 2048 + pos * 16 + 4 * q);
#pragma unroll
                    for (int j = 0; j < 4; ++j) {
                        const float x1 = v[2 * half][j], x2 = v[2 * half + 1][j];
                        o[2 * half][j] = x1 * c4[j] - x2 * s4[j];
                        o[2 * half + 1][j] = x2 * c4[j] + x1 * s4[j];
                    }
                }
            } else {
#pragma unroll
                for (int ni = 0; ni < 4; ++ni) o[ni] = v[ni];
            }
            if (!isq) {
#pragma unroll
                for (int half = 0; half < 2; ++half) {
                    float ssq = 0.f;
#pragma unroll
                    for (int j = 0; j < 4; ++j) ssq += o[2 * half][j] * o[2 * half][j] + o[2 * half + 1][j] * o[2 * half + 1][j];
                    ssq = quad_sum(ssq);
#pragma unroll
                    for (int of = 8; of >= 1; of >>= 1) ssq = fmaxf(ssq, __shfl_xor(ssq, of));
                    if ((threadIdx.x & 63) == 0) atomicMax((unsigned*)(kmax + ((b * 8 + head) * 2 + comp) * 2 + half), __float_as_uint(ssq));
                }
            }
            const float scl = isq ? 0.125f * 1.4426950408889634f : 1.0f;
            bf16_t* dst = isq ? Q + ((size_t)((b * 8 + head) * 2 + comp) * TLAT + t) * 64 : Kk + ((size_t)((b * 8 + head) * 2 + comp) * TKV + t) * 64;
#pragma unroll
            for (int ni = 0; ni < 4; ++ni) {
                uint2 u; u.x = pk2(o[ni][0] * scl, o[ni][1] * scl); u.y = pk2(o[ni][2] * scl, o[ni][3] * scl);
                *(uint2*)(dst + 16 * ni + 4 * q) = u;
            }
        } else if (cb < 3072) {
        } else if (cb < 4096) {
            const bool isq = cb < 3584;
            if (isq && !lat) return;
            const int c = (cb - 3072) & 511;
            const float scl = isq ? 0.08838834764831845f : 1.0f;
            bf16_t* dst = (isq ? gq : gk) + (size_t)row * 512 + c;
#pragma unroll
            for (int ni = 0; ni < 4; ++ni) {
                uint2 u; u.x = pk2(v[ni][0] * scl, v[ni][1] * scl); u.y = pk2(v[ni][2] * scl, v[ni][3] * scl);
                *(uint2*)(dst + 16 * ni + 4 * q) = u;
            }
        } else if (cb < 5120) {
        } else if (cb < 6144) {
            if (!lat) return;
            bf16_t* dst = sg + (size_t)row * 1024 + (cb - 5120);
#pragma unroll
            for (int ni = 0; ni < 4; ++ni) {
                float s[4];
#pragma unroll
                for (int j = 0; j < 4; ++j) { const float xx = v[ni][j]; s[j] = xx * sigmoidf_(xx); }
                uint2 u; u.x = pk2(s[0], s[1]); u.y = pk2(s[2], s[3]);
                *(uint2*)(dst + 16 * ni + 4 * q) = u;
            }
        } else if (cb < 8192) {
            if (!lat) return;
            bf16_t* dst = mg + (size_t)row * 2048 + (cb - 6144);
#pragma unroll
            for (int ni = 0; ni < 4; ++ni) {
                uint2 u; u.x = pk2(sigmoidf_(v[ni][0]), sigmoidf_(v[ni][1])); u.y = pk2(sigmoidf_(v[ni][2]), sigmoidf_(v[ni][3]));
                *(uint2*)(dst + 16 * ni + 4 * q) = u;
            }
        } else {
            float* dst = glow + (size_t)row * 32;
#pragma unroll
            for (int ni = 0; ni < 2; ++ni) *(f32x4*)(dst + 16 * ni + 4 * q) = v[ni];
        }
    }
};

struct EpiGate0 {
    bf16_t* mg;
    DI void operator()(int row, int cb, const f32x4 (&v)[4], int q) const {
#pragma unroll
        for (int ni = 0; ni < 4; ++ni) {
            const int col = cb + 16 * ni + 4 * q;
            const uint2 m = *(const uint2*)(mg + (size_t)row * 2048 + col);
            uint2 u; u.x = pk2(v[ni][0] * bflo(m.x), v[ni][1] * bfhi(m.x)); u.y = pk2(v[ni][2] * bflo(m.y), v[ni][3] * bfhi(m.y));
            *(uint2*)(mg + (size_t)row * 2048 + col) = u;
        }
    }
};
struct EpiGate1 {
    bf16_t* Y; const bf16_t* mg;
    DI void operator()(int row, int cb, const f32x4 (&v)[4], int q) const {
#pragma unroll
        for (int ni = 0; ni < 4; ++ni) {
            const int col = cb + 16 * ni + 4 * q;
            const uint2 m = *(const uint2*)(mg + (size_t)row * 2048 + 1024 + col);
            const uint2 pr = *(const uint2*)(mg + (size_t)row * 2048 + col);
            uint2 u; u.x = pk2(bflo(pr.x) + v[ni][0] * bflo(m.x), bfhi(pr.x) + v[ni][1] * bfhi(m.x));
            u.y = pk2(bflo(pr.y) + v[ni][2] * bflo(m.y), bfhi(pr.y) + v[ni][3] * bfhi(m.y));
            *(uint2*)(Y + (size_t)row * 1024 + col) = u;
        }
    }
};
template <int ACT>
struct EpiStore {
    bf16_t* O; int ldo;
    DI void operator()(int row, int cb, const f32x4 (&v)[4], int q) const {
#pragma unroll
        for (int ni = 0; ni < 4; ++ni) {
            float s[4];
#pragma unroll
            for (int j = 0; j < 4; ++j) { float xx = v[ni][j]; if (ACT == 1) { xx = fmaxf(xx, 0.f); xx = xx * xx; } s[j] = xx; }
            uint2 u; u.x = pk2(s[0], s[1]); u.y = pk2(s[2], s[3]);
            *(uint2*)(O + (size_t)row * ldo + cb + 16 * ni + 4 * q) = u;
        }
    }
};

DI int kappa(int r) { return (r & ~12) | ((r & 4) << 1) | ((r & 8) >> 1); }

DI float max16(const f32x16& s) {
    const float a = fmaxf(fmaxf(fmaxf(s[0], s[1]), fmaxf(s[2], s[3])), fmaxf(fmaxf(s[4], s[5]), fmaxf(s[6], s[7])));
    const float b = fmaxf(fmaxf(fmaxf(s[8], s[9]), fmaxf(s[10], s[11])), fmaxf(fmaxf(s[12], s[13]), fmaxf(s[14], s[15])));
    return fmaxf(a, b);
}

template <bool FAST>
DI void attn_kloop(char* smem, char* sdst, const bf16_t* gk0, const bf16_t* gk1, const bf16_t* gv, int comp, int krow, int ksw, int vsw, int l31, int hh,
                   const bf16x8 (&qf)[4], f32x16 (&O)[4], float& m, float& l) {
#define ATT_STAGE(buf, kt_) do { _Pragma("unroll") for (int jj = 0; jj < 2; ++jj) { \
            GLDS16(gk0 + (size_t)((kt_) * 128 + 64 * jj) * 64, sdst + (buf) * 65536 + jj * 8192); \
            GLDS16(gk1 + (size_t)((kt_) * 128 + 64 * jj) * 64, sdst + (buf) * 65536 + 16384 + jj * 8192); } \
            _Pragma("unroll") for (int jj = 0; jj < 4; ++jj) GLDS16(gv + (size_t)(32 * jj) * TKV + (kt_) * 128, sdst + (buf) * 65536 + 32768 + jj * 8192); } while (0)
    ATT_STAGE(0, 0);
    asm volatile("s_waitcnt vmcnt(0)" ::: "memory");
    __syncthreads();
    f32x16 sinit;
#pragma unroll
    for (int e = 0; e < 16; ++e) sinit[e] = FAST ? -m : 0.f;
    constexpr int NKT = TKV / 128;
    for (int kt = 0; kt < NKT; ++kt) {
        const int cur = kt & 1;
        if (kt + 1 < NKT) ATT_STAGE(cur ^ 1, kt + 1);
        const char* sb = smem + cur * 65536;
        const char* skc = sb + comp * 16384;
        if (FAST) {
            bf16x8 kf[4];
#pragma unroll
            for (int ks = 0; ks < 4; ++ks) kf[ks] = *(const bf16x8*)(skc + krow * 128 + (((2 * ks + hh) ^ ksw) << 4));
            f32x16 Sn = MFMA32(kf[0], qf[0], sinit);
            Sn = MFMA32(kf[1], qf[1], Sn); Sn = MFMA32(kf[2], qf[2], Sn); Sn = MFMA32(kf[3], qf[3], Sn);
#pragma unroll
            for (int sub = 0; sub < 4; ++sub) {
                const f32x16 Sc = Sn;
                bf16x8 va[4], vb[4];
#pragma unroll
                for (int dt = 0; dt < 4; ++dt) va[dt] = *(const bf16x8*)(sb + 32768 + (32 * dt + l31) * 256 + (((4 * sub + hh) ^ vsw) << 4));
                if (sub < 3) {
#pragma unroll
                    for (int ks = 0; ks < 4; ++ks) kf[ks] = *(const bf16x8*)(skc + (32 * (sub + 1) + krow) * 128 + (((2 * ks + hh) ^ ksw) << 4));
                }
                __builtin_amdgcn_sched_barrier(0);
                float pv[16];
#pragma unroll
                for (int e = 0; e < 16; ++e) { pv[e] = __builtin_amdgcn_exp2f(Sc[e]); l += pv[e]; }
                typedef unsigned u32x4 __attribute__((ext_vector_type(4)));
                const u32x4 ua = {pk2(pv[0], pv[1]), pk2(pv[2], pv[3]), pk2(pv[4], pv[5]), pk2(pv[6], pv[7])};
                const u32x4 ub = {pk2(pv[8], pv[9]), pk2(pv[10], pv[11]), pk2(pv[12], pv[13]), pk2(pv[14], pv[15])};
                const bf16x8 pb0 = __builtin_bit_cast(bf16x8, ua), pb1 = __builtin_bit_cast(bf16x8, ub);
#pragma unroll
                for (int dt = 0; dt < 4; ++dt) vb[dt] = *(const bf16x8*)(sb + 32768 + (32 * dt + l31) * 256 + (((4 * sub + 2 + hh) ^ vsw) << 4));
                __builtin_amdgcn_sched_barrier(0);
                if (sub < 3) {
                    O[0] = MFMA32(va[0], pb0, O[0]); Sn = MFMA32(kf[0], qf[0], sinit);
                    O[1] = MFMA32(va[1], pb0, O[1]); Sn = MFMA32(kf[1], qf[1], Sn);
                    O[2] = MFMA32(va[2], pb0, O[2]); Sn = MFMA32(kf[2], qf[2], Sn);
                    O[3] = MFMA32(va[3], pb0, O[3]); Sn = MFMA32(kf[3], qf[3], Sn);
                } else {
                    O[0] = MFMA32(va[0], pb0, O[0]); O[1] = MFMA32(va[1], pb0, O[1]); O[2] = MFMA32(va[2], pb0, O[2]); O[3] = MFMA32(va[3], pb0, O[3]);
                }
                O[0] = MFMA32(vb[0], pb1, O[0]); O[1] = MFMA32(vb[1], pb1, O[1]); O[2] = MFMA32(vb[2], pb1, O[2]); O[3] = MFMA32(vb[3], pb1, O[3]);
            }
        } else {
        f32x16 S[4];
#pragma unroll
        for (int sub = 0; sub < 4; ++sub) {
#pragma unroll
            for (int ks = 0; ks < 4; ++ks) {
                const bf16x8 kf = *(const bf16x8*)(skc + (32 * sub + krow) * 128 + (((2 * ks + hh) ^ ksw) << 4));
                S[sub] = MFMA32(kf, qf[ks], ks == 0 ? sinit : S[sub]);
            }
        }
        {
            float mt = fmaxf(fmaxf(max16(S[0]), max16(S[1])), fmaxf(max16(S[2]), max16(S[3])));
            mt = xhalf_max(mt);
            if (__any(mt > m + 8.0f)) {
                const float mn = fmaxf(m, mt);
                const float al = __builtin_amdgcn_exp2f(m - mn);
                l *= al;
#pragma unroll
                for (int d = 0; d < 4; ++d)
#pragma unroll
                    for (int e = 0; e < 16; ++e) O[d][e] *= al;
                m = mn;
            }
        }
#pragma unroll
        for (int sub = 0; sub < 4; ++sub) {
            float pv[16];
#pragma unroll
            for (int e = 0; e < 16; ++e) { pv[e] = __builtin_amdgcn_exp2f(S[sub][e] - m); l += pv[e]; }
            typedef unsigned u32x4 __attribute__((ext_vector_type(4)));
            const u32x4 ua = {pk2(pv[0], pv[1]), pk2(pv[2], pv[3]), pk2(pv[4], pv[5]), pk2(pv[6], pv[7])};
            const u32x4 ub = {pk2(pv[8], pv[9]), pk2(pv[10], pv[11]), pk2(pv[12], pv[13]), pk2(pv[14], pv[15])};
            const bf16x8 pb0 = __builtin_bit_cast(bf16x8, ua), pb1 = __builtin_bit_cast(bf16x8, ub);
#pragma unroll
            for (int dt = 0; dt < 4; ++dt) {
                const char* vr = sb + 32768 + (32 * dt + l31) * 256;
                const bf16x8 v0 = *(const bf16x8*)(vr + (((4 * sub + hh) ^ vsw) << 4));
                const bf16x8 v1 = *(const bf16x8*)(vr + (((4 * sub + 2 + hh) ^ vsw) << 4));
                O[dt] = MFMA32(v0, pb0, O[dt]);
                O[dt] = MFMA32(v1, pb1, O[dt]);
            }
        }
        }
        asm volatile("s_waitcnt vmcnt(0)" ::: "memory");
        __syncthreads();
    }
#undef ATT_STAGE
}

DI void phase_attn(const Params& p, char* smem) {
    const int tid = get_tid(), lane = tid & 63, w = tid >> 6, l31 = lane & 31, hh = lane >> 5;
    const int g = w >> 1, comp = w & 1;
    const bf16_t* Q = (const bf16_t*)(p.ws + R_Q);
    const bf16_t* Kk = (const bf16_t*)(p.ws + R_K);
    const bf16_t* Vt = (const bf16_t*)(p.ws + R_VT);
    const float* kmax = (const float*)(p.ws + OFF_KMAX);
    bf16_t* YDA = (bf16_t*)(p.ws + R_H);
    float d1 = 0.f, d2 = 0.f;
    for (int i = 0; i < 64; ++i) { d1 += p.lq1[i] * p.lk1[i]; d2 += p.lq2[i] * p.lk2[i]; }
    const float lam = __expf(d1) - __expf(d2) + 0.2f;
    const int krs = 8 * w + (lane >> 3), kcs = (lane & 7) ^ (4 * (w & 1) + (lane >> 4));
    const int vrs = 4 * w + (lane >> 4), vcs = (lane & 15) ^ ((4 * w + (lane >> 4)) & 15);
    const int krow = kappa(l31);
    const int ksw = (krow >> 1) & 7, vsw = l31 & 15;
    float* xbuf = (float*)smem + g * 4096;
    char* sdst = smem + w * 1024;
    for (int id = blockIdx.x; id < 4096; id += gridDim.x) {
        const int x = id & 7, j = id >> 3, bh = (j >> 6) * 8 + x, qt = j & 63;
        const int b = bh >> 3, h = bh & 7;
        const bf16_t* qp = Q + ((size_t)(bh * 2 + comp) * TLAT + qt * 128 + g * 32 + l31) * 64 + hh * 8;
        bf16x8 qf[4];
#pragma unroll
        for (int ks = 0; ks < 4; ++ks) qf[ks] = *(const bf16x8*)(qp + ks * 16);
        float qn = 0.f;
#pragma unroll
        for (int ks = 0; ks < 4; ++ks)
#pragma unroll
            for (int e = 0; e < 8; ++e) { const float qv = __uint_as_float(((unsigned)(unsigned short)qf[ks][e]) << 16); qn += qv * qv; }
        qn = xhalf_sum(qn);
        const float kb = sqrtf(kmax[(bh * 2 + comp) * 2] + kmax[(bh * 2 + comp) * 2 + 1]);
        const float mb = sqrtf(qn) * kb * 1.01f + 1e-3f;
        const bf16_t* gk0 = Kk + ((size_t)(bh * 2 + 0) * TKV + krs) * 64 + kcs * 8;
        const bf16_t* gk1 = gk0 + (size_t)TKV * 64;
        const bf16_t* gv = Vt + ((size_t)bh * 128 + vrs) * TKV + vcs * 8;
        f32x16 O[4];
#pragma unroll
        for (int d = 0; d < 4; ++d)
#pragma unroll
            for (int e = 0; e < 16; ++e) O[d][e] = 0.f;
        float m, l = 0.f;
        const int slow = __syncthreads_or(!(mb <= 60.0f));
        if (!slow) { m = mb; attn_kloop<true>(smem, sdst, gk0, gk1, gv, comp, krow, ksw, vsw, l31, hh, qf, O, m, l); }
        else { m = -INFINITY; attn_kloop<false>(smem, sdst, gk0, gk1, gv, comp, krow, ksw, vsw, l31, hh, qf, O, m, l); }
        l = xhalf_sum(l);
        if (comp == 1) {
            const float i1 = lam / l;
#pragma unroll
            for (int d = 0; d < 4; ++d)
#pragma unroll
                for (int e = 0; e < 16; ++e) xbuf[(d * 16 + e) * 64 + lane] = O[d][e] * i1;
        }
        __syncthreads();
        if (comp == 0) {
            const float i0 = 1.0f / l;
            float ss = 0.f;
#pragma unroll
            for (int d = 0; d < 4; ++d)
#pragma unroll
                for (int e = 0; e < 16; ++e) { const float o = O[d][e] * i0 - xbuf[(d * 16 + e) * 64 + lane]; O[d][e] = o; ss += o * o; }
            ss = xhalf_sum(ss);
            const float rs = rsqrtf(ss * (1.0f / 128.0f) + EPS) * 0.8f;
            const int t = qt * 128 + g * 32 + l31;
            bf16_t* dst = YDA + ((size_t)b * TLAT + t) * 1024 + h * 128;
#pragma unroll
            for (int d = 0; d < 4; ++d)
#pragma unroll
                for (int gg = 0; gg < 4; ++gg) {
                    const int dv = 32 * d + 8 * gg + 4 * hh;
                    const f32x4 hn = *(const f32x4*)(p.da_hn + dv);
                    uint2 u; u.x = pk2(O[d][4 * gg] * rs * hn.x, O[d][4 * gg + 1] * rs * hn.y); u.y = pk2(O[d][4 * gg + 2] * rs * hn.z, O[d][4 * gg + 3] * rs * hn.w);
                    *(uint2*)(dst + dv) = u;
                }
        }
    }
}

DI void phase_gate(const Params& p, char* smem) {
    const int tid = get_tid();
    const float* glow = (const float*)(p.ws + OFF_GLOW);
    float* sg = (float*)smem;
    float wf[16], wb[16];
#pragma unroll
    for (int r = 0; r < 16; ++r) { wf[r] = p.w_gate_up[(size_t)r * 512 + tid]; wb[r] = p.w_gate_up[(size_t)(16 + r) * 512 + tid]; }
    const float biasf = p.b_gate_up[tid], biasb = p.b_gate_up[512 + tid];
    _Float16* BF = (_Float16*)(p.ws + R_BF);
    _Float16* BB = (_Float16*)(p.ws + R_BB);
    for (int ch = blockIdx.x; ch < 1056; ch += gridDim.x) {
        __syncthreads();
        *(f32x4*)(sg + tid * 4) = *(const f32x4*)(glow + (size_t)ch * 2048 + tid * 4);
        __syncthreads();
        float run = 0.f;
#pragma unroll 4
        for (int i = 0; i < 64; ++i) {
            const float* gl = sg + i * 32;
            float a = biasf;
#pragma unroll
            for (int r = 0; r < 16; ++r) a = fmaf(gl[r], wf[r], a);
            const float ls = fminf(a, 0.f) - __logf(1.0f + __expf(-fabsf(a)));
            run += ls * (1.0f / 16.0f);
            BF[(size_t)(ch * 64 + i) * 512 + tid] = (_Float16)run;
        }
        run = 0.f;
#pragma unroll 4
        for (int i = 63; i >= 0; --i) {
            const float* gl = sg + i * 32 + 16;
            float a = biasb;
#pragma unroll
            for (int r = 0; r < 16; ++r) a = fmaf(gl[r], wb[r], a);
            const float ls = fminf(a, 0.f) - __logf(1.0f + __expf(-fabsf(a)));
            run += ls * (1.0f / 16.0f);
            BB[(size_t)(ch * 64 + i) * 512 + tid] = (_Float16)run;
        }
    }
}

struct GlaRegs { uint2 k[2][2], q[2][2], bb[2][2], bl[2][2]; uint4 v[4]; };

DI void phase_gla(const Params& p, char* smem) {
    const int tid = get_tid(), lane = tid & 63, w = tid >> 6, l31 = lane & 31, hh = lane >> 5;
    const int unit = blockIdx.x, dir = unit & 1, bh = unit >> 1, b = bh >> 2, h = bh & 3;
    const bf16_t* gq = (const bf16_t*)(p.ws + R_GQ);
    const bf16_t* gk = (const bf16_t*)(p.ws + R_GK);
    const bf16_t* gvT = (const bf16_t*)(p.ws + R_GVT) + (size_t)bh * 256 * TKV;
    const _Float16* B16 = (const _Float16*)(p.ws + (dir ? R_BB : R_BF));
    bf16_t* Oo = (bf16_t*)(p.ws + (dir ? R_OB : R_OF));
    char* sQt = smem;
    char* sKt = smem + 16384;
    char* sKh = smem + 32768;
    char* sVT = smem + 49152;
    char* sA = smem + 81920;
    float* sD = (float*)(smem + 90112);
    f32x16 S[4];
#pragma unroll
    for (int k = 0; k < 4; ++k)
#pragma unroll
        for (int e = 0; e < 16; ++e) S[k][e] = 0.f;
    const int sw = (l31 >> 1) & 7;
    GlaRegs R;
    auto chunk_info = [&](int step, int& rowbase, int& tcol, bool& emit) {
        if (step < 4) { const int cc = dir ? 3 - step : step; rowbase = NLAT + b * 256 + cc * 64; tcol = TLAT + cc * 64; emit = false; }
        else { const int cc = dir ? 127 - (step - 4) : step - 4; rowbase = b * TLAT + cc * 64; tcol = cc * 64; emit = true; }
    };
    auto load_chunk = [&](int step) {
        int rowbase, tcol; bool emit; chunk_info(step, rowbase, tcol, emit);
        const int rl = rowbase + (dir ? 0 : 63);
#pragma unroll
        for (int i = 0; i < 2; ++i) {
            const int item = tid + NT * i, tok = item >> 4, c = item & 15, d0 = 16 * (c >> 1) + 4 * (c & 1);
            const size_t ro = (size_t)(rowbase + tok) * 512 + h * 128 + d0;
            R.k[i][0] = *(const uint2*)(gk + ro); R.k[i][1] = *(const uint2*)(gk + ro + 8);
            if (emit) { R.q[i][0] = *(const uint2*)(gq + ro); R.q[i][1] = *(const uint2*)(gq + ro + 8); }
            else { R.q[i][0] = make_uint2(0, 0); R.q[i][1] = make_uint2(0, 0); }
            R.bb[i][0] = *(const uint2*)(B16 + ro); R.bb[i][1] = *(const uint2*)(B16 + ro + 8);
            const size_t rlo = (size_t)rl * 512 + h * 128 + d0;
            R.bl[i][0] = *(const uint2*)(B16 + rlo); R.bl[i][1] = *(const uint2*)(B16 + rlo + 8);
        }
#pragma unroll
        for (int i = 0; i < 4; ++i) R.v[i] = *(const uint4*)(gvT + (size_t)((tid >> 3) + 64 * i) * TKV + tcol + (tid & 7) * 8);
    };
    auto stage_chunk = [&]() {
#pragma unroll
        for (int i = 0; i < 2; ++i) {
            const int item = tid + NT * i, tok = item >> 4, c = item & 15, d0 = 16 * (c >> 1) + 4 * (c & 1);
            float qo[8], ko[8];
#pragma unroll
            for (int g = 0; g < 2; ++g) {
                const h4_t bv = __builtin_bit_cast(h4_t, R.bb[i][g]), lv = __builtin_bit_cast(h4_t, R.bl[i][g]);
                const float kk[4] = {bflo(R.k[i][g].x), bfhi(R.k[i][g].x), bflo(R.k[i][g].y), bfhi(R.k[i][g].y)};
                const float qq[4] = {bflo(R.q[i][g].x), bfhi(R.q[i][g].x), bflo(R.q[i][g].y), bfhi(R.q[i][g].y)};
#pragma unroll
                for (int j = 0; j < 4; ++j) {
                    const float bb = (float)bv[j], bl = (float)lv[j];
                    qo[4 * g + j] = qq[j] * __expf(bb);
                    ko[4 * g + j] = kk[j] * __expf(-bb);
                    const float kh = kk[j] * __expf(bl - bb);
                    const int dk = d0 + 8 * g + j;
                    *(bf16_t*)(sKh + dk * 128 + ((((tok >> 3) ^ ((dk >> 1) & 7))) << 4) + (tok & 7) * 2) = bf1(kh);
                    if (tok == 0) sD[dk] = __expf(bl);
                }
            }
            const int po = tok * 256 + ((c ^ (tok & 15)) << 4);
            uint4 uq, uk;
            uq.x = pk2(qo[0], qo[1]); uq.y = pk2(qo[2], qo[3]); uq.z = pk2(qo[4], qo[5]); uq.w = pk2(qo[6], qo[7]);
            uk.x = pk2(ko[0], ko[1]); uk.y = pk2(ko[2], ko[3]); uk.z = pk2(ko[4], ko[5]); uk.w = pk2(ko[6], ko[7]);
            *(uint4*)(sQt + po) = uq; *(uint4*)(sKt + po) = uk;
        }
#pragma unroll
        for (int i = 0; i < 4; ++i) {
            const int row = (tid >> 3) + 64 * i, scn = tid & 7;
            *(uint4*)(sVT + row * 128 + ((scn ^ ((row >> 1) & 7)) << 4)) = R.v[i];
        }
    };
    load_chunk(0);
    for (int step = 0; step < 132; ++step) {
        int rowbase, tcol; bool emit; chunk_info(step, rowbase, tcol, emit);
        stage_chunk();
        __syncthreads();
        if (step + 1 < 132) load_chunk(step + 1);
        const int dvb = 32 * w;
        if (emit) {
            if (w < 4) {
                const int ti = w >> 1, tj = w & 1;
                f32x16 a;
#pragma unroll
                for (int e = 0; e < 16; ++e) a[e] = 0.f;
                const bool dead = dir ? (tj < ti) : (tj > ti);
                if (!dead) {
#pragma unroll
                    for (int ks = 0; ks < 8; ++ks) {
                        const int ri = 32 * ti + l31, rj = 32 * tj + l31, c = 2 * ks + hh;
                        const bf16x8 af = *(const bf16x8*)(sQt + ri * 256 + ((c ^ (ri & 15)) << 4));
                        const bf16x8 bf = *(const bf16x8*)(sKt + rj * 256 + ((c ^ (rj & 15)) << 4));
                        a = MFMA32(af, bf, a);
                    }
                }
                const int jj = 32 * tj + l31;
#pragma unroll
                for (int e = 0; e < 16; ++e) {
                    const int ii = 32 * ti + (e & 3) + 8 * (e >> 2) + 4 * hh;
                    const bool keep = dir ? (jj >= ii) : (jj <= ii);
                    *(bf16_t*)(sA + ii * 128 + ((((jj >> 3) ^ ((ii >> 1) & 7))) << 4) + (jj & 7) * 2) = bf1(keep ? a[e] : 0.f);
                }
            }
            f32x16 o[2];
#pragma unroll
            for (int mt = 0; mt < 2; ++mt)
#pragma unroll
                for (int e = 0; e < 16; ++e) o[mt][e] = 0.f;
#pragma unroll
            for (int kt = 0; kt < 4; ++kt)
#pragma unroll
                for (int s = 0; s < 2; ++s) {
                    typedef unsigned u32x4 __attribute__((ext_vector_type(4)));
                    u32x4 pu = {pk2(S[kt][8 * s], S[kt][8 * s + 1]), pk2(S[kt][8 * s + 2], S[kt][8 * s + 3]), pk2(S[kt][8 * s + 4], S[kt][8 * s + 5]), pk2(S[kt][8 * s + 6], S[kt][8 * s + 7])};
                    const bf16x8 sf = __builtin_bit_cast(bf16x8, pu);
#pragma unroll
                    for (int mt = 0; mt < 2; ++mt) {
                        const int ri = 32 * mt + l31, c = 4 * kt + 2 * s + hh;
                        const bf16x8 af = *(const bf16x8*)(sQt + ri * 256 + ((c ^ (ri & 15)) << 4));
                        o[mt] = MFMA32(af, sf, o[mt]);
                    }
                }
            __syncthreads();
#pragma unroll
            for (int s2 = 0; s2 < 4; ++s2) {
                const int c = 2 * s2 + hh;
                const bf16x8 vf = *(const bf16x8*)(sVT + (dvb + l31) * 128 + ((c ^ sw) << 4));
#pragma unroll
                for (int mt = 0; mt < 2; ++mt) {
                    const bf16x8 af = *(const bf16x8*)(sA + (32 * mt + l31) * 128 + ((c ^ sw) << 4));
                    o[mt] = MFMA32(af, vf, o[mt]);
                }
            }
            bf16_t* od = Oo + (size_t)rowbase * 1024 + h * 256 + dvb + l31;
#pragma unroll
            for (int mt = 0; mt < 2; ++mt)
#pragma unroll
                for (int e = 0; e < 16; ++e) od[(size_t)(32 * mt + (e & 3) + 8 * (e >> 2) + 4 * hh) * 1024] = bf1(o[mt][e]);
        }
#pragma unroll
        for (int kt = 0; kt < 4; ++kt)
#pragma unroll
            for (int g4 = 0; g4 < 4; ++g4) {
                const f32x4 dd = *(const f32x4*)(sD + 32 * kt + 8 * g4 + 4 * hh);
#pragma unroll
                for (int jq = 0; jq < 4; ++jq) S[kt][4 * g4 + jq] *= dd[jq];
            }
#pragma unroll
        for (int s2 = 0; s2 < 4; ++s2) {
            const int c = 2 * s2 + hh;
            const bf16x8 vf = *(const bf16x8*)(sVT + (dvb + l31) * 128 + ((c ^ sw) << 4));
#pragma unroll
            for (int kt = 0; kt < 4; ++kt) {
                const bf16x8 af = *(const bf16x8*)(sKh + (32 * kt + l31) * 128 + ((c ^ sw) << 4));
                S[kt] = MFMA32(af, vf, S[kt]);
            }
        }
        __syncthreads();
    }
}

DI void phase_combine(const Params& p, int panel) {
    const int tid = get_tid(), lane = tid & 63, w = tid >> 6;
    const bf16_t* OF = (const bf16_t*)(p.ws + R_OF);
    const bf16_t* OB = (const bf16_t*)(p.ws + R_OB);
    const bf16_t* SG = (const bf16_t*)(p.ws + R_SG);
    bf16_t* Y = (bf16_t*)(p.ws + R_YGLA);
    for (int row = panel * 256 + w; row < panel * 256 + 256; row += 8) {
        const size_t o = (size_t)row * 1024 + lane * 16;
        const uint4 a0 = *(const uint4*)(OF + o), a1 = *(const uint4*)(OF + o + 8);
        const uint4 b0 = *(const uint4*)(OB + o), b1 = *(const uint4*)(OB + o + 8);
        const uint4 g0 = *(const uint4*)(SG + o), g1 = *(const uint4*)(SG + o + 8);
        const unsigned au[8] = {a0.x, a0.y, a0.z, a0.w, a1.x, a1.y, a1.z, a1.w};
        const unsigned bu[8] = {b0.x, b0.y, b0.z, b0.w, b1.x, b1.y, b1.z, b1.w};
        const unsigned gu[8] = {g0.x, g0.y, g0.z, g0.w, g1.x, g1.y, g1.z, g1.w};
        float v[16]; float ss = 0.f;
#pragma unroll
        for (int e = 0; e < 8; ++e) { v[2 * e] = bflo(au[e]) + bflo(bu[e]); v[2 * e + 1] = bfhi(au[e]) + bfhi(bu[e]); ss += v[2 * e] * v[2 * e] + v[2 * e + 1] * v[2 * e + 1]; }
#pragma unroll
        for (int of = 8; of >= 1; of >>= 1) ss += __shfl_xor(ss, of);
        const float rs = rsqrtf(ss * (1.0f / 256.0f) + EPS);
        const float* gn = p.gla_hn + ((lane * 16) & 255);
        unsigned ou[8];
#pragma unroll
        for (int e = 0; e < 8; ++e) ou[e] = pk2(v[2 * e] * rs * gn[2 * e] * bflo(gu[e]), v[2 * e + 1] * rs * gn[2 * e + 1] * bfhi(gu[e]));
        *(uint4*)(Y + o) = make_uint4(ou[0], ou[1], ou[2], ou[3]);
        *(uint4*)(Y + o + 8) = make_uint4(ou[4], ou[5], ou[6], ou[7]);
    }
}

template <int MODE>
DI void phase_rows(const Params& p, char* smem, int panel) {
    float* md = (float*)smem;
    const int tid = get_tid(), lane = tid & 63, w = tid >> 6;
    const bf16_t* Yin = (const bf16_t*)(p.ws + (MODE == 0 ? R_Y2 : R_Y3));
    bf16_t* H2 = (bf16_t*)(p.ws + R_H2);
    const float* pn = MODE == 0 ? p.post_norm1 : p.post_norm2;
    for (int tile = panel; tile == panel; ++tile) {
        const int r = tile >> 5;
        __syncthreads();
        if (MODE == 0) { load_mod(p, r, 2, md); load_mod(p, r, 3, md + 1024); load_mod(p, r, 4, md + 2048); }
        else load_mod(p, r, 5, md);
        __syncthreads();
        for (int i = 0; i < 32; ++i) {
            const int row = tile * 256 + w * 32 + i;
            float y[16]; float ss = 0.f;
#pragma unroll
            for (int j = 0; j < 4; ++j) {
                const uint2 u = *(const uint2*)(Yin + (size_t)row * 1024 + lane * 4 + 256 * j);
                y[4 * j] = bflo(u.x); y[4 * j + 1] = bfhi(u.x); y[4 * j + 2] = bflo(u.y); y[4 * j + 3] = bfhi(u.y);
                ss += y[4 * j] * y[4 * j] + y[4 * j + 1] * y[4 * j + 1] + y[4 * j + 2] * y[4 * j + 2] + y[4 * j + 3] * y[4 * j + 3];
            }
            ss = wave_sum(ss);
            const float rs = rsqrtf(ss * (1.0f / 1024.0f) + EPS);
            float xn[16]; float s2 = 0.f;
#pragma unroll
            for (int j = 0; j < 4; ++j) {
                const int col = lane * 4 + 256 * j;
                const float* xs = (MODE == 0 ? p.x : (const float*)p.out) + (size_t)row * 1024 + col;
                const f32x4 xv = *(const f32x4*)xs, g = *(const f32x4*)(pn + col), gt = *(const f32x4*)(md + col);
#pragma unroll
                for (int e = 0; e < 4; ++e) { xn[4 * j + e] = xv[e] + gt[e] * (y[4 * j + e] * rs * g[e]); s2 += xn[4 * j + e] * xn[4 * j + e]; }
                f32x4 ov = {xn[4 * j], xn[4 * j + 1], xn[4 * j + 2], xn[4 * j + 3]};
                *(f32x4*)(p.out + (size_t)row * 1024 + col) = ov;
            }
            if (MODE == 0) {
                s2 = wave_sum(s2);
                const float rs2 = rsqrtf(s2 * (1.0f / 1024.0f) + EPS);
#pragma unroll
                for (int j = 0; j < 4; ++j) {
                    const int col = lane * 4 + 256 * j;
                    const f32x4 g = *(const f32x4*)(p.pre_norm2 + col), sh = *(const f32x4*)(md + 1024 + col), sc = *(const f32x4*)(md + 2048 + col);
                    float o[4];
#pragma unroll
                    for (int e = 0; e < 4; ++e) o[e] = xn[4 * j + e] * rs2 * g[e] * (1.f + sc[e]) + sh[e];
                    uint2 u; u.x = pk2(o[0], o[1]); u.y = pk2(o[2], o[3]);
                    *(uint2*)(H2 + (size_t)row * 1024 + col) = u;
                }
            }
        }
    }
}

DI void gsync(unsigned* bar, unsigned k) {
    __syncthreads();
    const unsigned epoch = k * gridDim.x;
    if (threadIdx.x == 0) {
        __threadfence();
        atomicAdd(bar, 1u);
        while (__hip_atomic_load(bar, __ATOMIC_RELAXED, __HIP_MEMORY_SCOPE_AGENT) < epoch) __builtin_amdgcn_s_sleep(1);
        __threadfence();
    }
    __syncthreads();
}

__global__ void __launch_bounds__(NT) fwd_megakernel(Params p) {
    __shared__ __attribute__((aligned(16))) char smem[131072];
    cg::grid_group grid = cg::this_grid();
    char* ws = p.ws;
    unsigned* bar = (unsigned*)(ws + OFF_BAR);
    phase_prep(p, smem);
    grid.sync();
    phase_h(p, smem);
    gsync(bar, 1u);
    {
        EpiIn e; e.Q = (bf16_t*)(ws + R_Q); e.Kk = (bf16_t*)(ws + R_K); e.Vt = (bf16_t*)(ws + R_VT); e.gq = (bf16_t*)(ws + R_GQ); e.gk = (bf16_t*)(ws + R_GK);
        e.gvT = (bf16_t*)(ws + R_GVT); e.sg = (bf16_t*)(ws + R_SG); e.mg = (bf16_t*)p.out; e.glow = (float*)(ws + OFF_GLOW); e.rope = (const float*)(ws + OFF_ROPE); e.kmax = (float*)(ws + OFF_KMAX);
        gemm_phase_ex<true>((const bf16_t*)(ws + R_H), 1024, (const bf16_t*)(ws + OFF_WIN), 1024, 1024, 264, 33, smem, e, blockIdx.x, gridDim.x);
    }
    gsync(bar, 2u);
    phase_attn(p, smem);
    gsync(bar, 3u);
    phase_gate(p, smem);
    gsync(bar, 4u);
    if (blockIdx.x < 64) phase_gla(p, smem);
    else {
        EpiGate0 e0; e0.mg = (bf16_t*)p.out;
        gemm_phase_ex<false>((const bf16_t*)(ws + R_H), 1024, (const bf16_t*)(ws + OFF_WDA), 1024, 1024, 256, 4, smem, e0, blockIdx.x - 64, gridDim.x - 64);
        const long gsz2 = (long)(gridDim.x - 64) * NT, gtid2 = (long)(blockIdx.x - 64) * NT + get_tid();
        repack<0>(p.w_bgla, 1024, 1024, (bf16_t*)(ws + OFF_WGLA), 1024, gtid2, gsz2);
        repack<0>(p.w_out, 1024, 1024, (bf16_t*)(ws + OFF_WOUT), 1024, gtid2, gsz2);
        repack<0>(p.w_ff1, 1024, 4096, (bf16_t*)(ws + OFF_WFF1), 4096, gtid2, gsz2);
        repack<0>(p.w_ff2, 4096, 1024, (bf16_t*)(ws + OFF_WFF2), 1024, gtid2, gsz2);
    }
    gsync(bar, 5u);
    for (int panel = blockIdx.x; panel < 256; panel += gridDim.x) phase_combine(p, panel);
    gsync(bar, 6u);
    for (int panel = blockIdx.x; panel < 256; panel += gridDim.x) {
        { EpiGate1 e1; e1.Y = (bf16_t*)(ws + R_Y); e1.mg = (const bf16_t*)p.out;
          gemm_panel((const bf16_t*)(ws + R_YGLA), 1024, (const bf16_t*)(ws + OFF_WGLA), 1024, 1024, panel, 4, smem, e1); }
        __syncthreads();
        { EpiStore<0> e; e.O = (bf16_t*)(ws + R_Y2); e.ldo = 1024;
          gemm_panel((const bf16_t*)(ws + R_Y), 1024, (const bf16_t*)(ws + OFF_WOUT), 1024, 1024, panel, 4, smem, e); }
        __syncthreads();
        phase_rows<0>(p, smem, panel);
        __syncthreads();
        { EpiStore<1> e; e.O = (bf16_t*)(ws + R_U); e.ldo = 4096;
          gemm_panel((const bf16_t*)(ws + R_H2), 1024, (const bf16_t*)(ws + OFF_WFF1), 1024, 1024, panel, 16, smem, e); }
        __syncthreads();
        { EpiStore<0> e; e.O = (bf16_t*)(ws + R_Y3); e.ldo = 1024;
          gemm_panel((const bf16_t*)(ws + R_U), 4096, (const bf16_t*)(ws + OFF_WFF2), 4096, 4096, panel, 4, smem, e); }
        __syncthreads();
        phase_rows<1>(p, smem, panel);
        __syncthreads();
    }
}

extern "C" void kernel_launch(void* const* d_in, const int* in_sizes, int n_in, void* d_out, int out_size, void* d_ws, size_t ws_size, hipStream_t stream) {
    static int grid_blocks = 0;
    if (!grid_blocks) {
        int dev = 0, cus = 0, per_cu = 0;
        hipGetDevice(&dev);
        hipDeviceGetAttribute(&cus, hipDeviceAttributeMultiprocessorCount, dev);
        hipOccupancyMaxActiveBlocksPerMultiprocessor(&per_cu, fwd_megakernel, NT, 0);
        if (per_cu < 1) per_cu = 1;
        grid_blocks = cus * per_cu;
        if (grid_blocks > 256) grid_blocks = 256;
    }
    Params p{};
    const float* const* in = (const float* const*)d_in;
    p.x = in[0]; p.c = in[1]; p.ctx = in[2]; p.c_ctx = in[3]; p.w_mod = in[4]; p.b_mod = in[5]; p.pre_norm1 = in[6]; p.w_in = in[7];
    p.w_gate_up = in[8]; p.b_gate_up = in[9]; p.lq1 = in[10]; p.lk1 = in[11]; p.lq2 = in[12]; p.lk2 = in[13]; p.da_hn = in[14]; p.gla_hn = in[15];
    p.w_bda = in[16]; p.w_bgla = in[17]; p.w_out = in[18]; p.post_norm1 = in[19]; p.pre_norm2 = in[20]; p.w_ff1 = in[21]; p.w_ff2 = in[22]; p.post_norm2 = in[23];
    p.out = (float*)d_out; p.ws = (char*)d_ws;
    hipMemsetAsync((char*)d_ws + OFF_BAR, 0, 256, stream);
    void* args[] = {&p};
    hipError_t e = hipLaunchCooperativeKernel((void*)fwd_megakernel, dim3(grid_blocks), dim3(NT), args, 0, stream);
    if (e != hipSuccess) fprintf(stderr, "cooperative launch failed: %s (grid %d)\n", hipGetErrorString(e), grid_blocks);
}
```

```cpp
#include <hip/hip_runtime.h>
#include <hip/hip_cooperative_groups.h>
#include <cstdio>
namespace cg = cooperative_groups;

typedef unsigned short bf16_t;
typedef short bf16x8 __attribute__((ext_vector_type(8)));
typedef float f32x16 __attribute__((ext_vector_type(16)));
typedef float f32x4 __attribute__((ext_vector_type(4)));
typedef float f32x2 __attribute__((ext_vector_type(2)));
typedef __bf16 bf2_t __attribute__((ext_vector_type(2)));
typedef _Float16 h4_t __attribute__((ext_vector_type(4)));

#define DI __device__ __forceinline__
#define MFMA32(a, b, c) __builtin_amdgcn_mfma_f32_32x32x16_bf16((a), (b), (c), 0, 0, 0)

constexpr int NT = 512;
constexpr int TLAT = 8192, NB = 8, NLAT = 65536, NROW = 67584, TKV = 8448;
constexpr float EPS = 1e-6f;
constexpr size_t MiB = 1048576;
constexpr size_t OFF_WIN = 0;
constexpr size_t OFF_WDA = OFF_WIN + 8448ull * 1024 * 2;
constexpr size_t OFF_WGLA = OFF_WDA + 2 * MiB;
constexpr size_t OFF_WOUT = OFF_WGLA + 2 * MiB;
constexpr size_t OFF_WFF1 = OFF_WOUT + 2 * MiB;
constexpr size_t OFF_WFF2 = OFF_WFF1 + 8 * MiB;
constexpr size_t OFF_MODP = OFF_WFF2 + 8 * MiB;
constexpr size_t OFF_ROPE = OFF_MODP + 16ull * 9 * 6144 * 4;
constexpr size_t OFF_GLOW = OFF_ROPE + 16384;
constexpr size_t OFF_KMAX = OFF_GLOW + 67584ull * 32 * 4;
constexpr size_t OFF_BAR = OFF_KMAX + 1024;
constexpr size_t R_H = 64 * MiB;
constexpr size_t R_Q = R_H + 132 * MiB;
constexpr size_t R_K = R_Q + 128 * MiB;
constexpr size_t R_VT = R_K + 132 * MiB;
constexpr size_t R_GQ = R_VT + 132 * MiB;
constexpr size_t R_GK = R_GQ + 64 * MiB;
constexpr size_t R_GVT = R_GK + 66 * MiB;
constexpr size_t R_SG = R_GVT + 132 * MiB;
constexpr size_t WS_END = R_SG + 128 * MiB;
static_assert(OFF_BAR + 1024 <= R_H, "small region overflow");
static_assert(WS_END <= 1024 * MiB, "workspace overflow");
constexpr size_t R_BF = R_Q;
constexpr size_t R_BB = R_Q + 66 * MiB;
constexpr size_t R_OF = R_K + 4 * MiB;
constexpr size_t R_OB = R_VT;
constexpr size_t R_YGLA = R_SG;
constexpr size_t R_Y = R_GVT;
constexpr size_t R_Y2 = R_SG;
constexpr size_t R_H2 = R_H;
constexpr size_t R_U = R_Q;
constexpr size_t R_Y3 = R_GVT;

struct Params {
    const float *x, *c, *ctx, *c_ctx, *w_mod, *b_mod, *pre_norm1, *w_in, *w_gate_up, *b_gate_up;
    const float *lq1, *lk1, *lq2, *lk2, *da_hn, *gla_hn, *w_bda, *w_bgla, *w_out, *post_norm1, *pre_norm2, *w_ff1, *w_ff2, *post_norm2;
    float* out;
    char* ws;
};

DI unsigned pk2(float a, float b) { f32x2 v = {a, b}; bf2_t r = __builtin_convertvector(v, bf2_t); return __builtin_bit_cast(unsigned, r); }
DI bf16_t bf1(float a) { __bf16 r = (__bf16)a; return __builtin_bit_cast(unsigned short, r); }
DI float bflo(unsigned v) { return __uint_as_float(v << 16); }
DI float bfhi(unsigned v) { return __uint_as_float(v & 0xffff0000u); }
DI float wave_sum(float v) {
#pragma unroll
    for (int o = 32; o >= 1; o >>= 1) v += __shfl_xor(v, o);
    return v;
}
DI int get_tid() { int t = threadIdx.x; asm volatile("" : "+v"(t)); return t; }
DI float sigmoidf_(float x) { return 1.0f / (1.0f + __expf(-x)); }

template <int MODE>
DI void repack(const float* __restrict__ src, int K, int Nsrc, bf16_t* __restrict__ dst, int Nd, long gtid, long gsz) {
    const long total = (long)Nd * (K / 8);
    for (long it = gtid; it < total; it += gsz) {
        const int n = (int)(it % Nd), kc = (int)(it / Nd);
        int col = n; bool valid = true;
        if (MODE == 1) { if (n < 5120) col = n; else if (n < 8192) col = n + 32; else if (n < 8224) col = n - 8192 + 5120; else valid = false; }
        float v[8];
#pragma unroll
        for (int j = 0; j < 8; ++j) v[j] = valid ? src[(size_t)(kc * 8 + j) * Nsrc + col] : 0.f;
        uint4 o; o.x = pk2(v[0], v[1]); o.y = pk2(v[2], v[3]); o.z = pk2(v[4], v[5]); o.w = pk2(v[6], v[7]);
        *(uint4*)(dst + (size_t)n * K + kc * 8) = o;
    }
}

DI void sincos_acc(float a, float& s, float& c) {
    const float q = rintf(a * 0.63661977236758134f);
    float r = fmaf(-q, 1.5703125f, a); r = fmaf(-q, 4.837512969970703125e-4f, r); r = fmaf(-q, 7.54978995489188216e-8f, r);
    const float r2 = r * r;
    const float sp = r + r * r2 * (-1.6666666666e-1f + r2 * (8.3333333333e-3f + r2 * (-1.98412698e-4f + r2 * 2.7557319e-6f)));
    const float cp = 1.0f + r2 * (-0.5f + r2 * (4.16666666667e-2f + r2 * (-1.38888888889e-3f + r2 * (2.48015873e-5f + r2 * -2.75573192e-7f))));
    const int qi = ((int)q) & 3;
    s = (qi == 0) ? sp : (qi == 1) ? cp : (qi == 2) ? -sp : -cp;
    c = (qi == 0) ? cp : (qi == 1) ? -sp : (qi == 2) ? -cp : sp;
}

DI void phase_prep(const Params& p, char* smem) {
    const int tid = get_tid();
    const long gsz = (long)gridDim.x * NT, gtid = (long)blockIdx.x * NT + tid;
    char* ws = p.ws;
    repack<1>(p.w_in, 1024, 8224, (bf16_t*)(ws + OFF_WIN), 8448, gtid, gsz);
    repack<0>(p.w_bda, 1024, 1024, (bf16_t*)(ws + OFF_WDA), 1024, gtid, gsz);
    if (gtid < 256) ((float*)(ws + OFF_KMAX))[gtid] = 0.f;
    if (gtid < 2048) {
        const int pos = (int)gtid >> 4, f = (int)gtid & 15;
        const float inv = exp2f(-(float)f * (13.287712379549449f / 16.0f));
        float s, c; sincos_acc((float)pos * inv, s, c);
        float* rt = (float*)(ws + OFF_ROPE);
        rt[gtid] = c; rt[2048 + gtid] = s;
    }
    float* sil = (float*)smem;
    float* modp = (float*)(ws + OFF_MODP);
    for (int item = blockIdx.x; item < 192; item += gridDim.x) {
        const int cb = item % 12, ks = item / 12;
        __syncthreads();
        for (int i = tid; i < 9 * 64; i += NT) {
            const int r = i >> 6, kk = i & 63;
            const float v = (r < 8) ? p.c[r * 1024 + ks * 64 + kk] : p.c_ctx[ks * 64 + kk];
            sil[i] = v * sigmoidf_(v);
        }
        __syncthreads();
        const int n = cb * 512 + tid;
        float acc[9];
#pragma unroll
        for (int r = 0; r < 9; ++r) acc[r] = 0.f;
        for (int kk = 0; kk < 64; ++kk) {
            const float w = p.w_mod[(size_t)(ks * 64 + kk) * 6144 + n];
#pragma unroll
            for (int r = 0; r < 9; ++r) acc[r] = fmaf(sil[r * 64 + kk], w, acc[r]);
        }
#pragma unroll
        for (int r = 0; r < 9; ++r) modp[(size_t)(ks * 9 + r) * 6144 + n] = acc[r];
    }
}

DI void load_mod(const Params& p, int r, int which, float* dst) {
    const float* modp = (const float*)(p.ws + OFF_MODP);
    for (int n = threadIdx.x; n < 1024; n += NT) {
        float a = p.b_mod[which * 1024 + n];
#pragma unroll
        for (int ks = 0; ks < 16; ++ks) a += modp[(size_t)(ks * 9 + r) * 6144 + which * 1024 + n];
        dst[n] = a;
    }
}

DI void h_row2(const Params& p, const float* md, bf16_t* H, int rowA, int rowB, int lane) {
    const float* sa = rowA < NLAT ? p.x + (size_t)rowA * 1024 : p.ctx + (size_t)(rowA - NLAT) * 1024;
    const float* sbp = rowB < NLAT ? p.x + (size_t)rowB * 1024 : p.ctx + (size_t)(rowB - NLAT) * 1024;
    f32x4 va[4], vb[4]; float sa2 = 0.f, sb2 = 0.f;
#pragma unroll
    for (int j = 0; j < 4; ++j) { va[j] = *(const f32x4*)(sa + lane * 4 + 256 * j); vb[j] = *(const f32x4*)(sbp + lane * 4 + 256 * j); }
#pragma unroll
    for (int j = 0; j < 4; ++j) {
        sa2 += va[j].x * va[j].x + va[j].y * va[j].y + va[j].z * va[j].z + va[j].w * va[j].w;
        sb2 += vb[j].x * vb[j].x + vb[j].y * vb[j].y + vb[j].z * vb[j].z + vb[j].w * vb[j].w;
    }
    sa2 = wave_sum(sa2); sb2 = wave_sum(sb2);
    const float ra = rsqrtf(sa2 * (1.0f / 1024.0f) + EPS), rb = rsqrtf(sb2 * (1.0f / 1024.0f) + EPS);
#pragma unroll
    for (int j = 0; j < 4; ++j) {
        const int col = lane * 4 + 256 * j;
        const f32x4 g = *(const f32x4*)(p.pre_norm1 + col);
        const f32x4 sh = *(const f32x4*)(md + col), sc = *(const f32x4*)(md + 1024 + col);
        float oa[4], ob[4];
#pragma unroll
        for (int e = 0; e < 4; ++e) { const float gm = g[e] * (1.f + sc[e]); oa[e] = va[j][e] * ra * gm + sh[e]; ob[e] = vb[j][e] * rb * gm + sh[e]; }
        uint2 o; o.x = pk2(oa[0], oa[1]); o.y = pk2(oa[2], oa[3]);
        *(uint2*)(H + (size_t)rowA * 1024 + col) = o;
        o.x = pk2(ob[0], ob[1]); o.y = pk2(ob[2], ob[3]);
        *(uint2*)(H + (size_t)rowB * 1024 + col) = o;
    }
}

DI void phase_h(const Params& p, char* smem) {
    float* md = (float*)smem;
    const int tid = get_tid(), lane = tid & 63, w = tid >> 6;
    bf16_t* H = (bf16_t*)(p.ws + R_H);
    for (int tile = blockIdx.x; tile < 256; tile += gridDim.x) {
        __syncthreads();
        load_mod(p, tile >> 5, 0, md); load_mod(p, tile >> 5, 1, md + 1024);
        __syncthreads();
        for (int i = 0; i < 16; ++i) h_row2(p, md, H, tile * 256 + w * 32 + i, tile * 256 + w * 32 + 16 + i, lane);
    }
    __syncthreads();
    load_mod(p, 8, 0, md); load_mod(p, 8, 1, md + 1024);
    __syncthreads();
    for (int r2 = blockIdx.x * 8 + w; r2 < 1024; r2 += gridDim.x * 8) h_row2(p, md, H, NLAT + 2 * r2, NLAT + 2 * r2 + 1, lane);
}

typedef __attribute__((address_space(3))) unsigned lds_u32;
DI lds_u32* to_lds(const void* p) { return (lds_u32*)(unsigned)(size_t)p; }
#define GLDS16(src, dst) __builtin_amdgcn_global_load_lds((const unsigned*)(src), to_lds(dst), 16, 0, 0)

#define MFMA16(a, b, c) __builtin_amdgcn_mfma_f32_16x16x32_bf16((a), (b), (c), 0, 0, 0)
template <bool SWAP, class Epi>
DI void gemm_tile(const bf16_t* A, int lda, const bf16_t* B, int ldb, int K, int m0, int n0, bool first, bool has_next, int nm0, int nn0, char* smem, Epi& epi) {
    const int tid = get_tid(), lane = tid & 63, w = tid >> 6, wm = w >> 2, wn = w & 3, l15 = lane & 15, q = lane >> 4;
    f32x4 acc[8][4];
#pragma unroll
    for (int i = 0; i < 8; ++i)
#pragma unroll
        for (int j = 0; j < 4; ++j) acc[i][j] = (f32x4){0.f, 0.f, 0.f, 0.f};
    const int srow = 8 * w + (lane >> 3), schunk = (lane & 7) ^ (4 * (w & 1) + (lane >> 4));
    const bf16_t* ga = A + (size_t)(m0 + srow) * lda + schunk * 8;
    const bf16_t* gb = B + (size_t)(n0 + srow) * ldb + schunk * 8;
    const bf16_t* nga = A + (size_t)(nm0 + srow) * lda + schunk * 8;
    const bf16_t* ngb = B + (size_t)(nn0 + srow) * ldb + schunk * 8;
    const int sw = (l15 >> 1) & 7;
    const int aofs = (128 * wm + l15) * 128, bofs = 32768 + (64 * wn + l15) * 128;
    char* sdst = smem + w * 1024;
#define GEMM_STAGE(pa, pb, buf, kt_) do { _Pragma("unroll") for (int i = 0; i < 4; ++i) { \
        GLDS16(pa + (size_t)i * 64 * lda + (kt_) * 64, sdst + (buf) * 65536 + i * 8192); \
        GLDS16(pb + (size_t)i * 64 * ldb + (kt_) * 64, sdst + (buf) * 65536 + 32768 + i * 8192); } } while (0)
    if (first) {
        GEMM_STAGE(ga, gb, 0, 0);
        asm volatile("s_waitcnt vmcnt(0)" ::: "memory");
        __syncthreads();
    }
    const int KT = K >> 6;
    for (int kt = 0; kt < KT; ++kt) {
        const int cur = kt & 1;
        if (kt + 1 < KT) GEMM_STAGE(ga, gb, cur ^ 1, kt + 1);
        else if (has_next) GEMM_STAGE(nga, ngb, cur ^ 1, 0);
        const char* sb = smem + cur * 65536;
#pragma unroll
        for (int kk = 0; kk < 2; ++kk) {
            const int co = ((4 * kk + q) ^ sw) << 4;
            bf16x8 af[8], bf[4];
#pragma unroll
            for (int mi = 0; mi < 8; ++mi) af[mi] = *(const bf16x8*)(sb + aofs + mi * 2048 + co);
#pragma unroll
            for (int ni = 0; ni < 4; ++ni) bf[ni] = *(const bf16x8*)(sb + bofs + ni * 2048 + co);
#pragma unroll
            for (int mi = 0; mi < 8; ++mi)
#pragma unroll
                for (int ni = 0; ni < 4; ++ni) acc[mi][ni] = SWAP ? MFMA16(af[mi], bf[ni], acc[mi][ni]) : MFMA16(bf[ni], af[mi], acc[mi][ni]);
        }
        asm volatile("s_waitcnt vmcnt(0)" ::: "memory");
        __syncthreads();
    }
#undef GEMM_STAGE
#pragma unroll
    for (int mi = 0; mi < 8; ++mi) {
        if constexpr (SWAP) {
#pragma unroll
            for (int ni = 0; ni < 4; ++ni) epi.vt(m0 + 128 * wm + 16 * mi + 4 * q, n0 + 64 * wn + 16 * ni + l15, acc[mi][ni]);
        } else epi(m0 + 128 * wm + 16 * mi + l15, n0 + 64 * wn, acc[mi], q);
        asm volatile("" ::: "memory");
    }
}

DI void tile_map(int id, int MT, int NTl, int& mt, int& nt) {
    const int x = id & 7, local = id >> 3, mtx = MT >> 3;
    const int full = mtx >> 2, per = 4 * NTl;
    int patch = local / per, wv = local - patch * per, pm = 4;
    if (patch >= full) { patch = full; wv = local - full * per; pm = mtx - full * 4; }
    const int mo = wv % pm; nt = wv / pm;
    mt = (patch * 4 + mo) * 8 + x;
}

DI void tile_map_in(int id, int& mt, int& nt) {
    if (id < 8448) { tile_map(id, 256, 33, mt, nt); return; }
    const int id2 = id - 8448, k = id2 >> 3;
    mt = 256 + (id2 & 7);
    nt = k < 8 ? 4 + k : k < 10 ? 14 + (k - 8) : k < 14 ? 16 + (k - 10) : 32;
}
template <bool VSWAP, class Epi>
DI void gemm_phase_ex(const bf16_t* A, int lda, const bf16_t* B, int ldb, int K, int MT, int NTl, char* smem, Epi& epi, int bid, int nblk) {
    const int total = VSWAP ? 8448 + 120 : MT * NTl;
    bool first = true;
    for (int id = bid; id < total; id += nblk) {
        int mt, nt, mt2 = 0, nt2 = 0;
        if (VSWAP) tile_map_in(id, mt, nt); else tile_map(id, MT, NTl, mt, nt);
        const bool has_next = id + nblk < total;
        if (has_next) { if (VSWAP) tile_map_in(id + nblk, mt2, nt2); else tile_map(id + nblk, MT, NTl, mt2, nt2); }
        if constexpr (VSWAP) { if (Epi::is_vt(nt)) { gemm_tile<true>(A, lda, B, ldb, K, mt * 256, nt * 256, first, has_next, mt2 * 256, nt2 * 256, smem, epi); first = false; continue; } }
        gemm_tile<false>(A, lda, B, ldb, K, mt * 256, nt * 256, first, has_next, mt2 * 256, nt2 * 256, smem, epi);
        first = false;
    }
}
template <class Epi>
DI void gemm_phase(const bf16_t* A, int lda, const bf16_t* B, int ldb, int K, int MT, int NTl, char* smem, Epi& epi) {
    gemm_phase_ex<false>(A, lda, B, ldb, K, MT, NTl, smem, epi, blockIdx.x, gridDim.x);
}

DI float xhalf_max(float v) {
    typedef unsigned u32x2 __attribute__((ext_vector_type(2)));
    const unsigned u = __float_as_uint(v);
    const u32x2 r = __builtin_amdgcn_permlane32_swap(u, u, false, false);
    return fmaxf(__uint_as_float(r[0]), __uint_as_float(r[1]));
}
DI float xhalf_sum(float v) {
    typedef unsigned u32x2 __attribute__((ext_vector_type(2)));
    const unsigned u = __float_as_uint(v);
    const u32x2 r = __builtin_amdgcn_permlane32_swap(u, u, false, false);
    return __uint_as_float(r[0]) + __uint_as_float(r[1]);
}
template <class Epi>
DI void gemm_panel(const bf16_t* A, int lda, const bf16_t* B, int ldb, int K, int panel, int NTl, char* smem, Epi& epi) {
    for (int nt = 0; nt < NTl; ++nt)
        gemm_tile<false>(A, lda, B, ldb, K, panel * 256, nt * 256, nt == 0, nt + 1 < NTl, panel * 256, (nt + 1) * 256, smem, epi);
}

DI float quad_sum(float v) { v += __shfl_xor(v, 16); v += __shfl_xor(v, 32); return v; }
struct EpiIn {
    bf16_t *Q, *Kk, *Vt, *gq, *gk, *gvT, *sg, *mg; float* glow; const float* rope; float* kmax;
    static DI bool is_vt(int nt) { return (nt >= 8 && nt < 12) || (nt >= 16 && nt < 20); }
    DI void vt(int row0, int col, const f32x4& v) const {
        int b, t;
        if (row0 < NLAT) { b = row0 >> 13; t = row0 & 8191; } else { const int r2 = row0 - NLAT; b = r2 >> 8; t = TLAT + (r2 & 255); }
        bf16_t* dst;
        if (col < 3072) { const int c = col - 2048; dst = Vt + (size_t)((b * 8 + (c >> 7)) * 128 + (c & 127)) * TKV + t; }
        else { const int c = col - 4096; dst = gvT + (size_t)((b * 4 + (c >> 8)) * 256 + (c & 255)) * TKV + t; }
        uint2 u; u.x = pk2(v[0], v[1]); u.y = pk2(v[2], v[3]);
        *(uint2*)dst = u;
    }
    DI void operator()(int row, int cb, const f32x4 (&v)[4], int q) const {
        if (cb >= 8224) return;
        const bool lat = row < NLAT;
        int b, t;
        if (lat) { b = row >> 13; t = row & 8191; } else { const int r2 = row - NLAT; b = r2 >> 8; t = TLAT + (r2 & 255); }
        if (cb < 2048) {
            const bool isq = cb < 1024;
            if (isq && !lat) return;
            const int c = cb & 1023, head = c >> 7, comp = (c >> 6) & 1;
            f32x4 o[4];
            if (lat) {
#pragma unroll
                for (int half = 0; half < 2; ++half) {
                    const int pos = half ? (t & 63) : (t >> 6);
                    const f32x4 c4 = *(const f32x4*)(rope + pos * 16 + 4 * q), s4 = *(const f32x4*)(rope + 2048 + pos * 16 + 4 * q);
#pragma unroll
                    for (int j = 0; j < 4; ++j) {
                        const float x1 = v[2 * half][j], x2 = v[2 * half + 1][j];
                        o[2 * half][j] = x1 * c4[j] - x2 * s4[j];
                        o[2 * half + 1][j] = x2 * c4[j] + x1 * s4[j];
                    }
                }
            } else {
#pragma unroll
                for (int ni = 0; ni < 4; ++ni) o[ni] = v[ni];
            }
            if (!isq) {
#pragma unroll
                for (int half = 0; half < 2; ++half) {
                    float ssq = 0.f;
#pragma unroll
                    for (int j = 0; j < 4; ++j) ssq += o[2 * half][j] * o[2 * half][j] + o[2 * half + 1][j] * o[2 * half + 1][j];
                    ssq = quad_sum(ssq);
#pragma unroll
                    for (int of = 8; of >= 1; of >>= 1) ssq = fmaxf(ssq, __shfl_xor(ssq, of));
                    if ((threadIdx.x & 63) == 0) atomicMax((unsigned*)(kmax + ((b * 8 + head) * 2 + comp) * 2 + half), __float_as_uint(ssq));
                }
            }
            const float scl = isq ? 0.125f * 1.4426950408889634f : 1.0f;
            bf16_t* dst = isq ? Q + ((size_t)((b * 8 + head) * 2 + comp) * TLAT + t) * 64 : Kk + ((size_t)((b * 8 + head) * 2 + comp) * TKV + t) * 64;
#pragma unroll
            for (int ni = 0; ni < 4; ++ni) {
                uint2 u; u.x = pk2(o[ni][0] * scl, o[ni][1] * scl); u.y = pk2(o[ni][2] * scl, o[ni][3] * scl);
                *(uint2*)(dst + 16 * ni + 4 * q) = u;
            }
        } else if (cb < 3072) {
        } else if (cb < 4096) {
            const bool isq = cb < 3584;
            if (isq && !lat) return;
            const int c = (cb - 3072) & 511;
            const float scl = isq ? 0.08838834764831845f : 1.0f;
            bf16_t* dst = (isq ? gq : gk) + (size_t)row * 512 + c;
#pragma unroll
            for (int ni = 0; ni < 4; ++ni) {
                uint2 u; u.x = pk2(v[ni][0] * scl, v[ni][1] * scl); u.y = pk2(v[ni][2] * scl, v[ni][3] * scl);
                *(uint2*)(dst + 16 * ni + 4 * q) = u;
            }
        } else if (cb < 5120) {
        } else if (cb < 6144) {
            if (!lat) return;
            bf16_t* dst = sg + (size_t)row * 1024 + (cb - 5120);
#pragma unroll
            for (int ni = 0; ni < 4; ++ni) {
                float s[4];
#pragma unroll
                for (int j = 0; j < 4; ++j) { const float xx = v[ni][j]; s[j] = xx * sigmoidf_(xx); }
                uint2 u; u.x = pk2(s[0], s[1]); u.y = pk2(s[2], s[3]);
                *(uint2*)(dst + 16 * ni + 4 * q) = u;
            }
        } else if (cb < 8192) {
            if (!lat) return;
            bf16_t* dst = mg + (size_t)row * 2048 + (cb - 6144);
#pragma unroll
            for (int ni = 0; ni < 4; ++ni) {
                uint2 u; u.x = pk2(sigmoidf_(v[ni][0]), sigmoidf_(v[ni][1])); u.y = pk2(sigmoidf_(v[ni][2]), sigmoidf_(v[ni][3]));
                *(uint2*)(dst + 16 * ni + 4 * q) = u;
            }
        } else {
            float* dst = glow + (size_t)row * 32;
#pragma unroll
            for (int ni = 0; ni < 2; ++ni) *(f32x4*)(dst + 16 * ni + 4 * q) = v[ni];
        }
    }
};

struct EpiGate0 {
    bf16_t* mg;
    DI void operator()(int row, int cb, const f32x4 (&v)[4], int q) const {
#pragma unroll
        for (int ni = 0; ni < 4; ++ni) {
            const int col = cb + 16 * ni + 4 * q;
            const uint2 m = *(const uint2*)(mg + (size_t)row * 2048 + col);
            uint2 u; u.x = pk2(v[ni][0] * bflo(m.x), v[ni][1] * bfhi(m.x)); u.y = pk2(v[ni][2] * bflo(m.y), v[ni][3] * bfhi(m.y));
            *(uint2*)(mg + (size_t)row * 2048 + col) = u;
        }
    }
};
struct EpiGate1 {
    bf16_t* Y; const bf16_t* mg;
    DI void operator()(int row, int cb, const f32x4 (&v)[4], int q) const {
#pragma unroll
        for (int ni = 0; ni < 4; ++ni) {
            const int col = cb + 16 * ni + 4 * q;
            const uint2 m = *(const uint2*)(mg + (size_t)row * 2048 + 1024 + col);
            const uint2 pr = *(const uint2*)(mg + (size_t)row * 2048 + col);
            uint2 u; u.x = pk2(bflo(pr.x) + v[ni][0] * bflo(m.x), bfhi(pr.x) + v[ni][1] * bfhi(m.x));
            u.y = pk2(bflo(pr.y) + v[ni][2] * bflo(m.y), bfhi(pr.y) + v[ni][3] * bfhi(m.y));
            *(uint2*)(Y + (size_t)row * 1024 + col) = u;
        }
    }
};
template <int ACT>
struct EpiStore {
    bf16_t* O; int ldo;
    DI void operator()(int row, int cb, const f32x4 (&v)[4], int q) const {
#pragma unroll
        for (int ni = 0; ni < 4; ++ni) {
            float s[4];
#pragma unroll
            for (int j = 0; j < 4; ++j) { float xx = v[ni][j]; if (ACT == 1) { xx = fmaxf(xx, 0.f); xx = xx * xx; } s[j] = xx; }
            uint2 u; u.x = pk2(s[0], s[1]); u.y = pk2(s[2], s[3]);
            *(uint2*)(O + (size_t)row * ldo + cb + 16 * ni + 4 * q) = u;
        }
    }
};

DI float quad_max(float v) { v = fmaxf(v, __shfl_xor(v, 16)); v = fmaxf(v, __shfl_xor(v, 32)); return v; }
DI bf16x8 pack8(const f32x4& a, const f32x4& b) {
    typedef unsigned u32x4 __attribute__((ext_vector_type(4)));
    const u32x4 u = {pk2(a[0], a[1]), pk2(a[2], a[3]), pk2(b[0], b[1]), pk2(b[2], b[3])};
    return __builtin_bit_cast(bf16x8, u);
}

template <bool FAST>
DI void attn_kloop(char* smem, char* sdst, const bf16_t* gk0, const bf16_t* gk1, const bf16_t* gv, int comp, int krow0, int ksw, int l15, int qd,
                   const bf16x8 (&qf)[2][2], f32x4 (&O)[2][8], float (&m)[2], float (&l)[2]) {
#define ATT_STAGE(buf, kt_) do { _Pragma("unroll") for (int jj = 0; jj < 2; ++jj) { \
            GLDS16(gk0 + (size_t)((kt_) * 128 + 64 * jj) * 64, sdst + (buf) * 65536 + jj * 8192); \
            GLDS16(gk1 + (size_t)((kt_) * 128 + 64 * jj) * 64, sdst + (buf) * 65536 + 16384 + jj * 8192); } \
            _Pragma("unroll") for (int jj = 0; jj < 4; ++jj) GLDS16(gv + (size_t)(32 * jj) * TKV + (kt_) * 128, sdst + (buf) * 65536 + 32768 + jj * 8192); } while (0)
#define KFRAG(sub_, t_, kd_) (*(const bf16x8*)(skc + (32 * (sub_) + krow0 + 4 * (t_)) * 128 + (((4 * (kd_) + qd) ^ ksw) << 4)))
#define VFRAG(sub_, dt_) (*(const bf16x8*)(sb + 32768 + (16 * (dt_) + l15) * 256 + (((4 * (sub_) + qd) ^ l15) << 4)))
    ATT_STAGE(0, 0);
    asm volatile("s_waitcnt vmcnt(0)" ::: "memory");
    __syncthreads();
    f32x4 sinit[2];
#pragma unroll
    for (int qt = 0; qt < 2; ++qt) { const float v0 = FAST ? -m[qt] : 0.f; sinit[qt] = (f32x4){v0, v0, v0, v0}; }
    constexpr int NKT = TKV / 128;
    for (int kt = 0; kt < NKT; ++kt) {
        const int cur = kt & 1;
        if (kt + 1 < NKT) ATT_STAGE(cur ^ 1, kt + 1);
        const char* sb = smem + cur * 65536;
        const char* skc = sb + comp * 16384;
        if (FAST) {
            bf16x8 kf[2][2];
#pragma unroll
            for (int t = 0; t < 2; ++t)
#pragma unroll
                for (int kd = 0; kd < 2; ++kd) kf[t][kd] = KFRAG(0, t, kd);
            f32x4 Sn[2][2];
#pragma unroll
            for (int qt = 0; qt < 2; ++qt)
#pragma unroll
                for (int t = 0; t < 2; ++t) { Sn[qt][t] = MFMA16(kf[t][0], qf[qt][0], sinit[qt]); Sn[qt][t] = MFMA16(kf[t][1], qf[qt][1], Sn[qt][t]); }
#pragma unroll
            for (int sub = 0; sub < 4; ++sub) {
                f32x4 Sc[2][2];
#pragma unroll
                for (int qt = 0; qt < 2; ++qt)
#pragma unroll
                    for (int t = 0; t < 2; ++t) Sc[qt][t] = Sn[qt][t];
                bf16x8 va[4], vb[4];
#pragma unroll
                for (int dt = 0; dt < 4; ++dt) va[dt] = VFRAG(sub, dt);
                if (sub < 3) {
#pragma unroll
                    for (int t = 0; t < 2; ++t)
#pragma unroll
                        for (int kd = 0; kd < 2; ++kd) kf[t][kd] = KFRAG(sub + 1, t, kd);
                }
                __builtin_amdgcn_sched_barrier(0);
                bf16x8 pb[2];
#pragma unroll
                for (int qt = 0; qt < 2; ++qt) {
                    f32x4 p0, p1;
#pragma unroll
                    for (int i = 0; i < 4; ++i) { p0[i] = __builtin_amdgcn_exp2f(Sc[qt][0][i]); p1[i] = __builtin_amdgcn_exp2f(Sc[qt][1][i]); l[qt] += p0[i] + p1[i]; }
                    pb[qt] = pack8(p0, p1);
                }
#pragma unroll
                for (int dt = 0; dt < 4; ++dt) vb[dt] = VFRAG(sub, 4 + dt);
                __builtin_amdgcn_sched_barrier(0);
#pragma unroll
                for (int dt = 0; dt < 4; ++dt) {
                    O[0][dt] = MFMA16(va[dt], pb[0], O[0][dt]);
                    O[1][dt] = MFMA16(va[dt], pb[1], O[1][dt]);
                    if (sub < 3) Sn[dt >> 1][dt & 1] = MFMA16(kf[dt & 1][0], qf[dt >> 1][0], sinit[dt >> 1]);
                }
#pragma unroll
                for (int dt = 0; dt < 4; ++dt) {
                    O[0][4 + dt] = MFMA16(vb[dt], pb[0], O[0][4 + dt]);
                    O[1][4 + dt] = MFMA16(vb[dt], pb[1], O[1][4 + dt]);
                    if (sub < 3) Sn[dt >> 1][dt & 1] = MFMA16(kf[dt & 1][1], qf[dt >> 1][1], Sn[dt >> 1][dt & 1]);
                }
            }
        } else {
#pragma unroll 1
            for (int sub = 0; sub < 4; ++sub) {
                f32x4 S[2][2];
#pragma unroll
                for (int qt = 0; qt < 2; ++qt)
#pragma unroll
                    for (int t = 0; t < 2; ++t) { S[qt][t] = MFMA16(KFRAG(sub, t, 0), qf[qt][0], sinit[qt]); S[qt][t] = MFMA16(KFRAG(sub, t, 1), qf[qt][1], S[qt][t]); }
                bf16x8 pb[2];
#pragma unroll
                for (int qt = 0; qt < 2; ++qt) {
                    float mt = fmaxf(fmaxf(fmaxf(S[qt][0][0], S[qt][0][1]), fmaxf(S[qt][0][2], S[qt][0][3])), fmaxf(fmaxf(S[qt][1][0], S[qt][1][1]), fmaxf(S[qt][1][2], S[qt][1][3])));
                    mt = quad_max(mt);
                    if (mt > m[qt]) {
                        const float al = __builtin_amdgcn_exp2f(m[qt] - mt);
                        l[qt] *= al;
#pragma unroll
                        for (int dt = 0; dt < 8; ++dt) O[qt][dt] *= al;
                        m[qt] = mt;
                    }
                    f32x4 p0, p1;
#pragma unroll
                    for (int i = 0; i < 4; ++i) { p0[i] = __builtin_amdgcn_exp2f(S[qt][0][i] - m[qt]); p1[i] = __builtin_amdgcn_exp2f(S[qt][1][i] - m[qt]); l[qt] += p0[i] + p1[i]; }
                    pb[qt] = pack8(p0, p1);
                }
#pragma unroll
                for (int dt = 0; dt < 8; ++dt) {
                    const bf16x8 vf = VFRAG(sub, dt);
                    O[0][dt] = MFMA16(vf, pb[0], O[0][dt]);
                    O[1][dt] = MFMA16(vf, pb[1], O[1][dt]);
                }
            }
        }
        asm volatile("s_waitcnt vmcnt(0)" ::: "memory");
        __syncthreads();
    }
#undef ATT_STAGE
#undef KFRAG
#undef VFRAG
}

DI void phase_attn(const Params& p, char* smem) {
    const int tid = get_tid(), lane = tid & 63, w = tid >> 6, l15 = lane & 15, qd = lane >> 4;
    const int g = w >> 1, comp = w & 1;
    const bf16_t* Q = (const bf16_t*)(p.ws + R_Q);
    const bf16_t* Kk = (const bf16_t*)(p.ws + R_K);
    const bf16_t* Vt = (const bf16_t*)(p.ws + R_VT);
    const float* kmax = (const float*)(p.ws + OFF_KMAX);
    bf16_t* YDA = (bf16_t*)(p.ws + R_H);
    float d1 = 0.f, d2 = 0.f;
    for (int i = 0; i < 64; ++i) { d1 += p.lq1[i] * p.lk1[i]; d2 += p.lq2[i] * p.lk2[i]; }
    const float lam = __expf(d1) - __expf(d2) + 0.2f;
    const int krs = 8 * w + (lane >> 3), kcs = (lane & 7) ^ (((lane >> 4) & 1) | ((w & 3) << 1));
    const int vrs = 4 * w + (lane >> 4), vcs = (lane & 15) ^ ((4 * w + (lane >> 4)) & 15);
    const int krow0 = 8 * (l15 >> 2) + (l15 & 3);
    const int ksw = ((l15 >> 1) & 1) | (((l15 >> 2) & 3) << 1);
    float* xbuf = (float*)smem + g * 4096;
    char* sdst = smem + w * 1024;
    for (int id = blockIdx.x; id < 4096; id += gridDim.x) {
        const int x = id & 7, j = id >> 3, bh = (j >> 6) * 8 + x, qti = j & 63;
        const int b = bh >> 3, h = bh & 7;
        bf16x8 qf[2][2];
        float mb[2];
        const float kb = sqrtf(kmax[(bh * 2 + comp) * 2] + kmax[(bh * 2 + comp) * 2 + 1]);
#pragma unroll
        for (int qt = 0; qt < 2; ++qt) {
            const bf16_t* qp = Q + ((size_t)(bh * 2 + comp) * TLAT + qti * 128 + g * 32 + 16 * qt + l15) * 64 + qd * 8;
            qf[qt][0] = *(const bf16x8*)qp; qf[qt][1] = *(const bf16x8*)(qp + 32);
            float qn = 0.f;
#pragma unroll
            for (int kd = 0; kd < 2; ++kd)
#pragma unroll
                for (int e = 0; e < 8; ++e) { const float qv = __uint_as_float(((unsigned)(unsigned short)qf[qt][kd][e]) << 16); qn += qv * qv; }
            qn = quad_sum(qn);
            mb[qt] = sqrtf(qn) * kb * 1.01f + 1e-3f;
        }
        const bf16_t* gk0 = Kk + ((size_t)(bh * 2 + 0) * TKV + krs) * 64 + kcs * 8;
        const bf16_t* gk1 = gk0 + (size_t)TKV * 64;
        const bf16_t* gv = Vt + ((size_t)bh * 128 + vrs) * TKV + vcs * 8;
        f32x4 O[2][8];
#pragma unroll
        for (int qt = 0; qt < 2; ++qt)
#pragma unroll
            for (int d = 0; d < 8; ++d) O[qt][d] = (f32x4){0.f, 0.f, 0.f, 0.f};
        float m[2], l[2] = {0.f, 0.f};
        const int slow = __syncthreads_or(!(mb[0] <= 60.0f && mb[1] <= 60.0f));
        if (!slow) { m[0] = mb[0]; m[1] = mb[1]; attn_kloop<true>(smem, sdst, gk0, gk1, gv, comp, krow0, ksw, l15, qd, qf, O, m, l); }
        else { m[0] = -INFINITY; m[1] = -INFINITY; attn_kloop<false>(smem, sdst, gk0, gk1, gv, comp, krow0, ksw, l15, qd, qf, O, m, l); }
        l[0] = quad_sum(l[0]); l[1] = quad_sum(l[1]);
        if (comp == 1) {
#pragma unroll
            for (int qt = 0; qt < 2; ++qt) {
                const float i1 = lam / l[qt];
#pragma unroll
                for (int d = 0; d < 8; ++d)
#pragma unroll
                    for (int i = 0; i < 4; ++i) xbuf[((qt * 8 + d) * 4 + i) * 64 + lane] = O[qt][d][i] * i1;
            }
        }
        __syncthreads();
        if (comp == 0) {
#pragma unroll
            for (int qt = 0; qt < 2; ++qt) {
                const float i0 = 1.0f / l[qt];
                float ss = 0.f;
#pragma unroll
                for (int d = 0; d < 8; ++d)
#pragma unroll
                    for (int i = 0; i < 4; ++i) { const float o = O[qt][d][i] * i0 - xbuf[((qt * 8 + d) * 4 + i) * 64 + lane]; O[qt][d][i] = o; ss += o * o; }
                ss = quad_sum(ss);
                const float rs = rsqrtf(ss * (1.0f / 128.0f) + EPS) * 0.8f;
                const int t = qti * 128 + g * 32 + 16 * qt + l15;
                bf16_t* dst = YDA + ((size_t)b * TLAT + t) * 1024 + h * 128;
#pragma unroll
                for (int d = 0; d < 8; ++d) {
                    const int dv = 16 * d + 4 * qd;
                    const f32x4 hn = *(const f32x4*)(p.da_hn + dv);
                    uint2 u; u.x = pk2(O[qt][d][0] * rs * hn.x, O[qt][d][1] * rs * hn.y); u.y = pk2(O[qt][d][2] * rs * hn.z, O[qt][d][3] * rs * hn.w);
                    *(uint2*)(dst + dv) = u;
                }
            }
        }
    }
}

DI void phase_gate(const Params& p, char* smem) {
    const int tid = get_tid();
    const float* glow = (const float*)(p.ws + OFF_GLOW);
    float* sg = (float*)smem;
    float wf[16], wb[16];
#pragma unroll
    for (int r = 0; r < 16; ++r) { wf[r] = p.w_gate_up[(size_t)r * 512 + tid]; wb[r] = p.w_gate_up[(size_t)(16 + r) * 512 + tid]; }
    const float biasf = p.b_gate_up[tid], biasb = p.b_gate_up[512 + tid];
    _Float16* BF = (_Float16*)(p.ws + R_BF);
    _Float16* BB = (_Float16*)(p.ws + R_BB);
    for (int ch = blockIdx.x; ch < 1056; ch += gridDim.x) {
        __syncthreads();
        *(f32x4*)(sg + tid * 4) = *(const f32x4*)(glow + (size_t)ch * 2048 + tid * 4);
        __syncthreads();
        float run = 0.f;
#pragma unroll 4
        for (int i = 0; i < 64; ++i) {
            const float* gl = sg + i * 32;
            float a = biasf;
#pragma unroll
            for (int r = 0; r < 16; ++r) a = fmaf(gl[r], wf[r], a);
            const float ls = fminf(a, 0.f) - __logf(1.0f + __expf(-fabsf(a)));
            run += ls * (1.0f / 16.0f);
            BF[(size_t)(ch * 64 + i) * 512 + tid] = (_Float16)run;
        }
        run = 0.f;
#pragma unroll 4
        for (int i = 63; i >= 0; --i) {
            const float* gl = sg + i * 32 + 16;
            float a = biasb;
#pragma unroll
            for (int r = 0; r < 16; ++r) a = fmaf(gl[r], wb[r], a);
            const float ls = fminf(a, 0.f) - __logf(1.0f + __expf(-fabsf(a)));
            run += ls * (1.0f / 16.0f);
            BB[(size_t)(ch * 64 + i) * 512 + tid] = (_Float16)run;
        }
    }
}

struct GlaRegs { uint2 k[2][2], q[2][2], bb[2][2], bl[2][2]; uint4 v[4]; };

DI void phase_gla(const Params& p, char* smem) {
    const int tid = get_tid(), lane = tid & 63, w = tid >> 6, l31 = lane & 31, hh = lane >> 5;
    const int unit = blockIdx.x, dir = unit & 1, bh = unit >> 1, b = bh >> 2, h = bh & 3;
    const bf16_t* gq = (const bf16_t*)(p.ws + R_GQ);
    const bf16_t* gk = (const bf16_t*)(p.ws + R_GK);
    const bf16_t* gvT = (const bf16_t*)(p.ws + R_GVT) + (size_t)bh * 256 * TKV;
    const _Float16* B16 = (const _Float16*)(p.ws + (dir ? R_BB : R_BF));
    bf16_t* Oo = (bf16_t*)(p.ws + (dir ? R_OB : R_OF));
    char* sQt = smem;
    char* sKt = smem + 16384;
    char* sKh = smem + 32768;
    char* sVT = smem + 49152;
    char* sA = smem + 81920;
    float* sD = (float*)(smem + 90112);
    f32x16 S[4];
#pragma unroll
    for (int k = 0; k < 4; ++k)
#pragma unroll
        for (int e = 0; e < 16; ++e) S[k][e] = 0.f;
    const int sw = (l31 >> 1) & 7;
    GlaRegs R;
    auto chunk_info = [&](int step, int& rowbase, int& tcol, bool& emit) {
        if (step < 4) { const int cc = dir ? 3 - step : step; rowbase = NLAT + b * 256 + cc * 64; tcol = TLAT + cc * 64; emit = false; }
        else { const int cc = dir ? 127 - (step - 4) : step - 4; rowbase = b * TLAT + cc * 64; tcol = cc * 64; emit = true; }
    };
    auto load_chunk = [&](int step) {
        int rowbase, tcol; bool emit; chunk_info(step, rowbase, tcol, emit);
        const int rl = rowbase + (dir ? 0 : 63);
#pragma unroll
        for (int i = 0; i < 2; ++i) {
            const int item = tid + NT * i, tok = item >> 4, c = item & 15, d0 = 16 * (c >> 1) + 4 * (c & 1);
            const size_t ro = (size_t)(rowbase + tok) * 512 + h * 128 + d0;
            R.k[i][0] = *(const uint2*)(gk + ro); R.k[i][1] = *(const uint2*)(gk + ro + 8);
            if (emit) { R.q[i][0] = *(const uint2*)(gq + ro); R.q[i][1] = *(const uint2*)(gq + ro + 8); }
            else { R.q[i][0] = make_uint2(0, 0); R.q[i][1] = make_uint2(0, 0); }
            R.bb[i][0] = *(const uint2*)(B16 + ro); R.bb[i][1] = *(const uint2*)(B16 + ro + 8);
            const size_t rlo = (size_t)rl * 512 + h * 128 + d0;
            R.bl[i][0] = *(const uint2*)(B16 + rlo); R.bl[i][1] = *(const uint2*)(B16 + rlo + 8);
        }
#pragma unroll
        for (int i = 0; i < 4; ++i) R.v[i] = *(const uint4*)(gvT + (size_t)((tid >> 3) + 64 * i) * TKV + tcol + (tid & 7) * 8);
    };
    auto stage_chunk = [&]() {
#pragma unroll
        for (int i = 0; i < 2; ++i) {
            const int item = tid + NT * i, tok = item >> 4, c = item & 15, d0 = 16 * (c >> 1) + 4 * (c & 1);
            float qo[8], ko[8];
#pragma unroll
            for (int g = 0; g < 2; ++g) {
                const h4_t bv = __builtin_bit_cast(h4_t, R.bb[i][g]), lv = __builtin_bit_cast(h4_t, R.bl[i][g]);
                const float kk[4] = {bflo(R.k[i][g].x), bfhi(R.k[i][g].x), bflo(R.k[i][g].y), bfhi(R.k[i][g].y)};
                const float qq[4] = {bflo(R.q[i][g].x), bfhi(R.q[i][g].x), bflo(R.q[i][g].y), bfhi(R.q[i][g].y)};
#pragma unroll
                for (int j = 0; j < 4; ++j) {
                    const float bb = (float)bv[j], bl = (float)lv[j];
                    qo[4 * g + j] = qq[j] * __expf(bb);
                    ko[4 * g + j] = kk[j] * __expf(-bb);
                    const float kh = kk[j] * __expf(bl - bb);
                    const int dk = d0 + 8 * g + j;
                    *(bf16_t*)(sKh + dk * 128 + ((((tok >> 3) ^ ((dk >> 1) & 7))) << 4) + (tok & 7) * 2) = bf1(kh);
                    if (tok == 0) sD[dk] = __expf(bl);
                }
            }
            const int po = tok * 256 + ((c ^ (tok & 15)) << 4);
            uint4 uq, uk;
            uq.x = pk2(qo[0], qo[1]); uq.y = pk2(qo[2], qo[3]); uq.z = pk2(qo[4], qo[5]); uq.w = pk2(qo[6], qo[7]);
            uk.x = pk2(ko[0], ko[1]); uk.y = pk2(ko[2], ko[3]); uk.z = pk2(ko[4], ko[5]); uk.w = pk2(ko[6], ko[7]);
            *(uint4*)(sQt + po) = uq; *(uint4*)(sKt + po) = uk;
        }
#pragma unroll
        for (int i = 0; i < 4; ++i) {
            const int row = (tid >> 3) + 64 * i, scn = tid & 7;
            *(uint4*)(sVT + row * 128 + ((scn ^ ((row >> 1) & 7)) << 4)) = R.v[i];
        }
    };
    load_chunk(0);
    for (int step = 0; step < 132; ++step) {
        int rowbase, tcol; bool emit; chunk_info(step, rowbase, tcol, emit);
        stage_chunk();
        __syncthreads();
        if (step + 1 < 132) load_chunk(step + 1);
        const int dvb = 32 * w;
        if (emit) {
            if (w < 4) {
                const int ti = w >> 1, tj = w & 1;
                f32x16 a;
#pragma unroll
                for (int e = 0; e < 16; ++e) a[e] = 0.f;
                const bool dead = dir ? (tj < ti) : (tj > ti);
                if (!dead) {
#pragma unroll
                    for (int ks = 0; ks < 8; ++ks) {
                        const int ri = 32 * ti + l31, rj = 32 * tj + l31, c = 2 * ks + hh;
                        const bf16x8 af = *(const bf16x8*)(sQt + ri * 256 + ((c ^ (ri & 15)) << 4));
                        const bf16x8 bf = *(const bf16x8*)(sKt + rj * 256 + ((c ^ (rj & 15)) << 4));
                        a = MFMA32(af, bf, a);
                    }
                }
                const int jj = 32 * tj + l31;
#pragma unroll
                for (int e = 0; e < 16; ++e) {
                    const int ii = 32 * ti + (e & 3) + 8 * (e >> 2) + 4 * hh;
                    const bool keep = dir ? (jj >= ii) : (jj <= ii);
                    *(bf16_t*)(sA + ii * 128 + ((((jj >> 3) ^ ((ii >> 1) & 7))) << 4) + (jj & 7) * 2) = bf1(keep ? a[e] : 0.f);
                }
            }
            f32x16 o[2];
#pragma unroll
            for (int mt = 0; mt < 2; ++mt)
#pragma unroll
                for (int e = 0; e < 16; ++e) o[mt][e] = 0.f;
#pragma unroll
            for (int kt = 0; kt < 4; ++kt)
#pragma unroll
                for (int s = 0; s < 2; ++s) {
                    typedef unsigned u32x4 __attribute__((ext_vector_type(4)));
                    u32x4 pu = {pk2(S[kt][8 * s], S[kt][8 * s + 1]), pk2(S[kt][8 * s + 2], S[kt][8 * s + 3]), pk2(S[kt][8 * s + 4], S[kt][8 * s + 5]), pk2(S[kt][8 * s + 6], S[kt][8 * s + 7])};
                    const bf16x8 sf = __builtin_bit_cast(bf16x8, pu);
#pragma unroll
                    for (int mt = 0; mt < 2; ++mt) {
                        const int ri = 32 * mt + l31, c = 4 * kt + 2 * s + hh;
                        const bf16x8 af = *(const bf16x8*)(sQt + ri * 256 + ((c ^ (ri & 15)) << 4));
                        o[mt] = MFMA32(af, sf, o[mt]);
                    }
                }
            __syncthreads();
#pragma unroll
            for (int s2 = 0; s2 < 4; ++s2) {
                const int c = 2 * s2 + hh;
                const bf16x8 vf = *(const bf16x8*)(sVT + (dvb + l31) * 128 + ((c ^ sw) << 4));
#pragma unroll
                for (int mt = 0; mt < 2; ++mt) {
                    const bf16x8 af = *(const bf16x8*)(sA + (32 * mt + l31) * 128 + ((c ^ sw) << 4));
                    o[mt] = MFMA32(af, vf, o[mt]);
                }
            }
            bf16_t* od = Oo + (size_t)rowbase * 1024 + h * 256 + dvb + l31;
#pragma unroll
            for (int mt = 0; mt < 2; ++mt)
#pragma unroll
                for (int e = 0; e < 16; ++e) od[(size_t)(32 * mt + (e & 3) + 8 * (e >> 2) + 4 * hh) * 1024] = bf1(o[mt][e]);
        }
#pragma unroll
        for (int kt = 0; kt < 4; ++kt)
#pragma unroll
            for (int g4 = 0; g4 < 4; ++g4) {
                const f32x4 dd = *(const f32x4*)(sD + 32 * kt + 8 * g4 + 4 * hh);
#pragma unroll
                for (int jq = 0; jq < 4; ++jq) S[kt][4 * g4 + jq] *= dd[jq];
            }
#pragma unroll
        for (int s2 = 0; s2 < 4; ++s2) {
            const int c = 2 * s2 + hh;
            const bf16x8 vf = *(const bf16x8*)(sVT + (dvb + l31) * 128 + ((c ^ sw) << 4));
#pragma unroll
            for (int kt = 0; kt < 4; ++kt) {
                const bf16x8 af = *(const bf16x8*)(sKh + (32 * kt + l31) * 128 + ((c ^ sw) << 4));
                S[kt] = MFMA32(af, vf, S[kt]);
            }
        }
        __syncthreads();
    }
}

DI void phase_combine(const Params& p, int panel) {
    const int tid = get_tid(), lane = tid & 63, w = tid >> 6;
    const bf16_t* OF = (const bf16_t*)(p.ws + R_OF);
    const bf16_t* OB = (const bf16_t*)(p.ws + R_OB);
    const bf16_t* SG = (const bf16_t*)(p.ws + R_SG);
    bf16_t* Y = (bf16_t*)(p.ws + R_YGLA);
    for (int row = panel * 256 + w; row < panel * 256 + 256; row += 8) {
        const size_t o = (size_t)row * 1024 + lane * 16;
        const uint4 a0 = *(const uint4*)(OF + o), a1 = *(const uint4*)(OF + o + 8);
        const uint4 b0 = *(const uint4*)(OB + o), b1 = *(const uint4*)(OB + o + 8);
        const uint4 g0 = *(const uint4*)(SG + o), g1 = *(const uint4*)(SG + o + 8);
        const unsigned au[8] = {a0.x, a0.y, a0.z, a0.w, a1.x, a1.y, a1.z, a1.w};
        const unsigned bu[8] = {b0.x, b0.y, b0.z, b0.w, b1.x, b1.y, b1.z, b1.w};
        const unsigned gu[8] = {g0.x, g0.y, g0.z, g0.w, g1.x, g1.y, g1.z, g1.w};
        float v[16]; float ss = 0.f;
#pragma unroll
        for (int e = 0; e < 8; ++e) { v[2 * e] = bflo(au[e]) + bflo(bu[e]); v[2 * e + 1] = bfhi(au[e]) + bfhi(bu[e]); ss += v[2 * e] * v[2 * e] + v[2 * e + 1] * v[2 * e + 1]; }
#pragma unroll
        for (int of = 8; of >= 1; of >>= 1) ss += __shfl_xor(ss, of);
        const float rs = rsqrtf(ss * (1.0f / 256.0f) + EPS);
        const float* gn = p.gla_hn + ((lane * 16) & 255);
        unsigned ou[8];
#pragma unroll
        for (int e = 0; e < 8; ++e) ou[e] = pk2(v[2 * e] * rs * gn[2 * e] * bflo(gu[e]), v[2 * e + 1] * rs * gn[2 * e + 1] * bfhi(gu[e]));
        *(uint4*)(Y + o) = make_uint4(ou[0], ou[1], ou[2], ou[3]);
        *(uint4*)(Y + o + 8) = make_uint4(ou[4], ou[5], ou[6], ou[7]);
    }
}

template <int MODE>
DI void phase_rows(const Params& p, char* smem, int panel) {
    float* md = (float*)smem;
    const int tid = get_tid(), lane = tid & 63, w = tid >> 6;
    const bf16_t* Yin = (const bf16_t*)(p.ws + (MODE == 0 ? R_Y2 : R_Y3));
    bf16_t* H2 = (bf16_t*)(p.ws + R_H2);
    const float* pn = MODE == 0 ? p.post_norm1 : p.post_norm2;
    for (int tile = panel; tile == panel; ++tile) {
        const int r = tile >> 5;
        __syncthreads();
        if (MODE == 0) { load_mod(p, r, 2, md); load_mod(p, r, 3, md + 1024); load_mod(p, r, 4, md + 2048); }
        else load_mod(p, r, 5, md);
        __syncthreads();
        for (int i = 0; i < 32; ++i) {
            const int row = tile * 256 + w * 32 + i;
            float y[16]; float ss = 0.f;
#pragma unroll
            for (int j = 0; j < 4; ++j) {
                const uint2 u = *(const uint2*)(Yin + (size_t)row * 1024 + lane * 4 + 256 * j);
                y[4 * j] = bflo(u.x); y[4 * j + 1] = bfhi(u.x); y[4 * j + 2] = bflo(u.y); y[4 * j + 3] = bfhi(u.y);
                ss += y[4 * j] * y[4 * j] + y[4 * j + 1] * y[4 * j + 1] + y[4 * j + 2] * y[4 * j + 2] + y[4 * j + 3] * y[4 * j + 3];
            }
            ss = wave_sum(ss);
            const float rs = rsqrtf(ss * (1.0f / 1024.0f) + EPS);
            float xn[16]; float s2 = 0.f;
#pragma unroll
            for (int j = 0; j < 4; ++j) {
                const int col = lane * 4 + 256 * j;
                const float* xs = (MODE == 0 ? p.x : (const float*)p.out) + (size_t)row * 1024 + col;
                const f32x4 xv = *(const f32x4*)xs, g = *(const f32x4*)(pn + col), gt = *(const f32x4*)(md + col);
#pragma unroll
                for (int e = 0; e < 4; ++e) { xn[4 * j + e] = xv[e] + gt[e] * (y[4 * j + e] * rs * g[e]); s2 += xn[4 * j + e] * xn[4 * j + e]; }
                f32x4 ov = {xn[4 * j], xn[4 * j + 1], xn[4 * j + 2], xn[4 * j + 3]};
                *(f32x4*)(p.out + (size_t)row * 1024 + col) = ov;
            }
            if (MODE == 0) {
                s2 = wave_sum(s2);
                const float rs2 = rsqrtf(s2 * (1.0f / 1024.0f) + EPS);
#pragma unroll
                for (int j = 0; j < 4; ++j) {
                    const int col = lane * 4 + 256 * j;
                    const f32x4 g = *(const f32x4*)(p.pre_norm2 + col), sh = *(const f32x4*)(md + 1024 + col), sc = *(const f32x4*)(md + 2048 + col);
                    float o[4];
#pragma unroll
                    for (int e = 0; e < 4; ++e) o[e] = xn[4 * j + e] * rs2 * g[e] * (1.f + sc[e]) + sh[e];
                    uint2 u; u.x = pk2(o[0], o[1]); u.y = pk2(o[2], o[3]);
                    *(uint2*)(H2 + (size_t)row * 1024 + col) = u;
                }
            }
        }
    }
}

DI void gsync(unsigned* bar, unsigned k) {
    __syncthreads();
    const unsigned epoch = k * gridDim.x;
    if (threadIdx.x == 0) {
        __threadfence();
        atomicAdd(bar, 1u);
        while (__hip_atomic_load(bar, __ATOMIC_RELAXED, __HIP_MEMORY_SCOPE_AGENT) < epoch) __builtin_amdgcn_s_sleep(1);
        __threadfence();
    }
    __syncthreads();
}

__global__ void __launch_bounds__(NT) fwd_megakernel(Params p) {
    __shared__ __attribute__((aligned(16))) char smem[131072];
    cg::grid_group grid = cg::this_grid();
    char* ws = p.ws;
    unsigned* bar = (unsigned*)(ws + OFF_BAR);
    phase_prep(p, smem);
    grid.sync();
    phase_h(p, smem);
    gsync(bar, 1u);
    {
        EpiIn e; e.Q = (bf16_t*)(ws + R_Q); e.Kk = (bf16_t*)(ws + R_K); e.Vt = (bf16_t*)(ws + R_VT); e.gq = (bf16_t*)(ws + R_GQ); e.gk = (bf16_t*)(ws + R_GK);
        e.gvT = (bf16_t*)(ws + R_GVT); e.sg = (bf16_t*)(ws + R_SG); e.mg = (bf16_t*)p.out; e.glow = (float*)(ws + OFF_GLOW); e.rope = (const float*)(ws + OFF_ROPE); e.kmax = (float*)(ws + OFF_KMAX);
        gemm_phase_ex<true>((const bf16_t*)(ws + R_H), 1024, (const bf16_t*)(ws + OFF_WIN), 1024, 1024, 264, 33, smem, e, blockIdx.x, gridDim.x);
    }
    gsync(bar, 2u);
    phase_attn(p, smem);
    gsync(bar, 3u);
    phase_gate(p, smem);
    gsync(bar, 4u);
    if (blockIdx.x < 64) phase_gla(p, smem);
    else {
        EpiGate0 e0; e0.mg = (bf16_t*)p.out;
        gemm_phase_ex<false>((const bf16_t*)(ws + R_H), 1024, (const bf16_t*)(ws + OFF_WDA), 1024, 1024, 256, 4, smem, e0, blockIdx.x - 64, gridDim.x - 64);
        const long gsz2 = (long)(gridDim.x - 64) * NT, gtid2 = (long)(blockIdx.x - 64) * NT + get_tid();
        repack<0>(p.w_bgla, 1024, 1024, (bf16_t*)(ws + OFF_WGLA), 1024, gtid2, gsz2);
        repack<0>(p.w_out, 1024, 1024, (bf16_t*)(ws + OFF_WOUT), 1024, gtid2, gsz2);
        repack<0>(p.w_ff1, 1024, 4096, (bf16_t*)(ws + OFF_WFF1), 4096, gtid2, gsz2);
        repack<0>(p.w_ff2, 4096, 1024, (bf16_t*)(ws + OFF_WFF2), 1024, gtid2, gsz2);
    }
    gsync(bar, 5u);
    for (int panel = blockIdx.x; panel < 256; panel += gridDim.x) phase_combine(p, panel);
    gsync(bar, 6u);
    for (int panel = blockIdx.x; panel < 256; panel += gridDim.x) {
        { EpiGate1 e1; e1.Y = (bf16_t*)(ws + R_Y); e1.mg = (const bf16_t*)p.out;
          gemm_panel((const bf16_t*)(ws + R_YGLA), 1024, (const bf16_t*)(ws + OFF_WGLA), 1024, 1024, panel, 4, smem, e1); }
        __syncthreads();
        { EpiStore<0> e; e.O = (bf16_t*)(ws + R_Y2); e.ldo = 1024;
          gemm_panel((const bf16_t*)(ws + R_Y), 1024, (const bf16_t*)(ws + OFF_WOUT), 1024, 1024, panel, 4, smem, e); }
        __syncthreads();
        phase_rows<0>(p, smem, panel);
        __syncthreads();
        { EpiStore<1> e; e.O = (bf16_t*)(ws + R_U); e.ldo = 4096;
          gemm_panel((const bf16_t*)(ws + R_H2), 1024, (const bf16_t*)(ws + OFF_WFF1), 1024, 1024, panel, 16, smem, e); }
        __syncthreads();
        { EpiStore<0> e; e.O = (bf16_t*)(ws + R_Y3); e.ldo = 1024;
          gemm_panel((const bf16_t*)(ws + R_U), 4096, (const bf16_t*)(ws + OFF_WFF2), 4096, 4096, panel, 4, smem, e); }
        __syncthreads();
        phase_rows<1>(p, smem, panel);
        __syncthreads();
    }
}

extern "C" void kernel_launch(void* const* d_in, const int* in_sizes, int n_in, void* d_out, int out_size, void* d_ws, size_t ws_size, hipStream_t stream) {
    static int grid_blocks = 0;
    if (!grid_blocks) {
        int dev = 0, cus = 0, per_cu = 0;
        hipGetDevice(&dev);
        hipDeviceGetAttribute(&cus, hipDeviceAttributeMultiprocessorCount, dev);
        hipOccupancyMaxActiveBlocksPerMultiprocessor(&per_cu, fwd_megakernel, NT, 0);
        if (per_cu < 1) per_cu = 1;
        grid_blocks = cus * per_cu;
        if (grid_blocks > 256) grid_blocks = 256;
    }
    Params p{};
    const float* const* in = (const float* const*)d_in;
    p.x = in[0]; p.c = in[1]; p.ctx = in[2]; p.c_ctx = in[3]; p.w_mod = in[4]; p.b_mod = in[5]; p.pre_norm1 = in[6]; p.w_in = in[7];
    p.w_gate_up = in[8]; p.b_gate_up = in[9]; p.lq1 = in[10]; p.lk1 = in[11]; p.lq2 = in[12]; p.lk2 = in[13]; p.da_hn = in[14]; p.gla_hn = in[15];
    p.w_bda = in[16]; p.w_bgla = in[17]; p.w_out = in[18]; p.post_norm1 = in[19]; p.pre_norm2 = in[20]; p.w_ff1 = in[21]; p.w_ff2 = in[22]; p.post_norm2 = in[23];
    p.out = (float*)d_out; p.ws = (char*)d_ws;
    hipMemsetAsync((char*)d_ws + OFF_BAR, 0, 256, stream);
    void* args[] = {&p};
    hipError_t e = hipLaunchCooperativeKernel((void*)fwd_megakernel, dim3(grid_blocks), dim3(NT), args, 0, stream);
    if (e != hipSuccess) fprintf(stderr, "cooperative launch failed: %s (grid %d)\n", hipGetErrorString(e), grid_blocks);
}
```

```cpp
#include <hip/hip_runtime.h>
#include <hip/hip_cooperative_groups.h>
#include <cstdio>
namespace cg = cooperative_groups;

typedef unsigned short bf16_t;
typedef short bf16x8 __attribute__((ext_vector_type(8)));
typedef float f32x16 __attribute__((ext_vector_type(16)));
typedef float f32x4 __attribute__((ext_vector_type(4)));
typedef float f32x2 __attribute__((ext_vector_type(2)));
typedef __bf16 bf2_t __attribute__((ext_vector_type(2)));
typedef _Float16 h4_t __attribute__((ext_vector_type(4)));

#define DI __device__ __forceinline__
#define MFMA32(a, b, c) __builtin_amdgcn_mfma_f32_32x32x16_bf16((a), (b), (c), 0, 0, 0)

constexpr int NT = 512;
constexpr int TLAT = 8192, NB = 8, NLAT = 65536, NROW = 67584, TKV = 8448;
constexpr float EPS = 1e-6f;
constexpr size_t MiB = 1048576;
constexpr size_t OFF_WIN = 0;
constexpr size_t OFF_WDA = OFF_WIN + 8448ull * 1024 * 2;
constexpr size_t OFF_WGLA = OFF_WDA + 2 * MiB;
constexpr size_t OFF_WOUT = OFF_WGLA + 2 * MiB;
constexpr size_t OFF_WFF1 = OFF_WOUT + 2 * MiB;
constexpr size_t OFF_WFF2 = OFF_WFF1 + 8 * MiB;
constexpr size_t OFF_MODP = OFF_WFF2 + 8 * MiB;
constexpr size_t OFF_ROPE = OFF_MODP + 16ull * 9 * 6144 * 4;
constexpr size_t OFF_GLOW = OFF_ROPE + 16384;
constexpr size_t OFF_KMAX = OFF_GLOW + 67584ull * 32 * 4;
constexpr size_t OFF_BAR = OFF_KMAX + 1024;
constexpr size_t R_H = 64 * MiB;
constexpr size_t R_Q = R_H + 132 * MiB;
constexpr size_t R_K = R_Q + 128 * MiB;
constexpr size_t R_VT = R_K + 132 * MiB;
constexpr size_t R_GQ = R_VT + 132 * MiB;
constexpr size_t R_GK = R_GQ + 64 * MiB;
constexpr size_t R_GVT = R_GK + 66 * MiB;
constexpr size_t R_SG = R_GVT + 132 * MiB;
constexpr size_t WS_END = R_SG + 128 * MiB;
static_assert(OFF_BAR + 1024 <= R_H, "small region overflow");
static_assert(WS_END <= 1024 * MiB, "workspace overflow");
constexpr size_t R_BF = R_Q;
constexpr size_t R_BB = R_Q + 66 * MiB;
constexpr size_t R_OF = R_K + 4 * MiB;
constexpr size_t R_OB = R_VT;
constexpr size_t R_YGLA = R_SG;
constexpr size_t R_Y = R_GVT;
constexpr size_t R_Y2 = R_SG;
constexpr size_t R_H2 = R_H;
constexpr size_t R_U = R_Q;
constexpr size_t R_Y3 = R_GVT;

struct Params {
    const float *x, *c, *ctx, *c_ctx, *w_mod, *b_mod, *pre_norm1, *w_in, *w_gate_up, *b_gate_up;
    const float *lq1, *lk1, *lq2, *lk2, *da_hn, *gla_hn, *w_bda, *w_bgla, *w_out, *post_norm1, *pre_norm2, *w_ff1, *w_ff2, *post_norm2;
    float* out;
    char* ws;
};

DI unsigned pk2(float a, float b) { f32x2 v = {a, b}; bf2_t r = __builtin_convertvector(v, bf2_t); return __builtin_bit_cast(unsigned, r); }
DI bf16_t bf1(float a) { __bf16 r = (__bf16)a; return __builtin_bit_cast(unsigned short, r); }
DI float bflo(unsigned v) { return __uint_as_float(v << 16); }
DI float bfhi(unsigned v) { return __uint_as_float(v & 0xffff0000u); }
DI float wave_sum(float v) {
#pragma unroll
    for (int o = 32; o >= 1; o >>= 1) v += __shfl_xor(v, o);
    return v;
}
DI int get_tid() { int t = threadIdx.x; asm volatile("" : "+v"(t)); return t; }
DI float sigmoidf_(float x) { return 1.0f / (1.0f + __expf(-x)); }

template <int MODE>
DI void repack(const float* __restrict__ src, int K, int Nsrc, bf16_t* __restrict__ dst, int Nd, long gtid, long gsz) {
    const long total = (long)Nd * (K / 8);
    for (long it = gtid; it < total; it += gsz) {
        const int n = (int)(it % Nd), kc = (int)(it / Nd);
        int col = n; bool valid = true;
        if (MODE == 1) { if (n < 5120) col = n; else if (n < 8192) col = n + 32; else if (n < 8224) col = n - 8192 + 5120; else valid = false; }
        float v[8];
#pragma unroll
        for (int j = 0; j < 8; ++j) v[j] = valid ? src[(size_t)(kc * 8 + j) * Nsrc + col] : 0.f;
        uint4 o; o.x = pk2(v[0], v[1]); o.y = pk2(v[2], v[3]); o.z = pk2(v[4], v[5]); o.w = pk2(v[6], v[7]);
        *(uint4*)(dst + (size_t)n * K + kc * 8) = o;
    }
}

DI void sincos_acc(float a, float& s, float& c) {
    const float q = rintf(a * 0.63661977236758134f);
    float r = fmaf(-q, 1.5703125f, a); r = fmaf(-q, 4.837512969970703125e-4f, r); r = fmaf(-q, 7.54978995489188216e-8f, r);
    const float r2 = r * r;
    const float sp = r + r * r2 * (-1.6666666666e-1f + r2 * (8.3333333333e-3f + r2 * (-1.98412698e-4f + r2 * 2.7557319e-6f)));
    const float cp = 1.0f + r2 * (-0.5f + r2 * (4.16666666667e-2f + r2 * (-1.38888888889e-3f + r2 * (2.48015873e-5f + r2 * -2.75573192e-7f))));
    const int qi = ((int)q) & 3;
    s = (qi == 0) ? sp : (qi == 1) ? cp : (qi == 2) ? -sp : -cp;
    c = (qi == 0) ? cp : (qi == 1) ? -sp : (qi == 2) ? -cp : sp;
}

DI void phase_prep(const Params& p, char* smem) {
    const int tid = get_tid();
    const long gsz = (long)gridDim.x * NT, gtid = (long)blockIdx.x * NT + tid;
    char* ws = p.ws;
    repack<1>(p.w_in, 1024, 8224, (bf16_t*)(ws + OFF_WIN), 8448, gtid, gsz);
    repack<0>(p.w_bda, 1024, 1024, (bf16_t*)(ws + OFF_WDA), 1024, gtid, gsz);
    if (gtid < 256) ((float*)(ws + OFF_KMAX))[gtid] = 0.f;
    if (gtid < 2048) {
        const int pos = (int)gtid >> 4, f = (int)gtid & 15;
        const float inv = exp2f(-(float)f * (13.287712379549449f / 16.0f));
        float s, c; sincos_acc((float)pos * inv, s, c);
        float* rt = (float*)(ws + OFF_ROPE);
        rt[gtid] = c; rt[2048 + gtid] = s;
    }
    float* sil = (float*)smem;
    float* modp = (float*)(ws + OFF_MODP);
    for (int item = blockIdx.x; item < 192; item += gridDim.x) {
        const int cb = item % 12, ks = item / 12;
        __syncthreads();
        for (int i = tid; i < 9 * 64; i += NT) {
            const int r = i >> 6, kk = i & 63;
            const float v = (r < 8) ? p.c[r * 1024 + ks * 64 + kk] : p.c_ctx[ks * 64 + kk];
            sil[i] = v * sigmoidf_(v);
        }
        __syncthreads();
        const int n = cb * 512 + tid;
        float acc[9];
#pragma unroll
        for (int r = 0; r < 9; ++r) acc[r] = 0.f;
        for (int kk = 0; kk < 64; ++kk) {
            const float w = p.w_mod[(size_t)(ks * 64 + kk) * 6144 + n];
#pragma unroll
            for (int r = 0; r < 9; ++r) acc[r] = fmaf(sil[r * 64 + kk], w, acc[r]);
        }
#pragma unroll
        for (int r = 0; r < 9; ++r) modp[(size_t)(ks * 9 + r) * 6144 + n] = acc[r];
    }
}

DI void load_mod(const Params& p, int r, int which, float* dst) {
    const float* modp = (const float*)(p.ws + OFF_MODP);
    for (int n = threadIdx.x; n < 1024; n += NT) {
        float a = p.b_mod[which * 1024 + n];
#pragma unroll
        for (int ks = 0; ks < 16; ++ks) a += modp[(size_t)(ks * 9 + r) * 6144 + which * 1024 + n];
        dst[n] = a;
    }
}

DI void h_row2(const Params& p, const float* md, bf16_t* H, int rowA, int rowB, int lane) {
    const float* sa = rowA < NLAT ? p.x + (size_t)rowA * 1024 : p.ctx + (size_t)(rowA - NLAT) * 1024;
    const float* sbp = rowB < NLAT ? p.x + (size_t)rowB * 1024 : p.ctx + (size_t)(rowB - NLAT) * 1024;
    f32x4 va[4], vb[4]; float sa2 = 0.f, sb2 = 0.f;
#pragma unroll
    for (int j = 0; j < 4; ++j) { va[j] = *(const f32x4*)(sa + lane * 4 + 256 * j); vb[j] = *(const f32x4*)(sbp + lane * 4 + 256 * j); }
#pragma unroll
    for (int j = 0; j < 4; ++j) {
        sa2 += va[j].x * va[j].x + va[j].y * va[j].y + va[j].z * va[j].z + va[j].w * va[j].w;
        sb2 += vb[j].x * vb[j].x + vb[j].y * vb[j].y + vb[j].z * vb[j].z + vb[j].w * vb[j].w;
    }
    sa2 = wave_sum(sa2); sb2 = wave_sum(sb2);
    const float ra = rsqrtf(sa2 * (1.0f / 1024.0f) + EPS), rb = rsqrtf(sb2 * (1.0f / 1024.0f) + EPS);
#pragma unroll
    for (int j = 0; j < 4; ++j) {
        const int col = lane * 4 + 256 * j;
        const f32x4 g = *(const f32x4*)(p.pre_norm1 + col);
        const f32x4 sh = *(const f32x4*)(md + col), sc = *(const f32x4*)(md + 1024 + col);
        float oa[4], ob[4];
#pragma unroll
        for (int e = 0; e < 4; ++e) { const float gm = g[e] * (1.f + sc[e]); oa[e] = va[j][e] * ra * gm + sh[e]; ob[e] = vb[j][e] * rb * gm + sh[e]; }
        uint2 o; o.x = pk2(oa[0], oa[1]); o.y = pk2(oa[2], oa[3]);
        *(uint2*)(H + (size_t)rowA * 1024 + col) = o;
        o.x = pk2(ob[0], ob[1]); o.y = pk2(ob[2], ob[3]);
        *(uint2*)(H + (size_t)rowB * 1024 + col) = o;
    }
}

DI void phase_h(const Params& p, char* smem) {
    float* md = (float*)smem;
    const int tid = get_tid(), lane = tid & 63, w = tid >> 6;
    bf16_t* H = (bf16_t*)(p.ws + R_H);
    for (int tile = blockIdx.x; tile < 256; tile += gridDim.x) {
        __syncthreads();
        load_mod(p, tile >> 5, 0, md); load_mod(p, tile >> 5, 1, md + 1024);
        __syncthreads();
        for (int i = 0; i < 16; ++i) h_row2(p, md, H, tile * 256 + w * 32 + i, tile * 256 + w * 32 + 16 + i, lane);
    }
    __syncthreads();
    load_mod(p, 8, 0, md); load_mod(p, 8, 1, md + 1024);
    __syncthreads();
    for (int r2 = blockIdx.x * 8 + w; r2 < 1024; r2 += gridDim.x * 8) h_row2(p, md, H, NLAT + 2 * r2, NLAT + 2 * r2 + 1, lane);
}

typedef __attribute__((address_space(3))) unsigned lds_u32;
DI lds_u32* to_lds(const void* p) { return (lds_u32*)(unsigned)(size_t)p; }
#define GLDS16(src, dst) __builtin_amdgcn_global_load_lds((const unsigned*)(src), to_lds(dst), 16, 0, 0)

#define MFMA16(a, b, c) __builtin_amdgcn_mfma_f32_16x16x32_bf16((a), (b), (c), 0, 0, 0)
template <bool SWAP, class Epi>
DI void gemm_tile(const bf16_t* A, int lda, const bf16_t* B, int ldb, int K, int m0, int n0, bool first, bool has_next, int nm0, int nn0, char* smem, Epi& epi) {
    const int tid = get_tid(), lane = tid & 63, w = tid >> 6, wm = w >> 2, wn = w & 3, l15 = lane & 15, q = lane >> 4;
    f32x4 acc[8][4];
#pragma unroll
    for (int i = 0; i < 8; ++i)
#pragma unroll
        for (int j = 0; j < 4; ++j) acc[i][j] = (f32x4){0.f, 0.f, 0.f, 0.f};
    const int srow = 8 * w + (lane >> 3), schunk = (lane & 7) ^ (4 * (w & 1) + (lane >> 4));
    const bf16_t* ga = A + (size_t)(m0 + srow) * lda + schunk * 8;
    const bf16_t* gb = B + (size_t)(n0 + srow) * ldb + schunk * 8;
    const bf16_t* nga = A + (size_t)(nm0 + srow) * lda + schunk * 8;
    const bf16_t* ngb = B + (size_t)(nn0 + srow) * ldb + schunk * 8;
    const int sw = (l15 >> 1) & 7;
    const int aofs = (128 * wm + l15) * 128, bofs = 32768 + (64 * wn + l15) * 128;
    char* sdst = smem + w * 1024;
#define GEMM_STAGE(pa, pb, buf, kt_) do { _Pragma("unroll") for (int i = 0; i < 4; ++i) { \
        GLDS16(pa + (size_t)i * 64 * lda + (kt_) * 64, sdst + (buf) * 65536 + i * 8192); \
        GLDS16(pb + (size_t)i * 64 * ldb + (kt_) * 64, sdst + (buf) * 65536 + 32768 + i * 8192); } } while (0)
    if (first) {
        GEMM_STAGE(ga, gb, 0, 0);
        asm volatile("s_waitcnt vmcnt(0)" ::: "memory");
        __syncthreads();
    }
    const int KT = K >> 6;
    for (int kt = 0; kt < KT; ++kt) {
        const int cur = kt & 1;
        if (kt + 1 < KT) GEMM_STAGE(ga, gb, cur ^ 1, kt + 1);
        else if (has_next) GEMM_STAGE(nga, ngb, cur ^ 1, 0);
        const char* sb = smem + cur * 65536;
#pragma unroll
        for (int kk = 0; kk < 2; ++kk) {
            const int co = ((4 * kk + q) ^ sw) << 4;
            bf16x8 af[8], bf[4];
#pragma unroll
            for (int mi = 0; mi < 8; ++mi) af[mi] = *(const bf16x8*)(sb + aofs + mi * 2048 + co);
#pragma unroll
            for (int ni = 0; ni < 4; ++ni) bf[ni] = *(const bf16x8*)(sb + bofs + ni * 2048 + co);
#pragma unroll
            for (int mi = 0; mi < 8; ++mi)
#pragma unroll
                for (int ni = 0; ni < 4; ++ni) acc[mi][ni] = SWAP ? MFMA16(af[mi], bf[ni], acc[mi][ni]) : MFMA16(bf[ni], af[mi], acc[mi][ni]);
        }
        asm volatile("s_waitcnt vmcnt(0)" ::: "memory");
        __syncthreads();
    }
#undef GEMM_STAGE
#pragma unroll
    for (int mi = 0; mi < 8; ++mi) {
        if constexpr (SWAP) {
#pragma unroll
            for (int ni = 0; ni < 4; ++ni) epi.vt(m0 + 128 * wm + 16 * mi + 4 * q, n0 + 64 * wn + 16 * ni + l15, acc[mi][ni]);
        } else epi(m0 + 128 * wm + 16 * mi + l15, n0 + 64 * wn, acc[mi], q);
        asm volatile("" ::: "memory");
    }
}

DI void tile_map(int id, int MT, int NTl, int& mt, int& nt) {
    const int x = id & 7, local = id >> 3, mtx = MT >> 3;
    const int full = mtx >> 2, per = 4 * NTl;
    int patch = local / per, wv = local - patch * per, pm = 4;
    if (patch >= full) { patch = full; wv = local - full * per; pm = mtx - full * 4; }
    const int mo = wv % pm; nt = wv / pm;
    mt = (patch * 4 + mo) * 8 + x;
}

DI void tile_map_in(int id, int& mt, int& nt) {
    if (id < 8448) { tile_map(id, 256, 33, mt, nt); return; }
    const int id2 = id - 8448, k = id2 >> 3;
    mt = 256 + (id2 & 7);
    nt = k < 8 ? 4 + k : k < 10 ? 14 + (k - 8) : k < 14 ? 16 + (k - 10) : 32;
}
template <bool VSWAP, class Epi>
DI void gemm_phase_ex(const bf16_t* A, int lda, const bf16_t* B, int ldb, int K, int MT, int NTl, char* smem, Epi& epi, int bid, int nblk) {
    const int total = VSWAP ? 8448 + 120 : MT * NTl;
    bool first = true;
    for (int id = bid; id < total; id += nblk) {
        int mt, nt, mt2 = 0, nt2 = 0;
        if (VSWAP) tile_map_in(id, mt, nt); else tile_map(id, MT, NTl, mt, nt);
        const bool has_next = id + nblk < total;
        if (has_next) { if (VSWAP) tile_map_in(id + nblk, mt2, nt2); else tile_map(id + nblk, MT, NTl, mt2, nt2); }
        if constexpr (VSWAP) { if (Epi::is_vt(nt)) { gemm_tile<true>(A, lda, B, ldb, K, mt * 256, nt * 256, first, has_next, mt2 * 256, nt2 * 256, smem, epi); first = false; continue; } }
        gemm_tile<false>(A, lda, B, ldb, K, mt * 256, nt * 256, first, has_next, mt2 * 256, nt2 * 256, smem, epi);
        first = false;
    }
}
template <class Epi>
DI void gemm_phase(const bf16_t* A, int lda, const bf16_t* B, int ldb, int K, int MT, int NTl, char* smem, Epi& epi) {
    gemm_phase_ex<false>(A, lda, B, ldb, K, MT, NTl, smem, epi, blockIdx.x, gridDim.x);
}

DI float xhalf_max(float v) {
    typedef unsigned u32x2 __attribute__((ext_vector_type(2)));
    const unsigned u = __float_as_uint(v);
    const u32x2 r = __builtin_amdgcn_permlane32_swap(u, u, false, false);
    return fmaxf(__uint_as_float(r[0]), __uint_as_float(r[1]));
}
DI float xhalf_sum(float v) {
    typedef unsigned u32x2 __attribute__((ext_vector_type(2)));
    const unsigned u = __float_as_uint(v);
    const u32x2 r = __builtin_amdgcn_permlane32_swap(u, u, false, false);
    return __uint_as_float(r[0]) + __uint_as_float(r[1]);
}
template <class Epi>
DI void gemm_panel(const bf16_t* A, int lda, const bf16_t* B, int ldb, int K, int panel, int NTl, char* smem, Epi& epi) {
    for (int nt = 0; nt < NTl; ++nt)
        gemm_tile<false>(A, lda, B, ldb, K, panel * 256, nt * 256, nt == 0, nt + 1 < NTl, panel * 256, (nt + 1) * 256, smem, epi);
}

DI float quad_sum(float v) { v += __shfl_xor(v, 16); v += __shfl_xor(v, 32); return v; }
struct EpiIn {
    bf16_t *Q, *Kk, *Vt, *gq, *gk, *gvT, *sg, *mg; float* glow; const float* rope; float* kmax;
    static DI bool is_vt(int nt) { return (nt >= 8 && nt < 12) || (nt >= 16 && nt < 20); }
    DI void vt(int row0, int col, const f32x4& v) const {
        int b, t;
        if (row0 < NLAT) { b = row0 >> 13; t = row0 & 8191; } else { const int r2 = row0 - NLAT; b = r2 >> 8; t = TLAT + (r2 & 255); }
        bf16_t* dst;
        if (col < 3072) { const int c = col - 2048; dst = Vt + (size_t)((b * 8 + (c >> 7)) * 128 + (c & 127)) * TKV + t; }
        else { const int c = col - 4096; dst = gvT + (size_t)((b * 4 + (c >> 8)) * 256 + (c & 255)) * TKV + t; }
        uint2 u; u.x = pk2(v[0], v[1]); u.y = pk2(v[2], v[3]);
        *(uint2*)dst = u;
    }
    DI void operator()(int row, int cb, const f32x4 (&v)[4], int q) const {
        if (cb >= 8224) return;
        const bool lat = row < NLAT;
        int b, t;
        if (lat) { b = row >> 13; t = row & 8191; } else { const int r2 = row - NLAT; b = r2 >> 8; t = TLAT + (r2 & 255); }
        if (cb < 2048) {
            const bool isq = cb < 1024;
            if (isq && !lat) return;
            const int c = cb & 1023, head = c >> 7, comp = (c >> 6) & 1;
            f32x4 o[4];
            if (lat) {
#pragma unroll
                for (int half = 0; half < 2; ++half) {
                    const int pos = half ? (t & 63) : (t >> 6);
                    const f32x4 c4 = *(const f32x4*)(rope + pos * 16 + 4 * q), s4 = *(const f32x4*)(rope + 2048 + pos * 16 + 4 * q);
#pragma unroll
                    for (int j = 0; j < 4; ++j) {
                        const float x1 = v[2 * half][j], x2 = v[2 * half + 1][j];
                        o[2 * half][j] = x1 * c4[j] - x2 * s4[j];
                        o[2 * half + 1][j] = x2 * c4[j] + x1 * s4[j];
                    }
                }
            } else {
#pragma unroll
                for (int ni = 0; ni < 4; ++ni) o[ni] = v[ni];
            }
            if (!isq) {
#pragma unroll
                for (int half = 0; half < 2; ++half) {
                    float ssq = 0.f;
#pragma unroll
                    for (int j = 0; j < 4; ++j) ssq += o[2 * half][j] * o[2 * half][j] + o[2 * half + 1][j] * o[2 * half + 1][j];
                    ssq = quad_sum(ssq);
#pragma unroll
                    for (int of = 8; of >= 1; of >>= 1) ssq = fmaxf(ssq, __shfl_xor(ssq, of));
                    if ((threadIdx.x & 63) == 0) atomicMax((unsigned*)(kmax + ((b * 8 + head) * 2 + comp) * 2 + half), __float_as_uint(ssq));
                }
            }
            const float scl = isq ? 0.125f * 1.4426950408889634f : 1.0f;
            bf16_t* dst = isq ? Q + ((size_t)((b * 8 + head) * 2 + comp) * TLAT + t) * 64 : Kk + ((size_t)((b * 8 + head) * 2 + comp) * TKV + t) * 64;
#pragma unroll
            for (int ni = 0; ni < 4; ++ni) {
                uint2 u; u.x = pk2(o[ni][0] * scl, o[ni][1] * scl); u.y = pk2(o[ni][2] * scl, o[ni][3] * scl);
                *(uint2*)(dst + 16 * ni + 4 * q) = u;
            }
        } else if (cb < 3072) {
        } else if (cb < 4096) {
            const bool isq = cb < 3584;
            if (isq && !lat) return;
            const int c = (cb - 3072) & 511;
            const float scl = isq ? 0.08838834764831845f : 1.0f;
            bf16_t* dst = (isq ? gq : gk) + (size_t)row * 512 + c;
#pragma unroll
            for (int ni = 0; ni < 4; ++ni) {
                uint2 u; u.x = pk2(v[ni][0] * scl, v[ni][1] * scl); u.y = pk2(v[ni][2] * scl, v[ni][3] * scl);
                *(uint2*)(dst + 16 * ni + 4 * q) = u;
            }
        } else if (cb < 5120) {
        } else if (cb < 6144) {
            if (!lat) return;
            bf16_t* dst = sg + (size_t)row * 1024 + (cb - 5120);
#pragma unroll
            for (int ni = 0; ni < 4; ++ni) {
                float s[4];
#pragma unroll
                for (int j = 0; j < 4; ++j) { const float xx = v[ni][j]; s[j] = xx * sigmoidf_(xx); }
                uint2 u; u.x = pk2(s[0], s[1]); u.y = pk2(s[2], s[3]);
                *(uint2*)(dst + 16 * ni + 4 * q) = u;
            }
        } else if (cb < 8192) {
            if (!lat) return;
            bf16_t* dst = mg + (size_t)row * 2048 + (cb - 6144);
#pragma unroll
            for (int ni = 0; ni < 4; ++ni) {
                uint2 u; u.x = pk2(sigmoidf_(v[ni][0]), sigmoidf_(v[ni][1])); u.y = pk2(sigmoidf_(v[ni][2]), sigmoidf_(v[ni][3]));
                *(uint2*)(dst + 16 * ni + 4 * q) = u;
            }
        } else {
            float* dst = glow + (size_t)row * 32;
#pragma unroll
            for (int ni = 0; ni < 2; ++ni) *(f32x4*)(dst + 16 * ni + 4 * q) = v[ni];
        }
    }
};

struct EpiGate0 {
    bf16_t* mg;
    DI void operator()(int row, int cb, const f32x4 (&v)[4], int q) const {
#pragma unroll
        for (int ni = 0; ni < 4; ++ni) {
            const int col = cb + 16 * ni + 4 * q;
            const uint2 m = *(const uint2*)(mg + (size_t)row * 2048 + col);
            uint2 u; u.x = pk2(v[ni][0] * bflo(m.x), v[ni][1] * bfhi(m.x)); u.y = pk2(v[ni][2] * bflo(m.y), v[ni][3] * bfhi(m.y));
            *(uint2*)(mg + (size_t)row * 2048 + col) = u;
        }
    }
};
struct EpiGate1 {
    bf16_t* Y; const bf16_t* mg;
    DI void operator()(int row, int cb, const f32x4 (&v)[4], int q) const {
#pragma unroll
        for (int ni = 0; ni < 4; ++ni) {
            const int col = cb + 16 * ni + 4 * q;
            const uint2 m = *(const uint2*)(mg + (size_t)row * 2048 + 1024 + col);
            const uint2 pr = *(const uint2*)(mg + (size_t)row * 2048 + col);
            uint2 u; u.x = pk2(bflo(pr.x) + v[ni][0] * bflo(m.x), bfhi(pr.x) + v[ni][1] * bfhi(m.x));
            u.y = pk2(bflo(pr.y) + v[ni][2] * bflo(m.y), bfhi(pr.y) + v[ni][3] * bfhi(m.y));
            *(uint2*)(Y + (size_t)row * 1024 + col) = u;
        }
    }
};
template <int ACT>
struct EpiStore {
    bf16_t* O; int ldo;
    DI void operator()(int row, int cb, const f32x4 (&v)[4], int q) const {
#pragma unroll
        for (int ni = 0; ni < 4; ++ni) {
            float s[4];
#pragma unroll
            for (int j = 0; j < 4; ++j) { float xx = v[ni][j]; if (ACT == 1) { xx = fmaxf(xx, 0.f); xx = xx * xx; } s[j] = xx; }
            uint2 u; u.x = pk2(s[0], s[1]); u.y = pk2(s[2], s[3]);
            *(uint2*)(O + (size_t)row * ldo + cb + 16 * ni + 4 * q) = u;
        }
    }
};

DI float quad_max(float v) { v = fmaxf(v, __shfl_xor(v, 16)); v = fmaxf(v, __shfl_xor(v, 32)); return v; }
DI bf16x8 pack8(const f32x4& a, const f32x4& b) {
    typedef unsigned u32x4 __attribute__((ext_vector_type(4)));
    const u32x4 u = {pk2(a[0], a[1]), pk2(a[2], a[3]), pk2(b[0], b[1]), pk2(b[2], b[3])};
    return __builtin_bit_cast(bf16x8, u);
}

template <bool FAST>
DI void attn_kloop(char* smem, char* sdst, const bf16_t* gk0, const bf16_t* gk1, const bf16_t* gv, int comp, int krow0, int ksw, int l15, int qd,
                   const bf16x8 (&qf)[2][2], f32x4 (&O)[2][8], float (&m)[2], float (&l)[2]) {
#define ATT_STAGE(buf, kt_) do { _Pragma("unroll") for (int jj = 0; jj < 2; ++jj) { \
            GLDS16(gk0 + (size_t)((kt_) * 128 + 64 * jj) * 64, sdst + (buf) * 65536 + jj * 8192); \
            GLDS16(gk1 + (size_t)((kt_) * 128 + 64 * jj) * 64, sdst + (buf) * 65536 + 16384 + jj * 8192); } \
            _Pragma("unroll") for (int jj = 0; jj < 4; ++jj) GLDS16(gv + (size_t)(32 * jj) * TKV + (kt_) * 128, sdst + (buf) * 65536 + 32768 + jj * 8192); } while (0)
#define KFRAG(sub_, t_, kd_) (*(const bf16x8*)(skc + (32 * (sub_) + krow0 + 4 * (t_)) * 128 + (((4 * (kd_) + qd) ^ ksw) << 4)))
#define VFRAG(sub_, dt_) (*(const bf16x8*)(sb + 32768 + (16 * (dt_) + l15) * 256 + (((4 * (sub_) + qd) ^ l15) << 4)))
    ATT_STAGE(0, 0);
    asm volatile("s_waitcnt vmcnt(0)" ::: "memory");
    __syncthreads();
    f32x4 sinit[2];
#pragma unroll
    for (int qt = 0; qt < 2; ++qt) { const float v0 = FAST ? -m[qt] : 0.f; sinit[qt] = (f32x4){v0, v0, v0, v0}; }
    constexpr int NKT = TKV / 128;
    for (int kt = 0; kt < NKT; ++kt) {
        const int cur = kt & 1;
        if (kt + 1 < NKT) ATT_STAGE(cur ^ 1, kt + 1);
        const char* sb = smem + cur * 65536;
        const char* skc = sb + comp * 16384;
        if (FAST) {
            bf16x8 kf[2][2];
#pragma unroll
            for (int t = 0; t < 2; ++t)
#pragma unroll
                for (int kd = 0; kd < 2; ++kd) kf[t][kd] = KFRAG(0, t, kd);
            f32x4 Sn[2][2];
#pragma unroll
            for (int qt = 0; qt < 2; ++qt)
#pragma unroll
                for (int t = 0; t < 2; ++t) { Sn[qt][t] = MFMA16(kf[t][0], qf[qt][0], sinit[qt]); Sn[qt][t] = MFMA16(kf[t][1], qf[qt][1], Sn[qt][t]); }
#pragma unroll
            for (int sub = 0; sub < 4; ++sub) {
                f32x4 Sc[2][2];
#pragma unroll
                for (int qt = 0; qt < 2; ++qt)
#pragma unroll
                    for (int t = 0; t < 2; ++t) Sc[qt][t] = Sn[qt][t];
                bf16x8 va[4], vb[4];
#pragma unroll
                for (int dt = 0; dt < 4; ++dt) va[dt] = VFRAG(sub, dt);
                if (sub < 3) {
#pragma unroll
                    for (int t = 0; t < 2; ++t)
#pragma unroll
                        for (int kd = 0; kd < 2; ++kd) kf[t][kd] = KFRAG(sub + 1, t, kd);
                }
                __builtin_amdgcn_sched_barrier(0);
                bf16x8 pb[2];
#pragma unroll
                for (int qt = 0; qt < 2; ++qt) {
                    f32x4 p0, p1;
#pragma unroll
                    for (int i = 0; i < 4; ++i) { p0[i] = __builtin_amdgcn_exp2f(Sc[qt][0][i]); p1[i] = __builtin_amdgcn_exp2f(Sc[qt][1][i]); l[qt] += p0[i] + p1[i]; }
                    pb[qt] = pack8(p0, p1);
                }
#pragma unroll
                for (int dt = 0; dt < 4; ++dt) vb[dt] = VFRAG(sub, 4 + dt);
                __builtin_amdgcn_sched_barrier(0);
#pragma unroll
                for (int dt = 0; dt < 4; ++dt) {
                    O[0][dt] = MFMA16(va[dt], pb[0], O[0][dt]);
                    O[1][dt] = MFMA16(va[dt], pb[1], O[1][dt]);
                    if (sub < 3) Sn[dt >> 1][dt & 1] = MFMA16(kf[dt & 1][0], qf[dt >> 1][0], sinit[dt >> 1]);
                }
#pragma unroll
                for (int dt = 0; dt < 4; ++dt) {
                    O[0][4 + dt] = MFMA16(vb[dt], pb[0], O[0][4 + dt]);
                    O[1][4 + dt] = MFMA16(vb[dt], pb[1], O[1][4 + dt]);
                    if (sub < 3) Sn[dt >> 1][dt & 1] = MFMA16(kf[dt & 1][1], qf[dt >> 1][1], Sn[dt >> 1][dt & 1]);
                }
            }
        } else {
#pragma unroll 1
            for (int sub = 0; sub < 4; ++sub) {
                f32x4 S[2][2];
#pragma unroll
                for (int qt = 0; qt < 2; ++qt)
#pragma unroll
                    for (int t = 0; t < 2; ++t) { S[qt][t] = MFMA16(KFRAG(sub, t, 0), qf[qt][0], sinit[qt]); S[qt][t] = MFMA16(KFRAG(sub, t, 1), qf[qt][1], S[qt][t]); }
                bf16x8 pb[2];
#pragma unroll
                for (int qt = 0; qt < 2; ++qt) {
                    float mt = fmaxf(fmaxf(fmaxf(S[qt][0][0], S[qt][0][1]), fmaxf(S[qt][0][2], S[qt][0][3])), fmaxf(fmaxf(S[qt][1][0], S[qt][1][1]), fmaxf(S[qt][1][2], S[qt][1][3])));
                    mt = quad_max(mt);
                    if (mt > m[qt]) {
                        const float al = __builtin_amdgcn_exp2f(m[qt] - mt);
                        l[qt] *= al;
#pragma unroll
                        for (int dt = 0; dt < 8; ++dt) O[qt][dt] *= al;
                        m[qt] = mt;
                    }
                    f32x4 p0, p1;
#pragma unroll
                    for (int i = 0; i < 4; ++i) { p0[i] = __builtin_amdgcn_exp2f(S[qt][0][i] - m[qt]); p1[i] = __builtin_amdgcn_exp2f(S[qt][1][i] - m[qt]); l[qt] += p0[i] + p1[i]; }
                    pb[qt] = pack8(p0, p1);
                }
#pragma unroll
                for (int dt = 0; dt < 8; ++dt) {
                    const bf16x8 vf = VFRAG(sub, dt);
                    O[0][dt] = MFMA16(vf, pb[0], O[0][dt]);
                    O[1][dt] = MFMA16(vf, pb[1], O[1][dt]);
                }
            }
        }
        asm volatile("s_waitcnt vmcnt(0)" ::: "memory");
        __syncthreads();
    }
#undef ATT_STAGE
#undef KFRAG
#undef VFRAG
}

DI void phase_attn(const Params& p, char* smem) {
    const int tid = get_tid(), lane = tid & 63, w = tid >> 6, l15 = lane & 15, qd = lane >> 4;
    const int g = w >> 1, comp = w & 1;
    const bf16_t* Q = (const bf16_t*)(p.ws + R_Q);
    const bf16_t* Kk = (const bf16_t*)(p.ws + R_K);
    const bf16_t* Vt = (const bf16_t*)(p.ws + R_VT);
    const float* kmax = (const float*)(p.ws + OFF_KMAX);
    bf16_t* YDA = (bf16_t*)(p.ws + R_H);
    float d1 = 0.f, d2 = 0.f;
    for (int i = 0; i < 64; ++i) { d1 += p.lq1[i] * p.lk1[i]; d2 += p.lq2[i] * p.lk2[i]; }
    const float lam = __expf(d1) - __expf(d2) + 0.2f;
    const int krs = 8 * w + (lane >> 3), kcs = (lane & 7) ^ (((lane >> 4) & 1) | ((w & 3) << 1));
    const int vrs = 4 * w + (lane >> 4), vcs = (lane & 15) ^ ((4 * w + (lane >> 4)) & 15);
    const int krow0 = 8 * (l15 >> 2) + (l15 & 3);
    const int ksw = ((l15 >> 1) & 1) | (((l15 >> 2) & 3) << 1);
    float* xbuf = (float*)smem + g * 4096;
    char* sdst = smem + w * 1024;
    for (int id = blockIdx.x; id < 4096; id += gridDim.x) {
        const int x = id & 7, j = id >> 3, bh = (j >> 6) * 8 + x, qti = j & 63;
        const int b = bh >> 3, h = bh & 7;
        bf16x8 qf[2][2];
        float mb[2];
        const float kb = sqrtf(kmax[(bh * 2 + comp) * 2] + kmax[(bh * 2 + comp) * 2 + 1]);
#pragma unroll
        for (int qt = 0; qt < 2; ++qt) {
            const bf16_t* qp = Q + ((size_t)(bh * 2 + comp) * TLAT + qti * 128 + g * 32 + 16 * qt + l15) * 64 + qd * 8;
            qf[qt][0] = *(const bf16x8*)qp; qf[qt][1] = *(const bf16x8*)(qp + 32);
            float qn = 0.f;
#pragma unroll
            for (int kd = 0; kd < 2; ++kd)
#pragma unroll
                for (int e = 0; e < 8; ++e) { const float qv = __uint_as_float(((unsigned)(unsigned short)qf[qt][kd][e]) << 16); qn += qv * qv; }
            qn = quad_sum(qn);
            mb[qt] = sqrtf(qn) * kb * 1.01f + 1e-3f;
        }
        const bf16_t* gk0 = Kk + ((size_t)(bh * 2 + 0) * TKV + krs) * 64 + kcs * 8;
        const bf16_t* gk1 = gk0 + (size_t)TKV * 64;
        const bf16_t* gv = Vt + ((size_t)bh * 128 + vrs) * TKV + vcs * 8;
        f32x4 O[2][8];
#pragma unroll
        for (int qt = 0; qt < 2; ++qt)
#pragma unroll
            for (int d = 0; d < 8; ++d) O[qt][d] = (f32x4){0.f, 0.f, 0.f, 0.f};
        float m[2], l[2] = {0.f, 0.f};
        const int slow = __syncthreads_or(!(mb[0] <= 60.0f && mb[1] <= 60.0f));
        if (!slow) { m[0] = mb[0]; m[1] = mb[1]; attn_kloop<true>(smem, sdst, gk0, gk1, gv, comp, krow0, ksw, l15, qd, qf, O, m, l); }
        else { m[0] = -INFINITY; m[1] = -INFINITY; attn_kloop<false>(smem, sdst, gk0, gk1, gv, comp, krow0, ksw, l15, qd, qf, O, m, l); }
        l[0] = quad_sum(l[0]); l[1] = quad_sum(l[1]);
        if (comp == 1) {
#pragma unroll
            for (int qt = 0; qt < 2; ++qt) {
                const float i1 = lam / l[qt];
#pragma unroll
                for (int d = 0; d < 8; ++d)
#pragma unroll
                    for (int i = 0; i < 4; ++i) xbuf[((qt * 8 + d) * 4 + i) * 64 + lane] = O[qt][d][i] * i1;
            }
        }
        __syncthreads();
        if (comp == 0) {
#pragma unroll
            for (int qt = 0; qt < 2; ++qt) {
                const float i0 = 1.0f / l[qt];
                float ss = 0.f;
#pragma unroll
                for (int d = 0; d < 8; ++d)
#pragma unroll
                    for (int i = 0; i < 4; ++i) { const float o = O[qt][d][i] * i0 - xbuf[((qt * 8 + d) * 4 + i) * 64 + lane]; O[qt][d][i] = o; ss += o * o; }
                ss = quad_sum(ss);
                const float rs = rsqrtf(ss * (1.0f / 128.0f) + EPS) * 0.8f;
                const int t = qti * 128 + g * 32 + 16 * qt + l15;
                bf16_t* dst = YDA + ((size_t)b * TLAT + t) * 1024 + h * 128;
#pragma unroll
                for (int d = 0; d < 8; ++d) {
                    const int dv = 16 * d + 4 * qd;
                    const f32x4 hn = *(const f32x4*)(p.da_hn + dv);
                    uint2 u; u.x = pk2(O[qt][d][0] * rs * hn.x, O[qt][d][1] * rs * hn.y); u.y = pk2(O[qt][d][2] * rs * hn.z, O[qt][d][3] * rs * hn.w);
                    *(uint2*)(dst + dv) = u;
                }
            }
        }
    }
}

DI void phase_gate(const Params& p, char* smem) {
    const int tid = get_tid();
    const float* glow = (const float*)(p.ws + OFF_GLOW);
    float* sg = (float*)smem;
    float wf[16], wb[16];
#pragma unroll
    for (int r = 0; r < 16; ++r) { wf[r] = p.w_gate_up[(size_t)r * 512 + tid]; wb[r] = p.w_gate_up[(size_t)(16 + r) * 512 + tid]; }
    const float biasf = p.b_gate_up[tid], biasb = p.b_gate_up[512 + tid];
    _Float16* BF = (_Float16*)(p.ws + R_BF);
    _Float16* BB = (_Float16*)(p.ws + R_BB);
    for (int ch = blockIdx.x; ch < 1056; ch += gridDim.x) {
        __syncthreads();
        *(f32x4*)(sg + tid * 4) = *(const f32x4*)(glow + (size_t)ch * 2048 + tid * 4);
        __syncthreads();
        float run = 0.f;
#pragma unroll 4
        for (int i = 0; i < 64; ++i) {
            const float* gl = sg + i * 32;
            float a = biasf;
#pragma unroll
            for (int r = 0; r < 16; ++r) a = fmaf(gl[r], wf[r], a);
            const float ls = fminf(a, 0.f) - __logf(1.0f + __expf(-fabsf(a)));
            run += ls * (1.4426950408889634f / 16.0f);
            BF[(size_t)(ch * 64 + i) * 512 + tid] = (_Float16)run;
        }
        run = 0.f;
#pragma unroll 4
        for (int i = 63; i >= 0; --i) {
            const float* gl = sg + i * 32 + 16;
            float a = biasb;
#pragma unroll
            for (int r = 0; r < 16; ++r) a = fmaf(gl[r], wb[r], a);
            const float ls = fminf(a, 0.f) - __logf(1.0f + __expf(-fabsf(a)));
            run += ls * (1.4426950408889634f / 16.0f);
            BB[(size_t)(ch * 64 + i) * 512 + tid] = (_Float16)run;
        }
    }
}

struct GlaRegs { uint2 k[2][2], q[2][2], bb[2][2], bl[2][2]; uint4 v[2]; };

DI void phase_gla(const Params& p, char* smem) {
    const int tid = get_tid(), lane = tid & 63, w = tid >> 6, l31 = lane & 31, hh = lane >> 5;
    const int unit = blockIdx.x, dir = unit & 1, dvh = (unit >> 1) & 1, bh = unit >> 2, b = bh >> 2, h = bh & 3;
    const bf16_t* gq = (const bf16_t*)(p.ws + R_GQ);
    const bf16_t* gk = (const bf16_t*)(p.ws + R_GK);
    const bf16_t* gvT = (const bf16_t*)(p.ws + R_GVT) + (size_t)(bh * 256 + dvh * 128) * TKV;
    const _Float16* B16 = (const _Float16*)(p.ws + (dir ? R_BB : R_BF));
    bf16_t* Oo = (bf16_t*)(p.ws + (dir ? R_OB : R_OF));
    char* sQt = smem;
    char* sKt = smem + 16384;
    char* sKh = smem + 32768;
    char* sVT = smem + 49152;
    char* sA = smem + 81920;
    float* sD = (float*)(smem + 90112);
    f32x16 S[4];
#pragma unroll
    for (int k = 0; k < 4; ++k)
#pragma unroll
        for (int e = 0; e < 16; ++e) S[k][e] = 0.f;
    const int sw = (l31 >> 1) & 7;
    GlaRegs R;
    auto chunk_info = [&](int step, int& rowbase, int& tcol, bool& emit) {
        if (step < 4) { const int cc = dir ? 3 - step : step; rowbase = NLAT + b * 256 + cc * 64; tcol = TLAT + cc * 64; emit = false; }
        else { const int cc = dir ? 127 - (step - 4) : step - 4; rowbase = b * TLAT + cc * 64; tcol = cc * 64; emit = true; }
    };
    auto load_chunk = [&](int step) {
        int rowbase, tcol; bool emit; chunk_info(step, rowbase, tcol, emit);
        const int rl = rowbase + (dir ? 0 : 63);
#pragma unroll
        for (int i = 0; i < 2; ++i) {
            const int item = tid + NT * i, tok = item >> 4, c = item & 15, d0 = 16 * (c >> 1) + 4 * (c & 1);
            const size_t ro = (size_t)(rowbase + tok) * 512 + h * 128 + d0;
            R.k[i][0] = *(const uint2*)(gk + ro); R.k[i][1] = *(const uint2*)(gk + ro + 8);
            if (emit) { R.q[i][0] = *(const uint2*)(gq + ro); R.q[i][1] = *(const uint2*)(gq + ro + 8); }
            else { R.q[i][0] = make_uint2(0, 0); R.q[i][1] = make_uint2(0, 0); }
            R.bb[i][0] = *(const uint2*)(B16 + ro); R.bb[i][1] = *(const uint2*)(B16 + ro + 8);
            const size_t rlo = (size_t)rl * 512 + h * 128 + d0;
            R.bl[i][0] = *(const uint2*)(B16 + rlo); R.bl[i][1] = *(const uint2*)(B16 + rlo + 8);
        }
#pragma unroll
        for (int i = 0; i < 2; ++i) R.v[i] = *(const uint4*)(gvT + (size_t)((tid >> 3) + 64 * i) * TKV + tcol + (tid & 7) * 8);
    };
    auto stage_chunk = [&]() {
#pragma unroll
        for (int i = 0; i < 2; ++i) {
            const int item = tid + NT * i, tok = item >> 4, c = item & 15, d0 = 16 * (c >> 1) + 4 * (c & 1);
            float qo[8], ko[8];
#pragma unroll
            for (int g = 0; g < 2; ++g) {
                const h4_t bv = __builtin_bit_cast(h4_t, R.bb[i][g]), lv = __builtin_bit_cast(h4_t, R.bl[i][g]);
                const float kk[4] = {bflo(R.k[i][g].x), bfhi(R.k[i][g].x), bflo(R.k[i][g].y), bfhi(R.k[i][g].y)};
                const float qq[4] = {bflo(R.q[i][g].x), bfhi(R.q[i][g].x), bflo(R.q[i][g].y), bfhi(R.q[i][g].y)};
#pragma unroll
                for (int j = 0; j < 4; ++j) {
                    const float bb = (float)bv[j], bl = (float)lv[j];
                    qo[4 * g + j] = qq[j] * __builtin_amdgcn_exp2f(bb);
                    ko[4 * g + j] = kk[j] * __builtin_amdgcn_exp2f(-bb);
                    const float kh = kk[j] * __builtin_amdgcn_exp2f(bl - bb);
                    const int dk = d0 + 8 * g + j;
                    *(bf16_t*)(sKh + dk * 128 + ((((tok >> 3) ^ ((dk >> 1) & 7))) << 4) + (tok & 7) * 2) = bf1(kh);
                }
            }
            const int po = tok * 256 + ((c ^ (tok & 15)) << 4);
            uint4 uq, uk;
            uq.x = pk2(qo[0], qo[1]); uq.y = pk2(qo[2], qo[3]); uq.z = pk2(qo[4], qo[5]); uq.w = pk2(qo[6], qo[7]);
            uk.x = pk2(ko[0], ko[1]); uk.y = pk2(ko[2], ko[3]); uk.z = pk2(ko[4], ko[5]); uk.w = pk2(ko[6], ko[7]);
            *(uint4*)(sQt + po) = uq; *(uint4*)(sKt + po) = uk;
        }
#pragma unroll
        for (int i = 0; i < 2; ++i) {
            const int row = (tid >> 3) + 64 * i, scn = tid & 7;
            *(uint4*)(sVT + row * 128 + ((scn ^ ((row >> 1) & 7)) << 4)) = R.v[i];
        }
        if (tid < 16) {
            const int d0 = 16 * (tid >> 1) + 4 * (tid & 1);
#pragma unroll
            for (int g = 0; g < 2; ++g) {
                const h4_t lv = __builtin_bit_cast(h4_t, R.bl[0][g]);
#pragma unroll
                for (int j = 0; j < 4; ++j) sD[d0 + 8 * g + j] = __builtin_amdgcn_exp2f((float)lv[j]);
            }
        }
    };
    load_chunk(0);
    for (int step = 0; step < 132; ++step) {
        int rowbase, tcol; bool emit; chunk_info(step, rowbase, tcol, emit);
        stage_chunk();
        __syncthreads();
        if (step + 1 < 132) load_chunk(step + 1);
        const int dvb = 32 * (w & 3);
        f32x16 o[2];
        if (emit) {
            if (w >= 4) {
                const int ti = (w - 4) >> 1, tj = (w - 4) & 1;
                f32x16 a;
#pragma unroll
                for (int e = 0; e < 16; ++e) a[e] = 0.f;
                const bool dead = dir ? (tj < ti) : (tj > ti);
                if (!dead) {
#pragma unroll
                    for (int ks = 0; ks < 8; ++ks) {
                        const int ri = 32 * ti + l31, rj = 32 * tj + l31, c = 2 * ks + hh;
                        const bf16x8 af = *(const bf16x8*)(sQt + ri * 256 + ((c ^ (ri & 15)) << 4));
                        const bf16x8 bf = *(const bf16x8*)(sKt + rj * 256 + ((c ^ (rj & 15)) << 4));
                        a = MFMA32(af, bf, a);
                    }
                }
                const int jj = 32 * tj + l31;
#pragma unroll
                for (int e = 0; e < 16; ++e) {
                    const int ii = 32 * ti + (e & 3) + 8 * (e >> 2) + 4 * hh;
                    const bool keep = dir ? (jj >= ii) : (jj <= ii);
                    *(bf16_t*)(sA + ii * 128 + ((((jj >> 3) ^ ((ii >> 1) & 7))) << 4) + (jj & 7) * 2) = bf1(keep ? a[e] : 0.f);
                }
            } else {
#pragma unroll
            for (int mt = 0; mt < 2; ++mt)
#pragma unroll
                for (int e = 0; e < 16; ++e) o[mt][e] = 0.f;
#pragma unroll
            for (int kt = 0; kt < 4; ++kt)
#pragma unroll
                for (int s = 0; s < 2; ++s) {
                    typedef unsigned u32x4 __attribute__((ext_vector_type(4)));
                    u32x4 pu = {pk2(S[kt][8 * s], S[kt][8 * s + 1]), pk2(S[kt][8 * s + 2], S[kt][8 * s + 3]), pk2(S[kt][8 * s + 4], S[kt][8 * s + 5]), pk2(S[kt][8 * s + 6], S[kt][8 * s + 7])};
                    const bf16x8 sf = __builtin_bit_cast(bf16x8, pu);
#pragma unroll
                    for (int mt = 0; mt < 2; ++mt) {
                        const int ri = 32 * mt + l31, c = 4 * kt + 2 * s + hh;
                        const bf16x8 af = *(const bf16x8*)(sQt + ri * 256 + ((c ^ (ri & 15)) << 4));
                        o[mt] = MFMA32(af, sf, o[mt]);
                    }
                }
            }
            __syncthreads();
            if (w < 4) {
#pragma unroll
            for (int s2 = 0; s2 < 4; ++s2) {
                const int c = 2 * s2 + hh;
                const bf16x8 vf = *(const bf16x8*)(sVT + (dvb + l31) * 128 + ((c ^ sw) << 4));
#pragma unroll
                for (int mt = 0; mt < 2; ++mt) {
                    const bf16x8 af = *(const bf16x8*)(sA + (32 * mt + l31) * 128 + ((c ^ sw) << 4));
                    o[mt] = MFMA32(af, vf, o[mt]);
                }
            }
            bf16_t* od = Oo + (size_t)rowbase * 1024 + h * 256 + dvh * 128 + dvb + l31;
#pragma unroll
            for (int mt = 0; mt < 2; ++mt)
#pragma unroll
                for (int e = 0; e < 16; ++e) od[(size_t)(32 * mt + (e & 3) + 8 * (e >> 2) + 4 * hh) * 1024] = bf1(o[mt][e]);
            }
        }
        if (w < 4) {
#pragma unroll
        for (int kt = 0; kt < 4; ++kt)
#pragma unroll
            for (int g4 = 0; g4 < 4; ++g4) {
                const f32x4 dd = *(const f32x4*)(sD + 32 * kt + 8 * g4 + 4 * hh);
#pragma unroll
                for (int jq = 0; jq < 4; ++jq) S[kt][4 * g4 + jq] *= dd[jq];
            }
#pragma unroll
        for (int s2 = 0; s2 < 4; ++s2) {
            const int c = 2 * s2 + hh;
            const bf16x8 vf = *(const bf16x8*)(sVT + (dvb + l31) * 128 + ((c ^ sw) << 4));
#pragma unroll
            for (int kt = 0; kt < 4; ++kt) {
                const bf16x8 af = *(const bf16x8*)(sKh + (32 * kt + l31) * 128 + ((c ^ sw) << 4));
                S[kt] = MFMA32(af, vf, S[kt]);
            }
        }
        }
        __syncthreads();
    }
}

DI void phase_combine(const Params& p, int panel) {
    const int tid = get_tid(), lane = tid & 63, w = tid >> 6;
    const bf16_t* OF = (const bf16_t*)(p.ws + R_OF);
    const bf16_t* OB = (const bf16_t*)(p.ws + R_OB);
    const bf16_t* SG = (const bf16_t*)(p.ws + R_SG);
    bf16_t* Y = (bf16_t*)(p.ws + R_YGLA);
    for (int row = panel * 256 + w; row < panel * 256 + 256; row += 8) {
        const size_t o = (size_t)row * 1024 + lane * 16;
        const uint4 a0 = *(const uint4*)(OF + o), a1 = *(const uint4*)(OF + o + 8);
        const uint4 b0 = *(const uint4*)(OB + o), b1 = *(const uint4*)(OB + o + 8);
        const uint4 g0 = *(const uint4*)(SG + o), g1 = *(const uint4*)(SG + o + 8);
        const unsigned au[8] = {a0.x, a0.y, a0.z, a0.w, a1.x, a1.y, a1.z, a1.w};
        const unsigned bu[8] = {b0.x, b0.y, b0.z, b0.w, b1.x, b1.y, b1.z, b1.w};
        const unsigned gu[8] = {g0.x, g0.y, g0.z, g0.w, g1.x, g1.y, g1.z, g1.w};
        float v[16]; float ss = 0.f;
#pragma unroll
        for (int e = 0; e < 8; ++e) { v[2 * e] = bflo(au[e]) + bflo(bu[e]); v[2 * e + 1] = bfhi(au[e]) + bfhi(bu[e]); ss += v[2 * e] * v[2 * e] + v[2 * e + 1] * v[2 * e + 1]; }
#pragma unroll
        for (int of = 8; of >= 1; of >>= 1) ss += __shfl_xor(ss, of);
        const float rs = rsqrtf(ss * (1.0f / 256.0f) + EPS);
        const float* gn = p.gla_hn + ((lane * 16) & 255);
        unsigned ou[8];
#pragma unroll
        for (int e = 0; e < 8; ++e) ou[e] = pk2(v[2 * e] * rs * gn[2 * e] * bflo(gu[e]), v[2 * e + 1] * rs * gn[2 * e + 1] * bfhi(gu[e]));
        *(uint4*)(Y + o) = make_uint4(ou[0], ou[1], ou[2], ou[3]);
        *(uint4*)(Y + o + 8) = make_uint4(ou[4], ou[5], ou[6], ou[7]);
    }
}

template <int MODE>
DI void phase_rows(const Params& p, char* smem, int panel) {
    float* md = (float*)smem;
    const int tid = get_tid(), lane = tid & 63, w = tid >> 6;
    const bf16_t* Yin = (const bf16_t*)(p.ws + (MODE == 0 ? R_Y2 : R_Y3));
    bf16_t* H2 = (bf16_t*)(p.ws + R_H2);
    const float* pn = MODE == 0 ? p.post_norm1 : p.post_norm2;
    for (int tile = panel; tile == panel; ++tile) {
        const int r = tile >> 5;
        __syncthreads();
        if (MODE == 0) { load_mod(p, r, 2, md); load_mod(p, r, 3, md + 1024); load_mod(p, r, 4, md + 2048); }
        else load_mod(p, r, 5, md);
        __syncthreads();
        for (int i = 0; i < 32; ++i) {
            const int row = tile * 256 + w * 32 + i;
            float y[16]; float ss = 0.f;
#pragma unroll
            for (int j = 0; j < 4; ++j) {
                const uint2 u = *(const uint2*)(Yin + (size_t)row * 1024 + lane * 4 + 256 * j);
                y[4 * j] = bflo(u.x); y[4 * j + 1] = bfhi(u.x); y[4 * j + 2] = bflo(u.y); y[4 * j + 3] = bfhi(u.y);
                ss += y[4 * j] * y[4 * j] + y[4 * j + 1] * y[4 * j + 1] + y[4 * j + 2] * y[4 * j + 2] + y[4 * j + 3] * y[4 * j + 3];
            }
            ss = wave_sum(ss);
            const float rs = rsqrtf(ss * (1.0f / 1024.0f) + EPS);
            float xn[16]; float s2 = 0.f;
#pragma unroll
            for (int j = 0; j < 4; ++j) {
                const int col = lane * 4 + 256 * j;
                const float* xs = (MODE == 0 ? p.x : (const float*)p.out) + (size_t)row * 1024 + col;
                const f32x4 xv = *(const f32x4*)xs, g = *(const f32x4*)(pn + col), gt = *(const f32x4*)(md + col);
#pragma unroll
                for (int e = 0; e < 4; ++e) { xn[4 * j + e] = xv[e] + gt[e] * (y[4 * j + e] * rs * g[e]); s2 += xn[4 * j + e] * xn[4 * j + e]; }
                f32x4 ov = {xn[4 * j], xn[4 * j + 1], xn[4 * j + 2], xn[4 * j + 3]};
                *(f32x4*)(p.out + (size_t)row * 1024 + col) = ov;
            }
            if (MODE == 0) {
                s2 = wave_sum(s2);
                const float rs2 = rsqrtf(s2 * (1.0f / 1024.0f) + EPS);
#pragma unroll
                for (int j = 0; j < 4; ++j) {
                    const int col = lane * 4 + 256 * j;
                    const f32x4 g = *(const f32x4*)(p.pre_norm2 + col), sh = *(const f32x4*)(md + 1024 + col), sc = *(const f32x4*)(md + 2048 + col);
                    float o[4];
#pragma unroll
                    for (int e = 0; e < 4; ++e) o[e] = xn[4 * j + e] * rs2 * g[e] * (1.f + sc[e]) + sh[e];
                    uint2 u; u.x = pk2(o[0], o[1]); u.y = pk2(o[2], o[3]);
                    *(uint2*)(H2 + (size_t)row * 1024 + col) = u;
                }
            }
        }
    }
}

DI void gsync(unsigned* bar, unsigned k) {
    __syncthreads();
    const unsigned epoch = k * gridDim.x;
    if (threadIdx.x == 0) {
        __threadfence();
        atomicAdd(bar, 1u);
        while (__hip_atomic_load(bar, __ATOMIC_RELAXED, __HIP_MEMORY_SCOPE_AGENT) < epoch) __builtin_amdgcn_s_sleep(1);
        __threadfence();
    }
    __syncthreads();
}

__global__ void __launch_bounds__(NT) fwd_megakernel(Params p) {
    __shared__ __attribute__((aligned(16))) char smem[131072];
    cg::grid_group grid = cg::this_grid();
    char* ws = p.ws;
    unsigned* bar = (unsigned*)(ws + OFF_BAR);
    phase_prep(p, smem);
    grid.sync();
    phase_h(p, smem);
    gsync(bar, 1u);
    {
        EpiIn e; e.Q = (bf16_t*)(ws + R_Q); e.Kk = (bf16_t*)(ws + R_K); e.Vt = (bf16_t*)(ws + R_VT); e.gq = (bf16_t*)(ws + R_GQ); e.gk = (bf16_t*)(ws + R_GK);
        e.gvT = (bf16_t*)(ws + R_GVT); e.sg = (bf16_t*)(ws + R_SG); e.mg = (bf16_t*)p.out; e.glow = (float*)(ws + OFF_GLOW); e.rope = (const float*)(ws + OFF_ROPE); e.kmax = (float*)(ws + OFF_KMAX);
        gemm_phase_ex<true>((const bf16_t*)(ws + R_H), 1024, (const bf16_t*)(ws + OFF_WIN), 1024, 1024, 264, 33, smem, e, blockIdx.x, gridDim.x);
    }
    gsync(bar, 2u);
    phase_attn(p, smem);
    gsync(bar, 3u);
    phase_gate(p, smem);
    gsync(bar, 4u);
    if (blockIdx.x < 128) phase_gla(p, smem);
    else {
        EpiGate0 e0; e0.mg = (bf16_t*)p.out;
        gemm_phase_ex<false>((const bf16_t*)(ws + R_H), 1024, (const bf16_t*)(ws + OFF_WDA), 1024, 1024, 256, 4, smem, e0, blockIdx.x - 128, gridDim.x - 128);
        const long gsz2 = (long)(gridDim.x - 128) * NT, gtid2 = (long)(blockIdx.x - 128) * NT + get_tid();
        repack<0>(p.w_bgla, 1024, 1024, (bf16_t*)(ws + OFF_WGLA), 1024, gtid2, gsz2);
        repack<0>(p.w_out, 1024, 1024, (bf16_t*)(ws + OFF_WOUT), 1024, gtid2, gsz2);
        repack<0>(p.w_ff1, 1024, 4096, (bf16_t*)(ws + OFF_WFF1), 4096, gtid2, gsz2);
        repack<0>(p.w_ff2, 4096, 1024, (bf16_t*)(ws + OFF_WFF2), 1024, gtid2, gsz2);
    }
    gsync(bar, 5u);
    for (int panel = blockIdx.x; panel < 256; panel += gridDim.x) phase_combine(p, panel);
    gsync(bar, 6u);
    for (int panel = blockIdx.x; panel < 256; panel += gridDim.x) {
        { EpiGate1 e1; e1.Y = (bf16_t*)(ws + R_Y); e1.mg = (const bf16_t*)p.out;
          gemm_panel((const bf16_t*)(ws + R_YGLA), 1024, (const bf16_t*)(ws + OFF_WGLA), 1024, 1024, panel, 4, smem, e1); }
        __syncthreads();
        { EpiStore<0> e; e.O = (bf16_t*)(ws + R_Y2); e.ldo = 1024;
          gemm_panel((const bf16_t*)(ws + R_Y), 1024, (const bf16_t*)(ws + OFF_WOUT), 1024, 1024, panel, 4, smem, e); }
        __syncthreads();
        phase_rows<0>(p, smem, panel);
        __syncthreads();
        { EpiStore<1> e; e.O = (bf16_t*)(ws + R_U); e.ldo = 4096;
          gemm_panel((const bf16_t*)(ws + R_H2), 1024, (const bf16_t*)(ws + OFF_WFF1), 1024, 1024, panel, 16, smem, e); }
        __syncthreads();
        { EpiStore<0> e; e.O = (bf16_t*)(ws + R_Y3); e.ldo = 1024;
          gemm_panel((const bf16_t*)(ws + R_U), 4096, (const bf16_t*)(ws + OFF_WFF2), 4096, 4096, panel, 4, smem, e); }
        __syncthreads();
        phase_rows<1>(p, smem, panel);
        __syncthreads();
    }
}

extern "C" void kernel_launch(void* const* d_in, const int* in_sizes, int n_in, void* d_out, int out_size, void* d_ws, size_t ws_size, hipStream_t stream) {
    static int grid_blocks = 0;
    if (!grid_blocks) {
        int dev = 0, cus = 0, per_cu = 0;
        hipGetDevice(&dev);
        hipDeviceGetAttribute(&cus, hipDeviceAttributeMultiprocessorCount, dev);
        hipOccupancyMaxActiveBlocksPerMultiprocessor(&per_cu, fwd_megakernel, NT, 0);
        if (per_cu < 1) per_cu = 1;
        grid_blocks = cus * per_cu;
        if (grid_blocks > 256) grid_blocks = 256;
    }
    Params p{};
    const float* const* in = (const float* const*)d_in;
    p.x = in[0]; p.c = in[1]; p.ctx = in[2]; p.c_ctx = in[3]; p.w_mod = in[4]; p.b_mod = in[5]; p.pre_norm1 = in[6]; p.w_in = in[7];
    p.w_gate_up = in[8]; p.b_gate_up = in[9]; p.lq1 = in[10]; p.lk1 = in[11]; p.lq2 = in[12]; p.lk2 = in[13]; p.da_hn = in[14]; p.gla_hn = in[15];
    p.w_bda = in[16]; p.w_bgla = in[17]; p.w_out = in[18]; p.post_norm1 = in[19]; p.pre_norm2 = in[20]; p.w_ff1 = in[21]; p.w_ff2 = in[22]; p.post_norm2 = in[23];
    p.out = (float*)d_out; p.ws = (char*)d_ws;
    hipMemsetAsync((char*)d_ws + OFF_BAR, 0, 256, stream);
    void* args[] = {&p};
    hipError_t e = hipLaunchCooperativeKernel((void*)fwd_megakernel, dim3(grid_blocks), dim3(NT), args, 0, stream);
    if (e != hipSuccess) fprintf(stderr, "cooperative launch failed: %s (grid %d)\n", hipGetErrorString(e), grid_blocks);
}
```

```cpp
#include <hip/hip_runtime.h>
#include <hip/hip_cooperative_groups.h>
#include <cstdio>
namespace cg = cooperative_groups;

typedef unsigned short bf16_t;
typedef short bf16x8 __attribute__((ext_vector_type(8)));
typedef float f32x16 __attribute__((ext_vector_type(16)));
typedef float f32x4 __attribute__((ext_vector_type(4)));
typedef float f32x2 __attribute__((ext_vector_type(2)));
typedef __bf16 bf2_t __attribute__((ext_vector_type(2)));
typedef _Float16 h4_t __attribute__((ext_vector_type(4)));

#define DI __device__ __forceinline__
#define MFMA32(a, b, c) __builtin_amdgcn_mfma_f32_32x32x16_bf16((a), (b), (c), 0, 0, 0)

constexpr int NT = 512;
constexpr int TLAT = 8192, NB = 8, NLAT = 65536, NROW = 67584, TKV = 8448;
constexpr float EPS = 1e-6f;
constexpr size_t MiB = 1048576;
constexpr size_t OFF_WIN = 0;
constexpr size_t OFF_WDA = OFF_WIN + 8448ull * 1024 * 2;
constexpr size_t OFF_WGLA = OFF_WDA + 2 * MiB;
constexpr size_t OFF_WOUT = OFF_WGLA + 2 * MiB;
constexpr size_t OFF_WFF1 = OFF_WOUT + 2 * MiB;
constexpr size_t OFF_WFF2 = OFF_WFF1 + 8 * MiB;
constexpr size_t OFF_MODP = OFF_WFF2 + 8 * MiB;
constexpr size_t OFF_ROPE = OFF_MODP + 16ull * 9 * 6144 * 4;
constexpr size_t OFF_GLOW = OFF_ROPE + 16384;
constexpr size_t OFF_KMAX = OFF_GLOW + 67584ull * 32 * 4;
constexpr size_t OFF_BAR = OFF_KMAX + 1024;
constexpr size_t R_H = 64 * MiB;
constexpr size_t R_Q = R_H + 132 * MiB;
constexpr size_t R_K = R_Q + 128 * MiB;
constexpr size_t R_VT = R_K + 132 * MiB;
constexpr size_t R_GQ = R_VT + 132 * MiB;
constexpr size_t R_GK = R_GQ + 64 * MiB;
constexpr size_t R_GVT = R_GK + 66 * MiB;
constexpr size_t R_SG = R_GVT + 132 * MiB;
constexpr size_t WS_END = R_SG + 128 * MiB;
static_assert(OFF_BAR + 1024 <= R_H, "small region overflow");
static_assert(WS_END <= 1024 * MiB, "workspace overflow");
constexpr size_t R_BF = R_Q;
constexpr size_t R_BB = R_Q + 66 * MiB;
constexpr size_t R_OF = R_K + 4 * MiB;
constexpr size_t R_OB = R_VT;
constexpr size_t R_YGLA = R_SG;
constexpr size_t R_Y = R_GVT;
constexpr size_t R_Y2 = R_SG;
constexpr size_t R_H2 = R_H;
constexpr size_t R_U = R_Q;
constexpr size_t R_Y3 = R_GVT;

struct Params {
    const float *x, *c, *ctx, *c_ctx, *w_mod, *b_mod, *pre_norm1, *w_in, *w_gate_up, *b_gate_up;
    const float *lq1, *lk1, *lq2, *lk2, *da_hn, *gla_hn, *w_bda, *w_bgla, *w_out, *post_norm1, *pre_norm2, *w_ff1, *w_ff2, *post_norm2;
    float* out;
    char* ws;
};

DI unsigned pk2(float a, float b) { f32x2 v = {a, b}; bf2_t r = __builtin_convertvector(v, bf2_t); return __builtin_bit_cast(unsigned, r); }
DI bf16_t bf1(float a) { __bf16 r = (__bf16)a; return __builtin_bit_cast(unsigned short, r); }
DI float bflo(unsigned v) { return __uint_as_float(v << 16); }
DI float bfhi(unsigned v) { return __uint_as_float(v & 0xffff0000u); }
DI float wave_sum(float v) {
#pragma unroll
    for (int o = 32; o >= 1; o >>= 1) v += __shfl_xor(v, o);
    return v;
}
DI int get_tid() { int t = threadIdx.x; asm volatile("" : "+v"(t)); return t; }
DI float sigmoidf_(float x) { return 1.0f / (1.0f + __expf(-x)); }

template <int MODE>
DI void repack(const float* __restrict__ src, int K, int Nsrc, bf16_t* __restrict__ dst, int Nd, long gtid, long gsz) {
    const long total = (long)Nd * (K / 8);
    for (long it = gtid; it < total; it += gsz) {
        const int n = (int)(it % Nd), kc = (int)(it / Nd);
        int col = n; bool valid = true;
        if (MODE == 1) { if (n < 5120) col = n; else if (n < 8192) col = n + 32; else if (n < 8224) col = n - 8192 + 5120; else valid = false; }
        float v[8];
#pragma unroll
        for (int j = 0; j < 8; ++j) v[j] = valid ? src[(size_t)(kc * 8 + j) * Nsrc + col] : 0.f;
        uint4 o; o.x = pk2(v[0], v[1]); o.y = pk2(v[2], v[3]); o.z = pk2(v[4], v[5]); o.w = pk2(v[6], v[7]);
        *(uint4*)(dst + (size_t)n * K + kc * 8) = o;
    }
}

DI void sincos_acc(float a, float& s, float& c) {
    const float q = rintf(a * 0.63661977236758134f);
    float r = fmaf(-q, 1.5703125f, a); r = fmaf(-q, 4.837512969970703125e-4f, r); r = fmaf(-q, 7.54978995489188216e-8f, r);
    const float r2 = r * r;
    const float sp = r + r * r2 * (-1.6666666666e-1f + r2 * (8.3333333333e-3f + r2 * (-1.98412698e-4f + r2 * 2.7557319e-6f)));
    const float cp = 1.0f + r2 * (-0.5f + r2 * (4.16666666667e-2f + r2 * (-1.38888888889e-3f + r2 * (2.48015873e-5f + r2 * -2.75573192e-7f))));
    const int qi = ((int)q) & 3;
    s = (qi == 0) ? sp : (qi == 1) ? cp : (qi == 2) ? -sp : -cp;
    c = (qi == 0) ? cp : (qi == 1) ? -sp : (qi == 2) ? -cp : sp;
}

DI void phase_prep(const Params& p, char* smem) {
    const int tid = get_tid();
    const long gsz = (long)gridDim.x * NT, gtid = (long)blockIdx.x * NT + tid;
    char* ws = p.ws;
    repack<1>(p.w_in, 1024, 8224, (bf16_t*)(ws + OFF_WIN), 8448, gtid, gsz);
    repack<0>(p.w_bda, 1024, 1024, (bf16_t*)(ws + OFF_WDA), 1024, gtid, gsz);
    if (gtid < 256) ((float*)(ws + OFF_KMAX))[gtid] = 0.f;
    if (gtid < 2048) {
        const int pos = (int)gtid >> 4, f = (int)gtid & 15;
        const float inv = exp2f(-(float)f * (13.287712379549449f / 16.0f));
        float s, c; sincos_acc((float)pos * inv, s, c);
        float* rt = (float*)(ws + OFF_ROPE);
        rt[gtid] = c; rt[2048 + gtid] = s;
    }
    float* sil = (float*)smem;
    float* modp = (float*)(ws + OFF_MODP);
    for (int item = blockIdx.x; item < 192; item += gridDim.x) {
        const int cb = item % 12, ks = item / 12;
        __syncthreads();
        for (int i = tid; i < 9 * 64; i += NT) {
            const int r = i >> 6, kk = i & 63;
            const float v = (r < 8) ? p.c[r * 1024 + ks * 64 + kk] : p.c_ctx[ks * 64 + kk];
            sil[i] = v * sigmoidf_(v);
        }
        __syncthreads();
        const int n = cb * 512 + tid;
        float acc[9];
#pragma unroll
        for (int r = 0; r < 9; ++r) acc[r] = 0.f;
        for (int kk = 0; kk < 64; ++kk) {
            const float w = p.w_mod[(size_t)(ks * 64 + kk) * 6144 + n];
#pragma unroll
            for (int r = 0; r < 9; ++r) acc[r] = fmaf(sil[r * 64 + kk], w, acc[r]);
        }
#pragma unroll
        for (int r = 0; r < 9; ++r) modp[(size_t)(ks * 9 + r) * 6144 + n] = acc[r];
    }
}

DI void load_mod(const Params& p, int r, int which, float* dst) {
    const float* modp = (const float*)(p.ws + OFF_MODP);
    for (int n = threadIdx.x; n < 1024; n += NT) {
        float a = p.b_mod[which * 1024 + n];
#pragma unroll
        for (int ks = 0; ks < 16; ++ks) a += modp[(size_t)(ks * 9 + r) * 6144 + which * 1024 + n];
        dst[n] = a;
    }
}

DI void h_row2(const Params& p, const float* md, bf16_t* H, int rowA, int rowB, int lane) {
    const float* sa = rowA < NLAT ? p.x + (size_t)rowA * 1024 : p.ctx + (size_t)(rowA - NLAT) * 1024;
    const float* sbp = rowB < NLAT ? p.x + (size_t)rowB * 1024 : p.ctx + (size_t)(rowB - NLAT) * 1024;
    f32x4 va[4], vb[4]; float sa2 = 0.f, sb2 = 0.f;
#pragma unroll
    for (int j = 0; j < 4; ++j) { va[j] = *(const f32x4*)(sa + lane * 4 + 256 * j); vb[j] = *(const f32x4*)(sbp + lane * 4 + 256 * j); }
#pragma unroll
    for (int j = 0; j < 4; ++j) {
        sa2 += va[j].x * va[j].x + va[j].y * va[j].y + va[j].z * va[j].z + va[j].w * va[j].w;
        sb2 += vb[j].x * vb[j].x + vb[j].y * vb[j].y + vb[j].z * vb[j].z + vb[j].w * vb[j].w;
    }
    sa2 = wave_sum(sa2); sb2 = wave_sum(sb2);
    const float ra = rsqrtf(sa2 * (1.0f / 1024.0f) + EPS), rb = rsqrtf(sb2 * (1.0f / 1024.0f) + EPS);
#pragma unroll
    for (int j = 0; j < 4; ++j) {
        const int col = lane * 4 + 256 * j;
        const f32x4 g = *(const f32x4*)(p.pre_norm1 + col);
        const f32x4 sh = *(const f32x4*)(md + col), sc = *(const f32x4*)(md + 1024 + col);
        float oa[4], ob[4];
#pragma unroll
        for (int e = 0; e < 4; ++e) { const float gm = g[e] * (1.f + sc[e]); oa[e] = va[j][e] * ra * gm + sh[e]; ob[e] = vb[j][e] * rb * gm + sh[e]; }
        uint2 o; o.x = pk2(oa[0], oa[1]); o.y = pk2(oa[2], oa[3]);
        *(uint2*)(H + (size_t)rowA * 1024 + col) = o;
        o.x = pk2(ob[0], ob[1]); o.y = pk2(ob[2], ob[3]);
        *(uint2*)(H + (size_t)rowB * 1024 + col) = o;
    }
}

DI void phase_h(const Params& p, char* smem) {
    float* md = (float*)smem;
    const int tid = get_tid(), lane = tid & 63, w = tid >> 6;
    bf16_t* H = (bf16_t*)(p.ws + R_H);
    for (int tile = blockIdx.x; tile < 256; tile += gridDim.x) {
        __syncthreads();
        load_mod(p, tile >> 5, 0, md); load_mod(p, tile >> 5, 1, md + 1024);
        __syncthreads();
        for (int i = 0; i < 16; ++i) h_row2(p, md, H, tile * 256 + w * 32 + i, tile * 256 + w * 32 + 16 + i, lane);
    }
    __syncthreads();
    load_mod(p, 8, 0, md); load_mod(p, 8, 1, md + 1024);
    __syncthreads();
    for (int r2 = blockIdx.x * 8 + w; r2 < 1024; r2 += gridDim.x * 8) h_row2(p, md, H, NLAT + 2 * r2, NLAT + 2 * r2 + 1, lane);
}

typedef __attribute__((address_space(3))) unsigned lds_u32;
DI lds_u32* to_lds(const void* p) { return (lds_u32*)(unsigned)(size_t)p; }
#define GLDS16(src, dst) __builtin_amdgcn_global_load_lds((const unsigned*)(src), to_lds(dst), 16, 0, 0)

#define MFMA16(a, b, c) __builtin_amdgcn_mfma_f32_16x16x32_bf16((a), (b), (c), 0, 0, 0)
template <bool SWAP, class Epi>
DI void gemm_tile(const bf16_t* A, int lda, const bf16_t* B, int ldb, int K, int m0, int n0, bool first, bool has_next, int nm0, int nn0, char* smem, Epi& epi) {
    const int tid = get_tid(), lane = tid & 63, w = tid >> 6, wm = w >> 2, wn = w & 3, l15 = lane & 15, q = lane >> 4;
    f32x4 acc[8][4];
#pragma unroll
    for (int i = 0; i < 8; ++i)
#pragma unroll
        for (int j = 0; j < 4; ++j) acc[i][j] = (f32x4){0.f, 0.f, 0.f, 0.f};
    const int srow = 8 * w + (lane >> 3), schunk = (lane & 7) ^ (4 * (w & 1) + (lane >> 4));
    const bf16_t* ga = A + (size_t)(m0 + srow) * lda + schunk * 8;
    const bf16_t* gb = B + (size_t)(n0 + srow) * ldb + schunk * 8;
    const bf16_t* nga = A + (size_t)(nm0 + srow) * lda + schunk * 8;
    const bf16_t* ngb = B + (size_t)(nn0 + srow) * ldb + schunk * 8;
    const int sw = (l15 >> 1) & 7;
    const int aofs = (128 * wm + l15) * 128, bofs = 32768 + (64 * wn + l15) * 128;
    char* sdst = smem + w * 1024;
#define GEMM_STAGE(pa, pb, buf, kt_) do { _Pragma("unroll") for (int i = 0; i < 4; ++i) { \
        GLDS16(pa + (size_t)i * 64 * lda + (kt_) * 64, sdst + (buf) * 65536 + i * 8192); \
        GLDS16(pb + (size_t)i * 64 * ldb + (kt_) * 64, sdst + (buf) * 65536 + 32768 + i * 8192); } } while (0)
    if (first) {
        GEMM_STAGE(ga, gb, 0, 0);
        asm volatile("s_waitcnt vmcnt(0)" ::: "memory");
        __syncthreads();
    }
    const int KT = K >> 6;
    for (int kt = 0; kt < KT; ++kt) {
        const int cur = kt & 1;
        if (kt + 1 < KT) GEMM_STAGE(ga, gb, cur ^ 1, kt + 1);
        else if (has_next) GEMM_STAGE(nga, ngb, cur ^ 1, 0);
        const char* sb = smem + cur * 65536;
#pragma unroll
        for (int kk = 0; kk < 2; ++kk) {
            const int co = ((4 * kk + q) ^ sw) << 4;
            bf16x8 af[8], bf[4];
#pragma unroll
            for (int mi = 0; mi < 8; ++mi) af[mi] = *(const bf16x8*)(sb + aofs + mi * 2048 + co);
#pragma unroll
            for (int ni = 0; ni < 4; ++ni) bf[ni] = *(const bf16x8*)(sb + bofs + ni * 2048 + co);
#pragma unroll
            for (int mi = 0; mi < 8; ++mi)
#pragma unroll
                for (int ni = 0; ni < 4; ++ni) acc[mi][ni] = SWAP ? MFMA16(af[mi], bf[ni], acc[mi][ni]) : MFMA16(bf[ni], af[mi], acc[mi][ni]);
        }
        asm volatile("s_waitcnt vmcnt(0)" ::: "memory");
        __syncthreads();
    }
#undef GEMM_STAGE
#pragma unroll
    for (int mi = 0; mi < 8; ++mi) {
        if constexpr (SWAP) {
#pragma unroll
            for (int ni = 0; ni < 4; ++ni) epi.vt(m0 + 128 * wm + 16 * mi + 4 * q, n0 + 64 * wn + 16 * ni + l15, acc[mi][ni]);
        } else epi(m0 + 128 * wm + 16 * mi + l15, n0 + 64 * wn, acc[mi], q);
        asm volatile("" ::: "memory");
    }
}

DI void tile_map(int id, int MT, int NTl, int& mt, int& nt) {
    const int x = id & 7, local = id >> 3, mtx = MT >> 3;
    const int full = mtx >> 2, per = 4 * NTl;
    int patch = local / per, wv = local - patch * per, pm = 4;
    if (patch >= full) { patch = full; wv = local - full * per; pm = mtx - full * 4; }
    const int mo = wv % pm; nt = wv / pm;
    mt = (patch * 4 + mo) * 8 + x;
}

DI void tile_map_in(int id, int& mt, int& nt) {
    if (id < 8448) { tile_map(id, 256, 33, mt, nt); return; }
    const int id2 = id - 8448, k = id2 >> 3;
    mt = 256 + (id2 & 7);
    nt = k < 8 ? 4 + k : k < 10 ? 14 + (k - 8) : k < 14 ? 16 + (k - 10) : 32;
}
template <bool VSWAP, class Epi>
DI void gemm_phase_ex(const bf16_t* A, int lda, const bf16_t* B, int ldb, int K, int MT, int NTl, char* smem, Epi& epi, int bid, int nblk) {
    const int total = VSWAP ? 8448 + 120 : MT * NTl;
    bool first = true;
    for (int id = bid; id < total; id += nblk) {
        int mt, nt, mt2 = 0, nt2 = 0;
        if (VSWAP) tile_map_in(id, mt, nt); else tile_map(id, MT, NTl, mt, nt);
        const bool has_next = id + nblk < total;
        if (has_next) { if (VSWAP) tile_map_in(id + nblk, mt2, nt2); else tile_map(id + nblk, MT, NTl, mt2, nt2); }
        if constexpr (VSWAP) { if (Epi::is_vt(nt)) { gemm_tile<true>(A, lda, B, ldb, K, mt * 256, nt * 256, first, has_next, mt2 * 256, nt2 * 256, smem, epi); first = false; continue; } }
        gemm_tile<false>(A, lda, B, ldb, K, mt * 256, nt * 256, first, has_next, mt2 * 256, nt2 * 256, smem, epi);
        first = false;
    }
}
template <class Epi>
DI void gemm_phase(const bf16_t* A, int lda, const bf16_t* B, int ldb, int K, int MT, int NTl, char* smem, Epi& epi) {
    gemm_phase_ex<false>(A, lda, B, ldb, K, MT, NTl, smem, epi, blockIdx.x, gridDim.x);
}

DI float xhalf_max(float v) {
    typedef unsigned u32x2 __attribute__((ext_vector_type(2)));
    const unsigned u = __float_as_uint(v);
    const u32x2 r = __builtin_amdgcn_permlane32_swap(u, u, false, false);
    return fmaxf(__uint_as_float(r[0]), __uint_as_float(r[1]));
}
DI float xhalf_sum(float v) {
    typedef unsigned u32x2 __attribute__((ext_vector_type(2)));
    const unsigned u = __float_as_uint(v);
    const u32x2 r = __builtin_amdgcn_permlane32_swap(u, u, false, false);
    return __uint_as_float(r[0]) + __uint_as_float(r[1]);
}
template <class Epi>
DI void gemm_panel(const bf16_t* A, int lda, const bf16_t* B, int ldb, int K, int panel, int NTl, char* smem, Epi& epi) {
    for (int nt = 0; nt < NTl; ++nt)
        gemm_tile<false>(A, lda, B, ldb, K, panel * 256, nt * 256, nt == 0, nt + 1 < NTl, panel * 256, (nt + 1) * 256, smem, epi);
}

DI float quad_sum(float v) { v += __shfl_xor(v, 16); v += __shfl_xor(v, 32); return v; }
struct EpiIn {
    bf16_t *Q, *Kk, *Vt, *gq, *gk, *gvT, *sg, *mg; float* glow; const float* rope; float* kmax;
    static DI bool is_vt(int nt) { return (nt >= 8 && nt < 12) || (nt >= 16 && nt < 20); }
    DI void vt(int row0, int col, const f32x4& v) const {
        int b, t;
        if (row0 < NLAT) { b = row0 >> 13; t = row0 & 8191; } else { const int r2 = row0 - NLAT; b = r2 >> 8; t = TLAT + (r2 & 255); }
        bf16_t* dst;
        if (col < 3072) { const int c = col - 2048; dst = Vt + (size_t)((b * 8 + (c >> 7)) * 128 + (c & 127)) * TKV + t; }
        else { const int c = col - 4096; dst = gvT + (size_t)((b * 4 + (c >> 8)) * 256 + (c & 255)) * TKV + t; }
        uint2 u; u.x = pk2(v[0], v[1]); u.y = pk2(v[2], v[3]);
        *(uint2*)dst = u;
    }
    DI void operator()(int row, int cb, const f32x4 (&v)[4], int q) const {
        if (cb >= 8224) return;
        const bool lat = row < NLAT;
        int b, t;
        if (lat) { b = row >> 13; t = row & 8191; } else { const int r2 = row - NLAT; b = r2 >> 8; t = TLAT + (r2 & 255); }
        if (cb < 2048) {
            const bool isq = cb < 1024;
            if (isq && !lat) return;
            const int c = cb & 1023, head = c >> 7, comp = (c >> 6) & 1;
            f32x4 o[4];
            if (lat) {
#pragma unroll
                for (int half = 0; half < 2; ++half) {
                    const int pos = half ? (t & 63) : (t >> 6);
                    const f32x4 c4 = *(const f32x4*)(rope + pos * 16 + 4 * q), s4 = *(const f32x4*)(rope + 2048 + pos * 16 + 4 * q);
#pragma unroll
                    for (int j = 0; j < 4; ++j) {
                        const float x1 = v[2 * half][j], x2 = v[2 * half + 1][j];
                        o[2 * half][j] = x1 * c4[j] - x2 * s4[j];
                        o[2 * half + 1][j] = x2 * c4[j] + x1 * s4[j];
                    }
                }
            } else {
#pragma unroll
                for (int ni = 0; ni < 4; ++ni) o[ni] = v[ni];
            }
            if (!isq) {
#pragma unroll
                for (int half = 0; half < 2; ++half) {
                    float ssq = 0.f;
#pragma unroll
                    for (int j = 0; j < 4; ++j) ssq += o[2 * half][j] * o[2 * half][j] + o[2 * half + 1][j] * o[2 * half + 1][j];
                    ssq = quad_sum(ssq);
#pragma unroll
                    for (int of = 8; of >= 1; of >>= 1) ssq = fmaxf(ssq, __shfl_xor(ssq, of));
                    if ((threadIdx.x & 63) == 0) atomicMax((unsigned*)(kmax + ((b * 8 + head) * 2 + comp) * 2 + half), __float_as_uint(ssq));
                }
            }
            const float scl = isq ? 0.125f * 1.4426950408889634f : 1.0f;
            bf16_t* dst = isq ? Q + ((size_t)((b * 8 + head) * 2 + comp) * TLAT + t) * 64 : Kk + ((size_t)((b * 8 + head) * 2 + comp) * TKV + t) * 64;
#pragma unroll
            for (int ni = 0; ni < 4; ++ni) {
                uint2 u; u.x = pk2(o[ni][0] * scl, o[ni][1] * scl); u.y = pk2(o[ni][2] * scl, o[ni][3] * scl);
                *(uint2*)(dst + 16 * ni + 4 * q) = u;
            }
        } else if (cb < 3072) {
        } else if (cb < 4096) {
            const bool isq = cb < 3584;
            if (isq && !lat) return;
            const int c = (cb - 3072) & 511;
            const float scl = isq ? 0.08838834764831845f : 1.0f;
            bf16_t* dst = (isq ? gq : gk) + (size_t)row * 512 + c;
#pragma unroll
            for (int ni = 0; ni < 4; ++ni) {
                uint2 u; u.x = pk2(v[ni][0] * scl, v[ni][1] * scl); u.y = pk2(v[ni][2] * scl, v[ni][3] * scl);
                *(uint2*)(dst + 16 * ni + 4 * q) = u;
            }
        } else if (cb < 5120) {
        } else if (cb < 6144) {
            if (!lat) return;
            bf16_t* dst = sg + (size_t)row * 1024 + (cb - 5120);
#pragma unroll
            for (int ni = 0; ni < 4; ++ni) {
                float s[4];
#pragma unroll
                for (int j = 0; j < 4; ++j) { const float xx = v[ni][j]; s[j] = xx * sigmoidf_(xx); }
                uint2 u; u.x = pk2(s[0], s[1]); u.y = pk2(s[2], s[3]);
                *(uint2*)(dst + 16 * ni + 4 * q) = u;
            }
        } else if (cb < 8192) {
            if (!lat) return;
            bf16_t* dst = mg + (size_t)row * 2048 + (cb - 6144);
#pragma unroll
            for (int ni = 0; ni < 4; ++ni) {
                uint2 u; u.x = pk2(sigmoidf_(v[ni][0]), sigmoidf_(v[ni][1])); u.y = pk2(sigmoidf_(v[ni][2]), sigmoidf_(v[ni][3]));
                *(uint2*)(dst + 16 * ni + 4 * q) = u;
            }
        } else {
            float* dst = glow + (size_t)row * 32;
#pragma unroll
            for (int ni = 0; ni < 2; ++ni) *(f32x4*)(dst + 16 * ni + 4 * q) = v[ni];
        }
    }
};

struct EpiGate0 {
    bf16_t* mg;
    DI void operator()(int row, int cb, const f32x4 (&v)[4], int q) const {
#pragma unroll
        for (int ni = 0; ni < 4; ++ni) {
            const int col = cb + 16 * ni + 4 * q;
            const uint2 m = *(const uint2*)(mg + (size_t)row * 2048 + col);
            uint2 u; u.x = pk2(v[ni][0] * bflo(m.x), v[ni][1] * bfhi(m.x)); u.y = pk2(v[ni][2] * bflo(m.y), v[ni][3] * bfhi(m.y));
            *(uint2*)(mg + (size_t)row * 2048 + col) = u;
        }
    }
};
struct EpiGate1 {
    bf16_t* Y; const bf16_t* mg;
    DI void operator()(int row, int cb, const f32x4 (&v)[4], int q) const {
#pragma unroll
        for (int ni = 0; ni < 4; ++ni) {
            const int col = cb + 16 * ni + 4 * q;
            const uint2 m = *(const uint2*)(mg + (size_t)row * 2048 + 1024 + col);
            const uint2 pr = *(const uint2*)(mg + (size_t)row * 2048 + col);
            uint2 u; u.x = pk2(bflo(pr.x) + v[ni][0] * bflo(m.x), bfhi(pr.x) + v[ni][1] * bfhi(m.x));
            u.y = pk2(bflo(pr.y) + v[ni][2] * bflo(m.y), bfhi(pr.y) + v[ni][3] * bfhi(m.y));
            *(uint2*)(Y + (size_t)row * 1024 + col) = u;
        }
    }
};
template <int ACT>
struct EpiStore {
    bf16_t* O; int ldo;
    DI void operator()(int row, int cb, const f32x4 (&v)[4], int q) const {
#pragma unroll
        for (int ni = 0; ni < 4; ++ni) {
            float s[4];
#pragma unroll
            for (int j = 0; j < 4; ++j) { float xx = v[ni][j]; if (ACT == 1) { xx = fmaxf(xx, 0.f); xx = xx * xx; } s[j] = xx; }
            uint2 u; u.x = pk2(s[0], s[1]); u.y = pk2(s[2], s[3]);
            *(uint2*)(O + (size_t)row * ldo + cb + 16 * ni + 4 * q) = u;
        }
    }
};

DI float quad_max(float v) { v = fmaxf(v, __shfl_xor(v, 16)); v = fmaxf(v, __shfl_xor(v, 32)); return v; }
DI bf16x8 pack8(const f32x4& a, const f32x4& b) {
    typedef unsigned u32x4 __attribute__((ext_vector_type(4)));
    const u32x4 u = {pk2(a[0], a[1]), pk2(a[2], a[3]), pk2(b[0], b[1]), pk2(b[2], b[3])};
    return __builtin_bit_cast(bf16x8, u);
}

template <bool FAST>
DI void attn_kloop(char* smem, char* sdst, const bf16_t* gk0, const bf16_t* gk1, const bf16_t* gv, bool first, bool has_next, const bf16_t* ngk0, const bf16_t* ngk1, const bf16_t* ngv,
                   int comp, int krow0, int ksw, int l15, int qd, const bf16x8 (&qf)[2][2], f32x4 (&O)[2][8], float (&m)[2], float (&l)[2]) {
#define ATT_STAGE_P(pk0, pk1, pv, buf, kt_) do { _Pragma("unroll") for (int jj = 0; jj < 2; ++jj) { \
            GLDS16(pk0 + (size_t)((kt_) * 128 + 64 * jj) * 64, sdst + (buf) * 65536 + jj * 8192); \
            GLDS16(pk1 + (size_t)((kt_) * 128 + 64 * jj) * 64, sdst + (buf) * 65536 + 16384 + jj * 8192); } \
            _Pragma("unroll") for (int jj = 0; jj < 4; ++jj) GLDS16(pv + (size_t)(32 * jj) * TKV + (kt_) * 128, sdst + (buf) * 65536 + 32768 + jj * 8192); } while (0)
#define ATT_STAGE(buf, kt_) ATT_STAGE_P(gk0, gk1, gv, buf, kt_)
#define KFRAG(sub_, t_, kd_) (*(const bf16x8*)(skc + (32 * (sub_) + krow0 + 4 * (t_)) * 128 + (((4 * (kd_) + qd) ^ ksw) << 4)))
#define VFRAG(sub_, dt_) (*(const bf16x8*)(sb + 32768 + (16 * (dt_) + l15) * 256 + (((4 * (sub_) + qd) ^ l15) << 4)))
    if (first) {
        ATT_STAGE(0, 0);
        asm volatile("s_waitcnt vmcnt(0)" ::: "memory");
        __syncthreads();
    }
    f32x4 sinit[2], Ls[2];
#pragma unroll
    for (int qt = 0; qt < 2; ++qt) { const float v0 = FAST ? -m[qt] : 0.f; sinit[qt] = (f32x4){v0, v0, v0, v0}; Ls[qt] = (f32x4){0.f, 0.f, 0.f, 0.f}; }
    constexpr int NKT = TKV / 128;
    for (int kt = 0; kt < NKT; ++kt) {
        const int cur = kt & 1;
        if (kt + 1 < NKT) ATT_STAGE(cur ^ 1, kt + 1);
        else if (has_next) ATT_STAGE_P(ngk0, ngk1, ngv, cur ^ 1, 0);
        const char* sb = smem + cur * 65536;
        const char* skc = sb + comp * 16384;
        if (FAST) {
            bf16x8 kf[2][2];
#pragma unroll
            for (int t = 0; t < 2; ++t)
#pragma unroll
                for (int kd = 0; kd < 2; ++kd) kf[t][kd] = KFRAG(0, t, kd);
            f32x4 Sn[2][2];
#pragma unroll
            for (int qt = 0; qt < 2; ++qt)
#pragma unroll
                for (int t = 0; t < 2; ++t) { Sn[qt][t] = MFMA16(kf[t][0], qf[qt][0], sinit[qt]); Sn[qt][t] = MFMA16(kf[t][1], qf[qt][1], Sn[qt][t]); }
            const bf16x8 ones = {0x3F80, 0x3F80, 0x3F80, 0x3F80, 0x3F80, 0x3F80, 0x3F80, 0x3F80};
#pragma unroll
            for (int sub = 0; sub < 4; ++sub) {
                f32x4 Sc[2][2];
#pragma unroll
                for (int qt = 0; qt < 2; ++qt)
#pragma unroll
                    for (int t = 0; t < 2; ++t) Sc[qt][t] = Sn[qt][t];
                bf16x8 va[4], vb[4];
#pragma unroll
                for (int dt = 0; dt < 4; ++dt) va[dt] = VFRAG(sub, dt);
                if (sub < 3) {
#pragma unroll
                    for (int t = 0; t < 2; ++t)
#pragma unroll
                        for (int kd = 0; kd < 2; ++kd) kf[t][kd] = KFRAG(sub + 1, t, kd);
                }
                __builtin_amdgcn_sched_barrier(0);
                bf16x8 pb[2];
#pragma unroll
                for (int qt = 0; qt < 2; ++qt) {
                    f32x4 p0, p1;
#pragma unroll
                    for (int i = 0; i < 4; ++i) { p0[i] = __builtin_amdgcn_exp2f(Sc[qt][0][i]); p1[i] = __builtin_amdgcn_exp2f(Sc[qt][1][i]); }
                    pb[qt] = pack8(p0, p1);
                }
#pragma unroll
                for (int dt = 0; dt < 4; ++dt) vb[dt] = VFRAG(sub, 4 + dt);
                __builtin_amdgcn_sched_barrier(0);
#pragma unroll
                for (int dt = 0; dt < 4; ++dt) {
                    O[0][dt] = MFMA16(va[dt], pb[0], O[0][dt]);
                    O[1][dt] = MFMA16(va[dt], pb[1], O[1][dt]);
                    if (sub < 3) Sn[dt >> 1][dt & 1] = MFMA16(kf[dt & 1][0], qf[dt >> 1][0], sinit[dt >> 1]);
                }
#pragma unroll
                for (int dt = 0; dt < 4; ++dt) {
                    O[0][4 + dt] = MFMA16(vb[dt], pb[0], O[0][4 + dt]);
                    O[1][4 + dt] = MFMA16(vb[dt], pb[1], O[1][4 + dt]);
                    if (sub < 3) Sn[dt >> 1][dt & 1] = MFMA16(kf[dt & 1][1], qf[dt >> 1][1], Sn[dt >> 1][dt & 1]);
                }
                Ls[0] = MFMA16(ones, pb[0], Ls[0]);
                Ls[1] = MFMA16(ones, pb[1], Ls[1]);
            }
        } else {
#pragma unroll 1
            for (int sub = 0; sub < 4; ++sub) {
                f32x4 S[2][2];
#pragma unroll
                for (int qt = 0; qt < 2; ++qt)
#pragma unroll
                    for (int t = 0; t < 2; ++t) { S[qt][t] = MFMA16(KFRAG(sub, t, 0), qf[qt][0], sinit[qt]); S[qt][t] = MFMA16(KFRAG(sub, t, 1), qf[qt][1], S[qt][t]); }
                bf16x8 pb[2];
#pragma unroll
                for (int qt = 0; qt < 2; ++qt) {
                    float mt = fmaxf(fmaxf(fmaxf(S[qt][0][0], S[qt][0][1]), fmaxf(S[qt][0][2], S[qt][0][3])), fmaxf(fmaxf(S[qt][1][0], S[qt][1][1]), fmaxf(S[qt][1][2], S[qt][1][3])));
                    mt = quad_max(mt);
                    if (mt > m[qt]) {
                        const float al = __builtin_amdgcn_exp2f(m[qt] - mt);
                        l[qt] *= al;
#pragma unroll
                        for (int dt = 0; dt < 8; ++dt) O[qt][dt] *= al;
                        m[qt] = mt;
                    }
                    f32x4 p0, p1;
#pragma unroll
                    for (int i = 0; i < 4; ++i) { p0[i] = __builtin_amdgcn_exp2f(S[qt][0][i] - m[qt]); p1[i] = __builtin_amdgcn_exp2f(S[qt][1][i] - m[qt]); l[qt] += p0[i] + p1[i]; }
                    pb[qt] = pack8(p0, p1);
                }
#pragma unroll
                for (int dt = 0; dt < 8; ++dt) {
                    const bf16x8 vf = VFRAG(sub, dt);
                    O[0][dt] = MFMA16(vf, pb[0], O[0][dt]);
                    O[1][dt] = MFMA16(vf, pb[1], O[1][dt]);
                }
            }
        }
        asm volatile("s_waitcnt vmcnt(0)" ::: "memory");
        __syncthreads();
    }
#undef ATT_STAGE
#undef ATT_STAGE_P
#undef KFRAG
#undef VFRAG
    if (FAST) { l[0] = Ls[0][0]; l[1] = Ls[1][0]; }
    else { l[0] = quad_sum(l[0]); l[1] = quad_sum(l[1]); }
}

DI void phase_attn(const Params& p, char* smem) {
    const int tid = get_tid(), lane = tid & 63, w = tid >> 6, l15 = lane & 15, qd = lane >> 4;
    const int g = w >> 1, comp = w & 1;
    const bf16_t* Q = (const bf16_t*)(p.ws + R_Q);
    const bf16_t* Kk = (const bf16_t*)(p.ws + R_K);
    const bf16_t* Vt = (const bf16_t*)(p.ws + R_VT);
    const float* kmax = (const float*)(p.ws + OFF_KMAX);
    bf16_t* YDA = (bf16_t*)(p.ws + R_H);
    float d1 = 0.f, d2 = 0.f;
    for (int i = 0; i < 64; ++i) { d1 += p.lq1[i] * p.lk1[i]; d2 += p.lq2[i] * p.lk2[i]; }
    const float lam = __expf(d1) - __expf(d2) + 0.2f;
    const int krs = 8 * w + (lane >> 3), kcs = (lane & 7) ^ (((lane >> 4) & 1) | ((w & 3) << 1));
    const int vrs = 4 * w + (lane >> 4), vcs = (lane & 15) ^ ((4 * w + (lane >> 4)) & 15);
    const int krow0 = 8 * (l15 >> 2) + (l15 & 3);
    const int ksw = ((l15 >> 1) & 1) | (((l15 >> 2) & 3) << 1);
    float* xbuf = (float*)(smem + 65536) + g * 4096;
    char* sdst = smem + w * 1024;
    for (int id = blockIdx.x; id < 4096; id += gridDim.x) {
        const int x = id & 7, j = id >> 3, bh = (j >> 6) * 8 + x, qti = j & 63;
        const int b = bh >> 3, h = bh & 7;
        bf16x8 qf[2][2];
        float mb[2];
        const float kb = sqrtf(kmax[(bh * 2 + comp) * 2] + kmax[(bh * 2 + comp) * 2 + 1]);
#pragma unroll
        for (int qt = 0; qt < 2; ++qt) {
            const bf16_t* qp = Q + ((size_t)(bh * 2 + comp) * TLAT + qti * 128 + g * 32 + 16 * qt + l15) * 64 + qd * 8;
            qf[qt][0] = *(const bf16x8*)qp; qf[qt][1] = *(const bf16x8*)(qp + 32);
            float qn = 0.f;
#pragma unroll
            for (int kd = 0; kd < 2; ++kd)
#pragma unroll
                for (int e = 0; e < 8; ++e) { const float qv = __uint_as_float(((unsigned)(unsigned short)qf[qt][kd][e]) << 16); qn += qv * qv; }
            qn = quad_sum(qn);
            mb[qt] = sqrtf(qn) * kb * 1.01f + 1e-3f;
        }
        const bf16_t* gk0 = Kk + ((size_t)(bh * 2 + 0) * TKV + krs) * 64 + kcs * 8;
        const bf16_t* gk1 = gk0 + (size_t)TKV * 64;
        const bf16_t* gv = Vt + ((size_t)bh * 128 + vrs) * TKV + vcs * 8;
        const bool first = id == (int)blockIdx.x, has_next = id + (int)gridDim.x < 4096;
        const int nid = has_next ? id + gridDim.x : id, nbh = ((nid >> 3) >> 6) * 8 + (nid & 7);
        const bf16_t* ngk0 = Kk + ((size_t)(nbh * 2 + 0) * TKV + krs) * 64 + kcs * 8;
        const bf16_t* ngk1 = ngk0 + (size_t)TKV * 64;
        const bf16_t* ngv = Vt + ((size_t)nbh * 128 + vrs) * TKV + vcs * 8;
        f32x4 O[2][8];
#pragma unroll
        for (int qt = 0; qt < 2; ++qt)
#pragma unroll
            for (int d = 0; d < 8; ++d) O[qt][d] = (f32x4){0.f, 0.f, 0.f, 0.f};
        float m[2], l[2] = {0.f, 0.f};
        const int slow = __syncthreads_or(!(mb[0] <= 60.0f && mb[1] <= 60.0f));
        if (!slow) { m[0] = mb[0]; m[1] = mb[1]; attn_kloop<true>(smem, sdst, gk0, gk1, gv, first, has_next, ngk0, ngk1, ngv, comp, krow0, ksw, l15, qd, qf, O, m, l); }
        else { m[0] = -INFINITY; m[1] = -INFINITY; attn_kloop<false>(smem, sdst, gk0, gk1, gv, first, has_next, ngk0, ngk1, ngv, comp, krow0, ksw, l15, qd, qf, O, m, l); }
        if (comp == 1) {
#pragma unroll
            for (int qt = 0; qt < 2; ++qt) {
                const float i1 = lam / l[qt];
#pragma unroll
                for (int d = 0; d < 8; ++d)
#pragma unroll
                    for (int i = 0; i < 4; ++i) xbuf[((qt * 8 + d) * 4 + i) * 64 + lane] = O[qt][d][i] * i1;
            }
        }
        __syncthreads();
        if (comp == 0) {
#pragma unroll
            for (int qt = 0; qt < 2; ++qt) {
                const float i0 = 1.0f / l[qt];
                float ss = 0.f;
#pragma unroll
                for (int d = 0; d < 8; ++d)
#pragma unroll
                    for (int i = 0; i < 4; ++i) { const float o = O[qt][d][i] * i0 - xbuf[((qt * 8 + d) * 4 + i) * 64 + lane]; O[qt][d][i] = o; ss += o * o; }
                ss = quad_sum(ss);
                const float rs = rsqrtf(ss * (1.0f / 128.0f) + EPS) * 0.8f;
                const int t = qti * 128 + g * 32 + 16 * qt + l15;
                bf16_t* dst = YDA + ((size_t)b * TLAT + t) * 1024 + h * 128;
#pragma unroll
                for (int d = 0; d < 8; ++d) {
                    const int dv = 16 * d + 4 * qd;
                    const f32x4 hn = *(const f32x4*)(p.da_hn + dv);
                    uint2 u; u.x = pk2(O[qt][d][0] * rs * hn.x, O[qt][d][1] * rs * hn.y); u.y = pk2(O[qt][d][2] * rs * hn.z, O[qt][d][3] * rs * hn.w);
                    *(uint2*)(dst + dv) = u;
                }
            }
        }
    }
}

DI void phase_gate(const Params& p, char* smem) {
    const int tid = get_tid();
    const float* glow = (const float*)(p.ws + OFF_GLOW);
    float* sg = (float*)smem;
    float wf[16], wb[16];
#pragma unroll
    for (int r = 0; r < 16; ++r) { wf[r] = p.w_gate_up[(size_t)r * 512 + tid]; wb[r] = p.w_gate_up[(size_t)(16 + r) * 512 + tid]; }
    const float biasf = p.b_gate_up[tid], biasb = p.b_gate_up[512 + tid];
    _Float16* BF = (_Float16*)(p.ws + R_BF);
    _Float16* BB = (_Float16*)(p.ws + R_BB);
    for (int ch = blockIdx.x; ch < 1056; ch += gridDim.x) {
        __syncthreads();
        *(f32x4*)(sg + tid * 4) = *(const f32x4*)(glow + (size_t)ch * 2048 + tid * 4);
        __syncthreads();
        float run = 0.f;
#pragma unroll 4
        for (int i = 0; i < 64; ++i) {
            const float* gl = sg + i * 32;
            float a = biasf;
#pragma unroll
            for (int r = 0; r < 16; ++r) a = fmaf(gl[r], wf[r], a);
            const float ls = fminf(a, 0.f) - __logf(1.0f + __expf(-fabsf(a)));
            run += ls * (1.4426950408889634f / 16.0f);
            BF[(size_t)(ch * 64 + i) * 512 + tid] = (_Float16)run;
        }
        run = 0.f;
#pragma unroll 4
        for (int i = 63; i >= 0; --i) {
            const float* gl = sg + i * 32 + 16;
            float a = biasb;
#pragma unroll
            for (int r = 0; r < 16; ++r) a = fmaf(gl[r], wb[r], a);
            const float ls = fminf(a, 0.f) - __logf(1.0f + __expf(-fabsf(a)));
            run += ls * (1.4426950408889634f / 16.0f);
            BB[(size_t)(ch * 64 + i) * 512 + tid] = (_Float16)run;
        }
    }
}

struct GlaRegs { uint2 k[2][2], q[2][2], bb[2][2], bl[2][2]; uint4 v[2]; };

DI void phase_gla(const Params& p, char* smem, int unit) {
    const int tid = get_tid(), lane = tid & 63, w = tid >> 6, l31 = lane & 31, hh = lane >> 5;
    const int dir = unit & 1, dvh = (unit >> 1) & 1, bh = unit >> 2, b = bh >> 2, h = bh & 3;
    const bf16_t* gq = (const bf16_t*)(p.ws + R_GQ);
    const bf16_t* gk = (const bf16_t*)(p.ws + R_GK);
    const bf16_t* gvT = (const bf16_t*)(p.ws + R_GVT) + (size_t)(bh * 256 + dvh * 128) * TKV;
    const _Float16* B16 = (const _Float16*)(p.ws + (dir ? R_BB : R_BF));
    bf16_t* Oo = (bf16_t*)(p.ws + (dir ? R_OB : R_OF));
    char* sQt = smem;
    char* sKt = smem + 16384;
    char* sKh = smem + 32768;
    char* sVT = smem + 49152;
    char* sA = smem + 81920;
    float* sD = (float*)(smem + 90112);
    f32x16 S[4];
#pragma unroll
    for (int k = 0; k < 4; ++k)
#pragma unroll
        for (int e = 0; e < 16; ++e) S[k][e] = 0.f;
    const int sw = (l31 >> 1) & 7;
    GlaRegs R;
    auto chunk_info = [&](int step, int& rowbase, int& tcol, bool& emit) {
        if (step < 4) { const int cc = dir ? 3 - step : step; rowbase = NLAT + b * 256 + cc * 64; tcol = TLAT + cc * 64; emit = false; }
        else { const int cc = dir ? 127 - (step - 4) : step - 4; rowbase = b * TLAT + cc * 64; tcol = cc * 64; emit = true; }
    };
    auto load_chunk = [&](int step) {
        int rowbase, tcol; bool emit; chunk_info(step, rowbase, tcol, emit);
        const int rl = rowbase + (dir ? 0 : 63);
#pragma unroll
        for (int i = 0; i < 2; ++i) {
            const int item = tid + NT * i, tok = item >> 4, c = item & 15, d0 = 16 * (c >> 1) + 4 * (c & 1);
            const size_t ro = (size_t)(rowbase + tok) * 512 + h * 128 + d0;
            R.k[i][0] = *(const uint2*)(gk + ro); R.k[i][1] = *(const uint2*)(gk + ro + 8);
            if (emit) { R.q[i][0] = *(const uint2*)(gq + ro); R.q[i][1] = *(const uint2*)(gq + ro + 8); }
            else { R.q[i][0] = make_uint2(0, 0); R.q[i][1] = make_uint2(0, 0); }
            R.bb[i][0] = *(const uint2*)(B16 + ro); R.bb[i][1] = *(const uint2*)(B16 + ro + 8);
            const size_t rlo = (size_t)rl * 512 + h * 128 + d0;
            R.bl[i][0] = *(const uint2*)(B16 + rlo); R.bl[i][1] = *(const uint2*)(B16 + rlo + 8);
        }
#pragma unroll
        for (int i = 0; i < 2; ++i) R.v[i] = *(const uint4*)(gvT + (size_t)((tid >> 3) + 64 * i) * TKV + tcol + (tid & 7) * 8);
    };
    auto stage_chunk = [&]() {
#pragma unroll
        for (int i = 0; i < 2; ++i) {
            const int item = tid + NT * i, tok = item >> 4, c = item & 15, d0 = 16 * (c >> 1) + 4 * (c & 1);
            float qo[8], ko[8];
#pragma unroll
            for (int g = 0; g < 2; ++g) {
                const h4_t bv = __builtin_bit_cast(h4_t, R.bb[i][g]), lv = __builtin_bit_cast(h4_t, R.bl[i][g]);
                const float kk[4] = {bflo(R.k[i][g].x), bfhi(R.k[i][g].x), bflo(R.k[i][g].y), bfhi(R.k[i][g].y)};
                const float qq[4] = {bflo(R.q[i][g].x), bfhi(R.q[i][g].x), bflo(R.q[i][g].y), bfhi(R.q[i][g].y)};
#pragma unroll
                for (int j = 0; j < 4; ++j) {
                    const float bb = (float)bv[j], bl = (float)lv[j];
                    qo[4 * g + j] = qq[j] * __builtin_amdgcn_exp2f(bb);
                    ko[4 * g + j] = kk[j] * __builtin_amdgcn_exp2f(-bb);
                    const float kh = kk[j] * __builtin_amdgcn_exp2f(bl - bb);
                    const int dk = d0 + 8 * g + j;
                    *(bf16_t*)(sKh + dk * 128 + ((((tok >> 3) ^ ((dk >> 1) & 7))) << 4) + (tok & 7) * 2) = bf1(kh);
                }
            }
            const int po = tok * 256 + ((c ^ (tok & 15)) << 4);
            uint4 uq, uk;
            uq.x = pk2(qo[0], qo[1]); uq.y = pk2(qo[2], qo[3]); uq.z = pk2(qo[4], qo[5]); uq.w = pk2(qo[6], qo[7]);
            uk.x = pk2(ko[0], ko[1]); uk.y = pk2(ko[2], ko[3]); uk.z = pk2(ko[4], ko[5]); uk.w = pk2(ko[6], ko[7]);
            *(uint4*)(sQt + po) = uq; *(uint4*)(sKt + po) = uk;
        }
#pragma unroll
        for (int i = 0; i < 2; ++i) {
            const int row = (tid >> 3) + 64 * i, scn = tid & 7;
            *(uint4*)(sVT + row * 128 + ((scn ^ ((row >> 1) & 7)) << 4)) = R.v[i];
        }
        if (tid < 16) {
            const int d0 = 16 * (tid >> 1) + 4 * (tid & 1);
#pragma unroll
            for (int g = 0; g < 2; ++g) {
                const h4_t lv = __builtin_bit_cast(h4_t, R.bl[0][g]);
#pragma unroll
                for (int j = 0; j < 4; ++j) sD[d0 + 8 * g + j] = __builtin_amdgcn_exp2f((float)lv[j]);
            }
        }
    };
    load_chunk(0);
    for (int step = 0; step < 132; ++step) {
        int rowbase, tcol; bool emit; chunk_info(step, rowbase, tcol, emit);
        stage_chunk();
        __syncthreads();
        if (step + 1 < 132) load_chunk(step + 1);
        const int dvb = 32 * (w & 3);
        f32x16 o[2];
        if (emit) {
            if (w >= 4) {
                const int ti = (w - 4) >> 1, tj = (w - 4) & 1;
                f32x16 a;
#pragma unroll
                for (int e = 0; e < 16; ++e) a[e] = 0.f;
                const bool dead = dir ? (tj < ti) : (tj > ti);
                if (!dead) {
#pragma unroll
                    for (int ks = 0; ks < 8; ++ks) {
                        const int ri = 32 * ti + l31, rj = 32 * tj + l31, c = 2 * ks + hh;
                        const bf16x8 af = *(const bf16x8*)(sQt + ri * 256 + ((c ^ (ri & 15)) << 4));
                        const bf16x8 bf = *(const bf16x8*)(sKt + rj * 256 + ((c ^ (rj & 15)) << 4));
                        a = MFMA32(af, bf, a);
                    }
                }
                const int jj = 32 * tj + l31;
#pragma unroll
                for (int e = 0; e < 16; ++e) {
                    const int ii = 32 * ti + (e & 3) + 8 * (e >> 2) + 4 * hh;
                    const bool keep = dir ? (jj >= ii) : (jj <= ii);
                    *(bf16_t*)(sA + ii * 128 + ((((jj >> 3) ^ ((ii >> 1) & 7))) << 4) + (jj & 7) * 2) = bf1(keep ? a[e] : 0.f);
                }
            } else {
#pragma unroll
            for (int mt = 0; mt < 2; ++mt)
#pragma unroll
                for (int e = 0; e < 16; ++e) o[mt][e] = 0.f;
#pragma unroll
            for (int kt = 0; kt < 4; ++kt)
#pragma unroll
                for (int s = 0; s < 2; ++s) {
                    typedef unsigned u32x4 __attribute__((ext_vector_type(4)));
                    u32x4 pu = {pk2(S[kt][8 * s], S[kt][8 * s + 1]), pk2(S[kt][8 * s + 2], S[kt][8 * s + 3]), pk2(S[kt][8 * s + 4], S[kt][8 * s + 5]), pk2(S[kt][8 * s + 6], S[kt][8 * s + 7])};
                    const bf16x8 sf = __builtin_bit_cast(bf16x8, pu);
#pragma unroll
                    for (int mt = 0; mt < 2; ++mt) {
                        const int ri = 32 * mt + l31, c = 4 * kt + 2 * s + hh;
                        const bf16x8 af = *(const bf16x8*)(sQt + ri * 256 + ((c ^ (ri & 15)) << 4));
                        o[mt] = MFMA32(af, sf, o[mt]);
                    }
                }
            }
            __syncthreads();
            if (w < 4) {
#pragma unroll
            for (int s2 = 0; s2 < 4; ++s2) {
                const int c = 2 * s2 + hh;
                const bf16x8 vf = *(const bf16x8*)(sVT + (dvb + l31) * 128 + ((c ^ sw) << 4));
#pragma unroll
                for (int mt = 0; mt < 2; ++mt) {
                    const bf16x8 af = *(const bf16x8*)(sA + (32 * mt + l31) * 128 + ((c ^ sw) << 4));
                    o[mt] = MFMA32(af, vf, o[mt]);
                }
            }
            bf16_t* od = Oo + (size_t)rowbase * 1024 + h * 256 + dvh * 128 + dvb + l31;
#pragma unroll
            for (int mt = 0; mt < 2; ++mt)
#pragma unroll
                for (int e = 0; e < 16; ++e) od[(size_t)(32 * mt + (e & 3) + 8 * (e >> 2) + 4 * hh) * 1024] = bf1(o[mt][e]);
            }
        }
        if (w < 4) {
#pragma unroll
        for (int kt = 0; kt < 4; ++kt)
#pragma unroll
            for (int g4 = 0; g4 < 4; ++g4) {
                const f32x4 dd = *(const f32x4*)(sD + 32 * kt + 8 * g4 + 4 * hh);
#pragma unroll
                for (int jq = 0; jq < 4; ++jq) S[kt][4 * g4 + jq] *= dd[jq];
            }
#pragma unroll
        for (int s2 = 0; s2 < 4; ++s2) {
            const int c = 2 * s2 + hh;
            const bf16x8 vf = *(const bf16x8*)(sVT + (dvb + l31) * 128 + ((c ^ sw) << 4));
#pragma unroll
            for (int kt = 0; kt < 4; ++kt) {
                const bf16x8 af = *(const bf16x8*)(sKh + (32 * kt + l31) * 128 + ((c ^ sw) << 4));
                S[kt] = MFMA32(af, vf, S[kt]);
            }
        }
        }
        __syncthreads();
    }
}

DI void phase_combine(const Params& p, int panel) {
    const int tid = get_tid(), lane = tid & 63, w = tid >> 6;
    const bf16_t* OF = (const bf16_t*)(p.ws + R_OF);
    const bf16_t* OB = (const bf16_t*)(p.ws + R_OB);
    const bf16_t* SG = (const bf16_t*)(p.ws + R_SG);
    bf16_t* Y = (bf16_t*)(p.ws + R_YGLA);
    for (int row = panel * 256 + w; row < panel * 256 + 256; row += 8) {
        const size_t o = (size_t)row * 1024 + lane * 16;
        const uint4 a0 = *(const uint4*)(OF + o), a1 = *(const uint4*)(OF + o + 8);
        const uint4 b0 = *(const uint4*)(OB + o), b1 = *(const uint4*)(OB + o + 8);
        const uint4 g0 = *(const uint4*)(SG + o), g1 = *(const uint4*)(SG + o + 8);
        const unsigned au[8] = {a0.x, a0.y, a0.z, a0.w, a1.x, a1.y, a1.z, a1.w};
        const unsigned bu[8] = {b0.x, b0.y, b0.z, b0.w, b1.x, b1.y, b1.z, b1.w};
        const unsigned gu[8] = {g0.x, g0.y, g0.z, g0.w, g1.x, g1.y, g1.z, g1.w};
        float v[16]; float ss = 0.f;
#pragma unroll
        for (int e = 0; e < 8; ++e) { v[2 * e] = bflo(au[e]) + bflo(bu[e]); v[2 * e + 1] = bfhi(au[e]) + bfhi(bu[e]); ss += v[2 * e] * v[2 * e] + v[2 * e + 1] * v[2 * e + 1]; }
#pragma unroll
        for (int of = 8; of >= 1; of >>= 1) ss += __shfl_xor(ss, of);
        const float rs = rsqrtf(ss * (1.0f / 256.0f) + EPS);
        const float* gn = p.gla_hn + ((lane * 16) & 255);
        unsigned ou[8];
#pragma unroll
        for (int e = 0; e < 8; ++e) ou[e] = pk2(v[2 * e] * rs * gn[2 * e] * bflo(gu[e]), v[2 * e + 1] * rs * gn[2 * e + 1] * bfhi(gu[e]));
        *(uint4*)(Y + o) = make_uint4(ou[0], ou[1], ou[2], ou[3]);
        *(uint4*)(Y + o + 8) = make_uint4(ou[4], ou[5], ou[6], ou[7]);
    }
}

template <int MODE>
DI void phase_rows(const Params& p, char* smem, int panel) {
    float* md = (float*)smem;
    const int tid = get_tid(), lane = tid & 63, w = tid >> 6;
    const bf16_t* Yin = (const bf16_t*)(p.ws + (MODE == 0 ? R_Y2 : R_Y3));
    bf16_t* H2 = (bf16_t*)(p.ws + R_H2);
    const float* pn = MODE == 0 ? p.post_norm1 : p.post_norm2;
    for (int tile = panel; tile == panel; ++tile) {
        const int r = tile >> 5;
        __syncthreads();
        if (MODE == 0) { load_mod(p, r, 2, md); load_mod(p, r, 3, md + 1024); load_mod(p, r, 4, md + 2048); }
        else load_mod(p, r, 5, md);
        __syncthreads();
        for (int i = 0; i < 32; ++i) {
            const int row = tile * 256 + w * 32 + i;
            float y[16]; float ss = 0.f;
#pragma unroll
            for (int j = 0; j < 4; ++j) {
                const uint2 u = *(const uint2*)(Yin + (size_t)row * 1024 + lane * 4 + 256 * j);
                y[4 * j] = bflo(u.x); y[4 * j + 1] = bfhi(u.x); y[4 * j + 2] = bflo(u.y); y[4 * j + 3] = bfhi(u.y);
                ss += y[4 * j] * y[4 * j] + y[4 * j + 1] * y[4 * j + 1] + y[4 * j + 2] * y[4 * j + 2] + y[4 * j + 3] * y[4 * j + 3];
            }
            ss = wave_sum(ss);
            const float rs = rsqrtf(ss * (1.0f / 1024.0f) + EPS);
            float xn[16]; float s2 = 0.f;
#pragma unroll
            for (int j = 0; j < 4; ++j) {
                const int col = lane * 4 + 256 * j;
                const float* xs = (MODE == 0 ? p.x : (const float*)p.out) + (size_t)row * 1024 + col;
                const f32x4 xv = *(const f32x4*)xs, g = *(const f32x4*)(pn + col), gt = *(const f32x4*)(md + col);
#pragma unroll
                for (int e = 0; e < 4; ++e) { xn[4 * j + e] = xv[e] + gt[e] * (y[4 * j + e] * rs * g[e]); s2 += xn[4 * j + e] * xn[4 * j + e]; }
                f32x4 ov = {xn[4 * j], xn[4 * j + 1], xn[4 * j + 2], xn[4 * j + 3]};
                *(f32x4*)(p.out + (size_t)row * 1024 + col) = ov;
            }
            if (MODE == 0) {
                s2 = wave_sum(s2);
                const float rs2 = rsqrtf(s2 * (1.0f / 1024.0f) + EPS);
#pragma unroll
                for (int j = 0; j < 4; ++j) {
                    const int col = lane * 4 + 256 * j;
                    const f32x4 g = *(const f32x4*)(p.pre_norm2 + col), sh = *(const f32x4*)(md + 1024 + col), sc = *(const f32x4*)(md + 2048 + col);
                    float o[4];
#pragma unroll
                    for (int e = 0; e < 4; ++e) o[e] = xn[4 * j + e] * rs2 * g[e] * (1.f + sc[e]) + sh[e];
                    uint2 u; u.x = pk2(o[0], o[1]); u.y = pk2(o[2], o[3]);
                    *(uint2*)(H2 + (size_t)row * 1024 + col) = u;
                }
            }
        }
    }
}

DI void gsync(unsigned* bar, unsigned k) {
    __syncthreads();
    const unsigned epoch = k * gridDim.x;
    if (threadIdx.x == 0) {
        __threadfence();
        atomicAdd(bar, 1u);
        while (__hip_atomic_load(bar, __ATOMIC_RELAXED, __HIP_MEMORY_SCOPE_AGENT) < epoch) __builtin_amdgcn_s_sleep(1);
        __threadfence();
    }
    __syncthreads();
}

__global__ void __launch_bounds__(NT) fwd_megakernel(Params p) {
    __shared__ __attribute__((aligned(16))) char smem[131072];
    cg::grid_group grid = cg::this_grid();
    char* ws = p.ws;
    unsigned* bar = (unsigned*)(ws + OFF_BAR);
    phase_prep(p, smem);
    grid.sync();
    phase_h(p, smem);
    gsync(bar, 1u);
    {
        EpiIn e; e.Q = (bf16_t*)(ws + R_Q); e.Kk = (bf16_t*)(ws + R_K); e.Vt = (bf16_t*)(ws + R_VT); e.gq = (bf16_t*)(ws + R_GQ); e.gk = (bf16_t*)(ws + R_GK);
        e.gvT = (bf16_t*)(ws + R_GVT); e.sg = (bf16_t*)(ws + R_SG); e.mg = (bf16_t*)p.out; e.glow = (float*)(ws + OFF_GLOW); e.rope = (const float*)(ws + OFF_ROPE); e.kmax = (float*)(ws + OFF_KMAX);
        gemm_phase_ex<true>((const bf16_t*)(ws + R_H), 1024, (const bf16_t*)(ws + OFF_WIN), 1024, 1024, 264, 33, smem, e, blockIdx.x, gridDim.x);
    }
    gsync(bar, 2u);
    phase_attn(p, smem);
    gsync(bar, 3u);
    phase_gate(p, smem);
    gsync(bar, 4u);
    const bool split = gridDim.x >= 192;
    const int nscan = split ? 128 : (int)gridDim.x, oth0 = split ? 128 : 0, noth = (int)gridDim.x - oth0;
    if ((int)blockIdx.x < nscan) { for (int unit = blockIdx.x; unit < 128; unit += nscan) { __syncthreads(); phase_gla(p, smem, unit); } }
    if ((int)blockIdx.x >= oth0) {
        EpiGate0 e0; e0.mg = (bf16_t*)p.out;
        gemm_phase_ex<false>((const bf16_t*)(ws + R_H), 1024, (const bf16_t*)(ws + OFF_WDA), 1024, 1024, 256, 4, smem, e0, blockIdx.x - oth0, noth);
        const long gsz2 = (long)noth * NT, gtid2 = (long)(blockIdx.x - oth0) * NT + get_tid();
        repack<0>(p.w_bgla, 1024, 1024, (bf16_t*)(ws + OFF_WGLA), 1024, gtid2, gsz2);
        repack<0>(p.w_out, 1024, 1024, (bf16_t*)(ws + OFF_WOUT), 1024, gtid2, gsz2);
        repack<0>(p.w_ff1, 1024, 4096, (bf16_t*)(ws + OFF_WFF1), 4096, gtid2, gsz2);
        repack<0>(p.w_ff2, 4096, 1024, (bf16_t*)(ws + OFF_WFF2), 1024, gtid2, gsz2);
    }
    gsync(bar, 5u);
    for (int panel = blockIdx.x; panel < 256; panel += gridDim.x) phase_combine(p, panel);
    gsync(bar, 6u);
    { EpiGate1 e1; e1.Y = (bf16_t*)(ws + R_Y); e1.mg = (const bf16_t*)p.out;
      gemm_phase((const bf16_t*)(ws + R_YGLA), 1024, (const bf16_t*)(ws + OFF_WGLA), 1024, 1024, 256, 4, smem, e1); }
    gsync(bar, 7u);
    { EpiStore<0> e; e.O = (bf16_t*)(ws + R_Y2); e.ldo = 1024;
      gemm_phase((const bf16_t*)(ws + R_Y), 1024, (const bf16_t*)(ws + OFF_WOUT), 1024, 1024, 256, 4, smem, e); }
    gsync(bar, 8u);
    for (int panel = blockIdx.x; panel < 256; panel += gridDim.x) phase_rows<0>(p, smem, panel);
    gsync(bar, 9u);
    { EpiStore<1> e; e.O = (bf16_t*)(ws + R_U); e.ldo = 4096;
      gemm_phase((const bf16_t*)(ws + R_H2), 1024, (const bf16_t*)(ws + OFF_WFF1), 1024, 1024, 256, 16, smem, e); }
    gsync(bar, 10u);
    { EpiStore<0> e; e.O = (bf16_t*)(ws + R_Y3); e.ldo = 1024;
      gemm_phase((const bf16_t*)(ws + R_U), 4096, (const bf16_t*)(ws + OFF_WFF2), 4096, 4096, 256, 4, smem, e); }
    gsync(bar, 11u);
    for (int panel = blockIdx.x; panel < 256; panel += gridDim.x) phase_rows<1>(p, smem, panel);
}

extern "C" void kernel_launch(void* const* d_in, const int* in_sizes, int n_in, void* d_out, int out_size, void* d_ws, size_t ws_size, hipStream_t stream) {
    static int grid_blocks = 0;
    if (!grid_blocks) {
        int dev = 0, cus = 0, per_cu = 0;
        hipGetDevice(&dev);
        hipDeviceGetAttribute(&cus, hipDeviceAttributeMultiprocessorCount, dev);
        hipOccupancyMaxActiveBlocksPerMultiprocessor(&per_cu, fwd_megakernel, NT, 0);
        if (per_cu < 1) per_cu = 1;
        grid_blocks = cus * per_cu;
        if (grid_blocks > 256) grid_blocks = 256;
    }
    Params p{};
    const float* const* in = (const float* const*)d_in;
    p.x = in[0]; p.c = in[1]; p.ctx = in[2]; p.c_ctx = in[3]; p.w_mod = in[4]; p.b_mod = in[5]; p.pre_norm1 = in[6]; p.w_in = in[7];
    p.w_gate_up = in[8]; p.b_gate_up = in[9]; p.lq1 = in[10]; p.lk1 = in[11]; p.lq2 = in[12]; p.lk2 = in[13]; p.da_hn = in[14]; p.gla_hn = in[15];
    p.w_bda = in[16]; p.w_bgla = in[17]; p.w_out = in[18]; p.post_norm1 = in[19]; p.pre_norm2 = in[20]; p.w_ff1 = in[21]; p.w_ff2 = in[22]; p.post_norm2 = in[23];
    p.out = (float*)d_out; p.ws = (char*)d_ws;
    hipMemsetAsync((char*)d_ws + OFF_BAR, 0, 256, stream);
    void* args[] = {&p};
    hipError_t e = hipLaunchCooperativeKernel((void*)fwd_megakernel, dim3(grid_blocks), dim3(NT), args, 0, stream);
    if (e != hipSuccess) fprintf(stderr, "cooperative launch failed: %s (grid %d)\n", hipGetErrorString(e), grid_blocks);
}
```

```cpp
#include <hip/hip_runtime.h>
#include <hip/hip_cooperative_groups.h>
#include <cstdio>
namespace cg = cooperative_groups;

typedef unsigned short bf16_t;
typedef short bf16x8 __attribute__((ext_vector_type(8)));
typedef float f32x16 __attribute__((ext_vector_type(16)));
typedef float f32x4 __attribute__((ext_vector_type(4)));
typedef float f32x2 __attribute__((ext_vector_type(2)));
typedef __bf16 bf2_t __attribute__((ext_vector_type(2)));
typedef _Float16 h4_t __attribute__((ext_vector_type(4)));

#define DI __device__ __forceinline__
#define MFMA32(a, b, c) __builtin_amdgcn_mfma_f32_32x32x16_bf16((a), (b), (c), 0, 0, 0)

constexpr int NT = 512;
constexpr int TLAT = 8192, NB = 8, NLAT = 65536, NROW = 67584, TKV = 8448;
constexpr float EPS = 1e-6f;
constexpr size_t MiB = 1048576;
constexpr size_t OFF_WIN = 0;
constexpr size_t OFF_WDA = OFF_WIN + 8448ull * 1024 * 2;
constexpr size_t OFF_WGLA = OFF_WDA + 2 * MiB;
constexpr size_t OFF_WOUT = OFF_WGLA + 2 * MiB;
constexpr size_t OFF_WFF1 = OFF_WOUT + 2 * MiB;
constexpr size_t OFF_WFF2 = OFF_WFF1 + 8 * MiB;
constexpr size_t OFF_MODP = OFF_WFF2 + 8 * MiB;
constexpr size_t OFF_ROPE = OFF_MODP + 16ull * 9 * 6144 * 4;
constexpr size_t OFF_GLOW = OFF_ROPE + 16384;
constexpr size_t OFF_KMAX = OFF_GLOW + 67584ull * 32 * 4;
constexpr size_t OFF_BAR = OFF_KMAX + 1024;
constexpr size_t R_H = 64 * MiB;
constexpr size_t R_Q = R_H + 132 * MiB;
constexpr size_t R_K = R_Q + 128 * MiB;
constexpr size_t R_VT = R_K + 132 * MiB;
constexpr size_t R_GQ = R_VT + 132 * MiB;
constexpr size_t R_GK = R_GQ + 64 * MiB;
constexpr size_t R_GVT = R_GK + 66 * MiB;
constexpr size_t R_SG = R_GVT + 132 * MiB;
constexpr size_t WS_END = R_SG + 128 * MiB;
static_assert(OFF_BAR + 1024 <= R_H, "small region overflow");
static_assert(WS_END <= 1024 * MiB, "workspace overflow");
constexpr size_t R_BF = R_Q;
constexpr size_t R_BB = R_Q + 66 * MiB;
constexpr size_t R_OF = R_K + 4 * MiB;
constexpr size_t R_OB = R_VT;
constexpr size_t R_YGLA = R_SG;
constexpr size_t R_Y = R_GVT;
constexpr size_t R_Y2 = R_SG;
constexpr size_t R_H2 = R_H;
constexpr size_t R_U = R_Q;
constexpr size_t R_Y3 = R_GVT;

struct Params {
    const float *x, *c, *ctx, *c_ctx, *w_mod, *b_mod, *pre_norm1, *w_in, *w_gate_up, *b_gate_up;
    const float *lq1, *lk1, *lq2, *lk2, *da_hn, *gla_hn, *w_bda, *w_bgla, *w_out, *post_norm1, *pre_norm2, *w_ff1, *w_ff2, *post_norm2;
    float* out;
    char* ws;
};

DI unsigned pk2(float a, float b) { f32x2 v = {a, b}; bf2_t r = __builtin_convertvector(v, bf2_t); return __builtin_bit_cast(unsigned, r); }
DI bf16_t bf1(float a) { __bf16 r = (__bf16)a; return __builtin_bit_cast(unsigned short, r); }
DI float bflo(unsigned v) { return __uint_as_float(v << 16); }
DI float bfhi(unsigned v) { return __uint_as_float(v & 0xffff0000u); }
DI float wave_sum(float v) {
#pragma unroll
    for (int o = 32; o >= 1; o >>= 1) v += __shfl_xor(v, o);
    return v;
}
DI int get_tid() { int t = threadIdx.x; asm volatile("" : "+v"(t)); return t; }
DI float sigmoidf_(float x) { return 1.0f / (1.0f + __expf(-x)); }

template <int MODE>
DI void repack(const float* __restrict__ src, int K, int Nsrc, bf16_t* __restrict__ dst, int Nd, long gtid, long gsz) {
    const long total = (long)Nd * (K / 8);
    for (long it = gtid; it < total; it += gsz) {
        const int n = (int)(it % Nd), kc = (int)(it / Nd);
        int col = n; bool valid = true;
        if (MODE == 1) { if (n < 5120) col = n; else if (n < 8192) col = n + 32; else if (n < 8224) col = n - 8192 + 5120; else valid = false; }
        float v[8];
#pragma unroll
        for (int j = 0; j < 8; ++j) v[j] = valid ? src[(size_t)(kc * 8 + j) * Nsrc + col] : 0.f;
        uint4 o; o.x = pk2(v[0], v[1]); o.y = pk2(v[2], v[3]); o.z = pk2(v[4], v[5]); o.w = pk2(v[6], v[7]);
        *(uint4*)(dst + (size_t)n * K + kc * 8) = o;
    }
}

DI void sincos_acc(float a, float& s, float& c) {
    const float q = rintf(a * 0.63661977236758134f);
    float r = fmaf(-q, 1.5703125f, a); r = fmaf(-q, 4.837512969970703125e-4f, r); r = fmaf(-q, 7.54978995489188216e-8f, r);
    const float r2 = r * r;
    const float sp = r + r * r2 * (-1.6666666666e-1f + r2 * (8.3333333333e-3f + r2 * (-1.98412698e-4f + r2 * 2.7557319e-6f)));
    const float cp = 1.0f + r2 * (-0.5f + r2 * (4.16666666667e-2f + r2 * (-1.38888888889e-3f + r2 * (2.48015873e-5f + r2 * -2.75573192e-7f))));
    const int qi = ((int)q) & 3;
    s = (qi == 0) ? sp : (qi == 1) ? cp : (qi == 2) ? -sp : -cp;
    c = (qi == 0) ? cp : (qi == 1) ? -sp : (qi == 2) ? -cp : sp;
}

DI void phase_prep(const Params& p, char* smem) {
    const int tid = get_tid();
    const long gsz = (long)gridDim.x * NT, gtid = (long)blockIdx.x * NT + tid;
    char* ws = p.ws;
    repack<1>(p.w_in, 1024, 8224, (bf16_t*)(ws + OFF_WIN), 8448, gtid, gsz);
    repack<0>(p.w_bda, 1024, 1024, (bf16_t*)(ws + OFF_WDA), 1024, gtid, gsz);
    if (gtid < 256) ((float*)(ws + OFF_KMAX))[gtid] = 0.f;
    if (gtid < 2048) {
        const int pos = (int)gtid >> 4, f = (int)gtid & 15;
        const float inv = exp2f(-(float)f * (13.287712379549449f / 16.0f));
        float s, c; sincos_acc((float)pos * inv, s, c);
        float* rt = (float*)(ws + OFF_ROPE);
        rt[gtid] = c; rt[2048 + gtid] = s;
    }
    float* sil = (float*)smem;
    float* modp = (float*)(ws + OFF_MODP);
    for (int item = blockIdx.x; item < 192; item += gridDim.x) {
        const int cb = item % 12, ks = item / 12;
        __syncthreads();
        for (int i = tid; i < 9 * 64; i += NT) {
            const int r = i >> 6, kk = i & 63;
            const float v = (r < 8) ? p.c[r * 1024 + ks * 64 + kk] : p.c_ctx[ks * 64 + kk];
            sil[i] = v * sigmoidf_(v);
        }
        __syncthreads();
        const int n = cb * 512 + tid;
        float acc[9];
#pragma unroll
        for (int r = 0; r < 9; ++r) acc[r] = 0.f;
        for (int kk = 0; kk < 64; ++kk) {
            const float w = p.w_mod[(size_t)(ks * 64 + kk) * 6144 + n];
#pragma unroll
            for (int r = 0; r < 9; ++r) acc[r] = fmaf(sil[r * 64 + kk], w, acc[r]);
        }
#pragma unroll
        for (int r = 0; r < 9; ++r) modp[(size_t)(ks * 9 + r) * 6144 + n] = acc[r];
    }
}

DI void load_mod(const Params& p, int r, int which, float* dst) {
    const float* modp = (const float*)(p.ws + OFF_MODP);
    for (int n = threadIdx.x; n < 1024; n += NT) {
        float a = p.b_mod[which * 1024 + n];
#pragma unroll
        for (int ks = 0; ks < 16; ++ks) a += modp[(size_t)(ks * 9 + r) * 6144 + which * 1024 + n];
        dst[n] = a;
    }
}

DI void h_row2(const Params& p, const float* md, bf16_t* H, int rowA, int rowB, int lane) {
    const float* sa = rowA < NLAT ? p.x + (size_t)rowA * 1024 : p.ctx + (size_t)(rowA - NLAT) * 1024;
    const float* sbp = rowB < NLAT ? p.x + (size_t)rowB * 1024 : p.ctx + (size_t)(rowB - NLAT) * 1024;
    f32x4 va[4], vb[4]; float sa2 = 0.f, sb2 = 0.f;
#pragma unroll
    for (int j = 0; j < 4; ++j) { va[j] = *(const f32x4*)(sa + lane * 4 + 256 * j); vb[j] = *(const f32x4*)(sbp + lane * 4 + 256 * j); }
#pragma unroll
    for (int j = 0; j < 4; ++j) {
        sa2 += va[j].x * va[j].x + va[j].y * va[j].y + va[j].z * va[j].z + va[j].w * va[j].w;
        sb2 += vb[j].x * vb[j].x + vb[j].y * vb[j].y + vb[j].z * vb[j].z + vb[j].w * vb[j].w;
    }
    sa2 = wave_sum(sa2); sb2 = wave_sum(sb2);
    const float ra = rsqrtf(sa2 * (1.0f / 1024.0f) + EPS), rb = rsqrtf(sb2 * (1.0f / 1024.0f) + EPS);
#pragma unroll
    for (int j = 0; j < 4; ++j) {
        const int col = lane * 4 + 256 * j;
        const f32x4 g = *(const f32x4*)(p.pre_norm1 + col);
        const f32x4 sh = *(const f32x4*)(md + col), sc = *(const f32x4*)(md + 1024 + col);
        float oa[4], ob[4];
#pragma unroll
        for (int e = 0; e < 4; ++e) { const float gm = g[e] * (1.f + sc[e]); oa[e] = va[j][e] * ra * gm + sh[e]; ob[e] = vb[j][e] * rb * gm + sh[e]; }
        uint2 o; o.x = pk2(oa[0], oa[1]); o.y = pk2(oa[2], oa[3]);
        *(uint2*)(H + (size_t)rowA * 1024 + col) = o;
        o.x = pk2(ob[0], ob[1]); o.y = pk2(ob[2], ob[3]);
        *(uint2*)(H + (size_t)rowB * 1024 + col) = o;
    }
}

DI void phase_h(const Params& p, char* smem) {
    float* md = (float*)smem;
    const int tid = get_tid(), lane = tid & 63, w = tid >> 6;
    bf16_t* H = (bf16_t*)(p.ws + R_H);
    for (int tile = blockIdx.x; tile < 256; tile += gridDim.x) {
        __syncthreads();
        load_mod(p, tile >> 5, 0, md); load_mod(p, tile >> 5, 1, md + 1024);
        __syncthreads();
        for (int i = 0; i < 16; ++i) h_row2(p, md, H, tile * 256 + w * 32 + i, tile * 256 + w * 32 + 16 + i, lane);
    }
    __syncthreads();
    load_mod(p, 8, 0, md); load_mod(p, 8, 1, md + 1024);
    __syncthreads();
    for (int r2 = blockIdx.x * 8 + w; r2 < 1024; r2 += gridDim.x * 8) h_row2(p, md, H, NLAT + 2 * r2, NLAT + 2 * r2 + 1, lane);
}

typedef __attribute__((address_space(3))) unsigned lds_u32;
DI lds_u32* to_lds(const void* p) { return (lds_u32*)(unsigned)(size_t)p; }
#define GLDS16(src, dst) __builtin_amdgcn_global_load_lds((const unsigned*)(src), to_lds(dst), 16, 0, 0)

#define MFMA16(a, b, c) __builtin_amdgcn_mfma_f32_16x16x32_bf16((a), (b), (c), 0, 0, 0)
template <bool SWAP, class Epi>
DI void gemm_tile(const bf16_t* A, int lda, const bf16_t* B, int ldb, int K, int m0, int n0, bool first, bool has_next, int nm0, int nn0, char* smem, Epi& epi) {
    const int tid = get_tid(), lane = tid & 63, w = tid >> 6, wm = w >> 2, wn = w & 3, l15 = lane & 15, q = lane >> 4;
    f32x4 acc[8][4];
#pragma unroll
    for (int i = 0; i < 8; ++i)
#pragma unroll
        for (int j = 0; j < 4; ++j) acc[i][j] = (f32x4){0.f, 0.f, 0.f, 0.f};
    const int srow = 8 * w + (lane >> 3), schunk = (lane & 7) ^ (4 * (w & 1) + (lane >> 4));
    const bf16_t* ga = A + (size_t)(m0 + srow) * lda + schunk * 8;
    const bf16_t* gb = B + (size_t)(n0 + srow) * ldb + schunk * 8;
    const bf16_t* nga = A + (size_t)(nm0 + srow) * lda + schunk * 8;
    const bf16_t* ngb = B + (size_t)(nn0 + srow) * ldb + schunk * 8;
    const int sw = (l15 >> 1) & 7;
    const int aofs = (128 * wm + l15) * 128, bofs = 32768 + (64 * wn + l15) * 128;
    char* sdst = smem + w * 1024;
#define GEMM_STAGE(pa, pb, buf, kt_) do { _Pragma("unroll") for (int i = 0; i < 4; ++i) { \
        GLDS16(pa + (size_t)i * 64 * lda + (kt_) * 64, sdst + (buf) * 65536 + i * 8192); \
        GLDS16(pb + (size_t)i * 64 * ldb + (kt_) * 64, sdst + (buf) * 65536 + 32768 + i * 8192); } } while (0)
    if (first) {
        GEMM_STAGE(ga, gb, 0, 0);
        asm volatile("s_waitcnt vmcnt(0)" ::: "memory");
        __syncthreads();
    }
    const int KT = K >> 6;
    for (int kt = 0; kt < KT; ++kt) {
        const int cur = kt & 1;
        if (kt + 1 < KT) GEMM_STAGE(ga, gb, cur ^ 1, kt + 1);
        else if (has_next) GEMM_STAGE(nga, ngb, cur ^ 1, 0);
        const char* sb = smem + cur * 65536;
#pragma unroll
        for (int kk = 0; kk < 2; ++kk) {
            const int co = ((4 * kk + q) ^ sw) << 4;
            bf16x8 af[8], bf[4];
#pragma unroll
            for (int mi = 0; mi < 8; ++mi) af[mi] = *(const bf16x8*)(sb + aofs + mi * 2048 + co);
#pragma unroll
            for (int ni = 0; ni < 4; ++ni) bf[ni] = *(const bf16x8*)(sb + bofs + ni * 2048 + co);
#pragma unroll
            for (int mi = 0; mi < 8; ++mi)
#pragma unroll
                for (int ni = 0; ni < 4; ++ni) acc[mi][ni] = SWAP ? MFMA16(af[mi], bf[ni], acc[mi][ni]) : MFMA16(bf[ni], af[mi], acc[mi][ni]);
        }
        asm volatile("s_waitcnt vmcnt(0)" ::: "memory");
        __syncthreads();
    }
#undef GEMM_STAGE
#pragma unroll
    for (int mi = 0; mi < 8; ++mi) {
        if constexpr (SWAP) {
#pragma unroll
            for (int ni = 0; ni < 4; ++ni) epi.vt(m0 + 128 * wm + 16 * mi + 4 * q, n0 + 64 * wn + 16 * ni + l15, acc[mi][ni]);
        } else epi(m0 + 128 * wm + 16 * mi + l15, n0 + 64 * wn, acc[mi], q);
        asm volatile("" ::: "memory");
    }
}

DI void tile_map(int id, int MT, int NTl, int& mt, int& nt) {
    const int x = id & 7, local = id >> 3, mtx = MT >> 3;
    const int full = mtx >> 2, per = 4 * NTl;
    int patch = local / per, wv = local - patch * per, pm = 4;
    if (patch >= full) { patch = full; wv = local - full * per; pm = mtx - full * 4; }
    const int mo = wv % pm; nt = wv / pm;
    mt = (patch * 4 + mo) * 8 + x;
}

DI void tile_map_in(int id, int& mt, int& nt) {
    if (id < 8448) { tile_map(id, 256, 33, mt, nt); return; }
    const int id2 = id - 8448, k = id2 >> 3;
    mt = 256 + (id2 & 7);
    nt = k < 8 ? 4 + k : k < 10 ? 14 + (k - 8) : k < 14 ? 16 + (k - 10) : 32;
}
template <bool VSWAP, class Epi>
DI void gemm_phase_ex(const bf16_t* A, int lda, const bf16_t* B, int ldb, int K, int MT, int NTl, char* smem, Epi& epi, int bid, int nblk) {
    const int total = VSWAP ? 8448 + 120 : MT * NTl;
    bool first = true;
    for (int id = bid; id < total; id += nblk) {
        int mt, nt, mt2 = 0, nt2 = 0;
        if (VSWAP) tile_map_in(id, mt, nt); else tile_map(id, MT, NTl, mt, nt);
        const bool has_next = id + nblk < total;
        if (has_next) { if (VSWAP) tile_map_in(id + nblk, mt2, nt2); else tile_map(id + nblk, MT, NTl, mt2, nt2); }
        if constexpr (VSWAP) { if (Epi::is_vt(nt)) { gemm_tile<true>(A, lda, B, ldb, K, mt * 256, nt * 256, first, has_next, mt2 * 256, nt2 * 256, smem, epi); first = false; continue; } }
        gemm_tile<false>(A, lda, B, ldb, K, mt * 256, nt * 256, first, has_next, mt2 * 256, nt2 * 256, smem, epi);
        first = false;
    }
}
template <class Epi>
DI void gemm_phase(const bf16_t* A, int lda, const bf16_t* B, int ldb, int K, int MT, int NTl, char* smem, Epi& epi) {
    gemm_phase_ex<false>(A, lda, B, ldb, K, MT, NTl, smem, epi, blockIdx.x, gridDim.x);
}

DI float xhalf_max(float v) {
    typedef unsigned u32x2 __attribute__((ext_vector_type(2)));
    const unsigned u = __float_as_uint(v);
    const u32x2 r = __builtin_amdgcn_permlane32_swap(u, u, false, false);
    return fmaxf(__uint_as_float(r[0]), __uint_as_float(r[1]));
}
DI float xhalf_sum(float v) {
    typedef unsigned u32x2 __attribute__((ext_vector_type(2)));
    const unsigned u = __float_as_uint(v);
    const u32x2 r = __builtin_amdgcn_permlane32_swap(u, u, false, false);
    return __uint_as_float(r[0]) + __uint_as_float(r[1]);
}
template <class Epi>
DI void gemm_panel(const bf16_t* A, int lda, const bf16_t* B, int ldb, int K, int panel, int NTl, char* smem, Epi& epi) {
    for (int nt = 0; nt < NTl; ++nt)
        gemm_tile<false>(A, lda, B, ldb, K, panel * 256, nt * 256, nt == 0, nt + 1 < NTl, panel * 256, (nt + 1) * 256, smem, epi);
}

DI float quad_sum(float v) { v += __shfl_xor(v, 16); v += __shfl_xor(v, 32); return v; }
struct EpiIn {
    bf16_t *Q, *Kk, *Vt, *gq, *gk, *gvT, *sg, *mg; float* glow; const float* rope; float* kmax;
    static DI bool is_vt(int nt) { return (nt >= 8 && nt < 12) || (nt >= 16 && nt < 20); }
    DI void vt(int row0, int col, const f32x4& v) const {
        int b, t;
        if (row0 < NLAT) { b = row0 >> 13; t = row0 & 8191; } else { const int r2 = row0 - NLAT; b = r2 >> 8; t = TLAT + (r2 & 255); }
        bf16_t* dst;
        if (col < 3072) { const int c = col - 2048; dst = Vt + (size_t)((b * 8 + (c >> 7)) * 128 + (c & 127)) * TKV + t; }
        else { const int c = col - 4096; dst = gvT + (size_t)((b * 4 + (c >> 8)) * 256 + (c & 255)) * TKV + t; }
        uint2 u; u.x = pk2(v[0], v[1]); u.y = pk2(v[2], v[3]);
        *(uint2*)dst = u;
    }
    DI void operator()(int row, int cb, const f32x4 (&v)[4], int q) const {
        if (cb >= 8224) return;
        const bool lat = row < NLAT;
        int b, t;
        if (lat) { b = row >> 13; t = row & 8191; } else { const int r2 = row - NLAT; b = r2 >> 8; t = TLAT + (r2 & 255); }
        if (cb < 2048) {
            const bool isq = cb < 1024;
            if (isq && !lat) return;
            const int c = cb & 1023, head = c >> 7, comp = (c >> 6) & 1;
            f32x4 o[4];
            if (lat) {
#pragma unroll
                for (int half = 0; half < 2; ++half) {
                    const int pos = half ? (t & 63) : (t >> 6);
                    const f32x4 c4 = *(const f32x4*)(rope + pos * 16 + 4 * q), s4 = *(const f32x4*)(rope + 2048 + pos * 16 + 4 * q);
#pragma unroll
                    for (int j = 0; j < 4; ++j) {
                        const float x1 = v[2 * half][j], x2 = v[2 * half + 1][j];
                        o[2 * half][j] = x1 * c4[j] - x2 * s4[j];
                        o[2 * half + 1][j] = x2 * c4[j] + x1 * s4[j];
                    }
                }
            } else {
#pragma unroll
                for (int ni = 0; ni < 4; ++ni) o[ni] = v[ni];
            }
            if (!isq) {
#pragma unroll
                for (int half = 0; half < 2; ++half) {
                    float ssq = 0.f;
#pragma unroll
                    for (int j = 0; j < 4; ++j) ssq += o[2 * half][j] * o[2 * half][j] + o[2 * half + 1][j] * o[2 * half + 1][j];
                    ssq = quad_sum(ssq);
#pragma unroll
                    for (int of = 8; of >= 1; of >>= 1) ssq = fmaxf(ssq, __shfl_xor(ssq, of));
                    if ((threadIdx.x & 63) == 0) atomicMax((unsigned*)(kmax + ((b * 8 + head) * 2 + comp) * 2 + half), __float_as_uint(ssq));
                }
            }
            const float scl = isq ? 0.125f * 1.4426950408889634f : 1.0f;
            bf16_t* dst = isq ? Q + ((size_t)((b * 8 + head) * 2 + comp) * TLAT + t) * 64 : Kk + ((size_t)((b * 8 + head) * 2 + comp) * TKV + t) * 64;
#pragma unroll
            for (int ni = 0; ni < 4; ++ni) {
                uint2 u; u.x = pk2(o[ni][0] * scl, o[ni][1] * scl); u.y = pk2(o[ni][2] * scl, o[ni][3] * scl);
                *(uint2*)(dst + 16 * ni + 4 * q) = u;
            }
        } else if (cb < 3072) {
        } else if (cb < 4096) {
            const bool isq = cb < 3584;
            if (isq && !lat) return;
            const int c = (cb - 3072) & 511;
            const float scl = isq ? 0.08838834764831845f : 1.0f;
            bf16_t* dst = (isq ? gq : gk) + (size_t)row * 512 + c;
#pragma unroll
            for (int ni = 0; ni < 4; ++ni) {
                uint2 u; u.x = pk2(v[ni][0] * scl, v[ni][1] * scl); u.y = pk2(v[ni][2] * scl, v[ni][3] * scl);
                *(uint2*)(dst + 16 * ni + 4 * q) = u;
            }
        } else if (cb < 5120) {
        } else if (cb < 6144) {
            if (!lat) return;
            bf16_t* dst = sg + (size_t)row * 1024 + (cb - 5120);
#pragma unroll
            for (int ni = 0; ni < 4; ++ni) {
                float s[4];
#pragma unroll
                for (int j = 0; j < 4; ++j) { const float xx = v[ni][j]; s[j] = xx * sigmoidf_(xx); }
                uint2 u; u.x = pk2(s[0], s[1]); u.y = pk2(s[2], s[3]);
                *(uint2*)(dst + 16 * ni + 4 * q) = u;
            }
        } else if (cb < 8192) {
            if (!lat) return;
            bf16_t* dst = mg + (size_t)row * 2048 + (cb - 6144);
#pragma unroll
            for (int ni = 0; ni < 4; ++ni) {
                uint2 u; u.x = pk2(sigmoidf_(v[ni][0]), sigmoidf_(v[ni][1])); u.y = pk2(sigmoidf_(v[ni][2]), sigmoidf_(v[ni][3]));
                *(uint2*)(dst + 16 * ni + 4 * q) = u;
            }
        } else {
            float* dst = glow + (size_t)row * 32;
#pragma unroll
            for (int ni = 0; ni < 2; ++ni) *(f32x4*)(dst + 16 * ni + 4 * q) = v[ni];
        }
    }
};

struct EpiGate0 {
    bf16_t* mg;
    DI void operator()(int row, int cb, const f32x4 (&v)[4], int q) const {
#pragma unroll
        for (int ni = 0; ni < 4; ++ni) {
            const int col = cb + 16 * ni + 4 * q;
            const uint2 m = *(const uint2*)(mg + (size_t)row * 2048 + col);
            uint2 u; u.x = pk2(v[ni][0] * bflo(m.x), v[ni][1] * bfhi(m.x)); u.y = pk2(v[ni][2] * bflo(m.y), v[ni][3] * bfhi(m.y));
            *(uint2*)(mg + (size_t)row * 2048 + col) = u;
        }
    }
};
struct EpiGate1 {
    bf16_t* Y; const bf16_t* mg;
    DI void operator()(int row, int cb, const f32x4 (&v)[4], int q) const {
#pragma unroll
        for (int ni = 0; ni < 4; ++ni) {
            const int col = cb + 16 * ni + 4 * q;
            const uint2 m = *(const uint2*)(mg + (size_t)row * 2048 + 1024 + col);
            const uint2 pr = *(const uint2*)(mg + (size_t)row * 2048 + col);
            uint2 u; u.x = pk2(bflo(pr.x) + v[ni][0] * bflo(m.x), bfhi(pr.x) + v[ni][1] * bfhi(m.x));
            u.y = pk2(bflo(pr.y) + v[ni][2] * bflo(m.y), bfhi(pr.y) + v[ni][3] * bfhi(m.y));
            *(uint2*)(Y + (size_t)row * 1024 + col) = u;
        }
    }
};
template <int ACT>
struct EpiStore {
    bf16_t* O; int ldo;
    DI void operator()(int row, int cb, const f32x4 (&v)[4], int q) const {
#pragma unroll
        for (int ni = 0; ni < 4; ++ni) {
            float s[4];
#pragma unroll
            for (int j = 0; j < 4; ++j) { float xx = v[ni][j]; if (ACT == 1) { xx = fmaxf(xx, 0.f); xx = xx * xx; } s[j] = xx; }
            uint2 u; u.x = pk2(s[0], s[1]); u.y = pk2(s[2], s[3]);
            *(uint2*)(O + (size_t)row * ldo + cb + 16 * ni + 4 * q) = u;
        }
    }
};

DI float quad_max(float v) { v = fmaxf(v, __shfl_xor(v, 16)); v = fmaxf(v, __shfl_xor(v, 32)); return v; }
DI bf16x8 pack8(const f32x4& a, const f32x4& b) {
    typedef unsigned u32x4 __attribute__((ext_vector_type(4)));
    const u32x4 u = {pk2(a[0], a[1]), pk2(a[2], a[3]), pk2(b[0], b[1]), pk2(b[2], b[3])};
    return __builtin_bit_cast(bf16x8, u);
}

template <bool FAST>
DI void attn_kloop(char* smem, char* sdst, const bf16_t* gk0, const bf16_t* gk1, const bf16_t* gv, bool first, bool has_next, const bf16_t* ngk0, const bf16_t* ngk1, const bf16_t* ngv,
                   int comp, int krow0, int ksw, int l15, int qd, const bf16x8 (&qf)[2][2], f32x4 (&O)[2][8], float (&m)[2], float (&l)[2]) {
#define ATT_STAGE_P(pk0, pk1, pv, buf, kt_) do { _Pragma("unroll") for (int jj = 0; jj < 2; ++jj) { \
            GLDS16(pk0 + (size_t)((kt_) * 128 + 64 * jj) * 64, sdst + (buf) * 65536 + jj * 8192); \
            GLDS16(pk1 + (size_t)((kt_) * 128 + 64 * jj) * 64, sdst + (buf) * 65536 + 16384 + jj * 8192); } \
            _Pragma("unroll") for (int jj = 0; jj < 4; ++jj) GLDS16(pv + (size_t)(32 * jj) * TKV + (kt_) * 128, sdst + (buf) * 65536 + 32768 + jj * 8192); } while (0)
#define ATT_STAGE(buf, kt_) ATT_STAGE_P(gk0, gk1, gv, buf, kt_)
#define KFRAG(sub_, t_, kd_) (*(const bf16x8*)(skc + (32 * (sub_) + krow0 + 4 * (t_)) * 128 + (((4 * (kd_) + qd) ^ ksw) << 4)))
#define VFRAG(sub_, dt_) (*(const bf16x8*)(sb + 32768 + (16 * (dt_) + l15) * 256 + (((4 * (sub_) + qd) ^ l15) << 4)))
    if (first) {
        ATT_STAGE(0, 0);
        asm volatile("s_waitcnt vmcnt(0)" ::: "memory");
        __syncthreads();
    }
    f32x4 sinit[2], Ls[2];
#pragma unroll
    for (int qt = 0; qt < 2; ++qt) { const float v0 = FAST ? -m[qt] : 0.f; sinit[qt] = (f32x4){v0, v0, v0, v0}; Ls[qt] = (f32x4){0.f, 0.f, 0.f, 0.f}; }
    constexpr int NKT = TKV / 128;
    for (int kt = 0; kt < NKT; ++kt) {
        const int cur = kt & 1;
        if (kt + 1 < NKT) ATT_STAGE(cur ^ 1, kt + 1);
        else if (has_next) ATT_STAGE_P(ngk0, ngk1, ngv, cur ^ 1, 0);
        const char* sb = smem + cur * 65536;
        const char* skc = sb + comp * 16384;
        if (FAST) {
            bf16x8 kf[2][2];
#pragma unroll
            for (int t = 0; t < 2; ++t)
#pragma unroll
                for (int kd = 0; kd < 2; ++kd) kf[t][kd] = KFRAG(0, t, kd);
            f32x4 Sn[2][2];
#pragma unroll
            for (int qt = 0; qt < 2; ++qt)
#pragma unroll
                for (int t = 0; t < 2; ++t) { Sn[qt][t] = MFMA16(kf[t][0], qf[qt][0], sinit[qt]); Sn[qt][t] = MFMA16(kf[t][1], qf[qt][1], Sn[qt][t]); }
            const bf16x8 ones = {0x3F80, 0x3F80, 0x3F80, 0x3F80, 0x3F80, 0x3F80, 0x3F80, 0x3F80};
#pragma unroll
            for (int sub = 0; sub < 4; ++sub) {
                f32x4 Sc[2][2];
#pragma unroll
                for (int qt = 0; qt < 2; ++qt)
#pragma unroll
                    for (int t = 0; t < 2; ++t) Sc[qt][t] = Sn[qt][t];
                bf16x8 va[4], vb[4];
#pragma unroll
                for (int dt = 0; dt < 4; ++dt) va[dt] = VFRAG(sub, dt);
                if (sub < 3) {
#pragma unroll
                    for (int t = 0; t < 2; ++t)
#pragma unroll
                        for (int kd = 0; kd < 2; ++kd) kf[t][kd] = KFRAG(sub + 1, t, kd);
                }
                __builtin_amdgcn_sched_barrier(0);
                bf16x8 pb[2];
#pragma unroll
                for (int qt = 0; qt < 2; ++qt) {
                    f32x4 p0, p1;
#pragma unroll
                    for (int i = 0; i < 4; ++i) { p0[i] = __builtin_amdgcn_exp2f(Sc[qt][0][i]); p1[i] = __builtin_amdgcn_exp2f(Sc[qt][1][i]); }
                    pb[qt] = pack8(p0, p1);
                }
#pragma unroll
                for (int dt = 0; dt < 4; ++dt) vb[dt] = VFRAG(sub, 4 + dt);
                __builtin_amdgcn_sched_barrier(0);
#pragma unroll
                for (int dt = 0; dt < 4; ++dt) {
                    O[0][dt] = MFMA16(va[dt], pb[0], O[0][dt]);
                    O[1][dt] = MFMA16(va[dt], pb[1], O[1][dt]);
                    if (sub < 3) Sn[dt >> 1][dt & 1] = MFMA16(kf[dt & 1][0], qf[dt >> 1][0], sinit[dt >> 1]);
                }
#pragma unroll
                for (int dt = 0; dt < 4; ++dt) {
                    O[0][4 + dt] = MFMA16(vb[dt], pb[0], O[0][4 + dt]);
                    O[1][4 + dt] = MFMA16(vb[dt], pb[1], O[1][4 + dt]);
                    if (sub < 3) Sn[dt >> 1][dt & 1] = MFMA16(kf[dt & 1][1], qf[dt >> 1][1], Sn[dt >> 1][dt & 1]);
                }
                Ls[0] = MFMA16(ones, pb[0], Ls[0]);
                Ls[1] = MFMA16(ones, pb[1], Ls[1]);
            }
        } else {
#pragma unroll 1
            for (int sub = 0; sub < 4; ++sub) {
                f32x4 S[2][2];
#pragma unroll
                for (int qt = 0; qt < 2; ++qt)
#pragma unroll
                    for (int t = 0; t < 2; ++t) { S[qt][t] = MFMA16(KFRAG(sub, t, 0), qf[qt][0], sinit[qt]); S[qt][t] = MFMA16(KFRAG(sub, t, 1), qf[qt][1], S[qt][t]); }
                bf16x8 pb[2];
#pragma unroll
                for (int qt = 0; qt < 2; ++qt) {
                    float mt = fmaxf(fmaxf(fmaxf(S[qt][0][0], S[qt][0][1]), fmaxf(S[qt][0][2], S[qt][0][3])), fmaxf(fmaxf(S[qt][1][0], S[qt][1][1]), fmaxf(S[qt][1][2], S[qt][1][3])));
                    mt = quad_max(mt);
                    if (mt > m[qt]) {
                        const float al = __builtin_amdgcn_exp2f(m[qt] - mt);
                        l[qt] *= al;
#pragma unroll
                        for (int dt = 0; dt < 8; ++dt) O[qt][dt] *= al;
                        m[qt] = mt;
                    }
                    f32x4 p0, p1;
#pragma unroll
                    for (int i = 0; i < 4; ++i) { p0[i] = __builtin_amdgcn_exp2f(S[qt][0][i] - m[qt]); p1[i] = __builtin_amdgcn_exp2f(S[qt][1][i] - m[qt]); l[qt] += p0[i] + p1[i]; }
                    pb[qt] = pack8(p0, p1);
                }
#pragma unroll
                for (int dt = 0; dt < 8; ++dt) {
                    const bf16x8 vf = VFRAG(sub, dt);
                    O[0][dt] = MFMA16(vf, pb[0], O[0][dt]);
                    O[1][dt] = MFMA16(vf, pb[1], O[1][dt]);
                }
            }
        }
        asm volatile("s_waitcnt vmcnt(0)" ::: "memory");
        __syncthreads();
    }
#undef ATT_STAGE
#undef ATT_STAGE_P
#undef KFRAG
#undef VFRAG
    if (FAST) { l[0] = Ls[0][0]; l[1] = Ls[1][0]; }
    else { l[0] = quad_sum(l[0]); l[1] = quad_sum(l[1]); }
}

DI void phase_attn(const Params& p, char* smem) {
    const int tid = get_tid(), lane = tid & 63, w = tid >> 6, l15 = lane & 15, qd = lane >> 4;
    const int g = w >> 1, comp = w & 1;
    const bf16_t* Q = (const bf16_t*)(p.ws + R_Q);
    const bf16_t* Kk = (const bf16_t*)(p.ws + R_K);
    const bf16_t* Vt = (const bf16_t*)(p.ws + R_VT);
    const float* kmax = (const float*)(p.ws + OFF_KMAX);
    bf16_t* YDA = (bf16_t*)(p.ws + R_H);
    float d1 = 0.f, d2 = 0.f;
    for (int i = 0; i < 64; ++i) { d1 += p.lq1[i] * p.lk1[i]; d2 += p.lq2[i] * p.lk2[i]; }
    const float lam = __expf(d1) - __expf(d2) + 0.2f;
    const int krs = 8 * w + (lane >> 3), kcs = (lane & 7) ^ (((lane >> 4) & 1) | ((w & 3) << 1));
    const int vrs = 4 * w + (lane >> 4), vcs = (lane & 15) ^ ((4 * w + (lane >> 4)) & 15);
    const int krow0 = 8 * (l15 >> 2) + (l15 & 3);
    const int ksw = ((l15 >> 1) & 1) | (((l15 >> 2) & 3) << 1);
    float* xbuf = (float*)(smem + 65536) + g * 4096;
    char* sdst = smem + w * 1024;
    for (int id = blockIdx.x; id < 4096; id += gridDim.x) {
        const int x = id & 7, j = id >> 3, bh = (j >> 6) * 8 + x, qti = j & 63;
        const int b = bh >> 3, h = bh & 7;
        bf16x8 qf[2][2];
        float mb[2];
        const float kb = sqrtf(kmax[(bh * 2 + comp) * 2] + kmax[(bh * 2 + comp) * 2 + 1]);
#pragma unroll
        for (int qt = 0; qt < 2; ++qt) {
            const bf16_t* qp = Q + ((size_t)(bh * 2 + comp) * TLAT + qti * 128 + g * 32 + 16 * qt + l15) * 64 + qd * 8;
            qf[qt][0] = *(const bf16x8*)qp; qf[qt][1] = *(const bf16x8*)(qp + 32);
            float qn = 0.f;
#pragma unroll
            for (int kd = 0; kd < 2; ++kd)
#pragma unroll
                for (int e = 0; e < 8; ++e) { const float qv = __uint_as_float(((unsigned)(unsigned short)qf[qt][kd][e]) << 16); qn += qv * qv; }
            qn = quad_sum(qn);
            mb[qt] = sqrtf(qn) * kb * 1.01f + 1e-3f;
        }
        const bf16_t* gk0 = Kk + ((size_t)(bh * 2 + 0) * TKV + krs) * 64 + kcs * 8;
        const bf16_t* gk1 = gk0 + (size_t)TKV * 64;
        const bf16_t* gv = Vt + ((size_t)bh * 128 + vrs) * TKV + vcs * 8;
        const bool first = id == (int)blockIdx.x, has_next = id + (int)gridDim.x < 4096;
        const int nid = has_next ? id + gridDim.x : id, nbh = ((nid >> 3) >> 6) * 8 + (nid & 7);
        const bf16_t* ngk0 = Kk + ((size_t)(nbh * 2 + 0) * TKV + krs) * 64 + kcs * 8;
        const bf16_t* ngk1 = ngk0 + (size_t)TKV * 64;
        const bf16_t* ngv = Vt + ((size_t)nbh * 128 + vrs) * TKV + vcs * 8;
        f32x4 O[2][8];
#pragma unroll
        for (int qt = 0; qt < 2; ++qt)
#pragma unroll
            for (int d = 0; d < 8; ++d) O[qt][d] = (f32x4){0.f, 0.f, 0.f, 0.f};
        float m[2], l[2] = {0.f, 0.f};
        const int slow = __syncthreads_or(!(mb[0] <= 60.0f && mb[1] <= 60.0f));
        if (!slow) { m[0] = mb[0]; m[1] = mb[1]; attn_kloop<true>(smem, sdst, gk0, gk1, gv, first, has_next, ngk0, ngk1, ngv, comp, krow0, ksw, l15, qd, qf, O, m, l); }
        else { m[0] = -INFINITY; m[1] = -INFINITY; attn_kloop<false>(smem, sdst, gk0, gk1, gv, first, has_next, ngk0, ngk1, ngv, comp, krow0, ksw, l15, qd, qf, O, m, l); }
        if (comp == 1) {
#pragma unroll
            for (int qt = 0; qt < 2; ++qt) {
                const float i1 = lam / l[qt];
#pragma unroll
                for (int d = 0; d < 8; ++d)
#pragma unroll
                    for (int i = 0; i < 4; ++i) xbuf[((qt * 8 + d) * 4 + i) * 64 + lane] = O[qt][d][i] * i1;
            }
        }
        __syncthreads();
        if (comp == 0) {
#pragma unroll
            for (int qt = 0; qt < 2; ++qt) {
                const float i0 = 1.0f / l[qt];
                float ss = 0.f;
#pragma unroll
                for (int d = 0; d < 8; ++d)
#pragma unroll
                    for (int i = 0; i < 4; ++i) { const float o = O[qt][d][i] * i0 - xbuf[((qt * 8 + d) * 4 + i) * 64 + lane]; O[qt][d][i] = o; ss += o * o; }
                ss = quad_sum(ss);
                const float rs = rsqrtf(ss * (1.0f / 128.0f) + EPS) * 0.8f;
                const int t = qti * 128 + g * 32 + 16 * qt + l15;
                bf16_t* dst = YDA + ((size_t)b * TLAT + t) * 1024 + h * 128;
#pragma unroll
                for (int d = 0; d < 8; ++d) {
                    const int dv = 16 * d + 4 * qd;
                    const f32x4 hn = *(const f32x4*)(p.da_hn + dv);
                    uint2 u; u.x = pk2(O[qt][d][0] * rs * hn.x, O[qt][d][1] * rs * hn.y); u.y = pk2(O[qt][d][2] * rs * hn.z, O[qt][d][3] * rs * hn.w);
                    *(uint2*)(dst + dv) = u;
                }
            }
        }
    }
}

DI void phase_gate(const Params& p, char* smem) {
    const int tid = get_tid();
    const float* glow = (const float*)(p.ws + OFF_GLOW);
    float* sg = (float*)smem;
    float wf[16], wb[16];
#pragma unroll
    for (int r = 0; r < 16; ++r) { wf[r] = p.w_gate_up[(size_t)r * 512 + tid]; wb[r] = p.w_gate_up[(size_t)(16 + r) * 512 + tid]; }
    const float biasf = p.b_gate_up[tid], biasb = p.b_gate_up[512 + tid];
    _Float16* BF = (_Float16*)(p.ws + R_BF);
    _Float16* BB = (_Float16*)(p.ws + R_BB);
    for (int ch = blockIdx.x; ch < 1056; ch += gridDim.x) {
        __syncthreads();
        *(f32x4*)(sg + tid * 4) = *(const f32x4*)(glow + (size_t)ch * 2048 + tid * 4);
        __syncthreads();
        float run = 0.f;
#pragma unroll 4
        for (int i = 0; i < 64; ++i) {
            const float* gl = sg + i * 32;
            float a = biasf;
#pragma unroll
            for (int r = 0; r < 16; ++r) a = fmaf(gl[r], wf[r], a);
            const float ls = fminf(a, 0.f) - __logf(1.0f + __expf(-fabsf(a)));
            run += ls * (1.4426950408889634f / 16.0f);
            BF[(size_t)(ch * 64 + i) * 512 + tid] = (_Float16)run;
        }
        run = 0.f;
#pragma unroll 4
        for (int i = 63; i >= 0; --i) {
            const float* gl = sg + i * 32 + 16;
            float a = biasb;
#pragma unroll
            for (int r = 0; r < 16; ++r) a = fmaf(gl[r], wb[r], a);
            const float ls = fminf(a, 0.f) - __logf(1.0f + __expf(-fabsf(a)));
            run += ls * (1.4426950408889634f / 16.0f);
            BB[(size_t)(ch * 64 + i) * 512 + tid] = (_Float16)run;
        }
    }
}

struct GlaRegs { uint2 k[2][2], q[2][2], bb[2][2], bl[2][2]; uint4 v[2]; };

DI void phase_gla(const Params& p, char* smem, int unit) {
    const int tid = get_tid(), lane = tid & 63, w = tid >> 6, l31 = lane & 31, hh = lane >> 5;
    const int dir = unit & 1, dvh = (unit >> 1) & 1, bh = unit >> 2, b = bh >> 2, h = bh & 3;
    const bf16_t* gq = (const bf16_t*)(p.ws + R_GQ);
    const bf16_t* gk = (const bf16_t*)(p.ws + R_GK);
    const bf16_t* gvT = (const bf16_t*)(p.ws + R_GVT) + (size_t)(bh * 256 + dvh * 128) * TKV;
    const _Float16* B16 = (const _Float16*)(p.ws + (dir ? R_BB : R_BF));
    bf16_t* Oo = (bf16_t*)(p.ws + (dir ? R_OB : R_OF));
    char* sQt = smem;
    char* sKt = smem + 16384;
    char* sKh = smem + 32768;
    char* sVT = smem + 49152;
    char* sA = smem + 81920;
    float* sD = (float*)(smem + 90112);
    f32x16 S[4];
#pragma unroll
    for (int k = 0; k < 4; ++k)
#pragma unroll
        for (int e = 0; e < 16; ++e) S[k][e] = 0.f;
    const int sw = (l31 >> 1) & 7;
    GlaRegs R;
    auto chunk_info = [&](int step, int& rowbase, int& tcol, bool& emit) {
        if (step < 4) { const int cc = dir ? 3 - step : step; rowbase = NLAT + b * 256 + cc * 64; tcol = TLAT + cc * 64; emit = false; }
        else { const int cc = dir ? 127 - (step - 4) : step - 4; rowbase = b * TLAT + cc * 64; tcol = cc * 64; emit = true; }
    };
    auto load_chunk = [&](int step) {
        int rowbase, tcol; bool emit; chunk_info(step, rowbase, tcol, emit);
        const int rl = rowbase + (dir ? 0 : 63);
#pragma unroll
        for (int i = 0; i < 2; ++i) {
            const int item = tid + NT * i, tok = item >> 4, c = item & 15, d0 = 16 * (c >> 1) + 4 * (c & 1);
            const size_t ro = (size_t)(rowbase + tok) * 512 + h * 128 + d0;
            R.k[i][0] = *(const uint2*)(gk + ro); R.k[i][1] = *(const uint2*)(gk + ro + 8);
            if (emit) { R.q[i][0] = *(const uint2*)(gq + ro); R.q[i][1] = *(const uint2*)(gq + ro + 8); }
            else { R.q[i][0] = make_uint2(0, 0); R.q[i][1] = make_uint2(0, 0); }
            R.bb[i][0] = *(const uint2*)(B16 + ro); R.bb[i][1] = *(const uint2*)(B16 + ro + 8);
            const size_t rlo = (size_t)rl * 512 + h * 128 + d0;
            R.bl[i][0] = *(const uint2*)(B16 + rlo); R.bl[i][1] = *(const uint2*)(B16 + rlo + 8);
        }
#pragma unroll
        for (int i = 0; i < 2; ++i) R.v[i] = *(const uint4*)(gvT + (size_t)((tid >> 3) + 64 * i) * TKV + tcol + (tid & 7) * 8);
    };
    auto stage_chunk = [&]() {
#pragma unroll
        for (int i = 0; i < 2; ++i) {
            const int item = tid + NT * i, tok = item >> 4, c = item & 15, d0 = 16 * (c >> 1) + 4 * (c & 1);
            float qo[8], ko[8];
#pragma unroll
            for (int g = 0; g < 2; ++g) {
                const h4_t bv = __builtin_bit_cast(h4_t, R.bb[i][g]), lv = __builtin_bit_cast(h4_t, R.bl[i][g]);
                const float kk[4] = {bflo(R.k[i][g].x), bfhi(R.k[i][g].x), bflo(R.k[i][g].y), bfhi(R.k[i][g].y)};
                const float qq[4] = {bflo(R.q[i][g].x), bfhi(R.q[i][g].x), bflo(R.q[i][g].y), bfhi(R.q[i][g].y)};
#pragma unroll
                for (int j = 0; j < 4; ++j) {
                    const float bb = (float)bv[j], bl = (float)lv[j];
                    qo[4 * g + j] = qq[j] * __builtin_amdgcn_exp2f(bb);
                    ko[4 * g + j] = kk[j] * __builtin_amdgcn_exp2f(-bb);
                    const float kh = kk[j] * __builtin_amdgcn_exp2f(bl - bb);
                    const int dk = d0 + 8 * g + j;
                    *(bf16_t*)(sKh + dk * 128 + ((((tok >> 3) ^ ((dk >> 1) & 7))) << 4) + (tok & 7) * 2) = bf1(kh);
                }
            }
            const int po = tok * 256 + ((c ^ (tok & 15)) << 4);
            uint4 uq, uk;
            uq.x = pk2(qo[0], qo[1]); uq.y = pk2(qo[2], qo[3]); uq.z = pk2(qo[4], qo[5]); uq.w = pk2(qo[6], qo[7]);
            uk.x = pk2(ko[0], ko[1]); uk.y = pk2(ko[2], ko[3]); uk.z = pk2(ko[4], ko[5]); uk.w = pk2(ko[6], ko[7]);
            *(uint4*)(sQt + po) = uq; *(uint4*)(sKt + po) = uk;
        }
#pragma unroll
        for (int i = 0; i < 2; ++i) {
            const int row = (tid >> 3) + 64 * i, scn = tid & 7;
            *(uint4*)(sVT + row * 128 + ((scn ^ ((row >> 1) & 7)) << 4)) = R.v[i];
        }
        if (tid < 16) {
            const int d0 = 16 * (tid >> 1) + 4 * (tid & 1);
#pragma unroll
            for (int g = 0; g < 2; ++g) {
                const h4_t lv = __builtin_bit_cast(h4_t, R.bl[0][g]);
#pragma unroll
                for (int j = 0; j < 4; ++j) sD[d0 + 8 * g + j] = __builtin_amdgcn_exp2f((float)lv[j]);
            }
        }
    };
    load_chunk(0);
    for (int step = 0; step < 132; ++step) {
        int rowbase, tcol; bool emit; chunk_info(step, rowbase, tcol, emit);
        stage_chunk();
        __syncthreads();
        if (step + 1 < 132) load_chunk(step + 1);
        const int dvb = 32 * (w & 3);
        f32x16 o[2];
        if (emit) {
            if (w >= 4) {
                const int ti = (w - 4) >> 1, tj = (w - 4) & 1;
                f32x16 a;
#pragma unroll
                for (int e = 0; e < 16; ++e) a[e] = 0.f;
                const bool dead = dir ? (tj < ti) : (tj > ti);
                if (!dead) {
#pragma unroll
                    for (int ks = 0; ks < 8; ++ks) {
                        const int ri = 32 * ti + l31, rj = 32 * tj + l31, c = 2 * ks + hh;
                        const bf16x8 af = *(const bf16x8*)(sQt + ri * 256 + ((c ^ (ri & 15)) << 4));
                        const bf16x8 bf = *(const bf16x8*)(sKt + rj * 256 + ((c ^ (rj & 15)) << 4));
                        a = MFMA32(af, bf, a);
                    }
                }
                const int jj = 32 * tj + l31;
#pragma unroll
                for (int e = 0; e < 16; ++e) {
                    const int ii = 32 * ti + (e & 3) + 8 * (e >> 2) + 4 * hh;
                    const bool keep = dir ? (jj >= ii) : (jj <= ii);
                    *(bf16_t*)(sA + ii * 128 + ((((jj >> 3) ^ ((ii >> 1) & 7))) << 4) + (jj & 7) * 2) = bf1(keep ? a[e] : 0.f);
                }
            } else {
#pragma unroll
            for (int mt = 0; mt < 2; ++mt)
#pragma unroll
                for (int e = 0; e < 16; ++e) o[mt][e] = 0.f;
#pragma unroll
            for (int kt = 0; kt < 4; ++kt)
#pragma unroll
                for (int s = 0; s < 2; ++s) {
                    typedef unsigned u32x4 __attribute__((ext_vector_type(4)));
                    u32x4 pu = {pk2(S[kt][8 * s], S[kt][8 * s + 1]), pk2(S[kt][8 * s + 2], S[kt][8 * s + 3]), pk2(S[kt][8 * s + 4], S[kt][8 * s + 5]), pk2(S[kt][8 * s + 6], S[kt][8 * s + 7])};
                    const bf16x8 sf = __builtin_bit_cast(bf16x8, pu);
#pragma unroll
                    for (int mt = 0; mt < 2; ++mt) {
                        const int ri = 32 * mt + l31, c = 4 * kt + 2 * s + hh;
                        const bf16x8 af = *(const bf16x8*)(sQt + ri * 256 + ((c ^ (ri & 15)) << 4));
                        o[mt] = MFMA32(af, sf, o[mt]);
                    }
                }
            }
            __syncthreads();
            if (w < 4) {
#pragma unroll
            for (int s2 = 0; s2 < 4; ++s2) {
                const int c = 2 * s2 + hh;
                const bf16x8 vf = *(const bf16x8*)(sVT + (dvb + l31) * 128 + ((c ^ sw) << 4));
#pragma unroll
                for (int mt = 0; mt < 2; ++mt) {
                    const bf16x8 af = *(const bf16x8*)(sA + (32 * mt + l31) * 128 + ((c ^ sw) << 4));
                    o[mt] = MFMA32(af, vf, o[mt]);
                }
            }
            bf16_t* od = Oo + (size_t)rowbase * 1024 + h * 256 + dvh * 128 + dvb + l31;
#pragma unroll
            for (int mt = 0; mt < 2; ++mt)
#pragma unroll
                for (int e = 0; e < 16; ++e) od[(size_t)(32 * mt + (e & 3) + 8 * (e >> 2) + 4 * hh) * 1024] = bf1(o[mt][e]);
            }
        }
        if (w < 4) {
#pragma unroll
        for (int kt = 0; kt < 4; ++kt)
#pragma unroll
            for (int g4 = 0; g4 < 4; ++g4) {
                const f32x4 dd = *(const f32x4*)(sD + 32 * kt + 8 * g4 + 4 * hh);
#pragma unroll
                for (int jq = 0; jq < 4; ++jq) S[kt][4 * g4 + jq] *= dd[jq];
            }
#pragma unroll
        for (int s2 = 0; s2 < 4; ++s2) {
            const int c = 2 * s2 + hh;
            const bf16x8 vf = *(const bf16x8*)(sVT + (dvb + l31) * 128 + ((c ^ sw) << 4));
#pragma unroll
            for (int kt = 0; kt < 4; ++kt) {
                const bf16x8 af = *(const bf16x8*)(sKh + (32 * kt + l31) * 128 + ((c ^ sw) << 4));
                S[kt] = MFMA32(af, vf, S[kt]);
            }
        }
        }
        __syncthreads();
    }
}

DI void phase_combine(const Params& p, int panel) {
    const int tid = get_tid(), lane = tid & 63, w = tid >> 6;
    const bf16_t* OF = (const bf16_t*)(p.ws + R_OF);
    const bf16_t* OB = (const bf16_t*)(p.ws + R_OB);
    const bf16_t* SG = (const bf16_t*)(p.ws + R_SG);
    bf16_t* Y = (bf16_t*)(p.ws + R_YGLA);
    for (int row2 = panel * 256 + w; row2 < panel * 256 + 256; row2 += 16)
#pragma unroll
    for (int rr = 0; rr < 2; ++rr) {
        const int row = row2 + 8 * rr;
        const size_t o = (size_t)row * 1024 + lane * 16;
        const uint4 a0 = *(const uint4*)(OF + o), a1 = *(const uint4*)(OF + o + 8);
        const uint4 b0 = *(const uint4*)(OB + o), b1 = *(const uint4*)(OB + o + 8);
        const uint4 g0 = *(const uint4*)(SG + o), g1 = *(const uint4*)(SG + o + 8);
        const unsigned au[8] = {a0.x, a0.y, a0.z, a0.w, a1.x, a1.y, a1.z, a1.w};
        const unsigned bu[8] = {b0.x, b0.y, b0.z, b0.w, b1.x, b1.y, b1.z, b1.w};
        const unsigned gu[8] = {g0.x, g0.y, g0.z, g0.w, g1.x, g1.y, g1.z, g1.w};
        float v[16]; float ss = 0.f;
#pragma unroll
        for (int e = 0; e < 8; ++e) { v[2 * e] = bflo(au[e]) + bflo(bu[e]); v[2 * e + 1] = bfhi(au[e]) + bfhi(bu[e]); ss += v[2 * e] * v[2 * e] + v[2 * e + 1] * v[2 * e + 1]; }
#pragma unroll
        for (int of = 8; of >= 1; of >>= 1) ss += __shfl_xor(ss, of);
        const float rs = rsqrtf(ss * (1.0f / 256.0f) + EPS);
        const float* gn = p.gla_hn + ((lane * 16) & 255);
        unsigned ou[8];
#pragma unroll
        for (int e = 0; e < 8; ++e) ou[e] = pk2(v[2 * e] * rs * gn[2 * e] * bflo(gu[e]), v[2 * e + 1] * rs * gn[2 * e + 1] * bfhi(gu[e]));
        *(uint4*)(Y + o) = make_uint4(ou[0], ou[1], ou[2], ou[3]);
        *(uint4*)(Y + o + 8) = make_uint4(ou[4], ou[5], ou[6], ou[7]);
    }
}

template <int MODE>
DI void phase_rows(const Params& p, char* smem, int panel) {
    float* md = (float*)smem;
    const int tid = get_tid(), lane = tid & 63, w = tid >> 6;
    const bf16_t* Yin = (const bf16_t*)(p.ws + (MODE == 0 ? R_Y2 : R_Y3));
    bf16_t* H2 = (bf16_t*)(p.ws + R_H2);
    const float* pn = MODE == 0 ? p.post_norm1 : p.post_norm2;
    const float* xsrc = MODE == 0 ? p.x : (const float*)p.out;
    const int r = panel >> 5;
    __syncthreads();
    if (MODE == 0) { load_mod(p, r, 2, md); load_mod(p, r, 3, md + 1024); load_mod(p, r, 4, md + 2048); }
    else load_mod(p, r, 5, md);
    __syncthreads();
    for (int i = 0; i < 16; ++i) {
        const int rows[2] = {panel * 256 + w * 32 + i, panel * 256 + w * 32 + 16 + i};
        uint2 yu[2][4]; f32x4 xv[2][4];
#pragma unroll
        for (int q = 0; q < 2; ++q)
#pragma unroll
            for (int j = 0; j < 4; ++j) {
                yu[q][j] = *(const uint2*)(Yin + (size_t)rows[q] * 1024 + lane * 4 + 256 * j);
                xv[q][j] = *(const f32x4*)(xsrc + (size_t)rows[q] * 1024 + lane * 4 + 256 * j);
            }
        float y[2][16], ss[2] = {0.f, 0.f};
#pragma unroll
        for (int q = 0; q < 2; ++q)
#pragma unroll
            for (int j = 0; j < 4; ++j) {
                y[q][4 * j] = bflo(yu[q][j].x); y[q][4 * j + 1] = bfhi(yu[q][j].x); y[q][4 * j + 2] = bflo(yu[q][j].y); y[q][4 * j + 3] = bfhi(yu[q][j].y);
#pragma unroll
                for (int e = 0; e < 4; ++e) ss[q] += y[q][4 * j + e] * y[q][4 * j + e];
            }
        ss[0] = wave_sum(ss[0]); ss[1] = wave_sum(ss[1]);
        float xn[2][16], s2[2] = {0.f, 0.f};
#pragma unroll
        for (int q = 0; q < 2; ++q) {
            const float rs = rsqrtf(ss[q] * (1.0f / 1024.0f) + EPS);
#pragma unroll
            for (int j = 0; j < 4; ++j) {
                const int col = lane * 4 + 256 * j;
                const f32x4 g = *(const f32x4*)(pn + col), gt = *(const f32x4*)(md + col);
#pragma unroll
                for (int e = 0; e < 4; ++e) { xn[q][4 * j + e] = xv[q][j][e] + gt[e] * (y[q][4 * j + e] * rs * g[e]); s2[q] += xn[q][4 * j + e] * xn[q][4 * j + e]; }
                f32x4 ov = {xn[q][4 * j], xn[q][4 * j + 1], xn[q][4 * j + 2], xn[q][4 * j + 3]};
                *(f32x4*)(p.out + (size_t)rows[q] * 1024 + col) = ov;
            }
        }
        if (MODE == 0) {
            s2[0] = wave_sum(s2[0]); s2[1] = wave_sum(s2[1]);
#pragma unroll
            for (int q = 0; q < 2; ++q) {
                const float rs2 = rsqrtf(s2[q] * (1.0f / 1024.0f) + EPS);
#pragma unroll
                for (int j = 0; j < 4; ++j) {
                    const int col = lane * 4 + 256 * j;
                    const f32x4 g = *(const f32x4*)(p.pre_norm2 + col), sh = *(const f32x4*)(md + 1024 + col), sc = *(const f32x4*)(md + 2048 + col);
                    float o[4];
#pragma unroll
                    for (int e = 0; e < 4; ++e) o[e] = xn[q][4 * j + e] * rs2 * g[e] * (1.f + sc[e]) + sh[e];
                    uint2 u; u.x = pk2(o[0], o[1]); u.y = pk2(o[2], o[3]);
                    *(uint2*)(H2 + (size_t)rows[q] * 1024 + col) = u;
                }
            }
        }
    }
}

DI void gsync(unsigned* bar, unsigned k) {
    __syncthreads();
    const unsigned epoch = k * gridDim.x;
    if (threadIdx.x == 0) {
        __threadfence();
        atomicAdd(bar, 1u);
        while (__hip_atomic_load(bar, __ATOMIC_RELAXED, __HIP_MEMORY_SCOPE_AGENT) < epoch) __builtin_amdgcn_s_sleep(1);
        __threadfence();
    }
    __syncthreads();
}

__global__ void __launch_bounds__(NT) fwd_megakernel(Params p) {
    __shared__ __attribute__((aligned(16))) char smem[131072];
    cg::grid_group grid = cg::this_grid();
    char* ws = p.ws;
    unsigned* bar = (unsigned*)(ws + OFF_BAR);
    phase_prep(p, smem);
    grid.sync();
    phase_h(p, smem);
    gsync(bar, 1u);
    {
        EpiIn e; e.Q = (bf16_t*)(ws + R_Q); e.Kk = (bf16_t*)(ws + R_K); e.Vt = (bf16_t*)(ws + R_VT); e.gq = (bf16_t*)(ws + R_GQ); e.gk = (bf16_t*)(ws + R_GK);
        e.gvT = (bf16_t*)(ws + R_GVT); e.sg = (bf16_t*)(ws + R_SG); e.mg = (bf16_t*)p.out; e.glow = (float*)(ws + OFF_GLOW); e.rope = (const float*)(ws + OFF_ROPE); e.kmax = (float*)(ws + OFF_KMAX);
        gemm_phase_ex<true>((const bf16_t*)(ws + R_H), 1024, (const bf16_t*)(ws + OFF_WIN), 1024, 1024, 264, 33, smem, e, blockIdx.x, gridDim.x);
    }
    gsync(bar, 2u);
    phase_attn(p, smem);
    gsync(bar, 3u);
    phase_gate(p, smem);
    gsync(bar, 4u);
    const bool split = gridDim.x >= 192;
    const int nscan = split ? 128 : (int)gridDim.x, oth0 = split ? 128 : 0, noth = (int)gridDim.x - oth0;
    if ((int)blockIdx.x < nscan) { for (int unit = blockIdx.x; unit < 128; unit += nscan) { __syncthreads(); phase_gla(p, smem, unit); } }
    if ((int)blockIdx.x >= oth0) {
        EpiGate0 e0; e0.mg = (bf16_t*)p.out;
        gemm_phase_ex<false>((const bf16_t*)(ws + R_H), 1024, (const bf16_t*)(ws + OFF_WDA), 1024, 1024, 256, 4, smem, e0, blockIdx.x - oth0, noth);
        const long gsz2 = (long)noth * NT, gtid2 = (long)(blockIdx.x - oth0) * NT + get_tid();
        repack<0>(p.w_bgla, 1024, 1024, (bf16_t*)(ws + OFF_WGLA), 1024, gtid2, gsz2);
        repack<0>(p.w_out, 1024, 1024, (bf16_t*)(ws + OFF_WOUT), 1024, gtid2, gsz2);
        repack<0>(p.w_ff1, 1024, 4096, (bf16_t*)(ws + OFF_WFF1), 4096, gtid2, gsz2);
        repack<0>(p.w_ff2, 4096, 1024, (bf16_t*)(ws + OFF_WFF2), 1024, gtid2, gsz2);
    }
    gsync(bar, 5u);
    for (int panel = blockIdx.x; panel < 256; panel += gridDim.x) phase_combine(p, panel);
    gsync(bar, 6u);
    { EpiGate1 e1; e1.Y = (bf16_t*)(ws + R_Y); e1.mg = (const bf16_t*)p.out;
      gemm_phase((const bf16_t*)(ws + R_YGLA), 1024, (const bf16_t*)(ws + OFF_WGLA), 1024, 1024, 256, 4, smem, e1); }
    gsync(bar, 7u);
    { EpiStore<0> e; e.O = (bf16_t*)(ws + R_Y2); e.ldo = 1024;
      gemm_phase((const bf16_t*)(ws + R_Y), 1024, (const bf16_t*)(ws + OFF_WOUT), 1024, 1024, 256, 4, smem, e); }
    gsync(bar, 8u);
    for (int panel = blockIdx.x; panel < 256; panel += gridDim.x) phase_rows<0>(p, smem, panel);
    gsync(bar, 9u);
    { EpiStore<1> e; e.O = (bf16_t*)(ws + R_U); e.ldo = 4096;
      gemm_phase((const bf16_t*)(ws + R_H2), 1024, (const bf16_t*)(ws + OFF_WFF1), 1024, 1024, 256, 16, smem, e); }
    gsync(bar, 10u);
    { EpiStore<0> e; e.O = (bf16_t*)(ws + R_Y3); e.ldo = 1024;
      gemm_phase((const bf16_t*)(ws + R_U), 4096, (const bf16_t*)(ws + OFF_WFF2), 4096, 4096, 256, 4, smem, e); }
    gsync(bar, 11u);
    for (int panel = blockIdx.x; panel < 256; panel += gridDim.x) phase_rows<1>(p, smem, panel);
}

extern "C" void kernel_launch(void* const* d_in, const int* in_sizes, int n_in, void* d_out, int out_size, void* d_ws, size_t ws_size, hipStream_t stream) {
    static int grid_blocks = 0;
    if (!grid_blocks) {
        int dev = 0, cus = 0, per_cu = 0;
        hipGetDevice(&dev);
        hipDeviceGetAttribute(&cus, hipDeviceAttributeMultiprocessorCount, dev);
        hipOccupancyMaxActiveBlocksPerMultiprocessor(&per_cu, fwd_megakernel, NT, 0);
        if (per_cu < 1) per_cu = 1;
        grid_blocks = cus * per_cu;
        if (grid_blocks > 256) grid_blocks = 256;
    }
    Params p{};
    const float* const* in = (const float* const*)d_in;
    p.x = in[0]; p.c = in[1]; p.ctx = in[2]; p.c_ctx = in[3]; p.w_mod = in[4]; p.b_mod = in[5]; p.pre_norm1 = in[6]; p.w_in = in[7];
    p.w_gate_up = in[8]; p.b_gate_up = in[9]; p.lq1 = in[10]; p.lk1 = in[11]; p.lq2 = in[12]; p.lk2 = in[13]; p.da_hn = in[14]; p.gla_hn = in[15];
    p.w_bda = in[16]; p.w_bgla = in[17]; p.w_out = in[18]; p.post_norm1 = in[19]; p.pre_norm2 = in[20]; p.w_ff1 = in[21]; p.w_ff2 = in[22]; p.post_norm2 = in[23];
    p.out = (float*)d_out; p.ws = (char*)d_ws;
    hipMemsetAsync((char*)d_ws + OFF_BAR, 0, 256, stream);
    void* args[] = {&p};
    hipError_t e = hipLaunchCooperativeKernel((void*)fwd_megakernel, dim3(grid_blocks), dim3(NT), args, 0, stream);
    if (e != hipSuccess) fprintf(stderr, "cooperative launch failed: %s (grid %d)\n", hipGetErrorString(e), grid_blocks);
}
```

```cpp
#include <hip/hip_runtime.h>
#include <hip/hip_cooperative_groups.h>
#include <cstdio>
namespace cg = cooperative_groups;

typedef unsigned short bf16_t;
typedef short bf16x8 __attribute__((ext_vector_type(8)));
typedef float f32x16 __attribute__((ext_vector_type(16)));
typedef float f32x4 __attribute__((ext_vector_type(4)));
typedef float f32x2 __attribute__((ext_vector_type(2)));
typedef __bf16 bf2_t __attribute__((ext_vector_type(2)));
typedef _Float16 h4_t __attribute__((ext_vector_type(4)));

#define DI __device__ __forceinline__
#define MFMA32(a, b, c) __builtin_amdgcn_mfma_f32_32x32x16_bf16((a), (b), (c), 0, 0, 0)

constexpr int NT = 512;
constexpr int TLAT = 8192, NB = 8, NLAT = 65536, NROW = 67584, TKV = 8448;
constexpr float EPS = 1e-6f;
constexpr size_t MiB = 1048576;
constexpr size_t OFF_WIN = 0;
constexpr size_t OFF_WDA = OFF_WIN + 8448ull * 1024 * 2;
constexpr size_t OFF_WGLA = OFF_WDA + 2 * MiB;
constexpr size_t OFF_WOUT = OFF_WGLA + 2 * MiB;
constexpr size_t OFF_WFF1 = OFF_WOUT + 2 * MiB;
constexpr size_t OFF_WFF2 = OFF_WFF1 + 8 * MiB;
constexpr size_t OFF_MODP = OFF_WFF2 + 8 * MiB;
constexpr size_t OFF_ROPE = OFF_MODP + 16ull * 9 * 6144 * 4;
constexpr size_t OFF_GLOW = OFF_ROPE + 16384;
constexpr size_t OFF_KMAX = OFF_GLOW + 67584ull * 32 * 4;
constexpr size_t OFF_BAR = OFF_KMAX + 1024;
constexpr size_t R_H = 64 * MiB;
constexpr size_t R_Q = R_H + 132 * MiB;
constexpr size_t R_K = R_Q + 128 * MiB;
constexpr size_t R_VT = R_K + 132 * MiB;
constexpr size_t R_GQ = R_VT + 132 * MiB;
constexpr size_t R_GK = R_GQ + 64 * MiB;
constexpr size_t R_GVT = R_GK + 66 * MiB;
constexpr size_t R_SG = R_GVT + 132 * MiB;
constexpr size_t WS_END = R_SG + 128 * MiB;
static_assert(OFF_BAR + 1024 <= R_H, "small region overflow");
static_assert(WS_END <= 1024 * MiB, "workspace overflow");
constexpr size_t R_BF = R_Q;
constexpr size_t R_BB = R_Q + 66 * MiB;
constexpr size_t R_OF = R_K + 4 * MiB;
constexpr size_t R_OB = R_VT;
constexpr size_t R_YGLA = R_SG;
constexpr size_t R_Y = R_GVT;
constexpr size_t R_Y2 = R_SG;
constexpr size_t R_H2 = R_H;
constexpr size_t R_U = R_Q;
constexpr size_t R_Y3 = R_GVT;

struct Params {
    const float *x, *c, *ctx, *c_ctx, *w_mod, *b_mod, *pre_norm1, *w_in, *w_gate_up, *b_gate_up;
    const float *lq1, *lk1, *lq2, *lk2, *da_hn, *gla_hn, *w_bda, *w_bgla, *w_out, *post_norm1, *pre_norm2, *w_ff1, *w_ff2, *post_norm2;
    float* out;
    char* ws;
};

DI unsigned pk2(float a, float b) { f32x2 v = {a, b}; bf2_t r = __builtin_convertvector(v, bf2_t); return __builtin_bit_cast(unsigned, r); }
DI bf16_t bf1(float a) { __bf16 r = (__bf16)a; return __builtin_bit_cast(unsigned short, r); }
DI float bflo(unsigned v) { return __uint_as_float(v << 16); }
DI float bfhi(unsigned v) { return __uint_as_float(v & 0xffff0000u); }
DI float wave_sum(float v) {
#pragma unroll
    for (int o = 32; o >= 1; o >>= 1) v += __shfl_xor(v, o);
    return v;
}
DI int get_tid() { int t = threadIdx.x; asm volatile("" : "+v"(t)); return t; }
DI float sigmoidf_(float x) { return __builtin_amdgcn_rcpf(1.0f + __expf(-x)); }

template <int MODE>
DI void repack(const float* __restrict__ src, int K, int Nsrc, bf16_t* __restrict__ dst, int Nd, long gtid, long gsz) {
    const long total = (long)Nd * (K / 8);
    for (long it = gtid; it < total; it += gsz) {
        const int n = (int)(it % Nd), kc = (int)(it / Nd);
        int col = n; bool valid = true;
        if (MODE == 1) { if (n < 5120) col = n; else if (n < 8192) col = n + 32; else if (n < 8224) col = n - 8192 + 5120; else valid = false; }
        float v[8];
#pragma unroll
        for (int j = 0; j < 8; ++j) v[j] = valid ? src[(size_t)(kc * 8 + j) * Nsrc + col] : 0.f;
        uint4 o; o.x = pk2(v[0], v[1]); o.y = pk2(v[2], v[3]); o.z = pk2(v[4], v[5]); o.w = pk2(v[6], v[7]);
        *(uint4*)(dst + (size_t)n * K + kc * 8) = o;
    }
}

DI void sincos_acc(float a, float& s, float& c) {
    const float q = rintf(a * 0.63661977236758134f);
    float r = fmaf(-q, 1.5703125f, a); r = fmaf(-q, 4.837512969970703125e-4f, r); r = fmaf(-q, 7.54978995489188216e-8f, r);
    const float r2 = r * r;
    const float sp = r + r * r2 * (-1.6666666666e-1f + r2 * (8.3333333333e-3f + r2 * (-1.98412698e-4f + r2 * 2.7557319e-6f)));
    const float cp = 1.0f + r2 * (-0.5f + r2 * (4.16666666667e-2f + r2 * (-1.38888888889e-3f + r2 * (2.48015873e-5f + r2 * -2.75573192e-7f))));
    const int qi = ((int)q) & 3;
    s = (qi == 0) ? sp : (qi == 1) ? cp : (qi == 2) ? -sp : -cp;
    c = (qi == 0) ? cp : (qi == 1) ? -sp : (qi == 2) ? -cp : sp;
}

DI void phase_prep(const Params& p, char* smem) {
    const int tid = get_tid();
    const long gsz = (long)gridDim.x * NT, gtid = (long)blockIdx.x * NT + tid;
    char* ws = p.ws;
    repack<1>(p.w_in, 1024, 8224, (bf16_t*)(ws + OFF_WIN), 8448, gtid, gsz);
    repack<0>(p.w_bda, 1024, 1024, (bf16_t*)(ws + OFF_WDA), 1024, gtid, gsz);
    if (gtid < 256) ((float*)(ws + OFF_KMAX))[gtid] = 0.f;
    if (gtid < 2048) {
        const int pos = (int)gtid >> 4, f = (int)gtid & 15;
        const float inv = exp2f(-(float)f * (13.287712379549449f / 16.0f));
        float s, c; sincos_acc((float)pos * inv, s, c);
        float* rt = (float*)(ws + OFF_ROPE);
        rt[gtid] = c; rt[2048 + gtid] = s;
    }
    float* sil = (float*)smem;
    float* modp = (float*)(ws + OFF_MODP);
    for (int item = blockIdx.x; item < 192; item += gridDim.x) {
        const int cb = item % 12, ks = item / 12;
        __syncthreads();
        for (int i = tid; i < 9 * 64; i += NT) {
            const int r = i >> 6, kk = i & 63;
            const float v = (r < 8) ? p.c[r * 1024 + ks * 64 + kk] : p.c_ctx[ks * 64 + kk];
            sil[i] = v * sigmoidf_(v);
        }
        __syncthreads();
        const int n = cb * 512 + tid;
        float acc[9];
#pragma unroll
        for (int r = 0; r < 9; ++r) acc[r] = 0.f;
        for (int kk = 0; kk < 64; ++kk) {
            const float w = p.w_mod[(size_t)(ks * 64 + kk) * 6144 + n];
#pragma unroll
            for (int r = 0; r < 9; ++r) acc[r] = fmaf(sil[r * 64 + kk], w, acc[r]);
        }
#pragma unroll
        for (int r = 0; r < 9; ++r) modp[(size_t)(ks * 9 + r) * 6144 + n] = acc[r];
    }
}

DI void load_mod(const Params& p, int r, int which, float* dst) {
    const float* modp = (const float*)(p.ws + OFF_MODP);
    for (int n = threadIdx.x; n < 1024; n += NT) {
        float a = p.b_mod[which * 1024 + n];
#pragma unroll
        for (int ks = 0; ks < 16; ++ks) a += modp[(size_t)(ks * 9 + r) * 6144 + which * 1024 + n];
        dst[n] = a;
    }
}

DI void h_row2(const Params& p, const float* md, bf16_t* H, int rowA, int rowB, int lane) {
    const float* sa = rowA < NLAT ? p.x + (size_t)rowA * 1024 : p.ctx + (size_t)(rowA - NLAT) * 1024;
    const float* sbp = rowB < NLAT ? p.x + (size_t)rowB * 1024 : p.ctx + (size_t)(rowB - NLAT) * 1024;
    f32x4 va[4], vb[4]; float sa2 = 0.f, sb2 = 0.f;
#pragma unroll
    for (int j = 0; j < 4; ++j) { va[j] = *(const f32x4*)(sa + lane * 4 + 256 * j); vb[j] = *(const f32x4*)(sbp + lane * 4 + 256 * j); }
#pragma unroll
    for (int j = 0; j < 4; ++j) {
        sa2 += va[j].x * va[j].x + va[j].y * va[j].y + va[j].z * va[j].z + va[j].w * va[j].w;
        sb2 += vb[j].x * vb[j].x + vb[j].y * vb[j].y + vb[j].z * vb[j].z + vb[j].w * vb[j].w;
    }
    sa2 = wave_sum(sa2); sb2 = wave_sum(sb2);
    const float ra = rsqrtf(sa2 * (1.0f / 1024.0f) + EPS), rb = rsqrtf(sb2 * (1.0f / 1024.0f) + EPS);
#pragma unroll
    for (int j = 0; j < 4; ++j) {
        const int col = lane * 4 + 256 * j;
        const f32x4 g = *(const f32x4*)(p.pre_norm1 + col);
        const f32x4 sh = *(const f32x4*)(md + col), sc = *(const f32x4*)(md + 1024 + col);
        float oa[4], ob[4];
#pragma unroll
        for (int e = 0; e < 4; ++e) { const float gm = g[e] * (1.f + sc[e]); oa[e] = va[j][e] * ra * gm + sh[e]; ob[e] = vb[j][e] * rb * gm + sh[e]; }
        uint2 o; o.x = pk2(oa[0], oa[1]); o.y = pk2(oa[2], oa[3]);
        *(uint2*)(H + (size_t)rowA * 1024 + col) = o;
        o.x = pk2(ob[0], ob[1]); o.y = pk2(ob[2], ob[3]);
        *(uint2*)(H + (size_t)rowB * 1024 + col) = o;
    }
}

DI void phase_h(const Params& p, char* smem) {
    float* md = (float*)smem;
    const int tid = get_tid(), lane = tid & 63, w = tid >> 6;
    bf16_t* H = (bf16_t*)(p.ws + R_H);
    for (int tile = blockIdx.x; tile < 256; tile += gridDim.x) {
        __syncthreads();
        load_mod(p, tile >> 5, 0, md); load_mod(p, tile >> 5, 1, md + 1024);
        __syncthreads();
        for (int i = 0; i < 16; ++i) h_row2(p, md, H, tile * 256 + w * 32 + i, tile * 256 + w * 32 + 16 + i, lane);
    }
    __syncthreads();
    load_mod(p, 8, 0, md); load_mod(p, 8, 1, md + 1024);
    __syncthreads();
    for (int r2 = blockIdx.x * 8 + w; r2 < 1024; r2 += gridDim.x * 8) h_row2(p, md, H, NLAT + 2 * r2, NLAT + 2 * r2 + 1, lane);
}

typedef __attribute__((address_space(3))) unsigned lds_u32;
DI lds_u32* to_lds(const void* p) { return (lds_u32*)(unsigned)(size_t)p; }
#define GLDS16(src, dst) __builtin_amdgcn_global_load_lds((const unsigned*)(src), to_lds(dst), 16, 0, 0)

#define MFMA16(a, b, c) __builtin_amdgcn_mfma_f32_16x16x32_bf16((a), (b), (c), 0, 0, 0)
template <bool SWAP, class Epi>
DI void gemm_tile(const bf16_t* A, int lda, const bf16_t* B, int ldb, int K, int m0, int n0, bool first, bool has_next, int nm0, int nn0, char* smem, Epi& epi) {
    const int tid = get_tid(), lane = tid & 63, w = tid >> 6, wm = w >> 2, wn = w & 3, l15 = lane & 15, q = lane >> 4;
    f32x4 acc[8][4];
#pragma unroll
    for (int i = 0; i < 8; ++i)
#pragma unroll
        for (int j = 0; j < 4; ++j) acc[i][j] = (f32x4){0.f, 0.f, 0.f, 0.f};
    const int srow = 8 * w + (lane >> 3), schunk = (lane & 7) ^ (4 * (w & 1) + (lane >> 4));
    const bf16_t* ga = A + (size_t)(m0 + srow) * lda + schunk * 8;
    const bf16_t* gb = B + (size_t)(n0 + srow) * ldb + schunk * 8;
    const bf16_t* nga = A + (size_t)(nm0 + srow) * lda + schunk * 8;
    const bf16_t* ngb = B + (size_t)(nn0 + srow) * ldb + schunk * 8;
    const int sw = (l15 >> 1) & 7;
    const int aofs = (128 * wm + l15) * 128, bofs = 32768 + (64 * wn + l15) * 128;
    char* sdst = smem + w * 1024;
#define GEMM_STAGE(pa, pb, buf, kt_) do { _Pragma("unroll") for (int i = 0; i < 4; ++i) { \
        GLDS16(pa + (size_t)i * 64 * lda + (kt_) * 64, sdst + (buf) * 65536 + i * 8192); \
        GLDS16(pb + (size_t)i * 64 * ldb + (kt_) * 64, sdst + (buf) * 65536 + 32768 + i * 8192); } } while (0)
    if (first) {
        GEMM_STAGE(ga, gb, 0, 0);
        asm volatile("s_waitcnt vmcnt(0)" ::: "memory");
        __syncthreads();
    }
    const int KT = K >> 6;
    for (int kt = 0; kt < KT; ++kt) {
        const int cur = kt & 1;
        if (kt + 1 < KT) GEMM_STAGE(ga, gb, cur ^ 1, kt + 1);
        else if (has_next) GEMM_STAGE(nga, ngb, cur ^ 1, 0);
        const char* sb = smem + cur * 65536;
#pragma unroll
        for (int kk = 0; kk < 2; ++kk) {
            const int co = ((4 * kk + q) ^ sw) << 4;
            bf16x8 af[8], bf[4];
#pragma unroll
            for (int mi = 0; mi < 8; ++mi) af[mi] = *(const bf16x8*)(sb + aofs + mi * 2048 + co);
#pragma unroll
            for (int ni = 0; ni < 4; ++ni) bf[ni] = *(const bf16x8*)(sb + bofs + ni * 2048 + co);
#pragma unroll
            for (int mi = 0; mi < 8; ++mi)
#pragma unroll
                for (int ni = 0; ni < 4; ++ni) acc[mi][ni] = SWAP ? MFMA16(af[mi], bf[ni], acc[mi][ni]) : MFMA16(bf[ni], af[mi], acc[mi][ni]);
        }
        asm volatile("s_waitcnt vmcnt(0)" ::: "memory");
        __syncthreads();
    }
#undef GEMM_STAGE
#pragma unroll
    for (int mi = 0; mi < 8; ++mi) {
        if constexpr (SWAP) {
#pragma unroll
            for (int ni = 0; ni < 4; ++ni) epi.vt(m0 + 128 * wm + 16 * mi + 4 * q, n0 + 64 * wn + 16 * ni + l15, acc[mi][ni]);
        } else epi(m0 + 128 * wm + 16 * mi + l15, n0 + 64 * wn, acc[mi], q);
        asm volatile("" ::: "memory");
    }
}

DI void tile_map(int id, int MT, int NTl, int& mt, int& nt) {
    const int x = id & 7, local = id >> 3, mtx = MT >> 3;
    const int full = mtx >> 2, per = 4 * NTl;
    int patch = local / per, wv = local - patch * per, pm = 4;
    if (patch >= full) { patch = full; wv = local - full * per; pm = mtx - full * 4; }
    const int mo = wv % pm; nt = wv / pm;
    mt = (patch * 4 + mo) * 8 + x;
}

DI void tile_map_in(int id, int& mt, int& nt) {
    if (id < 8448) { tile_map(id, 256, 33, mt, nt); return; }
    const int id2 = id - 8448, k = id2 >> 3;
    mt = 256 + (id2 & 7);
    nt = k < 8 ? 4 + k : k < 10 ? 14 + (k - 8) : k < 14 ? 16 + (k - 10) : 32;
}
template <bool VSWAP, class Epi>
DI void gemm_phase_ex(const bf16_t* A, int lda, const bf16_t* B, int ldb, int K, int MT, int NTl, char* smem, Epi& epi, int bid, int nblk) {
    const int total = VSWAP ? 8448 + 120 : MT * NTl;
    bool first = true;
    for (int id = bid; id < total; id += nblk) {
        int mt, nt, mt2 = 0, nt2 = 0;
        if (VSWAP) tile_map_in(id, mt, nt); else tile_map(id, MT, NTl, mt, nt);
        const bool has_next = id + nblk < total;
        if (has_next) { if (VSWAP) tile_map_in(id + nblk, mt2, nt2); else tile_map(id + nblk, MT, NTl, mt2, nt2); }
        if constexpr (VSWAP) { if (Epi::is_vt(nt)) { gemm_tile<true>(A, lda, B, ldb, K, mt * 256, nt * 256, first, has_next, mt2 * 256, nt2 * 256, smem, epi); first = false; continue; } }
        gemm_tile<false>(A, lda, B, ldb, K, mt * 256, nt * 256, first, has_next, mt2 * 256, nt2 * 256, smem, epi);
        first = false;
    }
}
template <class Epi>
DI void gemm_phase(const bf16_t* A, int lda, const bf16_t* B, int ldb, int K, int MT, int NTl, char* smem, Epi& epi) {
    gemm_phase_ex<false>(A, lda, B, ldb, K, MT, NTl, smem, epi, blockIdx.x, gridDim.x);
}

DI float xhalf_max(float v) {
    typedef unsigned u32x2 __attribute__((ext_vector_type(2)));
    const unsigned u = __float_as_uint(v);
    const u32x2 r = __builtin_amdgcn_permlane32_swap(u, u, false, false);
    return fmaxf(__uint_as_float(r[0]), __uint_as_float(r[1]));
}
DI float xhalf_sum(float v) {
    typedef unsigned u32x2 __attribute__((ext_vector_type(2)));
    const unsigned u = __float_as_uint(v);
    const u32x2 r = __builtin_amdgcn_permlane32_swap(u, u, false, false);
    return __uint_as_float(r[0]) + __uint_as_float(r[1]);
}
template <class Epi>
DI void gemm_panel(const bf16_t* A, int lda, const bf16_t* B, int ldb, int K, int panel, int NTl, char* smem, Epi& epi) {
    for (int nt = 0; nt < NTl; ++nt)
        gemm_tile<false>(A, lda, B, ldb, K, panel * 256, nt * 256, nt == 0, nt + 1 < NTl, panel * 256, (nt + 1) * 256, smem, epi);
}

DI float quad_sum(float v) { v += __shfl_xor(v, 16); v += __shfl_xor(v, 32); return v; }
struct EpiIn {
    bf16_t *Q, *Kk, *Vt, *gq, *gk, *gvT, *sg, *mg; float* glow; const float* rope; float* kmax;
    static DI bool is_vt(int nt) { return (nt >= 8 && nt < 12) || (nt >= 16 && nt < 20); }
    DI void vt(int row0, int col, const f32x4& v) const {
        int b, t;
        if (row0 < NLAT) { b = row0 >> 13; t = row0 & 8191; } else { const int r2 = row0 - NLAT; b = r2 >> 8; t = TLAT + (r2 & 255); }
        bf16_t* dst;
        if (col < 3072) { const int c = col - 2048; dst = Vt + (size_t)((b * 8 + (c >> 7)) * 128 + (c & 127)) * TKV + t; }
        else { const int c = col - 4096; dst = gvT + (size_t)((b * 4 + (c >> 8)) * 256 + (c & 255)) * TKV + t; }
        uint2 u; u.x = pk2(v[0], v[1]); u.y = pk2(v[2], v[3]);
        *(uint2*)dst = u;
    }
    DI void operator()(int row, int cb, const f32x4 (&v)[4], int q) const {
        if (cb >= 8224) return;
        const bool lat = row < NLAT;
        int b, t;
        if (lat) { b = row >> 13; t = row & 8191; } else { const int r2 = row - NLAT; b = r2 >> 8; t = TLAT + (r2 & 255); }
        if (cb < 2048) {
            const bool isq = cb < 1024;
            if (isq && !lat) return;
            const int c = cb & 1023, head = c >> 7, comp = (c >> 6) & 1;
            f32x4 o[4];
            if (lat) {
#pragma unroll
                for (int half = 0; half < 2; ++half) {
                    const int pos = half ? (t & 63) : (t >> 6);
                    const f32x4 c4 = *(const f32x4*)(rope + pos * 16 + 4 * q), s4 = *(const f32x4*)(rope + 2048 + pos * 16 + 4 * q);
#pragma unroll
                    for (int j = 0; j < 4; ++j) {
                        const float x1 = v[2 * half][j], x2 = v[2 * half + 1][j];
                        o[2 * half][j] = x1 * c4[j] - x2 * s4[j];
                        o[2 * half + 1][j] = x2 * c4[j] + x1 * s4[j];
                    }
                }
            } else {
#pragma unroll
                for (int ni = 0; ni < 4; ++ni) o[ni] = v[ni];
            }
            if (!isq) {
#pragma unroll
                for (int half = 0; half < 2; ++half) {
                    float ssq = 0.f;
#pragma unroll
                    for (int j = 0; j < 4; ++j) ssq += o[2 * half][j] * o[2 * half][j] + o[2 * half + 1][j] * o[2 * half + 1][j];
                    ssq = quad_sum(ssq);
#pragma unroll
                    for (int of = 8; of >= 1; of >>= 1) ssq = fmaxf(ssq, __shfl_xor(ssq, of));
                    if ((threadIdx.x & 63) == 0) atomicMax((unsigned*)(kmax + ((b * 8 + head) * 2 + comp) * 2 + half), __float_as_uint(ssq));
                }
            }
            const float scl = isq ? 0.125f * 1.4426950408889634f : 1.0f;
            bf16_t* dst = isq ? Q + ((size_t)((b * 8 + head) * 2 + comp) * TLAT + t) * 64 : Kk + ((size_t)((b * 8 + head) * 2 + comp) * TKV + t) * 64;
#pragma unroll
            for (int ni = 0; ni < 4; ++ni) {
                uint2 u; u.x = pk2(o[ni][0] * scl, o[ni][1] * scl); u.y = pk2(o[ni][2] * scl, o[ni][3] * scl);
                *(uint2*)(dst + 16 * ni + 4 * q) = u;
            }
        } else if (cb < 3072) {
        } else if (cb < 4096) {
            const bool isq = cb < 3584;
            if (isq && !lat) return;
            const int c = (cb - 3072) & 511;
            const float scl = isq ? 0.08838834764831845f : 1.0f;
            bf16_t* dst = (isq ? gq : gk) + (size_t)row * 512 + c;
#pragma unroll
            for (int ni = 0; ni < 4; ++ni) {
                uint2 u; u.x = pk2(v[ni][0] * scl, v[ni][1] * scl); u.y = pk2(v[ni][2] * scl, v[ni][3] * scl);
                *(uint2*)(dst + 16 * ni + 4 * q) = u;
            }
        } else if (cb < 5120) {
        } else if (cb < 6144) {
            if (!lat) return;
            bf16_t* dst = sg + (size_t)row * 1024 + (cb - 5120);
#pragma unroll
            for (int ni = 0; ni < 4; ++ni) {
                float s[4];
#pragma unroll
                for (int j = 0; j < 4; ++j) { const float xx = v[ni][j]; s[j] = xx * sigmoidf_(xx); }
                uint2 u; u.x = pk2(s[0], s[1]); u.y = pk2(s[2], s[3]);
                *(uint2*)(dst + 16 * ni + 4 * q) = u;
            }
        } else if (cb < 8192) {
            if (!lat) return;
            bf16_t* dst = mg + (size_t)row * 2048 + (cb - 6144);
#pragma unroll
            for (int ni = 0; ni < 4; ++ni) {
                uint2 u; u.x = pk2(sigmoidf_(v[ni][0]), sigmoidf_(v[ni][1])); u.y = pk2(sigmoidf_(v[ni][2]), sigmoidf_(v[ni][3]));
                *(uint2*)(dst + 16 * ni + 4 * q) = u;
            }
        } else {
            float* dst = glow + (size_t)row * 32;
#pragma unroll
            for (int ni = 0; ni < 2; ++ni) *(f32x4*)(dst + 16 * ni + 4 * q) = v[ni];
        }
    }
};

struct EpiGate0 {
    bf16_t* mg;
    DI void operator()(int row, int cb, const f32x4 (&v)[4], int q) const {
#pragma unroll
        for (int ni = 0; ni < 4; ++ni) {
            const int col = cb + 16 * ni + 4 * q;
            const uint2 m = *(const uint2*)(mg + (size_t)row * 2048 + col);
            uint2 u; u.x = pk2(v[ni][0] * bflo(m.x), v[ni][1] * bfhi(m.x)); u.y = pk2(v[ni][2] * bflo(m.y), v[ni][3] * bfhi(m.y));
            *(uint2*)(mg + (size_t)row * 2048 + col) = u;
        }
    }
};
struct EpiGate1 {
    bf16_t* Y; const bf16_t* mg;
    DI void operator()(int row, int cb, const f32x4 (&v)[4], int q) const {
#pragma unroll
        for (int ni = 0; ni < 4; ++ni) {
            const int col = cb + 16 * ni + 4 * q;
            const uint2 m = *(const uint2*)(mg + (size_t)row * 2048 + 1024 + col);
            const uint2 pr = *(const uint2*)(mg + (size_t)row * 2048 + col);
            uint2 u; u.x = pk2(bflo(pr.x) + v[ni][0] * bflo(m.x), bfhi(pr.x) + v[ni][1] * bfhi(m.x));
            u.y = pk2(bflo(pr.y) + v[ni][2] * bflo(m.y), bfhi(pr.y) + v[ni][3] * bfhi(m.y));
            *(uint2*)(Y + (size_t)row * 1024 + col) = u;
        }
    }
};
template <int ACT>
struct EpiStore {
    bf16_t* O; int ldo;
    DI void operator()(int row, int cb, const f32x4 (&v)[4], int q) const {
#pragma unroll
        for (int ni = 0; ni < 4; ++ni) {
            float s[4];
#pragma unroll
            for (int j = 0; j < 4; ++j) { float xx = v[ni][j]; if (ACT == 1) { xx = fmaxf(xx, 0.f); xx = xx * xx; } s[j] = xx; }
            uint2 u; u.x = pk2(s[0], s[1]); u.y = pk2(s[2], s[3]);
            *(uint2*)(O + (size_t)row * ldo + cb + 16 * ni + 4 * q) = u;
        }
    }
};

DI float quad_max(float v) { v = fmaxf(v, __shfl_xor(v, 16)); v = fmaxf(v, __shfl_xor(v, 32)); return v; }
DI bf16x8 pack8(const f32x4& a, const f32x4& b) {
    typedef unsigned u32x4 __attribute__((ext_vector_type(4)));
    const u32x4 u = {pk2(a[0], a[1]), pk2(a[2], a[3]), pk2(b[0], b[1]), pk2(b[2], b[3])};
    return __builtin_bit_cast(bf16x8, u);
}

template <bool FAST>
DI void attn_kloop(char* smem, char* sdst, const bf16_t* gk0, const bf16_t* gk1, const bf16_t* gv, bool first, bool has_next, const bf16_t* ngk0, const bf16_t* ngk1, const bf16_t* ngv,
                   int comp, int krow0, int ksw, int l15, int qd, const bf16x8 (&qf)[2][2], f32x4 (&O)[2][8], float (&m)[2], float (&l)[2]) {
#define ATT_STAGE_P(pk0, pk1, pv, buf, kt_) do { _Pragma("unroll") for (int jj = 0; jj < 2; ++jj) { \
            GLDS16(pk0 + (size_t)((kt_) * 128 + 64 * jj) * 64, sdst + (buf) * 65536 + jj * 8192); \
            GLDS16(pk1 + (size_t)((kt_) * 128 + 64 * jj) * 64, sdst + (buf) * 65536 + 16384 + jj * 8192); } \
            _Pragma("unroll") for (int jj = 0; jj < 4; ++jj) GLDS16(pv + (size_t)(32 * jj) * TKV + (kt_) * 128, sdst + (buf) * 65536 + 32768 + jj * 8192); } while (0)
#define ATT_STAGE(buf, kt_) ATT_STAGE_P(gk0, gk1, gv, buf, kt_)
#define KFRAG(sub_, t_, kd_) (*(const bf16x8*)(skc + (32 * (sub_) + krow0 + 4 * (t_)) * 128 + (((4 * (kd_) + qd) ^ ksw) << 4)))
#define VFRAG(sub_, dt_) (*(const bf16x8*)(sb + 32768 + (16 * (dt_) + l15) * 256 + (((4 * (sub_) + qd) ^ l15) << 4)))
    if (first) {
        ATT_STAGE(0, 0);
        asm volatile("s_waitcnt vmcnt(0)" ::: "memory");
        __syncthreads();
    }
    f32x4 sinit[2], Ls[2];
#pragma unroll
    for (int qt = 0; qt < 2; ++qt) { const float v0 = FAST ? -m[qt] : 0.f; sinit[qt] = (f32x4){v0, v0, v0, v0}; Ls[qt] = (f32x4){0.f, 0.f, 0.f, 0.f}; }
    constexpr int NKT = TKV / 128;
    for (int kt = 0; kt < NKT; ++kt) {
        const int cur = kt & 1;
        if (kt + 1 < NKT) ATT_STAGE(cur ^ 1, kt + 1);
        else if (has_next) ATT_STAGE_P(ngk0, ngk1, ngv, cur ^ 1, 0);
        const char* sb = smem + cur * 65536;
        const char* skc = sb + comp * 16384;
        if (FAST) {
            bf16x8 kf[2][2];
#pragma unroll
            for (int t = 0; t < 2; ++t)
#pragma unroll
                for (int kd = 0; kd < 2; ++kd) kf[t][kd] = KFRAG(0, t, kd);
            f32x4 Sn[2][2];
#pragma unroll
            for (int qt = 0; qt < 2; ++qt)
#pragma unroll
                for (int t = 0; t < 2; ++t) { Sn[qt][t] = MFMA16(kf[t][0], qf[qt][0], sinit[qt]); Sn[qt][t] = MFMA16(kf[t][1], qf[qt][1], Sn[qt][t]); }
            const bf16x8 ones = {0x3F80, 0x3F80, 0x3F80, 0x3F80, 0x3F80, 0x3F80, 0x3F80, 0x3F80};
#pragma unroll
            for (int sub = 0; sub < 4; ++sub) {
                f32x4 Sc[2][2];
#pragma unroll
                for (int qt = 0; qt < 2; ++qt)
#pragma unroll
                    for (int t = 0; t < 2; ++t) Sc[qt][t] = Sn[qt][t];
                bf16x8 va[4], vb[4];
#pragma unroll
                for (int dt = 0; dt < 4; ++dt) va[dt] = VFRAG(sub, dt);
                if (sub < 3) {
#pragma unroll
                    for (int t = 0; t < 2; ++t)
#pragma unroll
                        for (int kd = 0; kd < 2; ++kd) kf[t][kd] = KFRAG(sub + 1, t, kd);
                }
                __builtin_amdgcn_sched_barrier(0);
                bf16x8 pb[2];
#pragma unroll
                for (int qt = 0; qt < 2; ++qt) {
                    f32x4 p0, p1;
#pragma unroll
                    for (int i = 0; i < 4; ++i) { p0[i] = __builtin_amdgcn_exp2f(Sc[qt][0][i]); p1[i] = __builtin_amdgcn_exp2f(Sc[qt][1][i]); }
                    pb[qt] = pack8(p0, p1);
                }
#pragma unroll
                for (int dt = 0; dt < 4; ++dt) vb[dt] = VFRAG(sub, 4 + dt);
                __builtin_amdgcn_sched_barrier(0);
#pragma unroll
                for (int dt = 0; dt < 4; ++dt) {
                    O[0][dt] = MFMA16(va[dt], pb[0], O[0][dt]);
                    O[1][dt] = MFMA16(va[dt], pb[1], O[1][dt]);
                    if (sub < 3) Sn[dt >> 1][dt & 1] = MFMA16(kf[dt & 1][0], qf[dt >> 1][0], sinit[dt >> 1]);
                }
#pragma unroll
                for (int dt = 0; dt < 4; ++dt) {
                    O[0][4 + dt] = MFMA16(vb[dt], pb[0], O[0][4 + dt]);
                    O[1][4 + dt] = MFMA16(vb[dt], pb[1], O[1][4 + dt]);
                    if (sub < 3) Sn[dt >> 1][dt & 1] = MFMA16(kf[dt & 1][1], qf[dt >> 1][1], Sn[dt >> 1][dt & 1]);
                }
                Ls[0] = MFMA16(ones, pb[0], Ls[0]);
                Ls[1] = MFMA16(ones, pb[1], Ls[1]);
            }
        } else {
#pragma unroll 1
            for (int sub = 0; sub < 4; ++sub) {
                f32x4 S[2][2];
#pragma unroll
                for (int qt = 0; qt < 2; ++qt)
#pragma unroll
                    for (int t = 0; t < 2; ++t) { S[qt][t] = MFMA16(KFRAG(sub, t, 0), qf[qt][0], sinit[qt]); S[qt][t] = MFMA16(KFRAG(sub, t, 1), qf[qt][1], S[qt][t]); }
                bf16x8 pb[2];
#pragma unroll
                for (int qt = 0; qt < 2; ++qt) {
                    float mt = fmaxf(fmaxf(fmaxf(S[qt][0][0], S[qt][0][1]), fmaxf(S[qt][0][2], S[qt][0][3])), fmaxf(fmaxf(S[qt][1][0], S[qt][1][1]), fmaxf(S[qt][1][2], S[qt][1][3])));
                    mt = quad_max(mt);
                    if (mt > m[qt]) {
                        const float al = __builtin_amdgcn_exp2f(m[qt] - mt);
                        l[qt] *= al;
#pragma unroll
                        for (int dt = 0; dt < 8; ++dt) O[qt][dt] *= al;
                        m[qt] = mt;
                    }
                    f32x4 p0, p1;
#pragma unroll
                    for (int i = 0; i < 4; ++i) { p0[i] = __builtin_amdgcn_exp2f(S[qt][0][i] - m[qt]); p1[i] = __builtin_amdgcn_exp2f(S[qt][1][i] - m[qt]); l[qt] += p0[i] + p1[i]; }
                    pb[qt] = pack8(p0, p1);
                }
#pragma unroll
                for (int dt = 0; dt < 8; ++dt) {
                    const bf16x8 vf = VFRAG(sub, dt);
                    O[0][dt] = MFMA16(vf, pb[0], O[0][dt]);
                    O[1][dt] = MFMA16(vf, pb[1], O[1][dt]);
                }
            }
        }
        asm volatile("s_waitcnt vmcnt(0)" ::: "memory");
        __syncthreads();
    }
#undef ATT_STAGE
#undef ATT_STAGE_P
#undef KFRAG
#undef VFRAG
    if (FAST) { l[0] = Ls[0][0]; l[1] = Ls[1][0]; }
    else { l[0] = quad_sum(l[0]); l[1] = quad_sum(l[1]); }
}

DI void phase_attn(const Params& p, char* smem) {
    const int tid = get_tid(), lane = tid & 63, w = tid >> 6, l15 = lane & 15, qd = lane >> 4;
    const int g = w >> 1, comp = w & 1;
    const bf16_t* Q = (const bf16_t*)(p.ws + R_Q);
    const bf16_t* Kk = (const bf16_t*)(p.ws + R_K);
    const bf16_t* Vt = (const bf16_t*)(p.ws + R_VT);
    const float* kmax = (const float*)(p.ws + OFF_KMAX);
    bf16_t* YDA = (bf16_t*)(p.ws + R_H);
    float d1 = 0.f, d2 = 0.f;
    for (int i = 0; i < 64; ++i) { d1 += p.lq1[i] * p.lk1[i]; d2 += p.lq2[i] * p.lk2[i]; }
    const float lam = __expf(d1) - __expf(d2) + 0.2f;
    const int krs = 8 * w + (lane >> 3), kcs = (lane & 7) ^ (((lane >> 4) & 1) | ((w & 3) << 1));
    const int vrs = 4 * w + (lane >> 4), vcs = (lane & 15) ^ ((4 * w + (lane >> 4)) & 15);
    const int krow0 = 8 * (l15 >> 2) + (l15 & 3);
    const int ksw = ((l15 >> 1) & 1) | (((l15 >> 2) & 3) << 1);
    float* xbuf = (float*)(smem + 65536) + g * 4096;
    char* sdst = smem + w * 1024;
    for (int id = blockIdx.x; id < 4096; id += gridDim.x) {
        const int x = id & 7, j = id >> 3, bh = (j >> 6) * 8 + x, qti = j & 63;
        const int b = bh >> 3, h = bh & 7;
        bf16x8 qf[2][2];
        float mb[2];
        const float kb = sqrtf(kmax[(bh * 2 + comp) * 2] + kmax[(bh * 2 + comp) * 2 + 1]);
#pragma unroll
        for (int qt = 0; qt < 2; ++qt) {
            const bf16_t* qp = Q + ((size_t)(bh * 2 + comp) * TLAT + qti * 128 + g * 32 + 16 * qt + l15) * 64 + qd * 8;
            qf[qt][0] = *(const bf16x8*)qp; qf[qt][1] = *(const bf16x8*)(qp + 32);
            float qn = 0.f;
#pragma unroll
            for (int kd = 0; kd < 2; ++kd)
#pragma unroll
                for (int e = 0; e < 8; ++e) { const float qv = __uint_as_float(((unsigned)(unsigned short)qf[qt][kd][e]) << 16); qn += qv * qv; }
            qn = quad_sum(qn);
            mb[qt] = sqrtf(qn) * kb * 1.01f + 1e-3f;
        }
        const bf16_t* gk0 = Kk + ((size_t)(bh * 2 + 0) * TKV + krs) * 64 + kcs * 8;
        const bf16_t* gk1 = gk0 + (size_t)TKV * 64;
        const bf16_t* gv = Vt + ((size_t)bh * 128 + vrs) * TKV + vcs * 8;
        const bool first = id == (int)blockIdx.x, has_next = id + (int)gridDim.x < 4096;
        const int nid = has_next ? id + gridDim.x : id, nbh = ((nid >> 3) >> 6) * 8 + (nid & 7);
        const bf16_t* ngk0 = Kk + ((size_t)(nbh * 2 + 0) * TKV + krs) * 64 + kcs * 8;
        const bf16_t* ngk1 = ngk0 + (size_t)TKV * 64;
        const bf16_t* ngv = Vt + ((size_t)nbh * 128 + vrs) * TKV + vcs * 8;
        f32x4 O[2][8];
#pragma unroll
        for (int qt = 0; qt < 2; ++qt)
#pragma unroll
            for (int d = 0; d < 8; ++d) O[qt][d] = (f32x4){0.f, 0.f, 0.f, 0.f};
        float m[2], l[2] = {0.f, 0.f};
        const int slow = __syncthreads_or(!(mb[0] <= 60.0f && mb[1] <= 60.0f));
        if (!slow) { m[0] = mb[0]; m[1] = mb[1]; attn_kloop<true>(smem, sdst, gk0, gk1, gv, first, has_next, ngk0, ngk1, ngv, comp, krow0, ksw, l15, qd, qf, O, m, l); }
        else { m[0] = -INFINITY; m[1] = -INFINITY; attn_kloop<false>(smem, sdst, gk0, gk1, gv, first, has_next, ngk0, ngk1, ngv, comp, krow0, ksw, l15, qd, qf, O, m, l); }
        if (comp == 1) {
#pragma unroll
            for (int qt = 0; qt < 2; ++qt) {
                const float i1 = lam / l[qt];
#pragma unroll
                for (int d = 0; d < 8; ++d)
#pragma unroll
                    for (int i = 0; i < 4; ++i) xbuf[((qt * 8 + d) * 4 + i) * 64 + lane] = O[qt][d][i] * i1;
            }
        }
        __syncthreads();
        if (comp == 0) {
#pragma unroll
            for (int qt = 0; qt < 2; ++qt) {
                const float i0 = 1.0f / l[qt];
                float ss = 0.f;
#pragma unroll
                for (int d = 0; d < 8; ++d)
#pragma unroll
                    for (int i = 0; i < 4; ++i) { const float o = O[qt][d][i] * i0 - xbuf[((qt * 8 + d) * 4 + i) * 64 + lane]; O[qt][d][i] = o; ss += o * o; }
                ss = quad_sum(ss);
                const float rs = rsqrtf(ss * (1.0f / 128.0f) + EPS) * 0.8f;
                const int t = qti * 128 + g * 32 + 16 * qt + l15;
                bf16_t* dst = YDA + ((size_t)b * TLAT + t) * 1024 + h * 128;
#pragma unroll
                for (int d = 0; d < 8; ++d) {
                    const int dv = 16 * d + 4 * qd;
                    const f32x4 hn = *(const f32x4*)(p.da_hn + dv);
                    uint2 u; u.x = pk2(O[qt][d][0] * rs * hn.x, O[qt][d][1] * rs * hn.y); u.y = pk2(O[qt][d][2] * rs * hn.z, O[qt][d][3] * rs * hn.w);
                    *(uint2*)(dst + dv) = u;
                }
            }
        }
    }
}

DI void phase_gate(const Params& p, char* smem) {
    const int tid = get_tid();
    const float* glow = (const float*)(p.ws + OFF_GLOW);
    float* sg = (float*)smem;
    float wf[16], wb[16];
#pragma unroll
    for (int r = 0; r < 16; ++r) { wf[r] = p.w_gate_up[(size_t)r * 512 + tid]; wb[r] = p.w_gate_up[(size_t)(16 + r) * 512 + tid]; }
    const float biasf = p.b_gate_up[tid], biasb = p.b_gate_up[512 + tid];
    _Float16* BF = (_Float16*)(p.ws + R_BF);
    _Float16* BB = (_Float16*)(p.ws + R_BB);
    for (int ch = blockIdx.x; ch < 1056; ch += gridDim.x) {
        __syncthreads();
        *(f32x4*)(sg + tid * 4) = *(const f32x4*)(glow + (size_t)ch * 2048 + tid * 4);
        __syncthreads();
        float run = 0.f;
#pragma unroll 4
        for (int i = 0; i < 64; ++i) {
            const float* gl = sg + i * 32;
            float a = biasf;
#pragma unroll
            for (int r = 0; r < 16; ++r) a = fmaf(gl[r], wf[r], a);
            const float ls = fminf(a, 0.f) - __logf(1.0f + __expf(-fabsf(a)));
            run += ls * (1.4426950408889634f / 16.0f);
            BF[(size_t)(ch * 64 + i) * 512 + tid] = (_Float16)run;
        }
        run = 0.f;
#pragma unroll 4
        for (int i = 63; i >= 0; --i) {
            const float* gl = sg + i * 32 + 16;
            float a = biasb;
#pragma unroll
            for (int r = 0; r < 16; ++r) a = fmaf(gl[r], wb[r], a);
            const float ls = fminf(a, 0.f) - __logf(1.0f + __expf(-fabsf(a)));
            run += ls * (1.4426950408889634f / 16.0f);
            BB[(size_t)(ch * 64 + i) * 512 + tid] = (_Float16)run;
        }
    }
}

struct GlaRegs { uint2 k[2][2], q[2][2], bb[2][2], bl[2][2]; uint4 v[2]; };

DI void phase_gla(const Params& p, char* smem, int unit) {
    const int tid = get_tid(), lane = tid & 63, w = tid >> 6, l31 = lane & 31, hh = lane >> 5;
    const int dir = unit & 1, dvh = (unit >> 1) & 1, bh = unit >> 2, b = bh >> 2, h = bh & 3;
    const bf16_t* gq = (const bf16_t*)(p.ws + R_GQ);
    const bf16_t* gk = (const bf16_t*)(p.ws + R_GK);
    const bf16_t* gvT = (const bf16_t*)(p.ws + R_GVT) + (size_t)(bh * 256 + dvh * 128) * TKV;
    const _Float16* B16 = (const _Float16*)(p.ws + (dir ? R_BB : R_BF));
    bf16_t* Oo = (bf16_t*)(p.ws + (dir ? R_OB : R_OF));
    char* sQt = smem;
    char* sKt = smem + 16384;
    char* sKh = smem + 32768;
    char* sVT = smem + 49152;
    char* sA = smem + 81920;
    float* sD = (float*)(smem + 90112);
    f32x16 S[4];
#pragma unroll
    for (int k = 0; k < 4; ++k)
#pragma unroll
        for (int e = 0; e < 16; ++e) S[k][e] = 0.f;
    const int sw = (l31 >> 1) & 7;
    GlaRegs R;
    auto chunk_info = [&](int step, int& rowbase, int& tcol, bool& emit) {
        if (step < 4) { const int cc = dir ? 3 - step : step; rowbase = NLAT + b * 256 + cc * 64; tcol = TLAT + cc * 64; emit = false; }
        else { const int cc = dir ? 127 - (step - 4) : step - 4; rowbase = b * TLAT + cc * 64; tcol = cc * 64; emit = true; }
    };
    auto load_chunk = [&](int step) {
        int rowbase, tcol; bool emit; chunk_info(step, rowbase, tcol, emit);
        const int rl = rowbase + (dir ? 0 : 63);
#pragma unroll
        for (int i = 0; i < 2; ++i) {
            const int item = tid + NT * i, tok = item >> 4, c = item & 15, d0 = 16 * (c >> 1) + 4 * (c & 1);
            const size_t ro = (size_t)(rowbase + tok) * 512 + h * 128 + d0;
            R.k[i][0] = *(const uint2*)(gk + ro); R.k[i][1] = *(const uint2*)(gk + ro + 8);
            if (emit) { R.q[i][0] = *(const uint2*)(gq + ro); R.q[i][1] = *(const uint2*)(gq + ro + 8); }
            else { R.q[i][0] = make_uint2(0, 0); R.q[i][1] = make_uint2(0, 0); }
            R.bb[i][0] = *(const uint2*)(B16 + ro); R.bb[i][1] = *(const uint2*)(B16 + ro + 8);
            const size_t rlo = (size_t)rl * 512 + h * 128 + d0;
            R.bl[i][0] = *(const uint2*)(B16 + rlo); R.bl[i][1] = *(const uint2*)(B16 + rlo + 8);
        }
#pragma unroll
        for (int i = 0; i < 2; ++i) R.v[i] = *(const uint4*)(gvT + (size_t)((tid >> 3) + 64 * i) * TKV + tcol + (tid & 7) * 8);
    };
    auto stage_chunk = [&]() {
#pragma unroll
        for (int i = 0; i < 2; ++i) {
            const int item = tid + NT * i, tok = item >> 4, c = item & 15, d0 = 16 * (c >> 1) + 4 * (c & 1);
            float qo[8], ko[8];
#pragma unroll
            for (int g = 0; g < 2; ++g) {
                const h4_t bv = __builtin_bit_cast(h4_t, R.bb[i][g]), lv = __builtin_bit_cast(h4_t, R.bl[i][g]);
                const float kk[4] = {bflo(R.k[i][g].x), bfhi(R.k[i][g].x), bflo(R.k[i][g].y), bfhi(R.k[i][g].y)};
                const float qq[4] = {bflo(R.q[i][g].x), bfhi(R.q[i][g].x), bflo(R.q[i][g].y), bfhi(R.q[i][g].y)};
#pragma unroll
                for (int j = 0; j < 4; ++j) {
                    const float bb = (float)bv[j], bl = (float)lv[j];
                    qo[4 * g + j] = qq[j] * __builtin_amdgcn_exp2f(bb);
                    ko[4 * g + j] = kk[j] * __builtin_amdgcn_exp2f(-bb);
                    const float kh = kk[j] * __builtin_amdgcn_exp2f(bl - bb);
                    const int dk = d0 + 8 * g + j;
                    *(bf16_t*)(sKh + dk * 128 + ((((tok >> 3) ^ ((dk >> 1) & 7))) << 4) + (tok & 7) * 2) = bf1(kh);
                }
            }
            const int po = tok * 256 + ((c ^ (tok & 15)) << 4);
            uint4 uq, uk;
            uq.x = pk2(qo[0], qo[1]); uq.y = pk2(qo[2], qo[3]); uq.z = pk2(qo[4], qo[5]); uq.w = pk2(qo[6], qo[7]);
            uk.x = pk2(ko[0], ko[1]); uk.y = pk2(ko[2], ko[3]); uk.z = pk2(ko[4], ko[5]); uk.w = pk2(ko[6], ko[7]);
            *(uint4*)(sQt + po) = uq; *(uint4*)(sKt + po) = uk;
        }
#pragma unroll
        for (int i = 0; i < 2; ++i) {
            const int row = (tid >> 3) + 64 * i, scn = tid & 7;
            *(uint4*)(sVT + row * 128 + ((scn ^ ((row >> 1) & 7)) << 4)) = R.v[i];
        }
        if (tid < 16) {
            const int d0 = 16 * (tid >> 1) + 4 * (tid & 1);
#pragma unroll
            for (int g = 0; g < 2; ++g) {
                const h4_t lv = __builtin_bit_cast(h4_t, R.bl[0][g]);
#pragma unroll
                for (int j = 0; j < 4; ++j) sD[d0 + 8 * g + j] = __builtin_amdgcn_exp2f((float)lv[j]);
            }
        }
    };
    load_chunk(0);
    for (int step = 0; step < 132; ++step) {
        int rowbase, tcol; bool emit; chunk_info(step, rowbase, tcol, emit);
        stage_chunk();
        __syncthreads();
        if (step + 1 < 132) load_chunk(step + 1);
        const int dvb = 32 * (w & 3);
        f32x16 o[2];
        if (emit) {
            if (w >= 4) {
                const int ti = (w - 4) >> 1, tj = (w - 4) & 1;
                f32x16 a;
#pragma unroll
                for (int e = 0; e < 16; ++e) a[e] = 0.f;
                const bool dead = dir ? (tj < ti) : (tj > ti);
                if (!dead) {
#pragma unroll
                    for (int ks = 0; ks < 8; ++ks) {
                        const int ri = 32 * ti + l31, rj = 32 * tj + l31, c = 2 * ks + hh;
                        const bf16x8 af = *(const bf16x8*)(sQt + ri * 256 + ((c ^ (ri & 15)) << 4));
                        const bf16x8 bf = *(const bf16x8*)(sKt + rj * 256 + ((c ^ (rj & 15)) << 4));
                        a = MFMA32(af, bf, a);
                    }
                }
                const int jj = 32 * tj + l31;
#pragma unroll
                for (int e = 0; e < 16; ++e) {
                    const int ii = 32 * ti + (e & 3) + 8 * (e >> 2) + 4 * hh;
                    const bool keep = dir ? (jj >= ii) : (jj <= ii);
                    *(bf16_t*)(sA + ii * 128 + ((((jj >> 3) ^ ((ii >> 1) & 7))) << 4) + (jj & 7) * 2) = bf1(keep ? a[e] : 0.f);
                }
            } else {
#pragma unroll
            for (int mt = 0; mt < 2; ++mt)
#pragma unroll
                for (int e = 0; e < 16; ++e) o[mt][e] = 0.f;
#pragma unroll
            for (int kt = 0; kt < 4; ++kt)
#pragma unroll
                for (int s = 0; s < 2; ++s) {
                    typedef unsigned u32x4 __attribute__((ext_vector_type(4)));
                    u32x4 pu = {pk2(S[kt][8 * s], S[kt][8 * s + 1]), pk2(S[kt][8 * s + 2], S[kt][8 * s + 3]), pk2(S[kt][8 * s + 4], S[kt][8 * s + 5]), pk2(S[kt][8 * s + 6], S[kt][8 * s + 7])};
                    const bf16x8 sf = __builtin_bit_cast(bf16x8, pu);
#pragma unroll
                    for (int mt = 0; mt < 2; ++mt) {
                        const int ri = 32 * mt + l31, c = 4 * kt + 2 * s + hh;
                        const bf16x8 af = *(const bf16x8*)(sQt + ri * 256 + ((c ^ (ri & 15)) << 4));
                        o[mt] = MFMA32(af, sf, o[mt]);
                    }
                }
            }
            __syncthreads();
            if (w < 4) {
#pragma unroll
            for (int s2 = 0; s2 < 4; ++s2) {
                const int c = 2 * s2 + hh;
                const bf16x8 vf = *(const bf16x8*)(sVT + (dvb + l31) * 128 + ((c ^ sw) << 4));
#pragma unroll
                for (int mt = 0; mt < 2; ++mt) {
                    const bf16x8 af = *(const bf16x8*)(sA + (32 * mt + l31) * 128 + ((c ^ sw) << 4));
                    o[mt] = MFMA32(af, vf, o[mt]);
                }
            }
            bf16_t* od = Oo + (size_t)rowbase * 1024 + h * 256 + dvh * 128 + dvb + l31;
#pragma unroll
            for (int mt = 0; mt < 2; ++mt)
#pragma unroll
                for (int e = 0; e < 16; ++e) od[(size_t)(32 * mt + (e & 3) + 8 * (e >> 2) + 4 * hh) * 1024] = bf1(o[mt][e]);
            }
        }
        if (w < 4) {
#pragma unroll
        for (int kt = 0; kt < 4; ++kt)
#pragma unroll
            for (int g4 = 0; g4 < 4; ++g4) {
                const f32x4 dd = *(const f32x4*)(sD + 32 * kt + 8 * g4 + 4 * hh);
#pragma unroll
                for (int jq = 0; jq < 4; ++jq) S[kt][4 * g4 + jq] *= dd[jq];
            }
#pragma unroll
        for (int s2 = 0; s2 < 4; ++s2) {
            const int c = 2 * s2 + hh;
            const bf16x8 vf = *(const bf16x8*)(sVT + (dvb + l31) * 128 + ((c ^ sw) << 4));
#pragma unroll
            for (int kt = 0; kt < 4; ++kt) {
                const bf16x8 af = *(const bf16x8*)(sKh + (32 * kt + l31) * 128 + ((c ^ sw) << 4));
                S[kt] = MFMA32(af, vf, S[kt]);
            }
        }
        }
        __syncthreads();
    }
}

DI void phase_combine(const Params& p, int panel) {
    const int tid = get_tid(), lane = tid & 63, w = tid >> 6;
    const bf16_t* OF = (const bf16_t*)(p.ws + R_OF);
    const bf16_t* OB = (const bf16_t*)(p.ws + R_OB);
    const bf16_t* SG = (const bf16_t*)(p.ws + R_SG);
    bf16_t* Y = (bf16_t*)(p.ws + R_YGLA);
    for (int row2 = panel * 256 + w; row2 < panel * 256 + 256; row2 += 16)
#pragma unroll
    for (int rr = 0; rr < 2; ++rr) {
        const int row = row2 + 8 * rr;
        const size_t o = (size_t)row * 1024 + lane * 16;
        const uint4 a0 = *(const uint4*)(OF + o), a1 = *(const uint4*)(OF + o + 8);
        const uint4 b0 = *(const uint4*)(OB + o), b1 = *(const uint4*)(OB + o + 8);
        const uint4 g0 = *(const uint4*)(SG + o), g1 = *(const uint4*)(SG + o + 8);
        const unsigned au[8] = {a0.x, a0.y, a0.z, a0.w, a1.x, a1.y, a1.z, a1.w};
        const unsigned bu[8] = {b0.x, b0.y, b0.z, b0.w, b1.x, b1.y, b1.z, b1.w};
        const unsigned gu[8] = {g0.x, g0.y, g0.z, g0.w, g1.x, g1.y, g1.z, g1.w};
        float v[16]; float ss = 0.f;
#pragma unroll
        for (int e = 0; e < 8; ++e) { v[2 * e] = bflo(au[e]) + bflo(bu[e]); v[2 * e + 1] = bfhi(au[e]) + bfhi(bu[e]); ss += v[2 * e] * v[2 * e] + v[2 * e + 1] * v[2 * e + 1]; }
#pragma unroll
        for (int of = 8; of >= 1; of >>= 1) ss += __shfl_xor(ss, of);
        const float rs = rsqrtf(ss * (1.0f / 256.0f) + EPS);
        const float* gn = p.gla_hn + ((lane * 16) & 255);
        unsigned ou[8];
#pragma unroll
        for (int e = 0; e < 8; ++e) ou[e] = pk2(v[2 * e] * rs * gn[2 * e] * bflo(gu[e]), v[2 * e + 1] * rs * gn[2 * e + 1] * bfhi(gu[e]));
        *(uint4*)(Y + o) = make_uint4(ou[0], ou[1], ou[2], ou[3]);
        *(uint4*)(Y + o + 8) = make_uint4(ou[4], ou[5], ou[6], ou[7]);
    }
}

template <int MODE>
DI void phase_rows(const Params& p, char* smem, int panel) {
    float* md = (float*)smem;
    const int tid = get_tid(), lane = tid & 63, w = tid >> 6;
    const bf16_t* Yin = (const bf16_t*)(p.ws + (MODE == 0 ? R_Y2 : R_Y3));
    bf16_t* H2 = (bf16_t*)(p.ws + R_H2);
    const float* pn = MODE == 0 ? p.post_norm1 : p.post_norm2;
    const float* xsrc = MODE == 0 ? p.x : (const float*)p.out;
    const int r = panel >> 5;
    __syncthreads();
    if (MODE == 0) { load_mod(p, r, 2, md); load_mod(p, r, 3, md + 1024); load_mod(p, r, 4, md + 2048); }
    else load_mod(p, r, 5, md);
    __syncthreads();
    for (int i = 0; i < 16; ++i) {
        const int rows[2] = {panel * 256 + w * 32 + i, panel * 256 + w * 32 + 16 + i};
        uint2 yu[2][4]; f32x4 xv[2][4];
#pragma unroll
        for (int q = 0; q < 2; ++q)
#pragma unroll
            for (int j = 0; j < 4; ++j) {
                yu[q][j] = *(const uint2*)(Yin + (size_t)rows[q] * 1024 + lane * 4 + 256 * j);
                xv[q][j] = *(const f32x4*)(xsrc + (size_t)rows[q] * 1024 + lane * 4 + 256 * j);
            }
        float y[2][16], ss[2] = {0.f, 0.f};
#pragma unroll
        for (int q = 0; q < 2; ++q)
#pragma unroll
            for (int j = 0; j < 4; ++j) {
                y[q][4 * j] = bflo(yu[q][j].x); y[q][4 * j + 1] = bfhi(yu[q][j].x); y[q][4 * j + 2] = bflo(yu[q][j].y); y[q][4 * j + 3] = bfhi(yu[q][j].y);
#pragma unroll
                for (int e = 0; e < 4; ++e) ss[q] += y[q][4 * j + e] * y[q][4 * j + e];
            }
        ss[0] = wave_sum(ss[0]); ss[1] = wave_sum(ss[1]);
        float xn[2][16], s2[2] = {0.f, 0.f};
#pragma unroll
        for (int q = 0; q < 2; ++q) {
            const float rs = rsqrtf(ss[q] * (1.0f / 1024.0f) + EPS);
#pragma unroll
            for (int j = 0; j < 4; ++j) {
                const int col = lane * 4 + 256 * j;
                const f32x4 g = *(const f32x4*)(pn + col), gt = *(const f32x4*)(md + col);
#pragma unroll
                for (int e = 0; e < 4; ++e) { xn[q][4 * j + e] = xv[q][j][e] + gt[e] * (y[q][4 * j + e] * rs * g[e]); s2[q] += xn[q][4 * j + e] * xn[q][4 * j + e]; }
                f32x4 ov = {xn[q][4 * j], xn[q][4 * j + 1], xn[q][4 * j + 2], xn[q][4 * j + 3]};
                *(f32x4*)(p.out + (size_t)rows[q] * 1024 + col) = ov;
            }
        }
        if (MODE == 0) {
            s2[0] = wave_sum(s2[0]); s2[1] = wave_sum(s2[1]);
#pragma unroll
            for (int q = 0; q < 2; ++q) {
                const float rs2 = rsqrtf(s2[q] * (1.0f / 1024.0f) + EPS);
#pragma unroll
                for (int j = 0; j < 4; ++j) {
                    const int col = lane * 4 + 256 * j;
                    const f32x4 g = *(const f32x4*)(p.pre_norm2 + col), sh = *(const f32x4*)(md + 1024 + col), sc = *(const f32x4*)(md + 2048 + col);
                    float o[4];
#pragma unroll
                    for (int e = 0; e < 4; ++e) o[e] = xn[q][4 * j + e] * rs2 * g[e] * (1.f + sc[e]) + sh[e];
                    uint2 u; u.x = pk2(o[0], o[1]); u.y = pk2(o[2], o[3]);
                    *(uint2*)(H2 + (size_t)rows[q] * 1024 + col) = u;
                }
            }
        }
    }
}

DI void gsync(unsigned* bar, unsigned k) {
    __syncthreads();
    const unsigned epoch = k * gridDim.x;
    if (threadIdx.x == 0) {
        __threadfence();
        atomicAdd(bar, 1u);
        while (__hip_atomic_load(bar, __ATOMIC_RELAXED, __HIP_MEMORY_SCOPE_AGENT) < epoch) __builtin_amdgcn_s_sleep(1);
        __threadfence();
    }
    __syncthreads();
}

__global__ void __launch_bounds__(NT) fwd_megakernel(Params p) {
    __shared__ __attribute__((aligned(16))) char smem[131072 + 16384];
    cg::grid_group grid = cg::this_grid();
    char* ws = p.ws;
    unsigned* bar = (unsigned*)(ws + OFF_BAR);
    phase_prep(p, smem);
    grid.sync();
    phase_h(p, smem);
    gsync(bar, 1u);
    {
        EpiIn e; e.Q = (bf16_t*)(ws + R_Q); e.Kk = (bf16_t*)(ws + R_K); e.Vt = (bf16_t*)(ws + R_VT); e.gq = (bf16_t*)(ws + R_GQ); e.gk = (bf16_t*)(ws + R_GK);
        e.gvT = (bf16_t*)(ws + R_GVT); e.sg = (bf16_t*)(ws + R_SG); e.mg = (bf16_t*)p.out; e.glow = (float*)(ws + OFF_GLOW); e.kmax = (float*)(ws + OFF_KMAX);
        {
            const f32x4* src = (const f32x4*)(ws + OFF_ROPE); f32x4* dst = (f32x4*)(smem + 131072);
            for (int i = threadIdx.x; i < 1024; i += NT) dst[i] = src[i];
            __syncthreads();
            e.rope = (const float*)(smem + 131072);
        }
        gemm_phase_ex<true>((const bf16_t*)(ws + R_H), 1024, (const bf16_t*)(ws + OFF_WIN), 1024, 1024, 264, 33, smem, e, blockIdx.x, gridDim.x);
    }
    gsync(bar, 2u);
    phase_attn(p, smem);
    gsync(bar, 3u);
    phase_gate(p, smem);
    gsync(bar, 4u);
    const bool split = gridDim.x >= 192;
    const int nscan = split ? 128 : (int)gridDim.x, oth0 = split ? 128 : 0, noth = (int)gridDim.x - oth0;
    if ((int)blockIdx.x < nscan) { for (int unit = blockIdx.x; unit < 128; unit += nscan) { __syncthreads(); phase_gla(p, smem, unit); } }
    if ((int)blockIdx.x >= oth0) {
        EpiGate0 e0; e0.mg = (bf16_t*)p.out;
        gemm_phase_ex<false>((const bf16_t*)(ws + R_H), 1024, (const bf16_t*)(ws + OFF_WDA), 1024, 1024, 256, 4, smem, e0, blockIdx.x - oth0, noth);
        const long gsz2 = (long)noth * NT, gtid2 = (long)(blockIdx.x - oth0) * NT + get_tid();
        repack<0>(p.w_bgla, 1024, 1024, (bf16_t*)(ws + OFF_WGLA), 1024, gtid2, gsz2);
        repack<0>(p.w_out, 1024, 1024, (bf16_t*)(ws + OFF_WOUT), 1024, gtid2, gsz2);
        repack<0>(p.w_ff1, 1024, 4096, (bf16_t*)(ws + OFF_WFF1), 4096, gtid2, gsz2);
        repack<0>(p.w_ff2, 4096, 1024, (bf16_t*)(ws + OFF_WFF2), 1024, gtid2, gsz2);
    }
    gsync(bar, 5u);
    for (int panel = blockIdx.x; panel < 256; panel += gridDim.x) phase_combine(p, panel);
    gsync(bar, 6u);
    { EpiGate1 e1; e1.Y = (bf16_t*)(ws + R_Y); e1.mg = (const bf16_t*)p.out;
      gemm_phase((const bf16_t*)(ws + R_YGLA), 1024, (const bf16_t*)(ws + OFF_WGLA), 1024, 1024, 256, 4, smem, e1); }
    gsync(bar, 7u);
    { EpiStore<0> e; e.O = (bf16_t*)(ws + R_Y2); e.ldo = 1024;
      gemm_phase((const bf16_t*)(ws + R_Y), 1024, (const bf16_t*)(ws + OFF_WOUT), 1024, 1024, 256, 4, smem, e); }
    gsync(bar, 8u);
    for (int panel = blockIdx.x; panel < 256; panel += gridDim.x) phase_rows<0>(p, smem, panel);
    gsync(bar, 9u);
    { EpiStore<1> e; e.O = (bf16_t*)(ws + R_U); e.ldo = 4096;
      gemm_phase((const bf16_t*)(ws + R_H2), 1024, (const bf16_t*)(ws + OFF_WFF1), 1024, 1024, 256, 16, smem, e); }
    gsync(bar, 10u);
    { EpiStore<0> e; e.O = (bf16_t*)(ws + R_Y3); e.ldo = 1024;
      gemm_phase((const bf16_t*)(ws + R_U), 4096, (const bf16_t*)(ws + OFF_WFF2), 4096, 4096, 256, 4, smem, e); }
    gsync(bar, 11u);
    for (int panel = blockIdx.x; panel < 256; panel += gridDim.x) phase_rows<1>(p, smem, panel);
}

extern "C" void kernel_launch(void* const* d_in, const int* in_sizes, int n_in, void* d_out, int out_size, void* d_ws, size_t ws_size, hipStream_t stream) {
    static int grid_blocks = 0;
    if (!grid_blocks) {
        int dev = 0, cus = 0, per_cu = 0;
        hipGetDevice(&dev);
        hipDeviceGetAttribute(&cus, hipDeviceAttributeMultiprocessorCount, dev);
        hipOccupancyMaxActiveBlocksPerMultiprocessor(&per_cu, fwd_megakernel, NT, 0);
        if (per_cu < 1) per_cu = 1;
        grid_blocks = cus * per_cu;
        if (grid_blocks > 256) grid_blocks = 256;
    }
    Params p{};
    const float* const* in = (const float* const*)d_in;
    p.x = in[0]; p.c = in[1]; p.ctx = in[2]; p.c_ctx = in[3]; p.w_mod = in[4]; p.b_mod = in[5]; p.pre_norm1 = in[6]; p.w_in = in[7];
    p.w_gate_up = in[8]; p.b_gate_up = in[9]; p.lq1 = in[10]; p.lk1 = in[11]; p.lq2 = in[12]; p.lk2 = in[13]; p.da_hn = in[14]; p.gla_hn = in[15];
    p.w_bda = in[16]; p.w_bgla = in[17]; p.w_out = in[18]; p.post_norm1 = in[19]; p.pre_norm2 = in[20]; p.w_ff1 = in[21]; p.w_ff2 = in[22]; p.post_norm2 = in[23];
    p.out = (float*)d_out; p.ws = (char*)d_ws;
    hipMemsetAsync((char*)d_ws + OFF_BAR, 0, 256, stream);
    void* args[] = {&p};
    hipError_t e = hipLaunchCooperativeKernel((void*)fwd_megakernel, dim3(grid_blocks), dim3(NT), args, 0, stream);
    if (e != hipSuccess) fprintf(stderr, "cooperative launch failed: %s (grid %d)\n", hipGetErrorString(e), grid_blocks);
}
```

```cpp
#include <hip/hip_runtime.h>
#include <hip/hip_cooperative_groups.h>
#include <cstdio>
namespace cg = cooperative_groups;

typedef unsigned short bf16_t;
typedef short bf16x8 __attribute__((ext_vector_type(8)));
typedef float f32x16 __attribute__((ext_vector_type(16)));
typedef float f32x4 __attribute__((ext_vector_type(4)));
typedef float f32x2 __attribute__((ext_vector_type(2)));
typedef __bf16 bf2_t __attribute__((ext_vector_type(2)));
typedef _Float16 h4_t __attribute__((ext_vector_type(4)));

#define DI __device__ __forceinline__
#define MFMA32(a, b, c) __builtin_amdgcn_mfma_f32_32x32x16_bf16((a), (b), (c), 0, 0, 0)

constexpr int NT = 512;
constexpr int TLAT = 8192, NB = 8, NLAT = 65536, NROW = 67584, TKV = 8448;
constexpr float EPS = 1e-6f;
constexpr size_t MiB = 1048576;
constexpr size_t OFF_WIN = 0;
constexpr size_t OFF_WDA = OFF_WIN + 8448ull * 1024 * 2;
constexpr size_t OFF_WGLA = OFF_WDA + 2 * MiB;
constexpr size_t OFF_WOUT = OFF_WGLA + 2 * MiB;
constexpr size_t OFF_WFF1 = OFF_WOUT + 2 * MiB;
constexpr size_t OFF_WFF2 = OFF_WFF1 + 8 * MiB;
constexpr size_t OFF_MODP = OFF_WFF2 + 8 * MiB;
constexpr size_t OFF_ROPE = OFF_MODP + 16ull * 9 * 6144 * 4;
constexpr size_t OFF_GLOW = OFF_ROPE + 16384;
constexpr size_t OFF_KMAX = OFF_GLOW + 67584ull * 32 * 4;
constexpr size_t OFF_BAR = OFF_KMAX + 1024;
constexpr size_t R_H = 64 * MiB;
constexpr size_t R_Q = R_H + 132 * MiB;
constexpr size_t R_K = R_Q + 128 * MiB;
constexpr size_t R_VT = R_K + 132 * MiB;
constexpr size_t R_GQ = R_VT + 132 * MiB;
constexpr size_t R_GK = R_GQ + 64 * MiB;
constexpr size_t R_GVT = R_GK + 66 * MiB;
constexpr size_t R_SG = R_GVT + 132 * MiB;
constexpr size_t WS_END = R_SG + 128 * MiB;
static_assert(OFF_BAR + 1024 <= R_H, "small region overflow");
static_assert(WS_END <= 1024 * MiB, "workspace overflow");
constexpr size_t R_BF = R_Q;
constexpr size_t R_BB = R_Q + 66 * MiB;
constexpr size_t R_OF = R_K + 4 * MiB;
constexpr size_t R_OB = R_VT;
constexpr size_t R_YGLA = R_SG;
constexpr size_t R_Y = R_GVT;
constexpr size_t R_Y2 = R_SG;
constexpr size_t R_H2 = R_H;
constexpr size_t R_U = R_Q;
constexpr size_t R_Y3 = R_GVT;

struct Params {
    const float *x, *c, *ctx, *c_ctx, *w_mod, *b_mod, *pre_norm1, *w_in, *w_gate_up, *b_gate_up;
    const float *lq1, *lk1, *lq2, *lk2, *da_hn, *gla_hn, *w_bda, *w_bgla, *w_out, *post_norm1, *pre_norm2, *w_ff1, *w_ff2, *post_norm2;
    float* out;
    char* ws;
};

DI unsigned pk2(float a, float b) { f32x2 v = {a, b}; bf2_t r = __builtin_convertvector(v, bf2_t); return __builtin_bit_cast(unsigned, r); }
DI bf16_t bf1(float a) { __bf16 r = (__bf16)a; return __builtin_bit_cast(unsigned short, r); }
DI float bflo(unsigned v) { return __uint_as_float(v << 16); }
DI float bfhi(unsigned v) { return __uint_as_float(v & 0xffff0000u); }
DI float wave_sum(float v) {
#pragma unroll
    for (int o = 32; o >= 1; o >>= 1) v += __shfl_xor(v, o);
    return v;
}
DI int get_tid() { int t = threadIdx.x; asm volatile("" : "+v"(t)); return t; }
DI float sigmoidf_(float x) { return __builtin_amdgcn_rcpf(1.0f + __expf(-x)); }

template <int MODE>
DI void repack(const float* __restrict__ src, int K, int Nsrc, bf16_t* __restrict__ dst, int Nd, long gtid, long gsz) {
    const long total = (long)Nd * (K / 8);
    for (long it = gtid; it < total; it += gsz) {
        const int n = (int)(it % Nd), kc = (int)(it / Nd);
        int col = n; bool valid = true;
        if (MODE == 1) { if (n < 5120) col = n; else if (n < 8192) col = n + 32; else if (n < 8224) col = n - 8192 + 5120; else valid = false; }
        float v[8];
#pragma unroll
        for (int j = 0; j < 8; ++j) v[j] = valid ? src[(size_t)(kc * 8 + j) * Nsrc + col] : 0.f;
        uint4 o; o.x = pk2(v[0], v[1]); o.y = pk2(v[2], v[3]); o.z = pk2(v[4], v[5]); o.w = pk2(v[6], v[7]);
        *(uint4*)(dst + (size_t)n * K + kc * 8) = o;
    }
}

DI void sincos_acc(float a, float& s, float& c) {
    const float q = rintf(a * 0.63661977236758134f);
    float r = fmaf(-q, 1.5703125f, a); r = fmaf(-q, 4.837512969970703125e-4f, r); r = fmaf(-q, 7.54978995489188216e-8f, r);
    const float r2 = r * r;
    const float sp = r + r * r2 * (-1.6666666666e-1f + r2 * (8.3333333333e-3f + r2 * (-1.98412698e-4f + r2 * 2.7557319e-6f)));
    const float cp = 1.0f + r2 * (-0.5f + r2 * (4.16666666667e-2f + r2 * (-1.38888888889e-3f + r2 * (2.48015873e-5f + r2 * -2.75573192e-7f))));
    const int qi = ((int)q) & 3;
    s = (qi == 0) ? sp : (qi == 1) ? cp : (qi == 2) ? -sp : -cp;
    c = (qi == 0) ? cp : (qi == 1) ? -sp : (qi == 2) ? -cp : sp;
}

DI void phase_prep(const Params& p, char* smem) {
    const int tid = get_tid();
    const long gsz = (long)gridDim.x * NT, gtid = (long)blockIdx.x * NT + tid;
    char* ws = p.ws;
    repack<1>(p.w_in, 1024, 8224, (bf16_t*)(ws + OFF_WIN), 8448, gtid, gsz);
    repack<0>(p.w_bda, 1024, 1024, (bf16_t*)(ws + OFF_WDA), 1024, gtid, gsz);
    if (gtid < 256) ((float*)(ws + OFF_KMAX))[gtid] = 0.f;
    if (gtid < 2048) {
        const int pos = (int)gtid >> 4, f = (int)gtid & 15;
        const float inv = exp2f(-(float)f * (13.287712379549449f / 16.0f));
        float s, c; sincos_acc((float)pos * inv, s, c);
        float* rt = (float*)(ws + OFF_ROPE);
        rt[gtid] = c; rt[2048 + gtid] = s;
    }
    float* sil = (float*)smem;
    float* modp = (float*)(ws + OFF_MODP);
    for (int item = blockIdx.x; item < 192; item += gridDim.x) {
        const int cb = item % 12, ks = item / 12;
        __syncthreads();
        for (int i = tid; i < 9 * 64; i += NT) {
            const int r = i >> 6, kk = i & 63;
            const float v = (r < 8) ? p.c[r * 1024 + ks * 64 + kk] : p.c_ctx[ks * 64 + kk];
            sil[i] = v * sigmoidf_(v);
        }
        __syncthreads();
        const int n = cb * 512 + tid;
        float acc[9];
#pragma unroll
        for (int r = 0; r < 9; ++r) acc[r] = 0.f;
        for (int kk = 0; kk < 64; ++kk) {
            const float w = p.w_mod[(size_t)(ks * 64 + kk) * 6144 + n];
#pragma unroll
            for (int r = 0; r < 9; ++r) acc[r] = fmaf(sil[r * 64 + kk], w, acc[r]);
        }
#pragma unroll
        for (int r = 0; r < 9; ++r) modp[(size_t)(ks * 9 + r) * 6144 + n] = acc[r];
    }
}

DI void load_mod(const Params& p, int r, int which, float* dst) {
    const float* modp = (const float*)(p.ws + OFF_MODP);
    for (int n = threadIdx.x; n < 1024; n += NT) {
        float a = p.b_mod[which * 1024 + n];
#pragma unroll
        for (int ks = 0; ks < 16; ++ks) a += modp[(size_t)(ks * 9 + r) * 6144 + which * 1024 + n];
        dst[n] = a;
    }
}

DI void h_row2(const Params& p, const float* md, bf16_t* H, int rowA, int rowB, int lane) {
    const float* sa = rowA < NLAT ? p.x + (size_t)rowA * 1024 : p.ctx + (size_t)(rowA - NLAT) * 1024;
    const float* sbp = rowB < NLAT ? p.x + (size_t)rowB * 1024 : p.ctx + (size_t)(rowB - NLAT) * 1024;
    f32x4 va[4], vb[4]; float sa2 = 0.f, sb2 = 0.f;
#pragma unroll
    for (int j = 0; j < 4; ++j) { va[j] = *(const f32x4*)(sa + lane * 4 + 256 * j); vb[j] = *(const f32x4*)(sbp + lane * 4 + 256 * j); }
#pragma unroll
    for (int j = 0; j < 4; ++j) {
        sa2 += va[j].x * va[j].x + va[j].y * va[j].y + va[j].z * va[j].z + va[j].w * va[j].w;
        sb2 += vb[j].x * vb[j].x + vb[j].y * vb[j].y + vb[j].z * vb[j].z + vb[j].w * vb[j].w;
    }
    sa2 = wave_sum(sa2); sb2 = wave_sum(sb2);
    const float ra = rsqrtf(sa2 * (1.0f / 1024.0f) + EPS), rb = rsqrtf(sb2 * (1.0f / 1024.0f) + EPS);
#pragma unroll
    for (int j = 0; j < 4; ++j) {
        const int col = lane * 4 + 256 * j;
        const f32x4 g = *(const f32x4*)(p.pre_norm1 + col);
        const f32x4 sh = *(const f32x4*)(md + col), sc = *(const f32x4*)(md + 1024 + col);
        float oa[4], ob[4];
#pragma unroll
        for (int e = 0; e < 4; ++e) { const float gm = g[e] * (1.f + sc[e]); oa[e] = va[j][e] * ra * gm + sh[e]; ob[e] = vb[j][e] * rb * gm + sh[e]; }
        uint2 o; o.x = pk2(oa[0], oa[1]); o.y = pk2(oa[2], oa[3]);
        *(uint2*)(H + (size_t)rowA * 1024 + col) = o;
        o.x = pk2(ob[0], ob[1]); o.y = pk2(ob[2], ob[3]);
        *(uint2*)(H + (size_t)rowB * 1024 + col) = o;
    }
}

DI void phase_h(const Params& p, char* smem) {
    float* md = (float*)smem;
    const int tid = get_tid(), lane = tid & 63, w = tid >> 6;
    bf16_t* H = (bf16_t*)(p.ws + R_H);
    for (int tile = blockIdx.x; tile < 256; tile += gridDim.x) {
        __syncthreads();
        load_mod(p, tile >> 5, 0, md); load_mod(p, tile >> 5, 1, md + 1024);
        __syncthreads();
        for (int i = 0; i < 16; ++i) h_row2(p, md, H, tile * 256 + w * 32 + i, tile * 256 + w * 32 + 16 + i, lane);
    }
    __syncthreads();
    load_mod(p, 8, 0, md); load_mod(p, 8, 1, md + 1024);
    __syncthreads();
    for (int r2 = blockIdx.x * 8 + w; r2 < 1024; r2 += gridDim.x * 8) h_row2(p, md, H, NLAT + 2 * r2, NLAT + 2 * r2 + 1, lane);
}

typedef __attribute__((address_space(3))) unsigned lds_u32;
DI lds_u32* to_lds(const void* p) { return (lds_u32*)(unsigned)(size_t)p; }
#define GLDS16(src, dst) __builtin_amdgcn_global_load_lds((const unsigned*)(src), to_lds(dst), 16, 0, 0)

#define MFMA16(a, b, c) __builtin_amdgcn_mfma_f32_16x16x32_bf16((a), (b), (c), 0, 0, 0)
DI void stage_rc8(int b, int& R, int& C) { const int st = b >> 10, sb = b & 1023, swz = sb ^ (((sb >> 9) & 1) << 5); R = (st >> 1) * 16 + (swz >> 6); C = (st & 1) * 32 + ((swz & 63) >> 1); }
template <bool SWAP, class Epi>
DI void gemm_tile(const bf16_t* A, int lda, const bf16_t* B, int ldb, int K, int m0, int n0, bool, bool, int, int, char* smem, Epi& epi) {
    const int tid = get_tid(), lane = tid & 63, w = tid >> 6, wr = w >> 2, wc = w & 3, fr = lane & 15, fq = lane >> 4;
    f32x4 acc[2][2][4][2];
#pragma unroll
    for (int a = 0; a < 2; ++a)
#pragma unroll
        for (int b = 0; b < 2; ++b)
#pragma unroll
            for (int m = 0; m < 4; ++m)
#pragma unroll
                for (int n = 0; n < 2; ++n) acc[a][b][m][n] = (f32x4){0.f, 0.f, 0.f, 0.f};
    bf16x8 At[4][2], B0[2][2], B1[2][2];
    int R0, C0, R1, C1; stage_rc8(tid * 16, R0, C0); stage_rc8(tid * 16 + 8192, R1, C1);
    const char* Am = (const char*)(A + (size_t)m0 * lda); const char* Bn = (const char*)(B + (size_t)n0 * ldb);
    const unsigned a0 = 2u * (unsigned)(R0 * lda + C0), a1 = 2u * (unsigned)(R1 * lda + C1), b0 = 2u * (unsigned)(R0 * ldb + C0), b1 = 2u * (unsigned)(R1 * ldb + C1);
    const unsigned ahalf = 256u * (unsigned)lda, bhalf = 256u * (unsigned)ldb;
    char* sdst = smem + w * 1024;
    const int loff = (fr * 64 + fq * 16) ^ ((fr >> 3) << 5);
    const int aoff = wr * 8192 + loff, boff = wc * 4096 + loff;
#define SA8(b, h) (((b) * 2 + (h)) * 16384)
#define SB8(b, h) ((4 + (b) * 2 + (h)) * 16384)
#define STAGE_A(b, h, kt_) do { GLDS16(Am + (a0 + (h) * ahalf + (unsigned)(kt_) * 128u), sdst + SA8(b, h)); GLDS16(Am + (a1 + (h) * ahalf + (unsigned)(kt_) * 128u), sdst + SA8(b, h) + 8192); } while (0)
#define STAGE_B(b, h, kt_) do { GLDS16(Bn + (b0 + (h) * bhalf + (unsigned)(kt_) * 128u), sdst + SB8(b, h)); GLDS16(Bn + (b1 + (h) * bhalf + (unsigned)(kt_) * 128u), sdst + SB8(b, h) + 8192); } while (0)
#define LDA8(dst, b, h) do { _Pragma("unroll") for (int m = 0; m < 4; ++m) _Pragma("unroll") for (int k = 0; k < 2; ++k) \
        dst[m][k] = *(const bf16x8*)(smem + SA8(b, h) + aoff + (m * 2 + k) * 1024); } while (0)
#define LDB8(dst, b, h) do { _Pragma("unroll") for (int n = 0; n < 2; ++n) _Pragma("unroll") for (int k = 0; k < 2; ++k) \
        dst[n][k] = *(const bf16x8*)(smem + SB8(b, h) + boff + (n * 2 + k) * 1024); } while (0)
#define MMA8(ai, bj, Af, Bf) do { __builtin_amdgcn_s_setprio(1); \
        _Pragma("unroll") for (int m = 0; m < 4; ++m) _Pragma("unroll") for (int n = 0; n < 2; ++n) _Pragma("unroll") for (int k = 0; k < 2; ++k) \
            acc[ai][bj][m][n] = SWAP ? MFMA16(Af[m][k], Bf[n][k], acc[ai][bj][m][n]) : MFMA16(Bf[n][k], Af[m][k], acc[ai][bj][m][n]); \
        __builtin_amdgcn_s_setprio(0); } while (0)
#define WAIT_V(n) asm volatile("s_waitcnt vmcnt(" #n ")" ::: "memory")
#define WAIT_L(n) asm volatile("s_waitcnt lgkmcnt(" #n ")" ::: "memory")
#define BAR8 __builtin_amdgcn_s_barrier()
#define SCHED8 __builtin_amdgcn_sched_barrier(0)
    const int nt = K >> 6;
    WAIT_V(0);
    STAGE_B(0, 0, 0); STAGE_A(0, 0, 0); STAGE_B(0, 1, 0); STAGE_A(0, 1, 0);
    if (wr == 1) BAR8;
    WAIT_V(4); BAR8;
    STAGE_B(1, 0, 1); STAGE_A(1, 0, 1); STAGE_B(1, 1, 1);
    WAIT_V(6); BAR8;
    for (int t = 0; t < nt - 2; t += 2) {
        LDB8(B0, 0, 0); SCHED8; LDA8(At, 0, 0); STAGE_A(1, 1, t + 1);
        WAIT_L(8); BAR8; WAIT_L(0); MMA8(0, 0, At, B0); BAR8; SCHED8;
        LDB8(B1, 0, 1); STAGE_B(0, 0, t + 2);
        BAR8; WAIT_L(0); MMA8(0, 1, At, B1); BAR8;
        LDA8(At, 0, 1); STAGE_A(0, 0, t + 2);
        BAR8; WAIT_L(0); MMA8(1, 0, At, B0); BAR8; SCHED8;
        STAGE_B(0, 1, t + 2);
        WAIT_V(6); BAR8; MMA8(1, 1, At, B1); BAR8;
        LDB8(B0, 1, 0); SCHED8; LDA8(At, 1, 0); STAGE_A(0, 1, t + 2);
        WAIT_L(8); BAR8; WAIT_L(0); MMA8(0, 0, At, B0); BAR8; SCHED8;
        LDB8(B1, 1, 1); STAGE_B(1, 0, t + 3);
        BAR8; WAIT_L(0); MMA8(0, 1, At, B1); BAR8;
        LDA8(At, 1, 1); STAGE_A(1, 0, t + 3);
        BAR8; WAIT_L(0); MMA8(1, 0, At, B0); BAR8; SCHED8;
        STAGE_B(1, 1, t + 3);
        WAIT_V(6); BAR8; MMA8(1, 1, At, B1); BAR8;
    }
    {
        LDB8(B0, 0, 0); LDA8(At, 0, 0); STAGE_A(1, 1, nt - 1);
        BAR8; WAIT_L(0); MMA8(0, 0, At, B0); BAR8;
        LDB8(B1, 0, 1); BAR8; WAIT_L(0); MMA8(0, 1, At, B1); BAR8;
        LDA8(At, 0, 1); WAIT_V(4); BAR8; WAIT_L(0); MMA8(1, 0, At, B0); MMA8(1, 1, At, B1); BAR8;
    }
    {
        LDB8(B0, 1, 0); LDA8(At, 1, 0); WAIT_V(2); BAR8; WAIT_L(0); MMA8(0, 0, At, B0); BAR8;
        LDB8(B1, 1, 1); WAIT_V(0); BAR8; WAIT_L(0); MMA8(0, 1, At, B1); BAR8;
        LDA8(At, 1, 1); BAR8; WAIT_L(0); MMA8(1, 0, At, B0); MMA8(1, 1, At, B1); BAR8;
    }
    if (wr == 0) BAR8;
#undef SA8
#undef SB8
#undef STAGE_A
#undef STAGE_B
#undef LDA8
#undef LDB8
#undef MMA8
#undef WAIT_V
#undef WAIT_L
#undef BAR8
#undef SCHED8
    const int tid2 = get_tid(), wr2 = (tid2 >> 6) >> 2, wc2 = (tid2 >> 6) & 3, fr2 = tid2 & 15, fq2 = (tid2 & 63) >> 4;
#pragma unroll
    for (int ai = 0; ai < 2; ++ai)
#pragma unroll
        for (int bj = 0; bj < 2; ++bj)
#pragma unroll
            for (int m = 0; m < 4; ++m) {
                if constexpr (SWAP) {
#pragma unroll
                    for (int n = 0; n < 2; ++n) epi.vt(m0 + ai * 128 + wr2 * 64 + m * 16 + 4 * fq2, n0 + bj * 128 + wc2 * 32 + n * 16 + fr2, acc[ai][bj][m][n]);
                } else epi(m0 + ai * 128 + wr2 * 64 + m * 16 + fr2, n0 + bj * 128 + wc2 * 32, acc[ai][bj][m], fq2);
                if (m & 1) asm volatile("" ::: "memory");
            }
}

DI void tile_map(int id, int MT, int NTl, int& mt, int& nt) {
    const int x = id & 7, local = id >> 3, mtx = MT >> 3;
    const int full = mtx >> 2, per = 4 * NTl;
    int patch = local / per, wv = local - patch * per, pm = 4;
    if (patch >= full) { patch = full; wv = local - full * per; pm = mtx - full * 4; }
    const int mo = wv % pm; nt = wv / pm;
    mt = (patch * 4 + mo) * 8 + x;
}

DI void tile_map_in(int id, int& mt, int& nt) {
    if (id < 8448) { tile_map(id, 256, 33, mt, nt); return; }
    const int id2 = id - 8448, k = id2 >> 3;
    mt = 256 + (id2 & 7);
    nt = k < 8 ? 4 + k : k < 10 ? 14 + (k - 8) : k < 14 ? 16 + (k - 10) : 32;
}
template <bool VSWAP, class Epi>
DI void gemm_phase_ex(const bf16_t* A, int lda, const bf16_t* B, int ldb, int K, int MT, int NTl, char* smem, Epi& epi, int bid, int nblk) {
    const int total = VSWAP ? 8448 + 120 : MT * NTl;
    bool first = true;
    for (int id = bid; id < total; id += nblk) {
        int mt, nt, mt2 = 0, nt2 = 0;
        if (VSWAP) tile_map_in(id, mt, nt); else tile_map(id, MT, NTl, mt, nt);
        const bool has_next = id + nblk < total;
        if (has_next) { if (VSWAP) tile_map_in(id + nblk, mt2, nt2); else tile_map(id + nblk, MT, NTl, mt2, nt2); }
        if constexpr (VSWAP) { if (Epi::is_vt(nt)) { gemm_tile<true>(A, lda, B, ldb, K, mt * 256, nt * 256, first, has_next, mt2 * 256, nt2 * 256, smem, epi); first = false; continue; } }
        gemm_tile<false>(A, lda, B, ldb, K, mt * 256, nt * 256, first, has_next, mt2 * 256, nt2 * 256, smem, epi);
        first = false;
    }
}
template <class Epi>
DI void gemm_phase(const bf16_t* A, int lda, const bf16_t* B, int ldb, int K, int MT, int NTl, char* smem, Epi& epi) {
    gemm_phase_ex<false>(A, lda, B, ldb, K, MT, NTl, smem, epi, blockIdx.x, gridDim.x);
}

DI float xhalf_max(float v) {
    typedef unsigned u32x2 __attribute__((ext_vector_type(2)));
    const unsigned u = __float_as_uint(v);
    const u32x2 r = __builtin_amdgcn_permlane32_swap(u, u, false, false);
    return fmaxf(__uint_as_float(r[0]), __uint_as_float(r[1]));
}
DI float xhalf_sum(float v) {
    typedef unsigned u32x2 __attribute__((ext_vector_type(2)));
    const unsigned u = __float_as_uint(v);
    const u32x2 r = __builtin_amdgcn_permlane32_swap(u, u, false, false);
    return __uint_as_float(r[0]) + __uint_as_float(r[1]);
}
template <class Epi>
DI void gemm_panel(const bf16_t* A, int lda, const bf16_t* B, int ldb, int K, int panel, int NTl, char* smem, Epi& epi) {
    for (int nt = 0; nt < NTl; ++nt)
        gemm_tile<false>(A, lda, B, ldb, K, panel * 256, nt * 256, nt == 0, nt + 1 < NTl, panel * 256, (nt + 1) * 256, smem, epi);
}

DI float quad_sum(float v) { v += __shfl_xor(v, 16); v += __shfl_xor(v, 32); return v; }
struct EpiIn {
    bf16_t *Q, *Kk, *Vt, *gq, *gk, *gvT, *sg, *mg; float* glow; const float* rope; float* kmax;
    static DI bool is_vt(int nt) { return (nt >= 8 && nt < 12) || (nt >= 16 && nt < 20); }
    DI void vt(int row0, int col, const f32x4& v) const {
        int b, t;
        if (row0 < NLAT) { b = row0 >> 13; t = row0 & 8191; } else { const int r2 = row0 - NLAT; b = r2 >> 8; t = TLAT + (r2 & 255); }
        bf16_t* dst;
        if (col < 3072) { const int c = col - 2048; dst = Vt + (size_t)((b * 8 + (c >> 7)) * 128 + (c & 127)) * TKV + t; }
        else { const int c = col - 4096; dst = gvT + (size_t)((b * 4 + (c >> 8)) * 256 + (c & 255)) * TKV + t; }
        uint2 u; u.x = pk2(v[0], v[1]); u.y = pk2(v[2], v[3]);
        *(uint2*)dst = u;
    }
    DI void operator()(int row, int cb, const f32x4 (&v)[2], int q) const {
        if (cb >= 8224) return;
        const bool lat = row < NLAT;
        int b, t;
        if (lat) { b = row >> 13; t = row & 8191; } else { const int r2 = row - NLAT; b = r2 >> 8; t = TLAT + (r2 & 255); }
        if (cb < 2048) {
            const bool isq = cb < 1024;
            if (isq && !lat) return;
            const int c = cb & 1023, head = c >> 7, comp = (c >> 6) & 1, half = (c >> 5) & 1;
            f32x4 o[2];
            if (lat) {
                const int pos = half ? (t & 63) : (t >> 6);
                const f32x4 c4 = *(const f32x4*)(rope + pos * 16 + 4 * q), s4 = *(const f32x4*)(rope + 2048 + pos * 16 + 4 * q);
#pragma unroll
                for (int j = 0; j < 4; ++j) {
                    const float x1 = v[0][j], x2 = v[1][j];
                    o[0][j] = x1 * c4[j] - x2 * s4[j];
                    o[1][j] = x2 * c4[j] + x1 * s4[j];
                }
            } else { o[0] = v[0]; o[1] = v[1]; }
            if (!isq) {
                float ssq = 0.f;
#pragma unroll
                for (int j = 0; j < 4; ++j) ssq += o[0][j] * o[0][j] + o[1][j] * o[1][j];
                ssq = quad_sum(ssq);
#pragma unroll
                for (int of = 8; of >= 1; of >>= 1) ssq = fmaxf(ssq, __shfl_xor(ssq, of));
                if ((threadIdx.x & 63) == 0) atomicMax((unsigned*)(kmax + ((b * 8 + head) * 2 + comp) * 2 + half), __float_as_uint(ssq));
            }
            const float scl = isq ? 0.125f * 1.4426950408889634f : 1.0f;
            bf16_t* dst = (isq ? Q + ((size_t)((b * 8 + head) * 2 + comp) * TLAT + t) * 64 : Kk + ((size_t)((b * 8 + head) * 2 + comp) * TKV + t) * 64) + 32 * half;
#pragma unroll
            for (int n = 0; n < 2; ++n) {
                uint2 u; u.x = pk2(o[n][0] * scl, o[n][1] * scl); u.y = pk2(o[n][2] * scl, o[n][3] * scl);
                *(uint2*)(dst + 16 * n + 4 * q) = u;
            }
        } else if (cb < 3072) {
        } else if (cb < 4096) {
            const bool isq = cb < 3584;
            if (isq && !lat) return;
            const int c = (cb - 3072) & 511;
            const float scl = isq ? 0.08838834764831845f : 1.0f;
            bf16_t* dst = (isq ? gq : gk) + (size_t)row * 512 + c;
#pragma unroll
            for (int n = 0; n < 2; ++n) {
                uint2 u; u.x = pk2(v[n][0] * scl, v[n][1] * scl); u.y = pk2(v[n][2] * scl, v[n][3] * scl);
                *(uint2*)(dst + 16 * n + 4 * q) = u;
            }
        } else if (cb < 5120) {
        } else if (cb < 6144) {
            if (!lat) return;
            bf16_t* dst = sg + (size_t)row * 1024 + (cb - 5120);
#pragma unroll
            for (int n = 0; n < 2; ++n) {
                float s[4];
#pragma unroll
                for (int j = 0; j < 4; ++j) { const float xx = v[n][j]; s[j] = xx * sigmoidf_(xx); }
                uint2 u; u.x = pk2(s[0], s[1]); u.y = pk2(s[2], s[3]);
                *(uint2*)(dst + 16 * n + 4 * q) = u;
            }
        } else if (cb < 8192) {
            if (!lat) return;
            bf16_t* dst = mg + (size_t)row * 2048 + (cb - 6144);
#pragma unroll
            for (int n = 0; n < 2; ++n) {
                uint2 u; u.x = pk2(sigmoidf_(v[n][0]), sigmoidf_(v[n][1])); u.y = pk2(sigmoidf_(v[n][2]), sigmoidf_(v[n][3]));
                *(uint2*)(dst + 16 * n + 4 * q) = u;
            }
        } else {
            float* dst = glow + (size_t)row * 32;
#pragma unroll
            for (int n = 0; n < 2; ++n) *(f32x4*)(dst + 16 * n + 4 * q) = v[n];
        }
    }
};

struct EpiGate0 {
    bf16_t* mg;
    DI void operator()(int row, int cb, const f32x4 (&v)[2], int q) const {
#pragma unroll
        for (int n = 0; n < 2; ++n) {
            const int col = cb + 16 * n + 4 * q;
            const uint2 m = *(const uint2*)(mg + (size_t)row * 2048 + col);
            uint2 u; u.x = pk2(v[n][0] * bflo(m.x), v[n][1] * bfhi(m.x)); u.y = pk2(v[n][2] * bflo(m.y), v[n][3] * bfhi(m.y));
            *(uint2*)(mg + (size_t)row * 2048 + col) = u;
        }
    }
};
struct EpiGate1 {
    bf16_t* Y; const bf16_t* mg;
    DI void operator()(int row, int cb, const f32x4 (&v)[2], int q) const {
#pragma unroll
        for (int n = 0; n < 2; ++n) {
            const int col = cb + 16 * n + 4 * q;
            const uint2 m = *(const uint2*)(mg + (size_t)row * 2048 + 1024 + col);
            const uint2 pr = *(const uint2*)(mg + (size_t)row * 2048 + col);
            uint2 u; u.x = pk2(bflo(pr.x) + v[n][0] * bflo(m.x), bfhi(pr.x) + v[n][1] * bfhi(m.x));
            u.y = pk2(bflo(pr.y) + v[n][2] * bflo(m.y), bfhi(pr.y) + v[n][3] * bfhi(m.y));
            *(uint2*)(Y + (size_t)row * 1024 + col) = u;
        }
    }
};
template <int ACT>
struct EpiStore {
    bf16_t* O; int ldo;
    DI void operator()(int row, int cb, const f32x4 (&v)[2], int q) const {
#pragma unroll
        for (int n = 0; n < 2; ++n) {
            float s[4];
#pragma unroll
            for (int j = 0; j < 4; ++j) { float xx = v[n][j]; if (ACT == 1) { xx = fmaxf(xx, 0.f); xx = xx * xx; } s[j] = xx; }
            uint2 u; u.x = pk2(s[0], s[1]); u.y = pk2(s[2], s[3]);
            *(uint2*)(O + (size_t)row * ldo + cb + 16 * n + 4 * q) = u;
        }
    }
};

DI float quad_max(float v) { v = fmaxf(v, __shfl_xor(v, 16)); v = fmaxf(v, __shfl_xor(v, 32)); return v; }
DI bf16x8 pack8(const f32x4& a, const f32x4& b) {
    typedef unsigned u32x4 __attribute__((ext_vector_type(4)));
    const u32x4 u = {pk2(a[0], a[1]), pk2(a[2], a[3]), pk2(b[0], b[1]), pk2(b[2], b[3])};
    return __builtin_bit_cast(bf16x8, u);
}

template <bool FAST>
DI void attn_kloop(char* smem, char* sdst, const bf16_t* gk0, const bf16_t* gk1, const bf16_t* gv, bool first, bool has_next, const bf16_t* ngk0, const bf16_t* ngk1, const bf16_t* ngv,
                   int comp, int krow0, int ksw, int l15, int qd, const bf16x8 (&qf)[2][2], f32x4 (&O)[2][8], float (&m)[2], float (&l)[2]) {
#define ATT_STAGE_P(pk0, pk1, pv, buf, kt_) do { _Pragma("unroll") for (int jj = 0; jj < 2; ++jj) { \
            GLDS16(pk0 + (size_t)((kt_) * 128 + 64 * jj) * 64, sdst + (buf) * 65536 + jj * 8192); \
            GLDS16(pk1 + (size_t)((kt_) * 128 + 64 * jj) * 64, sdst + (buf) * 65536 + 16384 + jj * 8192); } \
            _Pragma("unroll") for (int jj = 0; jj < 4; ++jj) GLDS16(pv + (size_t)(32 * jj) * TKV + (kt_) * 128, sdst + (buf) * 65536 + 32768 + jj * 8192); } while (0)
#define ATT_STAGE(buf, kt_) ATT_STAGE_P(gk0, gk1, gv, buf, kt_)
#define KFRAG(sub_, t_, kd_) (*(const bf16x8*)(skc + (32 * (sub_) + krow0 + 4 * (t_)) * 128 + (((4 * (kd_) + qd) ^ ksw) << 4)))
#define VFRAG(sub_, dt_) (*(const bf16x8*)(sb + 32768 + (16 * (dt_) + l15) * 256 + (((4 * (sub_) + qd) ^ l15) << 4)))
    if (first) {
        ATT_STAGE(0, 0);
        asm volatile("s_waitcnt vmcnt(0)" ::: "memory");
        __syncthreads();
    }
    f32x4 sinit[2], Ls[2];
#pragma unroll
    for (int qt = 0; qt < 2; ++qt) { const float v0 = FAST ? -m[qt] : 0.f; sinit[qt] = (f32x4){v0, v0, v0, v0}; Ls[qt] = (f32x4){0.f, 0.f, 0.f, 0.f}; }
    constexpr int NKT = TKV / 128;
    for (int kt = 0; kt < NKT; ++kt) {
        const int cur = kt & 1;
        if (kt + 1 < NKT) ATT_STAGE(cur ^ 1, kt + 1);
        else if (has_next) ATT_STAGE_P(ngk0, ngk1, ngv, cur ^ 1, 0);
        const char* sb = smem + cur * 65536;
        const char* skc = sb + comp * 16384;
        if (FAST) {
            bf16x8 kf[2][2];
#pragma unroll
            for (int t = 0; t < 2; ++t)
#pragma unroll
                for (int kd = 0; kd < 2; ++kd) kf[t][kd] = KFRAG(0, t, kd);
            f32x4 Sn[2][2];
#pragma unroll
            for (int qt = 0; qt < 2; ++qt)
#pragma unroll
                for (int t = 0; t < 2; ++t) { Sn[qt][t] = MFMA16(kf[t][0], qf[qt][0], sinit[qt]); Sn[qt][t] = MFMA16(kf[t][1], qf[qt][1], Sn[qt][t]); }
            const bf16x8 ones = {0x3F80, 0x3F80, 0x3F80, 0x3F80, 0x3F80, 0x3F80, 0x3F80, 0x3F80};
#pragma unroll
            for (int sub = 0; sub < 4; ++sub) {
                f32x4 Sc[2][2];
#pragma unroll
                for (int qt = 0; qt < 2; ++qt)
#pragma unroll
                    for (int t = 0; t < 2; ++t) Sc[qt][t] = Sn[qt][t];
                bf16x8 va[4], vb[4];
#pragma unroll
                for (int dt = 0; dt < 4; ++dt) va[dt] = VFRAG(sub, dt);
                if (sub < 3) {
#pragma unroll
                    for (int t = 0; t < 2; ++t)
#pragma unroll
                        for (int kd = 0; kd < 2; ++kd) kf[t][kd] = KFRAG(sub + 1, t, kd);
                }
                __builtin_amdgcn_sched_barrier(0);
                bf16x8 pb[2];
#pragma unroll
                for (int qt = 0; qt < 2; ++qt) {
                    f32x4 p0, p1;
#pragma unroll
                    for (int i = 0; i < 4; ++i) { p0[i] = __builtin_amdgcn_exp2f(Sc[qt][0][i]); p1[i] = __builtin_amdgcn_exp2f(Sc[qt][1][i]); }
                    pb[qt] = pack8(p0, p1);
                }
#pragma unroll
                for (int dt = 0; dt < 4; ++dt) vb[dt] = VFRAG(sub, 4 + dt);
                __builtin_amdgcn_sched_barrier(0);
#pragma unroll
                for (int dt = 0; dt < 4; ++dt) {
                    O[0][dt] = MFMA16(va[dt], pb[0], O[0][dt]);
                    O[1][dt] = MFMA16(va[dt], pb[1], O[1][dt]);
                    if (sub < 3) Sn[dt >> 1][dt & 1] = MFMA16(kf[dt & 1][0], qf[dt >> 1][0], sinit[dt >> 1]);
                }
#pragma unroll
                for (int dt = 0; dt < 4; ++dt) {
                    O[0][4 + dt] = MFMA16(vb[dt], pb[0], O[0][4 + dt]);
                    O[1][4 + dt] = MFMA16(vb[dt], pb[1], O[1][4 + dt]);
                    if (sub < 3) Sn[dt >> 1][dt & 1] = MFMA16(kf[dt & 1][1], qf[dt >> 1][1], Sn[dt >> 1][dt & 1]);
                }
                Ls[0] = MFMA16(ones, pb[0], Ls[0]);
                Ls[1] = MFMA16(ones, pb[1], Ls[1]);
            }
        } else {
#pragma unroll 1
            for (int sub = 0; sub < 4; ++sub) {
                f32x4 S[2][2];
#pragma unroll
                for (int qt = 0; qt < 2; ++qt)
#pragma unroll
                    for (int t = 0; t < 2; ++t) { S[qt][t] = MFMA16(KFRAG(sub, t, 0), qf[qt][0], sinit[qt]); S[qt][t] = MFMA16(KFRAG(sub, t, 1), qf[qt][1], S[qt][t]); }
                bf16x8 pb[2];
#pragma unroll
                for (int qt = 0; qt < 2; ++qt) {
                    float mt = fmaxf(fmaxf(fmaxf(S[qt][0][0], S[qt][0][1]), fmaxf(S[qt][0][2], S[qt][0][3])), fmaxf(fmaxf(S[qt][1][0], S[qt][1][1]), fmaxf(S[qt][1][2], S[qt][1][3])));
                    mt = quad_max(mt);
                    if (mt > m[qt]) {
                        const float al = __builtin_amdgcn_exp2f(m[qt] - mt);
                        l[qt] *= al;
#pragma unroll
                        for (int dt = 0; dt < 8; ++dt) O[qt][dt] *= al;
                        m[qt] = mt;
                    }
                    f32x4 p0, p1;
#pragma unroll
                    for (int i = 0; i < 4; ++i) { p0[i] = __builtin_amdgcn_exp2f(S[qt][0][i] - m[qt]); p1[i] = __builtin_amdgcn_exp2f(S[qt][1][i] - m[qt]); l[qt] += p0[i] + p1[i]; }
                    pb[qt] = pack8(p0, p1);
                }
#pragma unroll
                for (int dt = 0; dt < 8; ++dt) {
                    const bf16x8 vf = VFRAG(sub, dt);
                    O[0][dt] = MFMA16(vf, pb[0], O[0][dt]);
                    O[1][dt] = MFMA16(vf, pb[1], O[1][dt]);
                }
            }
        }
        asm volatile("s_waitcnt vmcnt(0)" ::: "memory");
        __syncthreads();
    }
#undef ATT_STAGE
#undef ATT_STAGE_P
#undef KFRAG
#undef VFRAG
    if (FAST) { l[0] = Ls[0][0]; l[1] = Ls[1][0]; }
    else { l[0] = quad_sum(l[0]); l[1] = quad_sum(l[1]); }
}

DI void phase_attn(const Params& p, char* smem) {
    const int tid = get_tid(), lane = tid & 63, w = tid >> 6, l15 = lane & 15, qd = lane >> 4;
    const int g = w >> 1, comp = w & 1;
    const bf16_t* Q = (const bf16_t*)(p.ws + R_Q);
    const bf16_t* Kk = (const bf16_t*)(p.ws + R_K);
    const bf16_t* Vt = (const bf16_t*)(p.ws + R_VT);
    const float* kmax = (const float*)(p.ws + OFF_KMAX);
    bf16_t* YDA = (bf16_t*)(p.ws + R_H);
    float d1 = 0.f, d2 = 0.f;
    for (int i = 0; i < 64; ++i) { d1 += p.lq1[i] * p.lk1[i]; d2 += p.lq2[i] * p.lk2[i]; }
    const float lam = __expf(d1) - __expf(d2) + 0.2f;
    const int krs = 8 * w + (lane >> 3), kcs = (lane & 7) ^ (((lane >> 4) & 1) | ((w & 3) << 1));
    const int vrs = 4 * w + (lane >> 4), vcs = (lane & 15) ^ ((4 * w + (lane >> 4)) & 15);
    const int krow0 = 8 * (l15 >> 2) + (l15 & 3);
    const int ksw = ((l15 >> 1) & 1) | (((l15 >> 2) & 3) << 1);
    float* xbuf = (float*)(smem + 65536) + g * 4096;
    char* sdst = smem + w * 1024;
    for (int id = blockIdx.x; id < 4096; id += gridDim.x) {
        const int x = id & 7, j = id >> 3, bh = (j >> 6) * 8 + x, qti = j & 63;
        const int b = bh >> 3, h = bh & 7;
        bf16x8 qf[2][2];
        float mb[2];
        const float kb = sqrtf(kmax[(bh * 2 + comp) * 2] + kmax[(bh * 2 + comp) * 2 + 1]);
#pragma unroll
        for (int qt = 0; qt < 2; ++qt) {
            const bf16_t* qp = Q + ((size_t)(bh * 2 + comp) * TLAT + qti * 128 + g * 32 + 16 * qt + l15) * 64 + qd * 8;
            qf[qt][0] = *(const bf16x8*)qp; qf[qt][1] = *(const bf16x8*)(qp + 32);
            float qn = 0.f;
#pragma unroll
            for (int kd = 0; kd < 2; ++kd)
#pragma unroll
                for (int e = 0; e < 8; ++e) { const float qv = __uint_as_float(((unsigned)(unsigned short)qf[qt][kd][e]) << 16); qn += qv * qv; }
            qn = quad_sum(qn);
            mb[qt] = sqrtf(qn) * kb * 1.01f + 1e-3f;
        }
        const bf16_t* gk0 = Kk + ((size_t)(bh * 2 + 0) * TKV + krs) * 64 + kcs * 8;
        const bf16_t* gk1 = gk0 + (size_t)TKV * 64;
        const bf16_t* gv = Vt + ((size_t)bh * 128 + vrs) * TKV + vcs * 8;
        const bool first = id == (int)blockIdx.x, has_next = id + (int)gridDim.x < 4096;
        const int nid = has_next ? id + gridDim.x : id, nbh = ((nid >> 3) >> 6) * 8 + (nid & 7);
        const bf16_t* ngk0 = Kk + ((size_t)(nbh * 2 + 0) * TKV + krs) * 64 + kcs * 8;
        const bf16_t* ngk1 = ngk0 + (size_t)TKV * 64;
        const bf16_t* ngv = Vt + ((size_t)nbh * 128 + vrs) * TKV + vcs * 8;
        f32x4 O[2][8];
#pragma unroll
        for (int qt = 0; qt < 2; ++qt)
#pragma unroll
            for (int d = 0; d < 8; ++d) O[qt][d] = (f32x4){0.f, 0.f, 0.f, 0.f};
        float m[2], l[2] = {0.f, 0.f};
        const int slow = __syncthreads_or(!(mb[0] <= 60.0f && mb[1] <= 60.0f));
        if (!slow) { m[0] = mb[0]; m[1] = mb[1]; attn_kloop<true>(smem, sdst, gk0, gk1, gv, first, has_next, ngk0, ngk1, ngv, comp, krow0, ksw, l15, qd, qf, O, m, l); }
        else { m[0] = -INFINITY; m[1] = -INFINITY; attn_kloop<false>(smem, sdst, gk0, gk1, gv, first, has_next, ngk0, ngk1, ngv, comp, krow0, ksw, l15, qd, qf, O, m, l); }
        if (comp == 1) {
#pragma unroll
            for (int qt = 0; qt < 2; ++qt) {
                const float i1 = lam / l[qt];
#pragma unroll
                for (int d = 0; d < 8; ++d)
#pragma unroll
                    for (int i = 0; i < 4; ++i) xbuf[((qt * 8 + d) * 4 + i) * 64 + lane] = O[qt][d][i] * i1;
            }
        }
        __syncthreads();
        if (comp == 0) {
#pragma unroll
            for (int qt = 0; qt < 2; ++qt) {
                const float i0 = 1.0f / l[qt];
                float ss = 0.f;
#pragma unroll
                for (int d = 0; d < 8; ++d)
#pragma unroll
                    for (int i = 0; i < 4; ++i) { const float o = O[qt][d][i] * i0 - xbuf[((qt * 8 + d) * 4 + i) * 64 + lane]; O[qt][d][i] = o; ss += o * o; }
                ss = quad_sum(ss);
                const float rs = rsqrtf(ss * (1.0f / 128.0f) + EPS) * 0.8f;
                const int t = qti * 128 + g * 32 + 16 * qt + l15;
                bf16_t* dst = YDA + ((size_t)b * TLAT + t) * 1024 + h * 128;
#pragma unroll
                for (int d = 0; d < 8; ++d) {
                    const int dv = 16 * d + 4 * qd;
                    const f32x4 hn = *(const f32x4*)(p.da_hn + dv);
                    uint2 u; u.x = pk2(O[qt][d][0] * rs * hn.x, O[qt][d][1] * rs * hn.y); u.y = pk2(O[qt][d][2] * rs * hn.z, O[qt][d][3] * rs * hn.w);
                    *(uint2*)(dst + dv) = u;
                }
            }
        }
    }
}

DI void phase_gate(const Params& p, char* smem) {
    const int tid = get_tid();
    const float* glow = (const float*)(p.ws + OFF_GLOW);
    float* sg = (float*)smem;
    float wf[16], wb[16];
#pragma unroll
    for (int r = 0; r < 16; ++r) { wf[r] = p.w_gate_up[(size_t)r * 512 + tid]; wb[r] = p.w_gate_up[(size_t)(16 + r) * 512 + tid]; }
    const float biasf = p.b_gate_up[tid], biasb = p.b_gate_up[512 + tid];
    _Float16* BF = (_Float16*)(p.ws + R_BF);
    _Float16* BB = (_Float16*)(p.ws + R_BB);
    for (int ch = blockIdx.x; ch < 1056; ch += gridDim.x) {
        __syncthreads();
        *(f32x4*)(sg + tid * 4) = *(const f32x4*)(glow + (size_t)ch * 2048 + tid * 4);
        __syncthreads();
        float run = 0.f;
#pragma unroll 4
        for (int i = 0; i < 64; ++i) {
            const float* gl = sg + i * 32;
            float a = biasf;
#pragma unroll
            for (int r = 0; r < 16; ++r) a = fmaf(gl[r], wf[r], a);
            const float ls = fminf(a, 0.f) - __logf(1.0f + __expf(-fabsf(a)));
            run += ls * (1.4426950408889634f / 16.0f);
            BF[(size_t)(ch * 64 + i) * 512 + tid] = (_Float16)run;
        }
        run = 0.f;
#pragma unroll 4
        for (int i = 63; i >= 0; --i) {
            const float* gl = sg + i * 32 + 16;
            float a = biasb;
#pragma unroll
            for (int r = 0; r < 16; ++r) a = fmaf(gl[r], wb[r], a);
            const float ls = fminf(a, 0.f) - __logf(1.0f + __expf(-fabsf(a)));
            run += ls * (1.4426950408889634f / 16.0f);
            BB[(size_t)(ch * 64 + i) * 512 + tid] = (_Float16)run;
        }
    }
}

struct GlaRegs { uint2 k[2][2], q[2][2], bb[2][2], bl[2][2]; uint4 v[2]; };

DI void phase_gla(const Params& p, char* smem, int unit) {
    const int tid = get_tid(), lane = tid & 63, w = tid >> 6, l31 = lane & 31, hh = lane >> 5;
    const int dir = unit & 1, dvh = (unit >> 1) & 1, bh = unit >> 2, b = bh >> 2, h = bh & 3;
    const bf16_t* gq = (const bf16_t*)(p.ws + R_GQ);
    const bf16_t* gk = (const bf16_t*)(p.ws + R_GK);
    const bf16_t* gvT = (const bf16_t*)(p.ws + R_GVT) + (size_t)(bh * 256 + dvh * 128) * TKV;
    const _Float16* B16 = (const _Float16*)(p.ws + (dir ? R_BB : R_BF));
    bf16_t* Oo = (bf16_t*)(p.ws + (dir ? R_OB : R_OF));
    char* sQt = smem;
    char* sKt = smem + 16384;
    char* sKh = smem + 32768;
    char* sVT = smem + 49152;
    char* sA = smem + 81920;
    float* sD = (float*)(smem + 90112);
    f32x16 S[4];
#pragma unroll
    for (int k = 0; k < 4; ++k)
#pragma unroll
        for (int e = 0; e < 16; ++e) S[k][e] = 0.f;
    const int sw = (l31 >> 1) & 7;
    GlaRegs R;
    auto chunk_info = [&](int step, int& rowbase, int& tcol, bool& emit) {
        if (step < 4) { const int cc = dir ? 3 - step : step; rowbase = NLAT + b * 256 + cc * 64; tcol = TLAT + cc * 64; emit = false; }
        else { const int cc = dir ? 127 - (step - 4) : step - 4; rowbase = b * TLAT + cc * 64; tcol = cc * 64; emit = true; }
    };
    auto load_chunk = [&](int step) {
        int rowbase, tcol; bool emit; chunk_info(step, rowbase, tcol, emit);
        const int rl = rowbase + (dir ? 0 : 63);
#pragma unroll
        for (int i = 0; i < 2; ++i) {
            const int item = tid + NT * i, tok = item >> 4, c = item & 15, d0 = 16 * (c >> 1) + 4 * (c & 1);
            const size_t ro = (size_t)(rowbase + tok) * 512 + h * 128 + d0;
            R.k[i][0] = *(const uint2*)(gk + ro); R.k[i][1] = *(const uint2*)(gk + ro + 8);
            if (emit) { R.q[i][0] = *(const uint2*)(gq + ro); R.q[i][1] = *(const uint2*)(gq + ro + 8); }
            else { R.q[i][0] = make_uint2(0, 0); R.q[i][1] = make_uint2(0, 0); }
            R.bb[i][0] = *(const uint2*)(B16 + ro); R.bb[i][1] = *(const uint2*)(B16 + ro + 8);
            const size_t rlo = (size_t)rl * 512 + h * 128 + d0;
            R.bl[i][0] = *(const uint2*)(B16 + rlo); R.bl[i][1] = *(const uint2*)(B16 + rlo + 8);
        }
#pragma unroll
        for (int i = 0; i < 2; ++i) R.v[i] = *(const uint4*)(gvT + (size_t)((tid >> 3) + 64 * i) * TKV + tcol + (tid & 7) * 8);
    };
    auto stage_chunk = [&]() {
#pragma unroll
        for (int i = 0; i < 2; ++i) {
            const int item = tid + NT * i, tok = item >> 4, c = item & 15, d0 = 16 * (c >> 1) + 4 * (c & 1);
            float qo[8], ko[8];
#pragma unroll
            for (int g = 0; g < 2; ++g) {
                const h4_t bv = __builtin_bit_cast(h4_t, R.bb[i][g]), lv = __builtin_bit_cast(h4_t, R.bl[i][g]);
                const float kk[4] = {bflo(R.k[i][g].x), bfhi(R.k[i][g].x), bflo(R.k[i][g].y), bfhi(R.k[i][g].y)};
                const float qq[4] = {bflo(R.q[i][g].x), bfhi(R.q[i][g].x), bflo(R.q[i][g].y), bfhi(R.q[i][g].y)};
#pragma unroll
                for (int j = 0; j < 4; ++j) {
                    const float bb = (float)bv[j], bl = (float)lv[j];
                    qo[4 * g + j] = qq[j] * __builtin_amdgcn_exp2f(bb);
                    ko[4 * g + j] = kk[j] * __builtin_amdgcn_exp2f(-bb);
                    const float kh = kk[j] * __builtin_amdgcn_exp2f(bl - bb);
                    const int dk = d0 + 8 * g + j;
                    *(bf16_t*)(sKh + dk * 128 + ((((tok >> 3) ^ ((dk >> 1) & 7))) << 4) + (tok & 7) * 2) = bf1(kh);
                }
            }
            const int po = tok * 256 + ((c ^ (tok & 15)) << 4);
            uint4 uq, uk;
            uq.x = pk2(qo[0], qo[1]); uq.y = pk2(qo[2], qo[3]); uq.z = pk2(qo[4], qo[5]); uq.w = pk2(qo[6], qo[7]);
            uk.x = pk2(ko[0], ko[1]); uk.y = pk2(ko[2], ko[3]); uk.z = pk2(ko[4], ko[5]); uk.w = pk2(ko[6], ko[7]);
            *(uint4*)(sQt + po) = uq; *(uint4*)(sKt + po) = uk;
        }
#pragma unroll
        for (int i = 0; i < 2; ++i) {
            const int row = (tid >> 3) + 64 * i, scn = tid & 7;
            *(uint4*)(sVT + row * 128 + ((scn ^ ((row >> 1) & 7)) << 4)) = R.v[i];
        }
        if (tid < 16) {
            const int d0 = 16 * (tid >> 1) + 4 * (tid & 1);
#pragma unroll
            for (int g = 0; g < 2; ++g) {
                const h4_t lv = __builtin_bit_cast(h4_t, R.bl[0][g]);
#pragma unroll
                for (int j = 0; j < 4; ++j) sD[d0 + 8 * g + j] = __builtin_amdgcn_exp2f((float)lv[j]);
            }
        }
    };
    load_chunk(0);
    for (int step = 0; step < 132; ++step) {
        int rowbase, tcol; bool emit; chunk_info(step, rowbase, tcol, emit);
        stage_chunk();
        __syncthreads();
        if (step + 1 < 132) load_chunk(step + 1);
        const int dvb = 32 * (w & 3);
        f32x16 o[2];
        if (emit) {
            if (w >= 4) {
                const int ti = (w - 4) >> 1, tj = (w - 4) & 1;
                f32x16 a;
#pragma unroll
                for (int e = 0; e < 16; ++e) a[e] = 0.f;
                const bool dead = dir ? (tj < ti) : (tj > ti);
                if (!dead) {
#pragma unroll
                    for (int ks = 0; ks < 8; ++ks) {
                        const int ri = 32 * ti + l31, rj = 32 * tj + l31, c = 2 * ks + hh;
                        const bf16x8 af = *(const bf16x8*)(sQt + ri * 256 + ((c ^ (ri & 15)) << 4));
                        const bf16x8 bf = *(const bf16x8*)(sKt + rj * 256 + ((c ^ (rj & 15)) << 4));
                        a = MFMA32(af, bf, a);
                    }
                }
                const int jj = 32 * tj + l31;
#pragma unroll
                for (int e = 0; e < 16; ++e) {
                    const int ii = 32 * ti + (e & 3) + 8 * (e >> 2) + 4 * hh;
                    const bool keep = dir ? (jj >= ii) : (jj <= ii);
                    *(bf16_t*)(sA + ii * 128 + ((((jj >> 3) ^ ((ii >> 1) & 7))) << 4) + (jj & 7) * 2) = bf1(keep ? a[e] : 0.f);
                }
            } else {
#pragma unroll
            for (int mt = 0; mt < 2; ++mt)
#pragma unroll
                for (int e = 0; e < 16; ++e) o[mt][e] = 0.f;
#pragma unroll
            for (int kt = 0; kt < 4; ++kt)
#pragma unroll
                for (int s = 0; s < 2; ++s) {
                    typedef unsigned u32x4 __attribute__((ext_vector_type(4)));
                    u32x4 pu = {pk2(S[kt][8 * s], S[kt][8 * s + 1]), pk2(S[kt][8 * s + 2], S[kt][8 * s + 3]), pk2(S[kt][8 * s + 4], S[kt][8 * s + 5]), pk2(S[kt][8 * s + 6], S[kt][8 * s + 7])};
                    const bf16x8 sf = __builtin_bit_cast(bf16x8, pu);
#pragma unroll
                    for (int mt = 0; mt < 2; ++mt) {
                        const int ri = 32 * mt + l31, c = 4 * kt + 2 * s + hh;
                        const bf16x8 af = *(const bf16x8*)(sQt + ri * 256 + ((c ^ (ri & 15)) << 4));
                        o[mt] = MFMA32(af, sf, o[mt]);
                    }
                }
            }
            __syncthreads();
            if (w < 4) {
#pragma unroll
            for (int s2 = 0; s2 < 4; ++s2) {
                const int c = 2 * s2 + hh;
                const bf16x8 vf = *(const bf16x8*)(sVT + (dvb + l31) * 128 + ((c ^ sw) << 4));
#pragma unroll
                for (int mt = 0; mt < 2; ++mt) {
                    const bf16x8 af = *(const bf16x8*)(sA + (32 * mt + l31) * 128 + ((c ^ sw) << 4));
                    o[mt] = MFMA32(af, vf, o[mt]);
                }
            }
            bf16_t* od = Oo + (size_t)rowbase * 1024 + h * 256 + dvh * 128 + dvb + l31;
#pragma unroll
            for (int mt = 0; mt < 2; ++mt)
#pragma unroll
                for (int e = 0; e < 16; ++e) od[(size_t)(32 * mt + (e & 3) + 8 * (e >> 2) + 4 * hh) * 1024] = bf1(o[mt][e]);
            }
        }
        if (w < 4) {
#pragma unroll
        for (int kt = 0; kt < 4; ++kt)
#pragma unroll
            for (int g4 = 0; g4 < 4; ++g4) {
                const f32x4 dd = *(const f32x4*)(sD + 32 * kt + 8 * g4 + 4 * hh);
#pragma unroll
                for (int jq = 0; jq < 4; ++jq) S[kt][4 * g4 + jq] *= dd[jq];
            }
#pragma unroll
        for (int s2 = 0; s2 < 4; ++s2) {
            const int c = 2 * s2 + hh;
            const bf16x8 vf = *(const bf16x8*)(sVT + (dvb + l31) * 128 + ((c ^ sw) << 4));
#pragma unroll
            for (int kt = 0; kt < 4; ++kt) {
                const bf16x8 af = *(const bf16x8*)(sKh + (32 * kt + l31) * 128 + ((c ^ sw) << 4));
                S[kt] = MFMA32(af, vf, S[kt]);
            }
        }
        }
        __syncthreads();
    }
}

DI void phase_combine(const Params& p, int panel) {
    const int tid = get_tid(), lane = tid & 63, w = tid >> 6;
    const bf16_t* OF = (const bf16_t*)(p.ws + R_OF);
    const bf16_t* OB = (const bf16_t*)(p.ws + R_OB);
    const bf16_t* SG = (const bf16_t*)(p.ws + R_SG);
    bf16_t* Y = (bf16_t*)(p.ws + R_YGLA);
    for (int row2 = panel * 256 + w; row2 < panel * 256 + 256; row2 += 16)
#pragma unroll
    for (int rr = 0; rr < 2; ++rr) {
        const int row = row2 + 8 * rr;
        const size_t o = (size_t)row * 1024 + lane * 16;
        const uint4 a0 = *(const uint4*)(OF + o), a1 = *(const uint4*)(OF + o + 8);
        const uint4 b0 = *(const uint4*)(OB + o), b1 = *(const uint4*)(OB + o + 8);
        const uint4 g0 = *(const uint4*)(SG + o), g1 = *(const uint4*)(SG + o + 8);
        const unsigned au[8] = {a0.x, a0.y, a0.z, a0.w, a1.x, a1.y, a1.z, a1.w};
        const unsigned bu[8] = {b0.x, b0.y, b0.z, b0.w, b1.x, b1.y, b1.z, b1.w};
        const unsigned gu[8] = {g0.x, g0.y, g0.z, g0.w, g1.x, g1.y, g1.z, g1.w};
        float v[16]; float ss = 0.f;
#pragma unroll
        for (int e = 0; e < 8; ++e) { v[2 * e] = bflo(au[e]) + bflo(bu[e]); v[2 * e + 1] = bfhi(au[e]) + bfhi(bu[e]); ss += v[2 * e] * v[2 * e] + v[2 * e + 1] * v[2 * e + 1]; }
#pragma unroll
        for (int of = 8; of >= 1; of >>= 1) ss += __shfl_xor(ss, of);
        const float rs = rsqrtf(ss * (1.0f / 256.0f) + EPS);
        const float* gn = p.gla_hn + ((lane * 16) & 255);
        unsigned ou[8];
#pragma unroll
        for (int e = 0; e < 8; ++e) ou[e] = pk2(v[2 * e] * rs * gn[2 * e] * bflo(gu[e]), v[2 * e + 1] * rs * gn[2 * e + 1] * bfhi(gu[e]));
        *(uint4*)(Y + o) = make_uint4(ou[0], ou[1], ou[2], ou[3]);
        *(uint4*)(Y + o + 8) = make_uint4(ou[4], ou[5], ou[6], ou[7]);
    }
}

template <int MODE>
DI void phase_rows(const Params& p, char* smem, int panel) {
    float* md = (float*)smem;
    const int tid = get_tid(), lane = tid & 63, w = tid >> 6;
    const bf16_t* Yin = (const bf16_t*)(p.ws + (MODE == 0 ? R_Y2 : R_Y3));
    bf16_t* H2 = (bf16_t*)(p.ws + R_H2);
    const float* pn = MODE == 0 ? p.post_norm1 : p.post_norm2;
    const float* xsrc = MODE == 0 ? p.x : (const float*)p.out;
    const int r = panel >> 5;
    __syncthreads();
    if (MODE == 0) { load_mod(p, r, 2, md); load_mod(p, r, 3, md + 1024); load_mod(p, r, 4, md + 2048); }
    else load_mod(p, r, 5, md);
    __syncthreads();
    for (int i = 0; i < 16; ++i) {
        const int rows[2] = {panel * 256 + w * 32 + i, panel * 256 + w * 32 + 16 + i};
        uint2 yu[2][4]; f32x4 xv[2][4];
#pragma unroll
        for (int q = 0; q < 2; ++q)
#pragma unroll
            for (int j = 0; j < 4; ++j) {
                yu[q][j] = *(const uint2*)(Yin + (size_t)rows[q] * 1024 + lane * 4 + 256 * j);
                xv[q][j] = *(const f32x4*)(xsrc + (size_t)rows[q] * 1024 + lane * 4 + 256 * j);
            }
        float y[2][16], ss[2] = {0.f, 0.f};
#pragma unroll
        for (int q = 0; q < 2; ++q)
#pragma unroll
            for (int j = 0; j < 4; ++j) {
                y[q][4 * j] = bflo(yu[q][j].x); y[q][4 * j + 1] = bfhi(yu[q][j].x); y[q][4 * j + 2] = bflo(yu[q][j].y); y[q][4 * j + 3] = bfhi(yu[q][j].y);
#pragma unroll
                for (int e = 0; e < 4; ++e) ss[q] += y[q][4 * j + e] * y[q][4 * j + e];
            }
        ss[0] = wave_sum(ss[0]); ss[1] = wave_sum(ss[1]);
        float xn[2][16], s2[2] = {0.f, 0.f};
#pragma unroll
        for (int q = 0; q < 2; ++q) {
            const float rs = rsqrtf(ss[q] * (1.0f / 1024.0f) + EPS);
#pragma unroll
            for (int j = 0; j < 4; ++j) {
                const int col = lane * 4 + 256 * j;
                const f32x4 g = *(const f32x4*)(pn + col), gt = *(const f32x4*)(md + col);
#pragma unroll
                for (int e = 0; e < 4; ++e) { xn[q][4 * j + e] = xv[q][j][e] + gt[e] * (y[q][4 * j + e] * rs * g[e]); s2[q] += xn[q][4 * j + e] * xn[q][4 * j + e]; }
                f32x4 ov = {xn[q][4 * j], xn[q][4 * j + 1], xn[q][4 * j + 2], xn[q][4 * j + 3]};
                *(f32x4*)(p.out + (size_t)rows[q] * 1024 + col) = ov;
            }
        }
        if (MODE == 0) {
            s2[0] = wave_sum(s2[0]); s2[1] = wave_sum(s2[1]);
#pragma unroll
            for (int q = 0; q < 2; ++q) {
                const float rs2 = rsqrtf(s2[q] * (1.0f / 1024.0f) + EPS);
#pragma unroll
                for (int j = 0; j < 4; ++j) {
                    const int col = lane * 4 + 256 * j;
                    const f32x4 g = *(const f32x4*)(p.pre_norm2 + col), sh = *(const f32x4*)(md + 1024 + col), sc = *(const f32x4*)(md + 2048 + col);
                    float o[4];
#pragma unroll
                    for (int e = 0; e < 4; ++e) o[e] = xn[q][4 * j + e] * rs2 * g[e] * (1.f + sc[e]) + sh[e];
                    uint2 u; u.x = pk2(o[0], o[1]); u.y = pk2(o[2], o[3]);
                    *(uint2*)(H2 + (size_t)rows[q] * 1024 + col) = u;
                }
            }
        }
    }
}

DI void gsync(unsigned* bar, unsigned k) {
    __syncthreads();
    const unsigned epoch = k * gridDim.x;
    if (threadIdx.x == 0) {
        __threadfence();
        atomicAdd(bar, 1u);
        while (__hip_atomic_load(bar, __ATOMIC_RELAXED, __HIP_MEMORY_SCOPE_AGENT) < epoch) __builtin_amdgcn_s_sleep(1);
        __threadfence();
    }
    __syncthreads();
}

__global__ void __launch_bounds__(NT) fwd_megakernel(Params p) {
    __shared__ __attribute__((aligned(16))) char smem[131072 + 16384];
    cg::grid_group grid = cg::this_grid();
    char* ws = p.ws;
    unsigned* bar = (unsigned*)(ws + OFF_BAR);
    phase_prep(p, smem);
    grid.sync();
    phase_h(p, smem);
    gsync(bar, 1u);
    {
        EpiIn e; e.Q = (bf16_t*)(ws + R_Q); e.Kk = (bf16_t*)(ws + R_K); e.Vt = (bf16_t*)(ws + R_VT); e.gq = (bf16_t*)(ws + R_GQ); e.gk = (bf16_t*)(ws + R_GK);
        e.gvT = (bf16_t*)(ws + R_GVT); e.sg = (bf16_t*)(ws + R_SG); e.mg = (bf16_t*)p.out; e.glow = (float*)(ws + OFF_GLOW); e.kmax = (float*)(ws + OFF_KMAX);
        {
            const f32x4* src = (const f32x4*)(ws + OFF_ROPE); f32x4* dst = (f32x4*)(smem + 131072);
            for (int i = threadIdx.x; i < 1024; i += NT) dst[i] = src[i];
            __syncthreads();
            e.rope = (const float*)(smem + 131072);
        }
        gemm_phase_ex<true>((const bf16_t*)(ws + R_H), 1024, (const bf16_t*)(ws + OFF_WIN), 1024, 1024, 264, 33, smem, e, blockIdx.x, gridDim.x);
    }
    gsync(bar, 2u);
    phase_attn(p, smem);
    gsync(bar, 3u);
    phase_gate(p, smem);
    gsync(bar, 4u);
    const bool split = gridDim.x >= 192;
    const int nscan = split ? 128 : (int)gridDim.x, oth0 = split ? 128 : 0, noth = (int)gridDim.x - oth0;
    if ((int)blockIdx.x < nscan) { for (int unit = blockIdx.x; unit < 128; unit += nscan) { __syncthreads(); phase_gla(p, smem, unit); } }
    if ((int)blockIdx.x >= oth0) {
        EpiGate0 e0; e0.mg = (bf16_t*)p.out;
        gemm_phase_ex<false>((const bf16_t*)(ws + R_H), 1024, (const bf16_t*)(ws + OFF_WDA), 1024, 1024, 256, 4, smem, e0, blockIdx.x - oth0, noth);
        const long gsz2 = (long)noth * NT, gtid2 = (long)(blockIdx.x - oth0) * NT + get_tid();
        repack<0>(p.w_bgla, 1024, 1024, (bf16_t*)(ws + OFF_WGLA), 1024, gtid2, gsz2);
        repack<0>(p.w_out, 1024, 1024, (bf16_t*)(ws + OFF_WOUT), 1024, gtid2, gsz2);
        repack<0>(p.w_ff1, 1024, 4096, (bf16_t*)(ws + OFF_WFF1), 4096, gtid2, gsz2);
        repack<0>(p.w_ff2, 4096, 1024, (bf16_t*)(ws + OFF_WFF2), 1024, gtid2, gsz2);
    }
    gsync(bar, 5u);
    for (int panel = blockIdx.x; panel < 256; panel += gridDim.x) phase_combine(p, panel);
    gsync(bar, 6u);
    { EpiGate1 e1; e1.Y = (bf16_t*)(ws + R_Y); e1.mg = (const bf16_t*)p.out;
      gemm_phase((const bf16_t*)(ws + R_YGLA), 1024, (const bf16_t*)(ws + OFF_WGLA), 1024, 1024, 256, 4, smem, e1); }
    gsync(bar, 7u);
    { EpiStore<0> e; e.O = (bf16_t*)(ws + R_Y2); e.ldo = 1024;
      gemm_phase((const bf16_t*)(ws + R_Y), 1024, (const bf16_t*)(ws + OFF_WOUT), 1024, 1024, 256, 4, smem, e); }
    gsync(bar, 8u);
    for (int panel = blockIdx.x; panel < 256; panel += gridDim.x) phase_rows<0>(p, smem, panel);
    gsync(bar, 9u);
    { EpiStore<1> e; e.O = (bf16_t*)(ws + R_U); e.ldo = 4096;
      gemm_phase((const bf16_t*)(ws + R_H2), 1024, (const bf16_t*)(ws + OFF_WFF1), 1024, 1024, 256, 16, smem, e); }
    gsync(bar, 10u);
    { EpiStore<0> e; e.O = (bf16_t*)(ws + R_Y3); e.ldo = 1024;
      gemm_phase((const bf16_t*)(ws + R_U), 4096, (const bf16_t*)(ws + OFF_WFF2), 4096, 4096, 256, 4, smem, e); }
    gsync(bar, 11u);
    for (int panel = blockIdx.x; panel < 256; panel += gridDim.x) phase_rows<1>(p, smem, panel);
}

extern "C" void kernel_launch(void* const* d_in, const int* in_sizes, int n_in, void* d_out, int out_size, void* d_ws, size_t ws_size, hipStream_t stream) {
    static int grid_blocks = 0;
    if (!grid_blocks) {
        int dev = 0, cus = 0, per_cu = 0;
        hipGetDevice(&dev);
        hipDeviceGetAttribute(&cus, hipDeviceAttributeMultiprocessorCount, dev);
        hipOccupancyMaxActiveBlocksPerMultiprocessor(&per_cu, fwd_megakernel, NT, 0);
        if (per_cu < 1) per_cu = 1;
        grid_blocks = cus * per_cu;
        if (grid_blocks > 256) grid_blocks = 256;
    }
    Params p{};
    const float* const* in = (const float* const*)d_in;
    p.x = in[0]; p.c = in[1]; p.ctx = in[2]; p.c_ctx = in[3]; p.w_mod = in[4]; p.b_mod = in[5]; p.pre_norm1 = in[6]; p.w_in = in[7];
    p.w_gate_up = in[8]; p.b_gate_up = in[9]; p.lq1 = in[10]; p.lk1 = in[11]; p.lq2 = in[12]; p.lk2 = in[13]; p.da_hn = in[14]; p.gla_hn = in[15];
    p.w_bda = in[16]; p.w_bgla = in[17]; p.w_out = in[18]; p.post_norm1 = in[19]; p.pre_norm2 = in[20]; p.w_ff1 = in[21]; p.w_ff2 = in[22]; p.post_norm2 = in[23];
    p.out = (float*)d_out; p.ws = (char*)d_ws;
    hipMemsetAsync((char*)d_ws + OFF_BAR, 0, 256, stream);
    void* args[] = {&p};
    hipError_t e = hipLaunchCooperativeKernel((void*)fwd_megakernel, dim3(grid_blocks), dim3(NT), args, 0, stream);
    if (e != hipSuccess) fprintf(stderr, "cooperative launch failed: %s (grid %d)\n", hipGetErrorString(e), grid_blocks);
}
```

```cpp
#include <hip/hip_runtime.h>
#include <hip/hip_cooperative_groups.h>
#include <cstdio>
namespace cg = cooperative_groups;

typedef unsigned short bf16_t;
typedef short bf16x8 __attribute__((ext_vector_type(8)));
typedef float f32x16 __attribute__((ext_vector_type(16)));
typedef float f32x4 __attribute__((ext_vector_type(4)));
typedef float f32x2 __attribute__((ext_vector_type(2)));
typedef __bf16 bf2_t __attribute__((ext_vector_type(2)));
typedef _Float16 h4_t __attribute__((ext_vector_type(4)));

#define DI __device__ __forceinline__
#define MFMA32(a, b, c) __builtin_amdgcn_mfma_f32_32x32x16_bf16((a), (b), (c), 0, 0, 0)

constexpr int NT = 512;
constexpr int TLAT = 8192, NB = 8, NLAT = 65536, NROW = 67584, TKV = 8448;
constexpr float EPS = 1e-6f;
constexpr size_t MiB = 1048576;
constexpr size_t OFF_WIN = 0;
constexpr size_t OFF_WDA = OFF_WIN + 8448ull * 1024 * 2;
constexpr size_t OFF_WGLA = OFF_WDA + 2 * MiB;
constexpr size_t OFF_WOUT = OFF_WGLA + 2 * MiB;
constexpr size_t OFF_WFF1 = OFF_WOUT + 2 * MiB;
constexpr size_t OFF_WFF2 = OFF_WFF1 + 8 * MiB;
constexpr size_t OFF_MODP = OFF_WFF2 + 8 * MiB;
constexpr size_t OFF_ROPE = OFF_MODP + 16ull * 9 * 6144 * 4;
constexpr size_t OFF_GLOW = OFF_ROPE + 16384;
constexpr size_t OFF_KMAX = OFF_GLOW + 67584ull * 32 * 4;
constexpr size_t OFF_BAR = OFF_KMAX + 1024;
constexpr size_t R_H = 64 * MiB;
constexpr size_t R_Q = R_H + 132 * MiB;
constexpr size_t R_K = R_Q + 128 * MiB;
constexpr size_t R_VT = R_K + 132 * MiB;
constexpr size_t R_GQ = R_VT + 132 * MiB;
constexpr size_t R_GK = R_GQ + 64 * MiB;
constexpr size_t R_GVT = R_GK + 66 * MiB;
constexpr size_t R_SG = R_GVT + 132 * MiB;
constexpr size_t WS_END = R_SG + 128 * MiB;
static_assert(OFF_BAR + 1024 <= R_H, "small region overflow");
static_assert(WS_END <= 1024 * MiB, "workspace overflow");
constexpr size_t R_BF = R_Q;
constexpr size_t R_BB = R_Q + 66 * MiB;
constexpr size_t R_OF = R_K + 4 * MiB;
constexpr size_t R_OB = R_VT;
constexpr size_t R_YGLA = R_SG;
constexpr size_t R_Y = R_GVT;
constexpr size_t R_Y2 = R_SG;
constexpr size_t R_H2 = R_H;
constexpr size_t R_U = R_Q;
constexpr size_t R_Y3 = R_GVT;

struct Params {
    const float *x, *c, *ctx, *c_ctx, *w_mod, *b_mod, *pre_norm1, *w_in, *w_gate_up, *b_gate_up;
    const float *lq1, *lk1, *lq2, *lk2, *da_hn, *gla_hn, *w_bda, *w_bgla, *w_out, *post_norm1, *pre_norm2, *w_ff1, *w_ff2, *post_norm2;
    float* out;
    char* ws;
};

DI unsigned pk2(float a, float b) { f32x2 v = {a, b}; bf2_t r = __builtin_convertvector(v, bf2_t); return __builtin_bit_cast(unsigned, r); }
DI bf16_t bf1(float a) { __bf16 r = (__bf16)a; return __builtin_bit_cast(unsigned short, r); }
DI float bflo(unsigned v) { return __uint_as_float(v << 16); }
DI float bfhi(unsigned v) { return __uint_as_float(v & 0xffff0000u); }
DI float wave_sum(float v) {
#pragma unroll
    for (int o = 32; o >= 1; o >>= 1) v += __shfl_xor(v, o);
    return v;
}
DI int get_tid() { int t = threadIdx.x; asm volatile("" : "+v"(t)); return t; }
DI float sigmoidf_(float x) { return __builtin_amdgcn_rcpf(1.0f + __expf(-x)); }

template <int MODE>
DI void repack(const float* __restrict__ src, int K, int Nsrc, bf16_t* __restrict__ dst, int Nd, long gtid, long gsz) {
    const long total = (long)Nd * (K / 8);
    for (long it = gtid; it < total; it += gsz) {
        const int n = (int)(it % Nd), kc = (int)(it / Nd);
        int col = n; bool valid = true;
        if (MODE == 1) { if (n < 5120) col = n; else if (n < 8192) col = n + 32; else if (n < 8224) col = n - 8192 + 5120; else valid = false; }
        float v[8];
#pragma unroll
        for (int j = 0; j < 8; ++j) v[j] = valid ? src[(size_t)(kc * 8 + j) * Nsrc + col] : 0.f;
        uint4 o; o.x = pk2(v[0], v[1]); o.y = pk2(v[2], v[3]); o.z = pk2(v[4], v[5]); o.w = pk2(v[6], v[7]);
        *(uint4*)(dst + (size_t)n * K + kc * 8) = o;
    }
}

DI void sincos_acc(float a, float& s, float& c) {
    const float q = rintf(a * 0.63661977236758134f);
    float r = fmaf(-q, 1.5703125f, a); r = fmaf(-q, 4.837512969970703125e-4f, r); r = fmaf(-q, 7.54978995489188216e-8f, r);
    const float r2 = r * r;
    const float sp = r + r * r2 * (-1.6666666666e-1f + r2 * (8.3333333333e-3f + r2 * (-1.98412698e-4f + r2 * 2.7557319e-6f)));
    const float cp = 1.0f + r2 * (-0.5f + r2 * (4.16666666667e-2f + r2 * (-1.38888888889e-3f + r2 * (2.48015873e-5f + r2 * -2.75573192e-7f))));
    const int qi = ((int)q) & 3;
    s = (qi == 0) ? sp : (qi == 1) ? cp : (qi == 2) ? -sp : -cp;
    c = (qi == 0) ? cp : (qi == 1) ? -sp : (qi == 2) ? -cp : sp;
}

DI void phase_prep(const Params& p, char* smem) {
    const int tid = get_tid();
    const long gsz = (long)gridDim.x * NT, gtid = (long)blockIdx.x * NT + tid;
    char* ws = p.ws;
    repack<1>(p.w_in, 1024, 8224, (bf16_t*)(ws + OFF_WIN), 8448, gtid, gsz);
    repack<0>(p.w_bda, 1024, 1024, (bf16_t*)(ws + OFF_WDA), 1024, gtid, gsz);
    if (gtid < 256) ((float*)(ws + OFF_KMAX))[gtid] = 0.f;
    if (gtid < 2048) {
        const int pos = (int)gtid >> 4, f = (int)gtid & 15;
        const float inv = exp2f(-(float)f * (13.287712379549449f / 16.0f));
        float s, c; sincos_acc((float)pos * inv, s, c);
        float* rt = (float*)(ws + OFF_ROPE);
        rt[gtid] = c; rt[2048 + gtid] = s;
    }
    float* sil = (float*)smem;
    float* modp = (float*)(ws + OFF_MODP);
    for (int item = blockIdx.x; item < 192; item += gridDim.x) {
        const int cb = item % 12, ks = item / 12;
        __syncthreads();
        for (int i = tid; i < 9 * 64; i += NT) {
            const int r = i >> 6, kk = i & 63;
            const float v = (r < 8) ? p.c[r * 1024 + ks * 64 + kk] : p.c_ctx[ks * 64 + kk];
            sil[i] = v * sigmoidf_(v);
        }
        __syncthreads();
        const int n = cb * 512 + tid;
        float acc[9];
#pragma unroll
        for (int r = 0; r < 9; ++r) acc[r] = 0.f;
        for (int kk = 0; kk < 64; ++kk) {
            const float w = p.w_mod[(size_t)(ks * 64 + kk) * 6144 + n];
#pragma unroll
            for (int r = 0; r < 9; ++r) acc[r] = fmaf(sil[r * 64 + kk], w, acc[r]);
        }
#pragma unroll
        for (int r = 0; r < 9; ++r) modp[(size_t)(ks * 9 + r) * 6144 + n] = acc[r];
    }
}

DI void load_mod(const Params& p, int r, int which, float* dst) {
    const float* modp = (const float*)(p.ws + OFF_MODP);
    for (int n = threadIdx.x; n < 1024; n += NT) {
        float a = p.b_mod[which * 1024 + n];
#pragma unroll
        for (int ks = 0; ks < 16; ++ks) a += modp[(size_t)(ks * 9 + r) * 6144 + which * 1024 + n];
        dst[n] = a;
    }
}

DI void h_row2(const Params& p, const float* md, bf16_t* H, int rowA, int rowB, int lane) {
    const float* sa = rowA < NLAT ? p.x + (size_t)rowA * 1024 : p.ctx + (size_t)(rowA - NLAT) * 1024;
    const float* sbp = rowB < NLAT ? p.x + (size_t)rowB * 1024 : p.ctx + (size_t)(rowB - NLAT) * 1024;
    f32x4 va[4], vb[4]; float sa2 = 0.f, sb2 = 0.f;
#pragma unroll
    for (int j = 0; j < 4; ++j) { va[j] = *(const f32x4*)(sa + lane * 4 + 256 * j); vb[j] = *(const f32x4*)(sbp + lane * 4 + 256 * j); }
#pragma unroll
    for (int j = 0; j < 4; ++j) {
        sa2 += va[j].x * va[j].x + va[j].y * va[j].y + va[j].z * va[j].z + va[j].w * va[j].w;
        sb2 += vb[j].x * vb[j].x + vb[j].y * vb[j].y + vb[j].z * vb[j].z + vb[j].w * vb[j].w;
    }
    sa2 = wave_sum(sa2); sb2 = wave_sum(sb2);
    const float ra = rsqrtf(sa2 * (1.0f / 1024.0f) + EPS), rb = rsqrtf(sb2 * (1.0f / 1024.0f) + EPS);
#pragma unroll
    for (int j = 0; j < 4; ++j) {
        const int col = lane * 4 + 256 * j;
        const f32x4 g = *(const f32x4*)(p.pre_norm1 + col);
        const f32x4 sh = *(const f32x4*)(md + col), sc = *(const f32x4*)(md + 1024 + col);
        float oa[4], ob[4];
#pragma unroll
        for (int e = 0; e < 4; ++e) { const float gm = g[e] * (1.f + sc[e]); oa[e] = va[j][e] * ra * gm + sh[e]; ob[e] = vb[j][e] * rb * gm + sh[e]; }
        uint2 o; o.x = pk2(oa[0], oa[1]); o.y = pk2(oa[2], oa[3]);
        *(uint2*)(H + (size_t)rowA * 1024 + col) = o;
        o.x = pk2(ob[0], ob[1]); o.y = pk2(ob[2], ob[3]);
        *(uint2*)(H + (size_t)rowB * 1024 + col) = o;
    }
}

DI void phase_h(const Params& p, char* smem) {
    float* md = (float*)smem;
    const int tid = get_tid(), lane = tid & 63, w = tid >> 6;
    bf16_t* H = (bf16_t*)(p.ws + R_H);
    for (int tile = blockIdx.x; tile < 256; tile += gridDim.x) {
        __syncthreads();
        load_mod(p, tile >> 5, 0, md); load_mod(p, tile >> 5, 1, md + 1024);
        __syncthreads();
        for (int i = 0; i < 16; ++i) h_row2(p, md, H, tile * 256 + w * 32 + i, tile * 256 + w * 32 + 16 + i, lane);
    }
    __syncthreads();
    load_mod(p, 8, 0, md); load_mod(p, 8, 1, md + 1024);
    __syncthreads();
    for (int r2 = blockIdx.x * 8 + w; r2 < 1024; r2 += gridDim.x * 8) h_row2(p, md, H, NLAT + 2 * r2, NLAT + 2 * r2 + 1, lane);
}

typedef __attribute__((address_space(3))) unsigned lds_u32;
DI lds_u32* to_lds(const void* p) { return (lds_u32*)(unsigned)(size_t)p; }
#define GLDS16(src, dst) __builtin_amdgcn_global_load_lds((const unsigned*)(src), to_lds(dst), 16, 0, 0)

#define MFMA16(a, b, c) __builtin_amdgcn_mfma_f32_16x16x32_bf16((a), (b), (c), 0, 0, 0)
DI void stage_rc8(int b, int& R, int& C) { const int st = b >> 10, sb = b & 1023, swz = sb ^ (((sb >> 9) & 1) << 5); R = (st >> 1) * 16 + (swz >> 6); C = (st & 1) * 32 + ((swz & 63) >> 1); }
template <bool SWAP, class Epi>
DI void gemm_tile(const bf16_t* A, int lda, const bf16_t* B, int ldb, int K, int m0, int n0, bool, bool, int, int, char* smem, Epi& epi) {
    const int tid = get_tid(), lane = tid & 63, w = tid >> 6, wr = w >> 2, wc = w & 3, fr = lane & 15, fq = lane >> 4;
    f32x4 acc[2][2][4][2];
#pragma unroll
    for (int a = 0; a < 2; ++a)
#pragma unroll
        for (int b = 0; b < 2; ++b)
#pragma unroll
            for (int m = 0; m < 4; ++m)
#pragma unroll
                for (int n = 0; n < 2; ++n) acc[a][b][m][n] = (f32x4){0.f, 0.f, 0.f, 0.f};
    bf16x8 At[4][2], B0[2][2], B1[2][2];
    int R0, C0, R1, C1; stage_rc8(tid * 16, R0, C0); stage_rc8(tid * 16 + 8192, R1, C1);
    const char* Am = (const char*)(A + (size_t)m0 * lda); const char* Bn = (const char*)(B + (size_t)n0 * ldb);
    const unsigned a0 = 2u * (unsigned)(R0 * lda + C0), a1 = 2u * (unsigned)(R1 * lda + C1), b0 = 2u * (unsigned)(R0 * ldb + C0), b1 = 2u * (unsigned)(R1 * ldb + C1);
    const unsigned ahalf = 256u * (unsigned)lda, bhalf = 256u * (unsigned)ldb;
    char* sdst = smem + w * 1024;
    const int loff = (fr * 64 + fq * 16) ^ ((fr >> 3) << 5);
    const int aoff = wr * 8192 + loff, boff = wc * 4096 + loff;
#define SA8(b, h) (((b) * 2 + (h)) * 16384)
#define SB8(b, h) ((4 + (b) * 2 + (h)) * 16384)
#define STAGE_A(b, h, kt_) do { GLDS16(Am + (a0 + (h) * ahalf + (unsigned)(kt_) * 128u), sdst + SA8(b, h)); GLDS16(Am + (a1 + (h) * ahalf + (unsigned)(kt_) * 128u), sdst + SA8(b, h) + 8192); } while (0)
#define STAGE_B(b, h, kt_) do { GLDS16(Bn + (b0 + (h) * bhalf + (unsigned)(kt_) * 128u), sdst + SB8(b, h)); GLDS16(Bn + (b1 + (h) * bhalf + (unsigned)(kt_) * 128u), sdst + SB8(b, h) + 8192); } while (0)
#define LDA8(dst, b, h) do { _Pragma("unroll") for (int m = 0; m < 4; ++m) _Pragma("unroll") for (int k = 0; k < 2; ++k) \
        dst[m][k] = *(const bf16x8*)(smem + SA8(b, h) + aoff + (m * 2 + k) * 1024); } while (0)
#define LDB8(dst, b, h) do { _Pragma("unroll") for (int n = 0; n < 2; ++n) _Pragma("unroll") for (int k = 0; k < 2; ++k) \
        dst[n][k] = *(const bf16x8*)(smem + SB8(b, h) + boff + (n * 2 + k) * 1024); } while (0)
#define MMA8(ai, bj, Af, Bf) do { __builtin_amdgcn_s_setprio(1); \
        _Pragma("unroll") for (int m = 0; m < 4; ++m) _Pragma("unroll") for (int n = 0; n < 2; ++n) _Pragma("unroll") for (int k = 0; k < 2; ++k) \
            acc[ai][bj][m][n] = SWAP ? MFMA16(Af[m][k], Bf[n][k], acc[ai][bj][m][n]) : MFMA16(Bf[n][k], Af[m][k], acc[ai][bj][m][n]); \
        __builtin_amdgcn_s_setprio(0); } while (0)
#define WAIT_V(n) asm volatile("s_waitcnt vmcnt(" #n ")" ::: "memory")
#define WAIT_L(n) asm volatile("s_waitcnt lgkmcnt(" #n ")" ::: "memory")
#define BAR8 __builtin_amdgcn_s_barrier()
#define SCHED8 __builtin_amdgcn_sched_barrier(0)
    const int nt = K >> 6;
    WAIT_V(0);
    STAGE_B(0, 0, 0); STAGE_A(0, 0, 0); STAGE_B(0, 1, 0); STAGE_A(0, 1, 0);
    if (wr == 1) BAR8;
    WAIT_V(4); BAR8;
    STAGE_B(1, 0, 1); STAGE_A(1, 0, 1); STAGE_B(1, 1, 1);
    WAIT_V(6); BAR8;
    for (int t = 0; t < nt - 2; t += 2) {
        LDB8(B0, 0, 0); SCHED8; LDA8(At, 0, 0); STAGE_A(1, 1, t + 1);
        WAIT_L(8); BAR8; WAIT_L(0); MMA8(0, 0, At, B0); BAR8; SCHED8;
        LDB8(B1, 0, 1); STAGE_B(0, 0, t + 2);
        BAR8; WAIT_L(0); MMA8(0, 1, At, B1); BAR8;
        LDA8(At, 0, 1); STAGE_A(0, 0, t + 2);
        BAR8; WAIT_L(0); MMA8(1, 0, At, B0); BAR8; SCHED8;
        STAGE_B(0, 1, t + 2);
        WAIT_V(6); BAR8; MMA8(1, 1, At, B1); BAR8;
        LDB8(B0, 1, 0); SCHED8; LDA8(At, 1, 0); STAGE_A(0, 1, t + 2);
        WAIT_L(8); BAR8; WAIT_L(0); MMA8(0, 0, At, B0); BAR8; SCHED8;
        LDB8(B1, 1, 1); STAGE_B(1, 0, t + 3);
        BAR8; WAIT_L(0); MMA8(0, 1, At, B1); BAR8;
        LDA8(At, 1, 1); STAGE_A(1, 0, t + 3);
        BAR8; WAIT_L(0); MMA8(1, 0, At, B0); BAR8; SCHED8;
        STAGE_B(1, 1, t + 3);
        WAIT_V(6); BAR8; MMA8(1, 1, At, B1); BAR8;
    }
    {
        LDB8(B0, 0, 0); LDA8(At, 0, 0); STAGE_A(1, 1, nt - 1);
        BAR8; WAIT_L(0); MMA8(0, 0, At, B0); BAR8;
        LDB8(B1, 0, 1); BAR8; WAIT_L(0); MMA8(0, 1, At, B1); BAR8;
        LDA8(At, 0, 1); WAIT_V(4); BAR8; WAIT_L(0); MMA8(1, 0, At, B0); MMA8(1, 1, At, B1); BAR8;
    }
    {
        LDB8(B0, 1, 0); LDA8(At, 1, 0); WAIT_V(2); BAR8; WAIT_L(0); MMA8(0, 0, At, B0); BAR8;
        LDB8(B1, 1, 1); WAIT_V(0); BAR8; WAIT_L(0); MMA8(0, 1, At, B1); BAR8;
        LDA8(At, 1, 1); BAR8; WAIT_L(0); MMA8(1, 0, At, B0); MMA8(1, 1, At, B1); BAR8;
    }
    if (wr == 0) BAR8;
#undef SA8
#undef SB8
#undef STAGE_A
#undef STAGE_B
#undef LDA8
#undef LDB8
#undef MMA8
#undef WAIT_V
#undef WAIT_L
#undef BAR8
#undef SCHED8
    const int tid2 = get_tid(), wr2 = (tid2 >> 6) >> 2, wc2 = (tid2 >> 6) & 3, fr2 = tid2 & 15, fq2 = (tid2 & 63) >> 4;
#pragma unroll
    for (int ai = 0; ai < 2; ++ai)
#pragma unroll
        for (int bj = 0; bj < 2; ++bj)
#pragma unroll
            for (int m = 0; m < 4; ++m) {
                if constexpr (SWAP) {
#pragma unroll
                    for (int n = 0; n < 2; ++n) epi.vt(m0 + ai * 128 + wr2 * 64 + m * 16 + 4 * fq2, n0 + bj * 128 + wc2 * 32 + n * 16 + fr2, acc[ai][bj][m][n]);
                } else epi(m0 + ai * 128 + wr2 * 64 + m * 16 + fr2, n0 + bj * 128 + wc2 * 32, acc[ai][bj][m], fq2);
                if (m & 1) asm volatile("" ::: "memory");
            }
}

DI void tile_map(int id, int MT, int NTl, int& mt, int& nt) {
    const int x = id & 7, local = id >> 3, mtx = MT >> 3;
    const int full = mtx >> 2, per = 4 * NTl;
    int patch = local / per, wv = local - patch * per, pm = 4;
    if (patch >= full) { patch = full; wv = local - full * per; pm = mtx - full * 4; }
    const int mo = wv % pm; nt = wv / pm;
    mt = (patch * 4 + mo) * 8 + x;
}

DI void tile_map_in(int id, int& mt, int& nt) {
    if (id < 8448) { tile_map(id, 256, 33, mt, nt); return; }
    const int id2 = id - 8448, k = id2 >> 3;
    mt = 256 + (id2 & 7);
    nt = k < 8 ? 4 + k : k < 10 ? 14 + (k - 8) : k < 14 ? 16 + (k - 10) : 32;
}
template <bool VSWAP, class Epi>
DI void gemm_phase_ex(const bf16_t* A, int lda, const bf16_t* B, int ldb, int K, int MT, int NTl, char* smem, Epi& epi, int bid, int nblk) {
    const int total = VSWAP ? 8448 + 120 : MT * NTl;
    bool first = true;
    for (int id = bid; id < total; id += nblk) {
        int mt, nt, mt2 = 0, nt2 = 0;
        if (VSWAP) tile_map_in(id, mt, nt); else tile_map(id, MT, NTl, mt, nt);
        const bool has_next = id + nblk < total;
        if (has_next) { if (VSWAP) tile_map_in(id + nblk, mt2, nt2); else tile_map(id + nblk, MT, NTl, mt2, nt2); }
        if constexpr (VSWAP) { if (Epi::is_vt(nt)) { gemm_tile<true>(A, lda, B, ldb, K, mt * 256, nt * 256, first, has_next, mt2 * 256, nt2 * 256, smem, epi); first = false; continue; } }
        gemm_tile<false>(A, lda, B, ldb, K, mt * 256, nt * 256, first, has_next, mt2 * 256, nt2 * 256, smem, epi);
        first = false;
    }
}
template <class Epi>
DI void gemm_phase(const bf16_t* A, int lda, const bf16_t* B, int ldb, int K, int MT, int NTl, char* smem, Epi& epi) {
    gemm_phase_ex<false>(A, lda, B, ldb, K, MT, NTl, smem, epi, blockIdx.x, gridDim.x);
}

DI float xhalf_max(float v) {
    typedef unsigned u32x2 __attribute__((ext_vector_type(2)));
    const unsigned u = __float_as_uint(v);
    const u32x2 r = __builtin_amdgcn_permlane32_swap(u, u, false, false);
    return fmaxf(__uint_as_float(r[0]), __uint_as_float(r[1]));
}
DI float xhalf_sum(float v) {
    typedef unsigned u32x2 __attribute__((ext_vector_type(2)));
    const unsigned u = __float_as_uint(v);
    const u32x2 r = __builtin_amdgcn_permlane32_swap(u, u, false, false);
    return __uint_as_float(r[0]) + __uint_as_float(r[1]);
}
template <class Epi>
DI void gemm_panel(const bf16_t* A, int lda, const bf16_t* B, int ldb, int K, int panel, int NTl, char* smem, Epi& epi) {
    for (int nt = 0; nt < NTl; ++nt)
        gemm_tile<false>(A, lda, B, ldb, K, panel * 256, nt * 256, nt == 0, nt + 1 < NTl, panel * 256, (nt + 1) * 256, smem, epi);
}

DI float quad_sum(float v) { v += __shfl_xor(v, 16); v += __shfl_xor(v, 32); return v; }
struct EpiIn {
    bf16_t *Q, *Kk, *Vt, *gq, *gk, *gvT, *sg, *mg; float* glow; const float* rope; float* kmax;
    static DI bool is_vt(int nt) { return (nt >= 8 && nt < 12) || (nt >= 16 && nt < 20); }
    DI void vt(int row0, int col, const f32x4& v) const {
        int b, t;
        if (row0 < NLAT) { b = row0 >> 13; t = row0 & 8191; } else { const int r2 = row0 - NLAT; b = r2 >> 8; t = TLAT + (r2 & 255); }
        bf16_t* dst;
        if (col < 3072) { const int c = col - 2048; dst = Vt + (size_t)((b * 8 + (c >> 7)) * 128 + (c & 127)) * TKV + t; }
        else { const int c = col - 4096; dst = gvT + (size_t)((b * 4 + (c >> 8)) * 256 + (c & 255)) * TKV + t; }
        uint2 u; u.x = pk2(v[0], v[1]); u.y = pk2(v[2], v[3]);
        *(uint2*)dst = u;
    }
    DI void operator()(int row, int cb, const f32x4 (&v)[2], int q) const {
        if (cb >= 8224) return;
        const bool lat = row < NLAT;
        int b, t;
        if (lat) { b = row >> 13; t = row & 8191; } else { const int r2 = row - NLAT; b = r2 >> 8; t = TLAT + (r2 & 255); }
        if (cb < 2048) {
            const bool isq = cb < 1024;
            if (isq && !lat) return;
            const int c = cb & 1023, head = c >> 7, comp = (c >> 6) & 1, half = (c >> 5) & 1;
            f32x4 o[2];
            if (lat) {
                const int pos = half ? (t & 63) : (t >> 6);
                const f32x4 c4 = *(const f32x4*)(rope + pos * 16 + 4 * q), s4 = *(const f32x4*)(rope + 2048 + pos * 16 + 4 * q);
#pragma unroll
                for (int j = 0; j < 4; ++j) {
                    const float x1 = v[0][j], x2 = v[1][j];
                    o[0][j] = x1 * c4[j] - x2 * s4[j];
                    o[1][j] = x2 * c4[j] + x1 * s4[j];
                }
            } else { o[0] = v[0]; o[1] = v[1]; }
            if (!isq) {
                float ssq = 0.f;
#pragma unroll
                for (int j = 0; j < 4; ++j) ssq += o[0][j] * o[0][j] + o[1][j] * o[1][j];
                ssq = quad_sum(ssq);
#pragma unroll
                for (int of = 8; of >= 1; of >>= 1) ssq = fmaxf(ssq, __shfl_xor(ssq, of));
                if ((threadIdx.x & 63) == 0) atomicMax((unsigned*)(kmax + ((b * 8 + head) * 2 + comp) * 2 + half), __float_as_uint(ssq));
            }
            const float scl = isq ? 0.125f * 1.4426950408889634f : 1.0f;
            bf16_t* dst = (isq ? Q + ((size_t)((b * 8 + head) * 2 + comp) * TLAT + t) * 64 : Kk + ((size_t)((b * 8 + head) * 2 + comp) * TKV + t) * 64) + 32 * half;
#pragma unroll
            for (int n = 0; n < 2; ++n) {
                uint2 u; u.x = pk2(o[n][0] * scl, o[n][1] * scl); u.y = pk2(o[n][2] * scl, o[n][3] * scl);
                *(uint2*)(dst + 16 * n + 4 * q) = u;
            }
        } else if (cb < 3072) {
        } else if (cb < 4096) {
            const bool isq = cb < 3584;
            if (isq && !lat) return;
            const int c = (cb - 3072) & 511;
            const float scl = isq ? 0.08838834764831845f : 1.0f;
            bf16_t* dst = (isq ? gq : gk) + (size_t)row * 512 + c;
#pragma unroll
            for (int n = 0; n < 2; ++n) {
                uint2 u; u.x = pk2(v[n][0] * scl, v[n][1] * scl); u.y = pk2(v[n][2] * scl, v[n][3] * scl);
                *(uint2*)(dst + 16 * n + 4 * q) = u;
            }
        } else if (cb < 5120) {
        } else if (cb < 6144) {
            if (!lat) return;
            bf16_t* dst = sg + (size_t)row * 1024 + (cb - 5120);
#pragma unroll
            for (int n = 0; n < 2; ++n) {
                float s[4];
#pragma unroll
                for (int j = 0; j < 4; ++j) { const float xx = v[n][j]; s[j] = xx * sigmoidf_(xx); }
                uint2 u; u.x = pk2(s[0], s[1]); u.y = pk2(s[2], s[3]);
                *(uint2*)(dst + 16 * n + 4 * q) = u;
            }
        } else if (cb < 8192) {
            if (!lat) return;
            bf16_t* dst = mg + (size_t)row * 2048 + (cb - 6144);
#pragma unroll
            for (int n = 0; n < 2; ++n) {
                uint2 u; u.x = pk2(sigmoidf_(v[n][0]), sigmoidf_(v[n][1])); u.y = pk2(sigmoidf_(v[n][2]), sigmoidf_(v[n][3]));
                *(uint2*)(dst + 16 * n + 4 * q) = u;
            }
        } else {
            float* dst = glow + (size_t)row * 32;
#pragma unroll
            for (int n = 0; n < 2; ++n) *(f32x4*)(dst + 16 * n + 4 * q) = v[n];
        }
    }
};

struct EpiGate0 {
    bf16_t* mg;
    DI void operator()(int row, int cb, const f32x4 (&v)[2], int q) const {
#pragma unroll
        for (int n = 0; n < 2; ++n) {
            const int col = cb + 16 * n + 4 * q;
            const uint2 m = *(const uint2*)(mg + (size_t)row * 2048 + col);
            uint2 u; u.x = pk2(v[n][0] * bflo(m.x), v[n][1] * bfhi(m.x)); u.y = pk2(v[n][2] * bflo(m.y), v[n][3] * bfhi(m.y));
            *(uint2*)(mg + (size_t)row * 2048 + col) = u;
        }
    }
};
struct EpiGate1 {
    bf16_t* Y; const bf16_t* mg;
    DI void operator()(int row, int cb, const f32x4 (&v)[2], int q) const {
#pragma unroll
        for (int n = 0; n < 2; ++n) {
            const int col = cb + 16 * n + 4 * q;
            const uint2 m = *(const uint2*)(mg + (size_t)row * 2048 + 1024 + col);
            const uint2 pr = *(const uint2*)(mg + (size_t)row * 2048 + col);
            uint2 u; u.x = pk2(bflo(pr.x) + v[n][0] * bflo(m.x), bfhi(pr.x) + v[n][1] * bfhi(m.x));
            u.y = pk2(bflo(pr.y) + v[n][2] * bflo(m.y), bfhi(pr.y) + v[n][3] * bfhi(m.y));
            *(uint2*)(Y + (size_t)row * 1024 + col) = u;
        }
    }
};
template <int ACT>
struct EpiStore {
    bf16_t* O; int ldo;
    DI void operator()(int row, int cb, const f32x4 (&v)[2], int q) const {
#pragma unroll
        for (int n = 0; n < 2; ++n) {
            float s[4];
#pragma unroll
            for (int j = 0; j < 4; ++j) { float xx = v[n][j]; if (ACT == 1) { xx = fmaxf(xx, 0.f); xx = xx * xx; } s[j] = xx; }
            uint2 u; u.x = pk2(s[0], s[1]); u.y = pk2(s[2], s[3]);
            *(uint2*)(O + (size_t)row * ldo + cb + 16 * n + 4 * q) = u;
        }
    }
};

DI float quad_max(float v) { v = fmaxf(v, __shfl_xor(v, 16)); v = fmaxf(v, __shfl_xor(v, 32)); return v; }
DI bf16x8 pack8(const f32x4& a, const f32x4& b) {
    typedef unsigned u32x4 __attribute__((ext_vector_type(4)));
    const u32x4 u = {pk2(a[0], a[1]), pk2(a[2], a[3]), pk2(b[0], b[1]), pk2(b[2], b[3])};
    return __builtin_bit_cast(bf16x8, u);
}

template <bool FAST>
DI void attn_kloop(char* smem, char* sdst, const bf16_t* gk0, const bf16_t* gk1, const bf16_t* gv, bool first, bool has_next, const bf16_t* ngk0, const bf16_t* ngk1, const bf16_t* ngv,
                   int comp, int krow0, int ksw, int l15, int qd, const bf16x8 (&qf)[2][2], f32x4 (&O)[2][8], float (&m)[2], float (&l)[2]) {
#define ATT_STAGE_P(pk0, pk1, pv, buf, kt_) do { _Pragma("unroll") for (int jj = 0; jj < 2; ++jj) { \
            GLDS16(pk0 + (size_t)((kt_) * 128 + 64 * jj) * 64, sdst + (buf) * 65536 + jj * 8192); \
            GLDS16(pk1 + (size_t)((kt_) * 128 + 64 * jj) * 64, sdst + (buf) * 65536 + 16384 + jj * 8192); } \
            _Pragma("unroll") for (int jj = 0; jj < 4; ++jj) GLDS16(pv + (size_t)(32 * jj) * TKV + (kt_) * 128, sdst + (buf) * 65536 + 32768 + jj * 8192); } while (0)
#define ATT_STAGE(buf, kt_) ATT_STAGE_P(gk0, gk1, gv, buf, kt_)
#define KFRAG(sub_, t_, kd_) (*(const bf16x8*)(skc + (32 * (sub_) + krow0 + 4 * (t_)) * 128 + (((4 * (kd_) + qd) ^ ksw) << 4)))
#define VFRAG(sub_, dt_) (*(const bf16x8*)(sb + 32768 + (16 * (dt_) + l15) * 256 + (((4 * (sub_) + qd) ^ l15) << 4)))
    if (first) {
        ATT_STAGE(0, 0);
        asm volatile("s_waitcnt vmcnt(0)" ::: "memory");
        __syncthreads();
    }
    const bool late = (threadIdx.x >> 8) != 0;
    f32x4 sinit[2], Ls[2];
#pragma unroll
    for (int qt = 0; qt < 2; ++qt) { const float v0 = FAST ? -m[qt] : 0.f; sinit[qt] = (f32x4){v0, v0, v0, v0}; Ls[qt] = (f32x4){0.f, 0.f, 0.f, 0.f}; }
    constexpr int NKT = TKV / 128;
    for (int kt = 0; kt < NKT; ++kt) {
        const int cur = kt & 1;
        if (kt + 1 < NKT) ATT_STAGE(cur ^ 1, kt + 1);
        else if (has_next) ATT_STAGE_P(ngk0, ngk1, ngv, cur ^ 1, 0);
        const char* sb = smem + cur * 65536;
        const char* skc = sb + comp * 16384;
        if (FAST) {
            bf16x8 kf[2][2];
#pragma unroll
            for (int t = 0; t < 2; ++t)
#pragma unroll
                for (int kd = 0; kd < 2; ++kd) kf[t][kd] = KFRAG(0, t, kd);
            f32x4 Sn[2][2];
#pragma unroll
            for (int qt = 0; qt < 2; ++qt)
#pragma unroll
                for (int t = 0; t < 2; ++t) { Sn[qt][t] = MFMA16(kf[t][0], qf[qt][0], sinit[qt]); Sn[qt][t] = MFMA16(kf[t][1], qf[qt][1], Sn[qt][t]); }
            const bf16x8 ones = {0x3F80, 0x3F80, 0x3F80, 0x3F80, 0x3F80, 0x3F80, 0x3F80, 0x3F80};
#pragma unroll
            for (int sub = 0; sub < 4; ++sub) {
                f32x4 Sc[2][2];
#pragma unroll
                for (int qt = 0; qt < 2; ++qt)
#pragma unroll
                    for (int t = 0; t < 2; ++t) Sc[qt][t] = Sn[qt][t];
                bf16x8 va[4], vb[4];
#pragma unroll
                for (int dt = 0; dt < 4; ++dt) va[dt] = VFRAG(sub, dt);
                if (sub < 3) {
#pragma unroll
                    for (int t = 0; t < 2; ++t)
#pragma unroll
                        for (int kd = 0; kd < 2; ++kd) kf[t][kd] = KFRAG(sub + 1, t, kd);
                }
                __builtin_amdgcn_sched_barrier(0);
                bf16x8 pb[2];
#pragma unroll
                for (int qt = 0; qt < 2; ++qt) {
                    f32x4 p0, p1;
#pragma unroll
                    for (int i = 0; i < 4; ++i) { p0[i] = __builtin_amdgcn_exp2f(Sc[qt][0][i]); p1[i] = __builtin_amdgcn_exp2f(Sc[qt][1][i]); }
                    pb[qt] = pack8(p0, p1);
                }
#pragma unroll
                for (int dt = 0; dt < 4; ++dt) vb[dt] = VFRAG(sub, 4 + dt);
                __builtin_amdgcn_sched_barrier(0);
                if (sub == 3 && late) {
                    asm volatile("s_waitcnt vmcnt(0) lgkmcnt(0)" ::: "memory"); __builtin_amdgcn_s_barrier(); asm volatile("" ::: "memory");
                }
#pragma unroll
                for (int dt = 0; dt < 4; ++dt) {
                    O[0][dt] = MFMA16(va[dt], pb[0], O[0][dt]);
                    O[1][dt] = MFMA16(va[dt], pb[1], O[1][dt]);
                    if (sub < 3) Sn[dt >> 1][dt & 1] = MFMA16(kf[dt & 1][0], qf[dt >> 1][0], sinit[dt >> 1]);
                }
#pragma unroll
                for (int dt = 0; dt < 4; ++dt) {
                    O[0][4 + dt] = MFMA16(vb[dt], pb[0], O[0][4 + dt]);
                    O[1][4 + dt] = MFMA16(vb[dt], pb[1], O[1][4 + dt]);
                    if (sub < 3) Sn[dt >> 1][dt & 1] = MFMA16(kf[dt & 1][1], qf[dt >> 1][1], Sn[dt >> 1][dt & 1]);
                }
                Ls[0] = MFMA16(ones, pb[0], Ls[0]);
                Ls[1] = MFMA16(ones, pb[1], Ls[1]);
            }
        } else {
#pragma unroll 1
            for (int sub = 0; sub < 4; ++sub) {
                f32x4 S[2][2];
#pragma unroll
                for (int qt = 0; qt < 2; ++qt)
#pragma unroll
                    for (int t = 0; t < 2; ++t) { S[qt][t] = MFMA16(KFRAG(sub, t, 0), qf[qt][0], sinit[qt]); S[qt][t] = MFMA16(KFRAG(sub, t, 1), qf[qt][1], S[qt][t]); }
                bf16x8 pb[2];
#pragma unroll
                for (int qt = 0; qt < 2; ++qt) {
                    float mt = fmaxf(fmaxf(fmaxf(S[qt][0][0], S[qt][0][1]), fmaxf(S[qt][0][2], S[qt][0][3])), fmaxf(fmaxf(S[qt][1][0], S[qt][1][1]), fmaxf(S[qt][1][2], S[qt][1][3])));
                    mt = quad_max(mt);
                    if (mt > m[qt]) {
                        const float al = __builtin_amdgcn_exp2f(m[qt] - mt);
                        l[qt] *= al;
#pragma unroll
                        for (int dt = 0; dt < 8; ++dt) O[qt][dt] *= al;
                        m[qt] = mt;
                    }
                    f32x4 p0, p1;
#pragma unroll
                    for (int i = 0; i < 4; ++i) { p0[i] = __builtin_amdgcn_exp2f(S[qt][0][i] - m[qt]); p1[i] = __builtin_amdgcn_exp2f(S[qt][1][i] - m[qt]); l[qt] += p0[i] + p1[i]; }
                    pb[qt] = pack8(p0, p1);
                }
#pragma unroll
                for (int dt = 0; dt < 8; ++dt) {
                    const bf16x8 vf = VFRAG(sub, dt);
                    O[0][dt] = MFMA16(vf, pb[0], O[0][dt]);
                    O[1][dt] = MFMA16(vf, pb[1], O[1][dt]);
                }
            }
        }
        if (!(FAST && late)) { asm volatile("s_waitcnt vmcnt(0) lgkmcnt(0)" ::: "memory"); __builtin_amdgcn_s_barrier(); asm volatile("" ::: "memory"); }
    }
#undef ATT_STAGE
#undef ATT_STAGE_P
#undef KFRAG
#undef VFRAG
    if (FAST) { l[0] = Ls[0][0]; l[1] = Ls[1][0]; }
    else { l[0] = quad_sum(l[0]); l[1] = quad_sum(l[1]); }
}

DI void phase_attn(const Params& p, char* smem) {
    const int tid = get_tid(), lane = tid & 63, w = tid >> 6, l15 = lane & 15, qd = lane >> 4;
    const int g = w >> 1, comp = w & 1;
    const bf16_t* Q = (const bf16_t*)(p.ws + R_Q);
    const bf16_t* Kk = (const bf16_t*)(p.ws + R_K);
    const bf16_t* Vt = (const bf16_t*)(p.ws + R_VT);
    const float* kmax = (const float*)(p.ws + OFF_KMAX);
    bf16_t* YDA = (bf16_t*)(p.ws + R_H);
    float d1 = 0.f, d2 = 0.f;
    for (int i = 0; i < 64; ++i) { d1 += p.lq1[i] * p.lk1[i]; d2 += p.lq2[i] * p.lk2[i]; }
    const float lam = __expf(d1) - __expf(d2) + 0.2f;
    const int krs = 8 * w + (lane >> 3), kcs = (lane & 7) ^ (((lane >> 4) & 1) | ((w & 3) << 1));
    const int vrs = 4 * w + (lane >> 4), vcs = (lane & 15) ^ ((4 * w + (lane >> 4)) & 15);
    const int krow0 = 8 * (l15 >> 2) + (l15 & 3);
    const int ksw = ((l15 >> 1) & 1) | (((l15 >> 2) & 3) << 1);
    float* xbuf = (float*)(smem + 65536) + g * 4096;
    char* sdst = smem + w * 1024;
    for (int id = blockIdx.x; id < 4096; id += gridDim.x) {
        const int x = id & 7, j = id >> 3, bh = (j >> 6) * 8 + x, qti = j & 63;
        const int b = bh >> 3, h = bh & 7;
        bf16x8 qf[2][2];
        float mb[2];
        const float kb = sqrtf(kmax[(bh * 2 + comp) * 2] + kmax[(bh * 2 + comp) * 2 + 1]);
#pragma unroll
        for (int qt = 0; qt < 2; ++qt) {
            const bf16_t* qp = Q + ((size_t)(bh * 2 + comp) * TLAT + qti * 128 + g * 32 + 16 * qt + l15) * 64 + qd * 8;
            qf[qt][0] = *(const bf16x8*)qp; qf[qt][1] = *(const bf16x8*)(qp + 32);
            float qn = 0.f;
#pragma unroll
            for (int kd = 0; kd < 2; ++kd)
#pragma unroll
                for (int e = 0; e < 8; ++e) { const float qv = __uint_as_float(((unsigned)(unsigned short)qf[qt][kd][e]) << 16); qn += qv * qv; }
            qn = quad_sum(qn);
            mb[qt] = sqrtf(qn) * kb * 1.01f + 1e-3f;
        }
        const bf16_t* gk0 = Kk + ((size_t)(bh * 2 + 0) * TKV + krs) * 64 + kcs * 8;
        const bf16_t* gk1 = gk0 + (size_t)TKV * 64;
        const bf16_t* gv = Vt + ((size_t)bh * 128 + vrs) * TKV + vcs * 8;
        const bool first = id == (int)blockIdx.x, has_next = id + (int)gridDim.x < 4096;
        const int nid = has_next ? id + gridDim.x : id, nbh = ((nid >> 3) >> 6) * 8 + (nid & 7);
        const bf16_t* ngk0 = Kk + ((size_t)(nbh * 2 + 0) * TKV + krs) * 64 + kcs * 8;
        const bf16_t* ngk1 = ngk0 + (size_t)TKV * 64;
        const bf16_t* ngv = Vt + ((size_t)nbh * 128 + vrs) * TKV + vcs * 8;
        f32x4 O[2][8];
#pragma unroll
        for (int qt = 0; qt < 2; ++qt)
#pragma unroll
            for (int d = 0; d < 8; ++d) O[qt][d] = (f32x4){0.f, 0.f, 0.f, 0.f};
        float m[2], l[2] = {0.f, 0.f};
        const int slow = __syncthreads_or(!(mb[0] <= 60.0f && mb[1] <= 60.0f));
        if (!slow) { m[0] = mb[0]; m[1] = mb[1]; attn_kloop<true>(smem, sdst, gk0, gk1, gv, first, has_next, ngk0, ngk1, ngv, comp, krow0, ksw, l15, qd, qf, O, m, l); }
        else { m[0] = -INFINITY; m[1] = -INFINITY; attn_kloop<false>(smem, sdst, gk0, gk1, gv, first, has_next, ngk0, ngk1, ngv, comp, krow0, ksw, l15, qd, qf, O, m, l); }
        if (comp == 1) {
#pragma unroll
            for (int qt = 0; qt < 2; ++qt) {
                const float i1 = lam / l[qt];
#pragma unroll
                for (int d = 0; d < 8; ++d)
#pragma unroll
                    for (int i = 0; i < 4; ++i) xbuf[((qt * 8 + d) * 4 + i) * 64 + lane] = O[qt][d][i] * i1;
            }
        }
        __syncthreads();
        if (comp == 0) {
#pragma unroll
            for (int qt = 0; qt < 2; ++qt) {
                const float i0 = 1.0f / l[qt];
                float ss = 0.f;
#pragma unroll
                for (int d = 0; d < 8; ++d)
#pragma unroll
                    for (int i = 0; i < 4; ++i) { const float o = O[qt][d][i] * i0 - xbuf[((qt * 8 + d) * 4 + i) * 64 + lane]; O[qt][d][i] = o; ss += o * o; }
                ss = quad_sum(ss);
                const float rs = rsqrtf(ss * (1.0f / 128.0f) + EPS) * 0.8f;
                const int t = qti * 128 + g * 32 + 16 * qt + l15;
                bf16_t* dst = YDA + ((size_t)b * TLAT + t) * 1024 + h * 128;
#pragma unroll
                for (int d = 0; d < 8; ++d) {
                    const int dv = 16 * d + 4 * qd;
                    const f32x4 hn = *(const f32x4*)(p.da_hn + dv);
                    uint2 u; u.x = pk2(O[qt][d][0] * rs * hn.x, O[qt][d][1] * rs * hn.y); u.y = pk2(O[qt][d][2] * rs * hn.z, O[qt][d][3] * rs * hn.w);
                    *(uint2*)(dst + dv) = u;
                }
            }
        }
    }
}

DI void phase_gate(const Params& p, char* smem) {
    const int tid = get_tid();
    const float* glow = (const float*)(p.ws + OFF_GLOW);
    float* sg = (float*)smem;
    float wf[16], wb[16];
#pragma unroll
    for (int r = 0; r < 16; ++r) { wf[r] = p.w_gate_up[(size_t)r * 512 + tid]; wb[r] = p.w_gate_up[(size_t)(16 + r) * 512 + tid]; }
    const float biasf = p.b_gate_up[tid], biasb = p.b_gate_up[512 + tid];
    _Float16* BF = (_Float16*)(p.ws + R_BF);
    _Float16* BB = (_Float16*)(p.ws + R_BB);
    for (int ch = blockIdx.x; ch < 1056; ch += gridDim.x) {
        __syncthreads();
        *(f32x4*)(sg + tid * 4) = *(const f32x4*)(glow + (size_t)ch * 2048 + tid * 4);
        __syncthreads();
        float run = 0.f;
#pragma unroll 4
        for (int i = 0; i < 64; ++i) {
            const float* gl = sg + i * 32;
            float a = biasf;
#pragma unroll
            for (int r = 0; r < 16; ++r) a = fmaf(gl[r], wf[r], a);
            const float ls = fminf(a, 0.f) - __logf(1.0f + __expf(-fabsf(a)));
            run += ls * (1.4426950408889634f / 16.0f);
            BF[(size_t)(ch * 64 + i) * 512 + tid] = (_Float16)run;
        }
        run = 0.f;
#pragma unroll 4
        for (int i = 63; i >= 0; --i) {
            const float* gl = sg + i * 32 + 16;
            float a = biasb;
#pragma unroll
            for (int r = 0; r < 16; ++r) a = fmaf(gl[r], wb[r], a);
            const float ls = fminf(a, 0.f) - __logf(1.0f + __expf(-fabsf(a)));
            run += ls * (1.4426950408889634f / 16.0f);
            BB[(size_t)(ch * 64 + i) * 512 + tid] = (_Float16)run;
        }
    }
}

struct GlaRegs { uint2 k[2][2], q[2][2], bb[2][2], bl[2][2]; uint4 v[2]; };

DI void phase_gla(const Params& p, char* smem, int unit) {
    const int tid = get_tid(), lane = tid & 63, w = tid >> 6, l31 = lane & 31, hh = lane >> 5;
    const int dir = unit & 1, dvh = (unit >> 1) & 1, bh = unit >> 2, b = bh >> 2, h = bh & 3;
    const bf16_t* gq = (const bf16_t*)(p.ws + R_GQ);
    const bf16_t* gk = (const bf16_t*)(p.ws + R_GK);
    const bf16_t* gvT = (const bf16_t*)(p.ws + R_GVT) + (size_t)(bh * 256 + dvh * 128) * TKV;
    const _Float16* B16 = (const _Float16*)(p.ws + (dir ? R_BB : R_BF));
    bf16_t* Oo = (bf16_t*)(p.ws + (dir ? R_OB : R_OF));
    char* sQt = smem;
    char* sKt = smem + 16384;
    char* sKh = smem + 32768;
    char* sVT = smem + 49152;
    char* sA = smem + 81920;
    float* sD = (float*)(smem + 90112);
    f32x16 S[4];
#pragma unroll
    for (int k = 0; k < 4; ++k)
#pragma unroll
        for (int e = 0; e < 16; ++e) S[k][e] = 0.f;
    const int sw = (l31 >> 1) & 7;
    GlaRegs R;
    auto chunk_info = [&](int step, int& rowbase, int& tcol, bool& emit) {
        if (step < 4) { const int cc = dir ? 3 - step : step; rowbase = NLAT + b * 256 + cc * 64; tcol = TLAT + cc * 64; emit = false; }
        else { const int cc = dir ? 127 - (step - 4) : step - 4; rowbase = b * TLAT + cc * 64; tcol = cc * 64; emit = true; }
    };
    auto load_chunk = [&](int step) {
        int rowbase, tcol; bool emit; chunk_info(step, rowbase, tcol, emit);
        const int rl = rowbase + (dir ? 0 : 63);
#pragma unroll
        for (int i = 0; i < 2; ++i) {
            const int item = tid + NT * i, tok = item >> 4, c = item & 15, d0 = 16 * (c >> 1) + 4 * (c & 1);
            const size_t ro = (size_t)(rowbase + tok) * 512 + h * 128 + d0;
            R.k[i][0] = *(const uint2*)(gk + ro); R.k[i][1] = *(const uint2*)(gk + ro + 8);
            if (emit) { R.q[i][0] = *(const uint2*)(gq + ro); R.q[i][1] = *(const uint2*)(gq + ro + 8); }
            else { R.q[i][0] = make_uint2(0, 0); R.q[i][1] = make_uint2(0, 0); }
            R.bb[i][0] = *(const uint2*)(B16 + ro); R.bb[i][1] = *(const uint2*)(B16 + ro + 8);
            const size_t rlo = (size_t)rl * 512 + h * 128 + d0;
            R.bl[i][0] = *(const uint2*)(B16 + rlo); R.bl[i][1] = *(const uint2*)(B16 + rlo + 8);
        }
#pragma unroll
        for (int i = 0; i < 2; ++i) R.v[i] = *(const uint4*)(gvT + (size_t)((tid >> 3) + 64 * i) * TKV + tcol + (tid & 7) * 8);
    };
    auto stage_chunk = [&]() {
#pragma unroll
        for (int i = 0; i < 2; ++i) {
            const int item = tid + NT * i, tok = item >> 4, c = item & 15, d0 = 16 * (c >> 1) + 4 * (c & 1);
            float qo[8], ko[8];
#pragma unroll
            for (int g = 0; g < 2; ++g) {
                const h4_t bv = __builtin_bit_cast(h4_t, R.bb[i][g]), lv = __builtin_bit_cast(h4_t, R.bl[i][g]);
                const float kk[4] = {bflo(R.k[i][g].x), bfhi(R.k[i][g].x), bflo(R.k[i][g].y), bfhi(R.k[i][g].y)};
                const float qq[4] = {bflo(R.q[i][g].x), bfhi(R.q[i][g].x), bflo(R.q[i][g].y), bfhi(R.q[i][g].y)};
#pragma unroll
                for (int j = 0; j < 4; ++j) {
                    const float bb = (float)bv[j], bl = (float)lv[j];
                    qo[4 * g + j] = qq[j] * __builtin_amdgcn_exp2f(bb);
                    ko[4 * g + j] = kk[j] * __builtin_amdgcn_exp2f(-bb);
                    const float kh = kk[j] * __builtin_amdgcn_exp2f(bl - bb);
                    const int dk = d0 + 8 * g + j;
                    *(bf16_t*)(sKh + dk * 128 + ((((tok >> 3) ^ ((dk >> 1) & 7))) << 4) + (tok & 7) * 2) = bf1(kh);
                }
            }
            const int po = tok * 256 + ((c ^ (tok & 15)) << 4);
            uint4 uq, uk;
            uq.x = pk2(qo[0], qo[1]); uq.y = pk2(qo[2], qo[3]); uq.z = pk2(qo[4], qo[5]); uq.w = pk2(qo[6], qo[7]);
            uk.x = pk2(ko[0], ko[1]); uk.y = pk2(ko[2], ko[3]); uk.z = pk2(ko[4], ko[5]); uk.w = pk2(ko[6], ko[7]);
            *(uint4*)(sQt + po) = uq; *(uint4*)(sKt + po) = uk;
        }
#pragma unroll
        for (int i = 0; i < 2; ++i) {
            const int row = (tid >> 3) + 64 * i, scn = tid & 7;
            *(uint4*)(sVT + row * 128 + ((scn ^ ((row >> 1) & 7)) << 4)) = R.v[i];
        }
        if (tid < 16) {
            const int d0 = 16 * (tid >> 1) + 4 * (tid & 1);
#pragma unroll
            for (int g = 0; g < 2; ++g) {
                const h4_t lv = __builtin_bit_cast(h4_t, R.bl[0][g]);
#pragma unroll
                for (int j = 0; j < 4; ++j) sD[d0 + 8 * g + j] = __builtin_amdgcn_exp2f((float)lv[j]);
            }
        }
    };
    load_chunk(0);
    for (int step = 0; step < 132; ++step) {
        int rowbase, tcol; bool emit; chunk_info(step, rowbase, tcol, emit);
        stage_chunk();
        __syncthreads();
        if (step + 1 < 132) load_chunk(step + 1);
        const int dvb = 32 * (w & 3);
        f32x16 o[2];
        if (emit) {
            if (w >= 4) {
                const int ti = (w - 4) >> 1, tj = (w - 4) & 1;
                f32x16 a;
#pragma unroll
                for (int e = 0; e < 16; ++e) a[e] = 0.f;
                const bool dead = dir ? (tj < ti) : (tj > ti);
                if (!dead) {
#pragma unroll
                    for (int ks = 0; ks < 8; ++ks) {
                        const int ri = 32 * ti + l31, rj = 32 * tj + l31, c = 2 * ks + hh;
                        const bf16x8 af = *(const bf16x8*)(sQt + ri * 256 + ((c ^ (ri & 15)) << 4));
                        const bf16x8 bf = *(const bf16x8*)(sKt + rj * 256 + ((c ^ (rj & 15)) << 4));
                        a = MFMA32(af, bf, a);
                    }
                }
                const int jj = 32 * tj + l31;
#pragma unroll
                for (int e = 0; e < 16; ++e) {
                    const int ii = 32 * ti + (e & 3) + 8 * (e >> 2) + 4 * hh;
                    const bool keep = dir ? (jj >= ii) : (jj <= ii);
                    *(bf16_t*)(sA + ii * 128 + ((((jj >> 3) ^ ((ii >> 1) & 7))) << 4) + (jj & 7) * 2) = bf1(keep ? a[e] : 0.f);
                }
            } else {
#pragma unroll
            for (int mt = 0; mt < 2; ++mt)
#pragma unroll
                for (int e = 0; e < 16; ++e) o[mt][e] = 0.f;
#pragma unroll
            for (int kt = 0; kt < 4; ++kt)
#pragma unroll
                for (int s = 0; s < 2; ++s) {
                    typedef unsigned u32x4 __attribute__((ext_vector_type(4)));
                    u32x4 pu = {pk2(S[kt][8 * s], S[kt][8 * s + 1]), pk2(S[kt][8 * s + 2], S[kt][8 * s + 3]), pk2(S[kt][8 * s + 4], S[kt][8 * s + 5]), pk2(S[kt][8 * s + 6], S[kt][8 * s + 7])};
                    const bf16x8 sf = __builtin_bit_cast(bf16x8, pu);
#pragma unroll
                    for (int mt = 0; mt < 2; ++mt) {
                        const int ri = 32 * mt + l31, c = 4 * kt + 2 * s + hh;
                        const bf16x8 af = *(const bf16x8*)(sQt + ri * 256 + ((c ^ (ri & 15)) << 4));
                        o[mt] = MFMA32(af, sf, o[mt]);
                    }
                }
            }
            __syncthreads();
            if (w < 4) {
#pragma unroll
            for (int s2 = 0; s2 < 4; ++s2) {
                const int c = 2 * s2 + hh;
                const bf16x8 vf = *(const bf16x8*)(sVT + (dvb + l31) * 128 + ((c ^ sw) << 4));
#pragma unroll
                for (int mt = 0; mt < 2; ++mt) {
                    const bf16x8 af = *(const bf16x8*)(sA + (32 * mt + l31) * 128 + ((c ^ sw) << 4));
                    o[mt] = MFMA32(af, vf, o[mt]);
                }
            }
            bf16_t* od = Oo + (size_t)rowbase * 1024 + h * 256 + dvh * 128 + dvb + l31;
#pragma unroll
            for (int mt = 0; mt < 2; ++mt)
#pragma unroll
                for (int e = 0; e < 16; ++e) od[(size_t)(32 * mt + (e & 3) + 8 * (e >> 2) + 4 * hh) * 1024] = bf1(o[mt][e]);
            }
        }
        if (w < 4) {
#pragma unroll
        for (int kt = 0; kt < 4; ++kt)
#pragma unroll
            for (int g4 = 0; g4 < 4; ++g4) {
                const f32x4 dd = *(const f32x4*)(sD + 32 * kt + 8 * g4 + 4 * hh);
#pragma unroll
                for (int jq = 0; jq < 4; ++jq) S[kt][4 * g4 + jq] *= dd[jq];
            }
#pragma unroll
        for (int s2 = 0; s2 < 4; ++s2) {
            const int c = 2 * s2 + hh;
            const bf16x8 vf = *(const bf16x8*)(sVT + (dvb + l31) * 128 + ((c ^ sw) << 4));
#pragma unroll
            for (int kt = 0; kt < 4; ++kt) {
                const bf16x8 af = *(const bf16x8*)(sKh + (32 * kt + l31) * 128 + ((c ^ sw) << 4));
                S[kt] = MFMA32(af, vf, S[kt]);
            }
        }
        }
        __syncthreads();
    }
}

DI void phase_combine(const Params& p, int panel) {
    const int tid = get_tid(), lane = tid & 63, w = tid >> 6;
    const bf16_t* OF = (const bf16_t*)(p.ws + R_OF);
    const bf16_t* OB = (const bf16_t*)(p.ws + R_OB);
    const bf16_t* SG = (const bf16_t*)(p.ws + R_SG);
    bf16_t* Y = (bf16_t*)(p.ws + R_YGLA);
    for (int row2 = panel * 256 + w; row2 < panel * 256 + 256; row2 += 16)
#pragma unroll
    for (int rr = 0; rr < 2; ++rr) {
        const int row = row2 + 8 * rr;
        const size_t o = (size_t)row * 1024 + lane * 16;
        const uint4 a0 = *(const uint4*)(OF + o), a1 = *(const uint4*)(OF + o + 8);
        const uint4 b0 = *(const uint4*)(OB + o), b1 = *(const uint4*)(OB + o + 8);
        const uint4 g0 = *(const uint4*)(SG + o), g1 = *(const uint4*)(SG + o + 8);
        const unsigned au[8] = {a0.x, a0.y, a0.z, a0.w, a1.x, a1.y, a1.z, a1.w};
        const unsigned bu[8] = {b0.x, b0.y, b0.z, b0.w, b1.x, b1.y, b1.z, b1.w};
        const unsigned gu[8] = {g0.x, g0.y, g0.z, g0.w, g1.x, g1.y, g1.z, g1.w};
        float v[16]; float ss = 0.f;
#pragma unroll
        for (int e = 0; e < 8; ++e) { v[2 * e] = bflo(au[e]) + bflo(bu[e]); v[2 * e + 1] = bfhi(au[e]) + bfhi(bu[e]); ss += v[2 * e] * v[2 * e] + v[2 * e + 1] * v[2 * e + 1]; }
#pragma unroll
        for (int of = 8; of >= 1; of >>= 1) ss += __shfl_xor(ss, of);
        const float rs = rsqrtf(ss * (1.0f / 256.0f) + EPS);
        const float* gn = p.gla_hn + ((lane * 16) & 255);
        unsigned ou[8];
#pragma unroll
        for (int e = 0; e < 8; ++e) ou[e] = pk2(v[2 * e] * rs * gn[2 * e] * bflo(gu[e]), v[2 * e + 1] * rs * gn[2 * e + 1] * bfhi(gu[e]));
        *(uint4*)(Y + o) = make_uint4(ou[0], ou[1], ou[2], ou[3]);
        *(uint4*)(Y + o + 8) = make_uint4(ou[4], ou[5], ou[6], ou[7]);
    }
}

template <int MODE>
DI void phase_rows(const Params& p, char* smem, int panel) {
    float* md = (float*)smem;
    const int tid = get_tid(), lane = tid & 63, w = tid >> 6;
    const bf16_t* Yin = (const bf16_t*)(p.ws + (MODE == 0 ? R_Y2 : R_Y3));
    bf16_t* H2 = (bf16_t*)(p.ws + R_H2);
    const float* pn = MODE == 0 ? p.post_norm1 : p.post_norm2;
    const float* xsrc = MODE == 0 ? p.x : (const float*)p.out;
    const int r = panel >> 5;
    __syncthreads();
    if (MODE == 0) { load_mod(p, r, 2, md); load_mod(p, r, 3, md + 1024); load_mod(p, r, 4, md + 2048); }
    else load_mod(p, r, 5, md);
    __syncthreads();
    for (int i = 0; i < 16; ++i) {
        const int rows[2] = {panel * 256 + w * 32 + i, panel * 256 + w * 32 + 16 + i};
        uint2 yu[2][4]; f32x4 xv[2][4];
#pragma unroll
        for (int q = 0; q < 2; ++q)
#pragma unroll
            for (int j = 0; j < 4; ++j) {
                yu[q][j] = *(const uint2*)(Yin + (size_t)rows[q] * 1024 + lane * 4 + 256 * j);
                xv[q][j] = *(const f32x4*)(xsrc + (size_t)rows[q] * 1024 + lane * 4 + 256 * j);
            }
        float y[2][16], ss[2] = {0.f, 0.f};
#pragma unroll
        for (int q = 0; q < 2; ++q)
#pragma unroll
            for (int j = 0; j < 4; ++j) {
                y[q][4 * j] = bflo(yu[q][j].x); y[q][4 * j + 1] = bfhi(yu[q][j].x); y[q][4 * j + 2] = bflo(yu[q][j].y); y[q][4 * j + 3] = bfhi(yu[q][j].y);
#pragma unroll
                for (int e = 0; e < 4; ++e) ss[q] += y[q][4 * j + e] * y[q][4 * j + e];
            }
        ss[0] = wave_sum(ss[0]); ss[1] = wave_sum(ss[1]);
        float xn[2][16], s2[2] = {0.f, 0.f};
#pragma unroll
        for (int q = 0; q < 2; ++q) {
            const float rs = rsqrtf(ss[q] * (1.0f / 1024.0f) + EPS);
#pragma unroll
            for (int j = 0; j < 4; ++j) {
                const int col = lane * 4 + 256 * j;
                const f32x4 g = *(const f32x4*)(pn + col), gt = *(const f32x4*)(md + col);
#pragma unroll
                for (int e = 0; e < 4; ++e) { xn[q][4 * j + e] = xv[q][j][e] + gt[e] * (y[q][4 * j + e] * rs * g[e]); s2[q] += xn[q][4 * j + e] * xn[q][4 * j + e]; }
                f32x4 ov = {xn[q][4 * j], xn[q][4 * j + 1], xn[q][4 * j + 2], xn[q][4 * j + 3]};
                *(f32x4*)(p.out + (size_t)rows[q] * 1024 + col) = ov;
            }
        }
        if (MODE == 0) {
            s2[0] = wave_sum(s2[0]); s2[1] = wave_sum(s2[1]);
#pragma unroll
            for (int q = 0; q < 2; ++q) {
                const float rs2 = rsqrtf(s2[q] * (1.0f / 1024.0f) + EPS);
#pragma unroll
                for (int j = 0; j < 4; ++j) {
                    const int col = lane * 4 + 256 * j;
                    const f32x4 g = *(const f32x4*)(p.pre_norm2 + col), sh = *(const f32x4*)(md + 1024 + col), sc = *(const f32x4*)(md + 2048 + col);
                    float o[4];
#pragma unroll
                    for (int e = 0; e < 4; ++e) o[e] = xn[q][4 * j + e] * rs2 * g[e] * (1.f + sc[e]) + sh[e];
                    uint2 u; u.x = pk2(o[0], o[1]); u.y = pk2(o[2], o[3]);
                    *(uint2*)(H2 + (size_t)rows[q] * 1024 + col) = u;
                }
            }
        }
    }
}

DI void gsync(unsigned* bar, unsigned k) {
    __syncthreads();
    const unsigned epoch = k * gridDim.x;
    if (threadIdx.x == 0) {
        __threadfence();
        atomicAdd(bar, 1u);
        while (__hip_atomic_load(bar, __ATOMIC_RELAXED, __HIP_MEMORY_SCOPE_AGENT) < epoch) __builtin_amdgcn_s_sleep(1);
        __threadfence();
    }
    __syncthreads();
}

__global__ void __launch_bounds__(NT) fwd_megakernel(Params p) {
    __shared__ __attribute__((aligned(16))) char smem[131072 + 16384];
    cg::grid_group grid = cg::this_grid();
    char* ws = p.ws;
    unsigned* bar = (unsigned*)(ws + OFF_BAR);
    phase_prep(p, smem);
    grid.sync();
    phase_h(p, smem);
    gsync(bar, 1u);
    {
        EpiIn e; e.Q = (bf16_t*)(ws + R_Q); e.Kk = (bf16_t*)(ws + R_K); e.Vt = (bf16_t*)(ws + R_VT); e.gq = (bf16_t*)(ws + R_GQ); e.gk = (bf16_t*)(ws + R_GK);
        e.gvT = (bf16_t*)(ws + R_GVT); e.sg = (bf16_t*)(ws + R_SG); e.mg = (bf16_t*)p.out; e.glow = (float*)(ws + OFF_GLOW); e.kmax = (float*)(ws + OFF_KMAX);
        {
            const f32x4* src = (const f32x4*)(ws + OFF_ROPE); f32x4* dst = (f32x4*)(smem + 131072);
            for (int i = threadIdx.x; i < 1024; i += NT) dst[i] = src[i];
            __syncthreads();
            e.rope = (const float*)(smem + 131072);
        }
        gemm_phase_ex<true>((const bf16_t*)(ws + R_H), 1024, (const bf16_t*)(ws + OFF_WIN), 1024, 1024, 264, 33, smem, e, blockIdx.x, gridDim.x);
    }
    gsync(bar, 2u);
    phase_attn(p, smem);
    gsync(bar, 3u);
    phase_gate(p, smem);
    gsync(bar, 4u);
    const bool split = gridDim.x >= 192;
    const int nscan = split ? 128 : (int)gridDim.x, oth0 = split ? 128 : 0, noth = (int)gridDim.x - oth0;
    if ((int)blockIdx.x < nscan) { for (int unit = blockIdx.x; unit < 128; unit += nscan) { __syncthreads(); phase_gla(p, smem, unit); } }
    if ((int)blockIdx.x >= oth0) {
        EpiGate0 e0; e0.mg = (bf16_t*)p.out;
        gemm_phase_ex<false>((const bf16_t*)(ws + R_H), 1024, (const bf16_t*)(ws + OFF_WDA), 1024, 1024, 256, 4, smem, e0, blockIdx.x - oth0, noth);
        const long gsz2 = (long)noth * NT, gtid2 = (long)(blockIdx.x - oth0) * NT + get_tid();
        repack<0>(p.w_bgla, 1024, 1024, (bf16_t*)(ws + OFF_WGLA), 1024, gtid2, gsz2);
        repack<0>(p.w_out, 1024, 1024, (bf16_t*)(ws + OFF_WOUT), 1024, gtid2, gsz2);
        repack<0>(p.w_ff1, 1024, 4096, (bf16_t*)(ws + OFF_WFF1), 4096, gtid2, gsz2);
        repack<0>(p.w_ff2, 4096, 1024, (bf16_t*)(ws + OFF_WFF2), 1024, gtid2, gsz2);
    }
    gsync(bar, 5u);
    for (int panel = blockIdx.x; panel < 256; panel += gridDim.x) phase_combine(p, panel);
    gsync(bar, 6u);
    { EpiGate1 e1; e1.Y = (bf16_t*)(ws + R_Y); e1.mg = (const bf16_t*)p.out;
      gemm_phase((const bf16_t*)(ws + R_YGLA), 1024, (const bf16_t*)(ws + OFF_WGLA), 1024, 1024, 256, 4, smem, e1); }
    gsync(bar, 7u);
    { EpiStore<0> e; e.O = (bf16_t*)(ws + R_Y2); e.ldo = 1024;
      gemm_phase((const bf16_t*)(ws + R_Y), 1024, (const bf16_t*)(ws + OFF_WOUT), 1024, 1024, 256, 4, smem, e); }
    gsync(bar, 8u);
    for (int panel = blockIdx.x; panel < 256; panel += gridDim.x) phase_rows<0>(p, smem, panel);
    gsync(bar, 9u);
    { EpiStore<1> e; e.O = (bf16_t*)(ws + R_U); e.ldo = 4096;
      gemm_phase((const bf16_t*)(ws + R_H2), 1024, (const bf16_t*)(ws + OFF_WFF1), 1024, 1024, 256, 16, smem, e); }
    gsync(bar, 10u);
    { EpiStore<0> e; e.O = (bf16_t*)(ws + R_Y3); e.ldo = 1024;
      gemm_phase((const bf16_t*)(ws + R_U), 4096, (const bf16_t*)(ws + OFF_WFF2), 4096, 4096, 256, 4, smem, e); }
    gsync(bar, 11u);
    for (int panel = blockIdx.x; panel < 256; panel += gridDim.x) phase_rows<1>(p, smem, panel);
}

extern "C" void kernel_launch(void* const* d_in, const int* in_sizes, int n_in, void* d_out, int out_size, void* d_ws, size_t ws_size, hipStream_t stream) {
    static int grid_blocks = 0;
    if (!grid_blocks) {
        int dev = 0, cus = 0, per_cu = 0;
        hipGetDevice(&dev);
        hipDeviceGetAttribute(&cus, hipDeviceAttributeMultiprocessorCount, dev);
        hipOccupancyMaxActiveBlocksPerMultiprocessor(&per_cu, fwd_megakernel, NT, 0);
        if (per_cu < 1) per_cu = 1;
        grid_blocks = cus * per_cu;
        if (grid_blocks > 256) grid_blocks = 256;
    }
    Params p{};
    const float* const* in = (const float* const*)d_in;
    p.x = in[0]; p.c = in[1]; p.ctx = in[2]; p.c_ctx = in[3]; p.w_mod = in[4]; p.b_mod = in[5]; p.pre_norm1 = in[6]; p.w_in = in[7];
    p.w_gate_up = in[8]; p.b_gate_up = in[9]; p.lq1 = in[10]; p.lk1 = in[11]; p.lq2 = in[12]; p.lk2 = in[13]; p.da_hn = in[14]; p.gla_hn = in[15];
    p.w_bda = in[16]; p.w_bgla = in[17]; p.w_out = in[18]; p.post_norm1 = in[19]; p.pre_norm2 = in[20]; p.w_ff1 = in[21]; p.w_ff2 = in[22]; p.post_norm2 = in[23];
    p.out = (float*)d_out; p.ws = (char*)d_ws;
    hipMemsetAsync((char*)d_ws + OFF_BAR, 0, 256, stream);
    void* args[] = {&p};
    hipError_t e = hipLaunchCooperativeKernel((void*)fwd_megakernel, dim3(grid_blocks), dim3(NT), args, 0, stream);
    if (e != hipSuccess) fprintf(stderr, "cooperative launch failed: %s (grid %d)\n", hipGetErrorString(e), grid_blocks);
}
```

```cpp
#include <hip/hip_runtime.h>
#include <hip/hip_cooperative_groups.h>
#include <cstdio>
namespace cg = cooperative_groups;

typedef unsigned short bf16_t;
typedef short bf16x8 __attribute__((ext_vector_type(8)));
typedef float f32x16 __attribute__((ext_vector_type(16)));
typedef float f32x4 __attribute__((ext_vector_type(4)));
typedef float f32x2 __attribute__((ext_vector_type(2)));
typedef __bf16 bf2_t __attribute__((ext_vector_type(2)));
typedef _Float16 h4_t __attribute__((ext_vector_type(4)));

#define DI __device__ __forceinline__
#define MFMA32(a, b, c) __builtin_amdgcn_mfma_f32_32x32x16_bf16((a), (b), (c), 0, 0, 0)

constexpr int NT = 512;
constexpr int TLAT = 8192, NB = 8, NLAT = 65536, NROW = 67584, TKV = 8448;
constexpr float EPS = 1e-6f;
constexpr size_t MiB = 1048576;
constexpr size_t OFF_WIN = 0;
constexpr size_t OFF_WDA = OFF_WIN + 8448ull * 1024 * 2;
constexpr size_t OFF_WGLA = OFF_WDA + 2 * MiB;
constexpr size_t OFF_WOUT = OFF_WGLA + 2 * MiB;
constexpr size_t OFF_WFF1 = OFF_WOUT + 2 * MiB;
constexpr size_t OFF_WFF2 = OFF_WFF1 + 8 * MiB;
constexpr size_t OFF_MODP = OFF_WFF2 + 8 * MiB;
constexpr size_t OFF_ROPE = OFF_MODP + 16ull * 9 * 6144 * 4;
constexpr size_t OFF_GLOW = OFF_ROPE + 16384;
constexpr size_t OFF_KMAX = OFF_GLOW + 67584ull * 32 * 4;
constexpr int KMS = 32;
constexpr size_t OFF_BAR = OFF_KMAX + 256 * KMS * 4;
constexpr size_t R_H = 64 * MiB;
constexpr size_t R_Q = R_H + 132 * MiB;
constexpr size_t R_K = R_Q + 128 * MiB;
constexpr size_t R_VT = R_K + 132 * MiB;
constexpr size_t R_GQ = R_VT + 132 * MiB;
constexpr size_t R_GK = R_GQ + 64 * MiB;
constexpr size_t R_GVT = R_GK + 66 * MiB;
constexpr size_t R_SG = R_GVT + 132 * MiB;
constexpr size_t WS_END = R_SG + 128 * MiB;
static_assert(OFF_BAR + 1024 <= R_H, "small region overflow");
static_assert(WS_END <= 1024 * MiB, "workspace overflow");
constexpr size_t R_BF = R_Q;
constexpr size_t R_BB = R_Q + 66 * MiB;
constexpr size_t R_OF = R_K + 4 * MiB;
constexpr size_t R_OB = R_VT;
constexpr size_t R_YGLA = R_SG;
constexpr size_t R_Y = R_GVT;
constexpr size_t R_Y2 = R_SG;
constexpr size_t R_H2 = R_H;
constexpr size_t R_U = R_Q;
constexpr size_t R_Y3 = R_GVT;

struct Params {
    const float *x, *c, *ctx, *c_ctx, *w_mod, *b_mod, *pre_norm1, *w_in, *w_gate_up, *b_gate_up;
    const float *lq1, *lk1, *lq2, *lk2, *da_hn, *gla_hn, *w_bda, *w_bgla, *w_out, *post_norm1, *pre_norm2, *w_ff1, *w_ff2, *post_norm2;
    float* out;
    char* ws;
};

DI unsigned pk2(float a, float b) { f32x2 v = {a, b}; bf2_t r = __builtin_convertvector(v, bf2_t); return __builtin_bit_cast(unsigned, r); }
DI bf16_t bf1(float a) { __bf16 r = (__bf16)a; return __builtin_bit_cast(unsigned short, r); }
DI float bflo(unsigned v) { return __uint_as_float(v << 16); }
DI float bfhi(unsigned v) { return __uint_as_float(v & 0xffff0000u); }
DI float wave_sum(float v) {
#pragma unroll
    for (int o = 32; o >= 1; o >>= 1) v += __shfl_xor(v, o);
    return v;
}
DI int get_tid() { int t = threadIdx.x; asm volatile("" : "+v"(t)); return t; }
DI float sigmoidf_(float x) { return __builtin_amdgcn_rcpf(1.0f + __expf(-x)); }

template <int MODE>
DI void repack(const float* __restrict__ src, int K, int Nsrc, bf16_t* __restrict__ dst, int Nd, long gtid, long gsz) {
    const long total = (long)Nd * (K / 8);
    for (long it = gtid; it < total; it += gsz) {
        const int n = (int)(it % Nd), kc = (int)(it / Nd);
        int col = n; bool valid = true;
        if (MODE == 1) { if (n < 5120) col = n; else if (n < 8192) col = n + 32; else if (n < 8224) col = n - 8192 + 5120; else valid = false; }
        float v[8];
#pragma unroll
        for (int j = 0; j < 8; ++j) v[j] = valid ? src[(size_t)(kc * 8 + j) * Nsrc + col] : 0.f;
        uint4 o; o.x = pk2(v[0], v[1]); o.y = pk2(v[2], v[3]); o.z = pk2(v[4], v[5]); o.w = pk2(v[6], v[7]);
        *(uint4*)(dst + (size_t)n * K + kc * 8) = o;
    }
}

DI void sincos_acc(float a, float& s, float& c) {
    const float q = rintf(a * 0.63661977236758134f);
    float r = fmaf(-q, 1.5703125f, a); r = fmaf(-q, 4.837512969970703125e-4f, r); r = fmaf(-q, 7.54978995489188216e-8f, r);
    const float r2 = r * r;
    const float sp = r + r * r2 * (-1.6666666666e-1f + r2 * (8.3333333333e-3f + r2 * (-1.98412698e-4f + r2 * 2.7557319e-6f)));
    const float cp = 1.0f + r2 * (-0.5f + r2 * (4.16666666667e-2f + r2 * (-1.38888888889e-3f + r2 * (2.48015873e-5f + r2 * -2.75573192e-7f))));
    const int qi = ((int)q) & 3;
    s = (qi == 0) ? sp : (qi == 1) ? cp : (qi == 2) ? -sp : -cp;
    c = (qi == 0) ? cp : (qi == 1) ? -sp : (qi == 2) ? -cp : sp;
}

DI void phase_prep(const Params& p, char* smem) {
    const int tid = get_tid();
    const long gsz = (long)gridDim.x * NT, gtid = (long)blockIdx.x * NT + tid;
    char* ws = p.ws;
    repack<1>(p.w_in, 1024, 8224, (bf16_t*)(ws + OFF_WIN), 8448, gtid, gsz);
    repack<0>(p.w_bda, 1024, 1024, (bf16_t*)(ws + OFF_WDA), 1024, gtid, gsz);
    if (gtid < 256) ((float*)(ws + OFF_KMAX))[gtid * KMS] = 0.f;
    if (gtid < 2048) {
        const int pos = (int)gtid >> 4, f = (int)gtid & 15;
        const float inv = exp2f(-(float)f * (13.287712379549449f / 16.0f));
        float s, c; sincos_acc((float)pos * inv, s, c);
        float* rt = (float*)(ws + OFF_ROPE);
        rt[gtid] = c; rt[2048 + gtid] = s;
    }
    float* sil = (float*)smem;
    float* modp = (float*)(ws + OFF_MODP);
    for (int item = blockIdx.x; item < 192; item += gridDim.x) {
        const int cb = item % 12, ks = item / 12;
        __syncthreads();
        for (int i = tid; i < 9 * 64; i += NT) {
            const int r = i >> 6, kk = i & 63;
            const float v = (r < 8) ? p.c[r * 1024 + ks * 64 + kk] : p.c_ctx[ks * 64 + kk];
            sil[i] = v * sigmoidf_(v);
        }
        __syncthreads();
        const int n = cb * 512 + tid;
        float acc[9];
#pragma unroll
        for (int r = 0; r < 9; ++r) acc[r] = 0.f;
        for (int kk = 0; kk < 64; ++kk) {
            const float w = p.w_mod[(size_t)(ks * 64 + kk) * 6144 + n];
#pragma unroll
            for (int r = 0; r < 9; ++r) acc[r] = fmaf(sil[r * 64 + kk], w, acc[r]);
        }
#pragma unroll
        for (int r = 0; r < 9; ++r) modp[(size_t)(ks * 9 + r) * 6144 + n] = acc[r];
    }
}

DI void load_mod(const Params& p, int r, int which, float* dst) {
    const float* modp = (const float*)(p.ws + OFF_MODP);
    for (int n = threadIdx.x; n < 1024; n += NT) {
        float a = p.b_mod[which * 1024 + n];
#pragma unroll
        for (int ks = 0; ks < 16; ++ks) a += modp[(size_t)(ks * 9 + r) * 6144 + which * 1024 + n];
        dst[n] = a;
    }
}

DI void h_row2(const Params& p, const float* md, bf16_t* H, int rowA, int rowB, int lane) {
    const float* sa = rowA < NLAT ? p.x + (size_t)rowA * 1024 : p.ctx + (size_t)(rowA - NLAT) * 1024;
    const float* sbp = rowB < NLAT ? p.x + (size_t)rowB * 1024 : p.ctx + (size_t)(rowB - NLAT) * 1024;
    f32x4 va[4], vb[4]; float sa2 = 0.f, sb2 = 0.f;
#pragma unroll
    for (int j = 0; j < 4; ++j) { va[j] = *(const f32x4*)(sa + lane * 4 + 256 * j); vb[j] = *(const f32x4*)(sbp + lane * 4 + 256 * j); }
#pragma unroll
    for (int j = 0; j < 4; ++j) {
        sa2 += va[j].x * va[j].x + va[j].y * va[j].y + va[j].z * va[j].z + va[j].w * va[j].w;
        sb2 += vb[j].x * vb[j].x + vb[j].y * vb[j].y + vb[j].z * vb[j].z + vb[j].w * vb[j].w;
    }
    sa2 = wave_sum(sa2); sb2 = wave_sum(sb2);
    const float ra = rsqrtf(sa2 * (1.0f / 1024.0f) + EPS), rb = rsqrtf(sb2 * (1.0f / 1024.0f) + EPS);
#pragma unroll
    for (int j = 0; j < 4; ++j) {
        const int col = lane * 4 + 256 * j;
        const f32x4 g = *(const f32x4*)(p.pre_norm1 + col);
        const f32x4 sh = *(const f32x4*)(md + col), sc = *(const f32x4*)(md + 1024 + col);
        float oa[4], ob[4];
#pragma unroll
        for (int e = 0; e < 4; ++e) { const float gm = g[e] * (1.f + sc[e]); oa[e] = va[j][e] * ra * gm + sh[e]; ob[e] = vb[j][e] * rb * gm + sh[e]; }
        uint2 o; o.x = pk2(oa[0], oa[1]); o.y = pk2(oa[2], oa[3]);
        *(uint2*)(H + (size_t)rowA * 1024 + col) = o;
        o.x = pk2(ob[0], ob[1]); o.y = pk2(ob[2], ob[3]);
        *(uint2*)(H + (size_t)rowB * 1024 + col) = o;
    }
}

DI void phase_h(const Params& p, char* smem) {
    float* md = (float*)smem;
    const int tid = get_tid(), lane = tid & 63, w = tid >> 6;
    bf16_t* H = (bf16_t*)(p.ws + R_H);
    for (int tile = blockIdx.x; tile < 256; tile += gridDim.x) {
        __syncthreads();
        load_mod(p, tile >> 5, 0, md); load_mod(p, tile >> 5, 1, md + 1024);
        __syncthreads();
        for (int i = 0; i < 16; ++i) h_row2(p, md, H, tile * 256 + w * 32 + i, tile * 256 + w * 32 + 16 + i, lane);
    }
    __syncthreads();
    load_mod(p, 8, 0, md); load_mod(p, 8, 1, md + 1024);
    __syncthreads();
    for (int r2 = blockIdx.x * 8 + w; r2 < 1024; r2 += gridDim.x * 8) h_row2(p, md, H, NLAT + 2 * r2, NLAT + 2 * r2 + 1, lane);
}

typedef __attribute__((address_space(3))) unsigned lds_u32;
DI lds_u32* to_lds(const void* p) { return (lds_u32*)(unsigned)(size_t)p; }
#define GLDS16(src, dst) __builtin_amdgcn_global_load_lds((const unsigned*)(src), to_lds(dst), 16, 0, 0)

#define MFMA16(a, b, c) __builtin_amdgcn_mfma_f32_16x16x32_bf16((a), (b), (c), 0, 0, 0)
DI void stage_rc8(int b, int& R, int& C) { const int st = b >> 10, sb = b & 1023, swz = sb ^ (((sb >> 9) & 1) << 5); R = (st >> 1) * 16 + (swz >> 6); C = (st & 1) * 32 + ((swz & 63) >> 1); }
template <bool SWAP, class Epi>
DI void gemm_tile(const bf16_t* A, int lda, const bf16_t* B, int ldb, int K, int m0, int n0, bool, bool, int, int, char* smem, Epi& epi) {
    const int tid = get_tid(), lane = tid & 63, w = tid >> 6, wr = w >> 2, wc = w & 3, fr = lane & 15, fq = lane >> 4;
    f32x4 acc[2][2][4][2];
#pragma unroll
    for (int a = 0; a < 2; ++a)
#pragma unroll
        for (int b = 0; b < 2; ++b)
#pragma unroll
            for (int m = 0; m < 4; ++m)
#pragma unroll
                for (int n = 0; n < 2; ++n) acc[a][b][m][n] = (f32x4){0.f, 0.f, 0.f, 0.f};
    bf16x8 At[4][2], B0[2][2], B1[2][2];
    int R0, C0, R1, C1; stage_rc8(tid * 16, R0, C0); stage_rc8(tid * 16 + 8192, R1, C1);
    const char* Am = (const char*)(A + (size_t)m0 * lda); const char* Bn = (const char*)(B + (size_t)n0 * ldb);
    const unsigned a0 = 2u * (unsigned)(R0 * lda + C0), a1 = 2u * (unsigned)(R1 * lda + C1), b0 = 2u * (unsigned)(R0 * ldb + C0), b1 = 2u * (unsigned)(R1 * ldb + C1);
    const unsigned ahalf = 256u * (unsigned)lda, bhalf = 256u * (unsigned)ldb;
    char* sdst = smem + w * 1024;
    const int loff = (fr * 64 + fq * 16) ^ ((fr >> 3) << 5);
    const int aoff = wr * 8192 + loff, boff = wc * 4096 + loff;
#define SA8(b, h) (((b) * 2 + (h)) * 16384)
#define SB8(b, h) ((4 + (b) * 2 + (h)) * 16384)
#define STAGE_A(b, h, kt_) do { GLDS16(Am + (a0 + (h) * ahalf + (unsigned)(kt_) * 128u), sdst + SA8(b, h)); GLDS16(Am + (a1 + (h) * ahalf + (unsigned)(kt_) * 128u), sdst + SA8(b, h) + 8192); } while (0)
#define STAGE_B(b, h, kt_) do { GLDS16(Bn + (b0 + (h) * bhalf + (unsigned)(kt_) * 128u), sdst + SB8(b, h)); GLDS16(Bn + (b1 + (h) * bhalf + (unsigned)(kt_) * 128u), sdst + SB8(b, h) + 8192); } while (0)
#define LDA8(dst, b, h) do { _Pragma("unroll") for (int m = 0; m < 4; ++m) _Pragma("unroll") for (int k = 0; k < 2; ++k) \
        dst[m][k] = *(const bf16x8*)(smem + SA8(b, h) + aoff + (m * 2 + k) * 1024); } while (0)
#define LDB8(dst, b, h) do { _Pragma("unroll") for (int n = 0; n < 2; ++n) _Pragma("unroll") for (int k = 0; k < 2; ++k) \
        dst[n][k] = *(const bf16x8*)(smem + SB8(b, h) + boff + (n * 2 + k) * 1024); } while (0)
#define MMA8(ai, bj, Af, Bf) do { __builtin_amdgcn_s_setprio(1); \
        _Pragma("unroll") for (int m = 0; m < 4; ++m) _Pragma("unroll") for (int n = 0; n < 2; ++n) _Pragma("unroll") for (int k = 0; k < 2; ++k) \
            acc[ai][bj][m][n] = SWAP ? MFMA16(Af[m][k], Bf[n][k], acc[ai][bj][m][n]) : MFMA16(Bf[n][k], Af[m][k], acc[ai][bj][m][n]); \
        __builtin_amdgcn_s_setprio(0); } while (0)
#define WAIT_V(n) asm volatile("s_waitcnt vmcnt(" #n ")" ::: "memory")
#define WAIT_L(n) asm volatile("s_waitcnt lgkmcnt(" #n ")" ::: "memory")
#define BAR8 __builtin_amdgcn_s_barrier()
#define SCHED8 __builtin_amdgcn_sched_barrier(0)
    const int nt = K >> 6;
    WAIT_V(0);
    STAGE_B(0, 0, 0); STAGE_A(0, 0, 0); STAGE_B(0, 1, 0); STAGE_A(0, 1, 0);
    if (wr == 1) BAR8;
    WAIT_V(4); BAR8;
    STAGE_B(1, 0, 1); STAGE_A(1, 0, 1); STAGE_B(1, 1, 1);
    WAIT_V(6); BAR8;
    for (int t = 0; t < nt - 2; t += 2) {
        LDB8(B0, 0, 0); SCHED8; LDA8(At, 0, 0); STAGE_A(1, 1, t + 1);
        WAIT_L(8); BAR8; WAIT_L(0); MMA8(0, 0, At, B0); BAR8; SCHED8;
        LDB8(B1, 0, 1); STAGE_B(0, 0, t + 2);
        BAR8; WAIT_L(0); MMA8(0, 1, At, B1); BAR8;
        LDA8(At, 0, 1); STAGE_A(0, 0, t + 2);
        BAR8; WAIT_L(0); MMA8(1, 0, At, B0); BAR8; SCHED8;
        STAGE_B(0, 1, t + 2);
        WAIT_V(6); BAR8; MMA8(1, 1, At, B1); BAR8;
        LDB8(B0, 1, 0); SCHED8; LDA8(At, 1, 0); STAGE_A(0, 1, t + 2);
        WAIT_L(8); BAR8; WAIT_L(0); MMA8(0, 0, At, B0); BAR8; SCHED8;
        LDB8(B1, 1, 1); STAGE_B(1, 0, t + 3);
        BAR8; WAIT_L(0); MMA8(0, 1, At, B1); BAR8;
        LDA8(At, 1, 1); STAGE_A(1, 0, t + 3);
        BAR8; WAIT_L(0); MMA8(1, 0, At, B0); BAR8; SCHED8;
        STAGE_B(1, 1, t + 3);
        WAIT_V(6); BAR8; MMA8(1, 1, At, B1); BAR8;
    }
    {
        LDB8(B0, 0, 0); LDA8(At, 0, 0); STAGE_A(1, 1, nt - 1);
        BAR8; WAIT_L(0); MMA8(0, 0, At, B0); BAR8;
        LDB8(B1, 0, 1); BAR8; WAIT_L(0); MMA8(0, 1, At, B1); BAR8;
        LDA8(At, 0, 1); WAIT_V(4); BAR8; WAIT_L(0); MMA8(1, 0, At, B0); MMA8(1, 1, At, B1); BAR8;
    }
    {
        LDB8(B0, 1, 0); LDA8(At, 1, 0); WAIT_V(2); BAR8; WAIT_L(0); MMA8(0, 0, At, B0); BAR8;
        LDB8(B1, 1, 1); WAIT_V(0); BAR8; WAIT_L(0); MMA8(0, 1, At, B1); BAR8;
        LDA8(At, 1, 1); BAR8; WAIT_L(0); MMA8(1, 0, At, B0); MMA8(1, 1, At, B1); BAR8;
    }
    if (wr == 0) BAR8;
#undef SA8
#undef SB8
#undef STAGE_A
#undef STAGE_B
#undef LDA8
#undef LDB8
#undef MMA8
#undef WAIT_V
#undef WAIT_L
#undef BAR8
#undef SCHED8
    const int tid2 = get_tid(), wr2 = (tid2 >> 6) >> 2, wc2 = (tid2 >> 6) & 3, fr2 = tid2 & 15, fq2 = (tid2 & 63) >> 4;
    if constexpr (!SWAP) epi.begin();
#pragma unroll
    for (int ai = 0; ai < 2; ++ai)
#pragma unroll
        for (int bj = 0; bj < 2; ++bj) {
#pragma unroll
            for (int m = 0; m < 4; ++m) {
                if constexpr (SWAP) {
#pragma unroll
                    for (int n = 0; n < 2; ++n) {
                        const f32x4 v = acc[ai][bj][m][n];
                        uint2 u; u.x = pk2(v[0], v[1]); u.y = pk2(v[2], v[3]);
                        *(uint2*)(smem + (wc2 * 32 + n * 16 + fr2) * 272 + (wr2 * 64 + m * 16 + 4 * fq2) * 2) = u;
                    }
                } else {
                    epi.xform(m0 + ai * 128 + wr2 * 64 + m * 16 + fr2, n0 + bj * 128 + wc2 * 32, acc[ai][bj][m], fq2);
#pragma unroll
                    for (int n = 0; n < 2; ++n) {
                        const f32x4 v = acc[ai][bj][m][n];
                        uint2 u; u.x = pk2(v[0], v[1]); u.y = pk2(v[2], v[3]);
                        *(uint2*)(smem + (wr2 * 64 + m * 16 + fr2) * 272 + (wc2 * 32 + n * 16 + 4 * fq2) * 2) = u;
                    }
                }
                if (m & 1) asm volatile("" ::: "memory");
            }
            __syncthreads();
#pragma unroll
            for (int i = 0; i < 4; ++i) {
                const int c = tid2 + NT * i, r = c >> 4, c16 = c & 15;
                const uint4 d = *(const uint4*)(smem + r * 272 + c16 * 16);
                bf16_t* dst;
                if constexpr (SWAP) dst = epi.addrT(n0 + bj * 128 + r, m0 + ai * 128 + (c16 >> 3) * 64);
                else dst = epi.addr64(m0 + ai * 128 + r, n0 + bj * 128 + (c16 >> 3) * 64);
                if (dst) *(uint4*)(dst + (c16 & 7) * 8) = d;
            }
            __syncthreads();
        }
    if constexpr (!SWAP) epi.flush(m0, n0, wc2);
}

DI void tile_map(int id, int MT, int NTl, int& mt, int& nt) {
    const int x = id & 7, local = id >> 3, mtx = MT >> 3;
    const int full = mtx >> 2, per = 4 * NTl;
    int patch = local / per, wv = local - patch * per, pm = 4;
    if (patch >= full) { patch = full; wv = local - full * per; pm = mtx - full * 4; }
    const int mo = wv % pm; nt = wv / pm;
    mt = (patch * 4 + mo) * 8 + x;
}

DI void tile_map_in(int id, int& mt, int& nt) {
    if (id < 8448) { tile_map(id, 256, 33, mt, nt); return; }
    const int id2 = id - 8448, k = id2 >> 3;
    mt = 256 + (id2 & 7);
    nt = k < 8 ? 4 + k : k < 10 ? 14 + (k - 8) : k < 14 ? 16 + (k - 10) : 32;
}
template <bool VSWAP, class Epi>
DI void gemm_phase_ex(const bf16_t* A, int lda, const bf16_t* B, int ldb, int K, int MT, int NTl, char* smem, Epi& epi, int bid, int nblk) {
    const int total = VSWAP ? 8448 + 120 : MT * NTl;
    bool first = true;
    for (int id = bid; id < total; id += nblk) {
        int mt, nt, mt2 = 0, nt2 = 0;
        if (VSWAP) tile_map_in(id, mt, nt); else tile_map(id, MT, NTl, mt, nt);
        const bool has_next = id + nblk < total;
        if (has_next) { if (VSWAP) tile_map_in(id + nblk, mt2, nt2); else tile_map(id + nblk, MT, NTl, mt2, nt2); }
        if constexpr (VSWAP) { if (Epi::is_vt(nt)) { gemm_tile<true>(A, lda, B, ldb, K, mt * 256, nt * 256, first, has_next, mt2 * 256, nt2 * 256, smem, epi); first = false; continue; } }
        gemm_tile<false>(A, lda, B, ldb, K, mt * 256, nt * 256, first, has_next, mt2 * 256, nt2 * 256, smem, epi);
        first = false;
    }
}
template <class Epi>
DI void gemm_phase(const bf16_t* A, int lda, const bf16_t* B, int ldb, int K, int MT, int NTl, char* smem, Epi& epi) {
    gemm_phase_ex<false>(A, lda, B, ldb, K, MT, NTl, smem, epi, blockIdx.x, gridDim.x);
}

DI float xhalf_max(float v) {
    typedef unsigned u32x2 __attribute__((ext_vector_type(2)));
    const unsigned u = __float_as_uint(v);
    const u32x2 r = __builtin_amdgcn_permlane32_swap(u, u, false, false);
    return fmaxf(__uint_as_float(r[0]), __uint_as_float(r[1]));
}
DI float xhalf_sum(float v) {
    typedef unsigned u32x2 __attribute__((ext_vector_type(2)));
    const unsigned u = __float_as_uint(v);
    const u32x2 r = __builtin_amdgcn_permlane32_swap(u, u, false, false);
    return __uint_as_float(r[0]) + __uint_as_float(r[1]);
}
template <class Epi>
DI void gemm_panel(const bf16_t* A, int lda, const bf16_t* B, int ldb, int K, int panel, int NTl, char* smem, Epi& epi) {
    for (int nt = 0; nt < NTl; ++nt)
        gemm_tile<false>(A, lda, B, ldb, K, panel * 256, nt * 256, nt == 0, nt + 1 < NTl, panel * 256, (nt + 1) * 256, smem, epi);
}

DI float quad_sum(float v) { v += __shfl_xor(v, 16); v += __shfl_xor(v, 32); return v; }
struct EpiIn {
    bf16_t *Q, *Kk, *Vt, *gq, *gk, *gvT, *sg, *mg; float* glow; const float* rope; float* kmax;
    float kacc0, kacc1;
    static DI bool is_vt(int nt) { return (nt >= 8 && nt < 12) || (nt >= 16 && nt < 20); }
    DI bf16_t* addrT(int col, int row64) const {
        int b, t;
        if (row64 < NLAT) { b = row64 >> 13; t = row64 & 8191; } else { const int r2 = row64 - NLAT; b = r2 >> 8; t = TLAT + (r2 & 255); }
        if (col < 3072) { const int c = col - 2048; return Vt + (size_t)((b * 8 + (c >> 7)) * 128 + (c & 127)) * TKV + t; }
        const int c = col - 4096; return gvT + (size_t)((b * 4 + (c >> 8)) * 256 + (c & 255)) * TKV + t;
    }
    DI bf16_t* addr64(int row, int col64) const {
        const bool lat = row < NLAT;
        int b, t;
        if (lat) { b = row >> 13; t = row & 8191; } else { const int r2 = row - NLAT; b = r2 >> 8; t = TLAT + (r2 & 255); }
        if (col64 < 2048) {
            const bool isq = col64 < 1024;
            if (isq && !lat) return nullptr;
            const int c = col64 & 1023, head = c >> 7, comp = (c >> 6) & 1;
            return isq ? Q + ((size_t)((b * 8 + head) * 2 + comp) * TLAT + t) * 64 : Kk + ((size_t)((b * 8 + head) * 2 + comp) * TKV + t) * 64;
        }
        if (col64 < 3072) return nullptr;
        if (col64 < 4096) { const bool isq = col64 < 3584; if (isq && !lat) return nullptr; return (isq ? gq : gk) + (size_t)row * 512 + ((col64 - 3072) & 511); }
        if (col64 < 5120) return nullptr;
        if (col64 < 6144) return lat ? sg + (size_t)row * 1024 + (col64 - 5120) : nullptr;
        if (col64 < 8192) return lat ? mg + (size_t)row * 2048 + (col64 - 6144) : nullptr;
        return nullptr;
    }
    DI void flush(int m0, int n0, int wc) {
        if (n0 < 1024 || n0 >= 2048) return;
        const int b = m0 < NLAT ? (m0 >> 13) : ((m0 - NLAT) >> 8);
#pragma unroll
        for (int bj = 0; bj < 2; ++bj) {
            float v = bj ? kacc1 : kacc0;
#pragma unroll
            for (int of = 8; of >= 1; of >>= 1) v = fmaxf(v, __shfl_xor(v, of));
            const int c = (n0 + bj * 128 + wc * 32) & 1023, head = c >> 7, comp = (c >> 6) & 1, half = (c >> 5) & 1;
            if ((threadIdx.x & 63) == 0) atomicMax((unsigned*)(kmax + (((b * 8 + head) * 2 + comp) * 2 + half) * KMS), __float_as_uint(v));
        }
    }
    DI void begin() { kacc0 = 0.f; kacc1 = 0.f; }
    DI void xform(int row, int cb, f32x4 (&v)[2], int q) {
        if (cb >= 8224) return;
        const bool lat = row < NLAT;
        int b, t;
        if (lat) { b = row >> 13; t = row & 8191; } else { const int r2 = row - NLAT; b = r2 >> 8; t = TLAT + (r2 & 255); }
        if (cb < 2048) {
            const bool isq = cb < 1024;
            if (isq && !lat) return;
            const int c = cb & 1023, head = c >> 7, comp = (c >> 6) & 1, half = (c >> 5) & 1;
            f32x4 o[2];
            if (lat) {
                const int pos = half ? (t & 63) : (t >> 6);
                const f32x4 c4 = *(const f32x4*)(rope + pos * 16 + 4 * q), s4 = *(const f32x4*)(rope + 2048 + pos * 16 + 4 * q);
#pragma unroll
                for (int j = 0; j < 4; ++j) {
                    const float x1 = v[0][j], x2 = v[1][j];
                    o[0][j] = x1 * c4[j] - x2 * s4[j];
                    o[1][j] = x2 * c4[j] + x1 * s4[j];
                }
            } else { o[0] = v[0]; o[1] = v[1]; }
            if (!isq) {
                float ssq = 0.f;
#pragma unroll
                for (int j = 0; j < 4; ++j) ssq += o[0][j] * o[0][j] + o[1][j] * o[1][j];
                ssq = quad_sum(ssq);
                if ((cb >> 7) & 1) kacc1 = fmaxf(kacc1, ssq); else kacc0 = fmaxf(kacc0, ssq);
            }
            const float scl = isq ? 0.125f * 1.4426950408889634f : 1.0f;
#pragma unroll
            for (int n = 0; n < 2; ++n) v[n] = o[n] * scl;
        } else if (cb < 3072) {
        } else if (cb < 4096) {
            const bool isq = cb < 3584;
            if (isq && !lat) return;
            const int c = (cb - 3072) & 511;
            const float scl = isq ? 0.08838834764831845f : 1.0f;
            (void)c;
#pragma unroll
            for (int n = 0; n < 2; ++n) v[n] = v[n] * scl;
        } else if (cb < 5120) {
        } else if (cb < 6144) {
            if (!lat) return;
#pragma unroll
            for (int n = 0; n < 2; ++n)
#pragma unroll
                for (int j = 0; j < 4; ++j) { const float xx = v[n][j]; v[n][j] = xx * sigmoidf_(xx); }
        } else if (cb < 8192) {
            if (!lat) return;
#pragma unroll
            for (int n = 0; n < 2; ++n)
#pragma unroll
                for (int j = 0; j < 4; ++j) v[n][j] = sigmoidf_(v[n][j]);
        } else {
            float* dst = glow + (size_t)row * 32;
#pragma unroll
            for (int n = 0; n < 2; ++n) *(f32x4*)(dst + 16 * n + 4 * q) = v[n];
        }
    }
};

struct EpiGate0 {
    bf16_t* mg;
    DI void flush(int, int, int) {}
    DI void begin() {}
    DI bf16_t* addr64(int row, int col64) const { return mg + (size_t)row * 2048 + col64; }
    DI void xform(int row, int cb, f32x4 (&v)[2], int q) const {
#pragma unroll
        for (int n = 0; n < 2; ++n) {
            const int col = cb + 16 * n + 4 * q;
            const uint2 m = *(const uint2*)(mg + (size_t)row * 2048 + col);
            v[n][0] *= bflo(m.x); v[n][1] *= bfhi(m.x); v[n][2] *= bflo(m.y); v[n][3] *= bfhi(m.y);
        }
    }
};
struct EpiGate1 {
    bf16_t* Y; const bf16_t* mg;
    DI void flush(int, int, int) {}
    DI void begin() {}
    DI bf16_t* addr64(int row, int col64) const { return Y + (size_t)row * 1024 + col64; }
    DI void xform(int row, int cb, f32x4 (&v)[2], int q) const {
#pragma unroll
        for (int n = 0; n < 2; ++n) {
            const int col = cb + 16 * n + 4 * q;
            const uint2 m = *(const uint2*)(mg + (size_t)row * 2048 + 1024 + col);
            const uint2 pr = *(const uint2*)(mg + (size_t)row * 2048 + col);
            v[n][0] = bflo(pr.x) + v[n][0] * bflo(m.x); v[n][1] = bfhi(pr.x) + v[n][1] * bfhi(m.x);
            v[n][2] = bflo(pr.y) + v[n][2] * bflo(m.y); v[n][3] = bfhi(pr.y) + v[n][3] * bfhi(m.y);
        }
    }
};
template <int ACT>
struct EpiStore {
    bf16_t* O; int ldo;
    DI void flush(int, int, int) {}
    DI void begin() {}
    DI bf16_t* addr64(int row, int col64) const { return O + (size_t)row * ldo + col64; }
    DI void xform(int row, int cb, f32x4 (&v)[2], int q) const {
        if (ACT == 1) {
#pragma unroll
            for (int n = 0; n < 2; ++n)
#pragma unroll
                for (int j = 0; j < 4; ++j) { const float xx = fmaxf(v[n][j], 0.f); v[n][j] = xx * xx; }
        }
    }
};

DI float quad_max(float v) { v = fmaxf(v, __shfl_xor(v, 16)); v = fmaxf(v, __shfl_xor(v, 32)); return v; }
DI bf16x8 pack8(const f32x4& a, const f32x4& b) {
    typedef unsigned u32x4 __attribute__((ext_vector_type(4)));
    const u32x4 u = {pk2(a[0], a[1]), pk2(a[2], a[3]), pk2(b[0], b[1]), pk2(b[2], b[3])};
    return __builtin_bit_cast(bf16x8, u);
}

template <bool FAST>
DI void attn_kloop(char* smem, char* sdst, const bf16_t* gk0, const bf16_t* gk1, const bf16_t* gv, bool first, bool has_next, const bf16_t* ngk0, const bf16_t* ngk1, const bf16_t* ngv,
                   int comp, int krow0, int ksw, int l15, int qd, const bf16x8 (&qf)[2][2], f32x4 (&O)[2][8], float (&m)[2], float (&l)[2]) {
#define ATT_STAGE_P(pk0, pk1, pv, buf, kt_) do { _Pragma("unroll") for (int jj = 0; jj < 2; ++jj) { \
            GLDS16(pk0 + (size_t)((kt_) * 128 + 64 * jj) * 64, sdst + (buf) * 65536 + jj * 8192); \
            GLDS16(pk1 + (size_t)((kt_) * 128 + 64 * jj) * 64, sdst + (buf) * 65536 + 16384 + jj * 8192); } \
            _Pragma("unroll") for (int jj = 0; jj < 4; ++jj) GLDS16(pv + (size_t)(32 * jj) * TKV + (kt_) * 128, sdst + (buf) * 65536 + 32768 + jj * 8192); } while (0)
#define ATT_STAGE(buf, kt_) ATT_STAGE_P(gk0, gk1, gv, buf, kt_)
#define KFRAG(sub_, t_, kd_) (*(const bf16x8*)(skc + (32 * (sub_) + krow0 + 4 * (t_)) * 128 + (((4 * (kd_) + qd) ^ ksw) << 4)))
#define VFRAG(sub_, dt_) (*(const bf16x8*)(sb + 32768 + (16 * (dt_) + l15) * 256 + (((4 * (sub_) + qd) ^ l15) << 4)))
    if (first) {
        ATT_STAGE(0, 0);
        asm volatile("s_waitcnt vmcnt(0)" ::: "memory");
        __syncthreads();
    }
    const bool late = (threadIdx.x >> 8) != 0;
    f32x4 sinit[2], Ls[2];
#pragma unroll
    for (int qt = 0; qt < 2; ++qt) { const float v0 = FAST ? -m[qt] : 0.f; sinit[qt] = (f32x4){v0, v0, v0, v0}; Ls[qt] = (f32x4){0.f, 0.f, 0.f, 0.f}; }
    constexpr int NKT = TKV / 128;
    for (int kt = 0; kt < NKT; ++kt) {
        const int cur = kt & 1;
        if (kt + 1 < NKT) ATT_STAGE(cur ^ 1, kt + 1);
        else if (has_next) ATT_STAGE_P(ngk0, ngk1, ngv, cur ^ 1, 0);
        const char* sb = smem + cur * 65536;
        const char* skc = sb + comp * 16384;
        if (FAST) {
            bf16x8 kf[2][2];
#pragma unroll
            for (int t = 0; t < 2; ++t)
#pragma unroll
                for (int kd = 0; kd < 2; ++kd) kf[t][kd] = KFRAG(0, t, kd);
            f32x4 Sn[2][2];
#pragma unroll
            for (int qt = 0; qt < 2; ++qt)
#pragma unroll
                for (int t = 0; t < 2; ++t) { Sn[qt][t] = MFMA16(kf[t][0], qf[qt][0], sinit[qt]); Sn[qt][t] = MFMA16(kf[t][1], qf[qt][1], Sn[qt][t]); }
            const bf16x8 ones = {0x3F80, 0x3F80, 0x3F80, 0x3F80, 0x3F80, 0x3F80, 0x3F80, 0x3F80};
#pragma unroll
            for (int sub = 0; sub < 4; ++sub) {
                f32x4 Sc[2][2];
#pragma unroll
                for (int qt = 0; qt < 2; ++qt)
#pragma unroll
                    for (int t = 0; t < 2; ++t) Sc[qt][t] = Sn[qt][t];
                bf16x8 va[4], vb[4];
#pragma unroll
                for (int dt = 0; dt < 4; ++dt) va[dt] = VFRAG(sub, dt);
                if (sub < 3) {
#pragma unroll
                    for (int t = 0; t < 2; ++t)
#pragma unroll
                        for (int kd = 0; kd < 2; ++kd) kf[t][kd] = KFRAG(sub + 1, t, kd);
                }
                __builtin_amdgcn_sched_barrier(0);
                bf16x8 pb[2];
#pragma unroll
                for (int qt = 0; qt < 2; ++qt) {
                    f32x4 p0, p1;
#pragma unroll
                    for (int i = 0; i < 4; ++i) { p0[i] = __builtin_amdgcn_exp2f(Sc[qt][0][i]); p1[i] = __builtin_amdgcn_exp2f(Sc[qt][1][i]); }
                    pb[qt] = pack8(p0, p1);
                }
#pragma unroll
                for (int dt = 0; dt < 4; ++dt) vb[dt] = VFRAG(sub, 4 + dt);
                __builtin_amdgcn_sched_barrier(0);
                if (sub == 3 && late) {
                    asm volatile("s_waitcnt vmcnt(0) lgkmcnt(0)" ::: "memory"); __builtin_amdgcn_s_barrier(); asm volatile("" ::: "memory");
                }
#pragma unroll
                for (int dt = 0; dt < 4; ++dt) {
                    O[0][dt] = MFMA16(va[dt], pb[0], O[0][dt]);
                    O[1][dt] = MFMA16(va[dt], pb[1], O[1][dt]);
                    if (sub < 3) Sn[dt >> 1][dt & 1] = MFMA16(kf[dt & 1][0], qf[dt >> 1][0], sinit[dt >> 1]);
                }
#pragma unroll
                for (int dt = 0; dt < 4; ++dt) {
                    O[0][4 + dt] = MFMA16(vb[dt], pb[0], O[0][4 + dt]);
                    O[1][4 + dt] = MFMA16(vb[dt], pb[1], O[1][4 + dt]);
                    if (sub < 3) Sn[dt >> 1][dt & 1] = MFMA16(kf[dt & 1][1], qf[dt >> 1][1], Sn[dt >> 1][dt & 1]);
                }
                Ls[0] = MFMA16(ones, pb[0], Ls[0]);
                Ls[1] = MFMA16(ones, pb[1], Ls[1]);
            }
        } else {
#pragma unroll 1
            for (int sub = 0; sub < 4; ++sub) {
                f32x4 S[2][2];
#pragma unroll
                for (int qt = 0; qt < 2; ++qt)
#pragma unroll
                    for (int t = 0; t < 2; ++t) { S[qt][t] = MFMA16(KFRAG(sub, t, 0), qf[qt][0], sinit[qt]); S[qt][t] = MFMA16(KFRAG(sub, t, 1), qf[qt][1], S[qt][t]); }
                bf16x8 pb[2];
#pragma unroll
                for (int qt = 0; qt < 2; ++qt) {
                    float mt = fmaxf(fmaxf(fmaxf(S[qt][0][0], S[qt][0][1]), fmaxf(S[qt][0][2], S[qt][0][3])), fmaxf(fmaxf(S[qt][1][0], S[qt][1][1]), fmaxf(S[qt][1][2], S[qt][1][3])));
                    mt = quad_max(mt);
                    if (mt > m[qt]) {
                        const float al = __builtin_amdgcn_exp2f(m[qt] - mt);
                        l[qt] *= al;
#pragma unroll
                        for (int dt = 0; dt < 8; ++dt) O[qt][dt] *= al;
                        m[qt] = mt;
                    }
                    f32x4 p0, p1;
#pragma unroll
                    for (int i = 0; i < 4; ++i) { p0[i] = __builtin_amdgcn_exp2f(S[qt][0][i] - m[qt]); p1[i] = __builtin_amdgcn_exp2f(S[qt][1][i] - m[qt]); l[qt] += p0[i] + p1[i]; }
                    pb[qt] = pack8(p0, p1);
                }
#pragma unroll
                for (int dt = 0; dt < 8; ++dt) {
                    const bf16x8 vf = VFRAG(sub, dt);
                    O[0][dt] = MFMA16(vf, pb[0], O[0][dt]);
                    O[1][dt] = MFMA16(vf, pb[1], O[1][dt]);
                }
            }
        }
        if (!(FAST && late)) { asm volatile("s_waitcnt vmcnt(0) lgkmcnt(0)" ::: "memory"); __builtin_amdgcn_s_barrier(); asm volatile("" ::: "memory"); }
    }
#undef ATT_STAGE
#undef ATT_STAGE_P
#undef KFRAG
#undef VFRAG
    if (FAST) { l[0] = Ls[0][0]; l[1] = Ls[1][0]; }
    else { l[0] = quad_sum(l[0]); l[1] = quad_sum(l[1]); }
}

DI void phase_attn(const Params& p, char* smem) {
    const int tid = get_tid(), lane = tid & 63, w = tid >> 6, l15 = lane & 15, qd = lane >> 4;
    const int g = w >> 1, comp = w & 1;
    const bf16_t* Q = (const bf16_t*)(p.ws + R_Q);
    const bf16_t* Kk = (const bf16_t*)(p.ws + R_K);
    const bf16_t* Vt = (const bf16_t*)(p.ws + R_VT);
    const float* kmax = (const float*)(p.ws + OFF_KMAX);
    bf16_t* YDA = (bf16_t*)(p.ws + R_H);
    float d1 = 0.f, d2 = 0.f;
    for (int i = 0; i < 64; ++i) { d1 += p.lq1[i] * p.lk1[i]; d2 += p.lq2[i] * p.lk2[i]; }
    const float lam = __expf(d1) - __expf(d2) + 0.2f;
    const int krs = 8 * w + (lane >> 3), kcs = (lane & 7) ^ (((lane >> 4) & 1) | ((w & 3) << 1));
    const int vrs = 4 * w + (lane >> 4), vcs = (lane & 15) ^ ((4 * w + (lane >> 4)) & 15);
    const int krow0 = 8 * (l15 >> 2) + (l15 & 3);
    const int ksw = ((l15 >> 1) & 1) | (((l15 >> 2) & 3) << 1);
    float* xbuf = (float*)(smem + 65536) + g * 4096;
    char* sdst = smem + w * 1024;
    for (int id = blockIdx.x; id < 4096; id += gridDim.x) {
        const int x = id & 7, j = id >> 3, bh = (j >> 6) * 8 + x, qti = j & 63;
        const int b = bh >> 3, h = bh & 7;
        bf16x8 qf[2][2];
        float mb[2];
        const float kb = sqrtf(kmax[((bh * 2 + comp) * 2) * KMS] + kmax[((bh * 2 + comp) * 2 + 1) * KMS]);
#pragma unroll
        for (int qt = 0; qt < 2; ++qt) {
            const bf16_t* qp = Q + ((size_t)(bh * 2 + comp) * TLAT + qti * 128 + g * 32 + 16 * qt + l15) * 64 + qd * 8;
            qf[qt][0] = *(const bf16x8*)qp; qf[qt][1] = *(const bf16x8*)(qp + 32);
            float qn = 0.f;
#pragma unroll
            for (int kd = 0; kd < 2; ++kd)
#pragma unroll
                for (int e = 0; e < 8; ++e) { const float qv = __uint_as_float(((unsigned)(unsigned short)qf[qt][kd][e]) << 16); qn += qv * qv; }
            qn = quad_sum(qn);
            mb[qt] = sqrtf(qn) * kb * 1.01f + 1e-3f;
        }
        const bf16_t* gk0 = Kk + ((size_t)(bh * 2 + 0) * TKV + krs) * 64 + kcs * 8;
        const bf16_t* gk1 = gk0 + (size_t)TKV * 64;
        const bf16_t* gv = Vt + ((size_t)bh * 128 + vrs) * TKV + vcs * 8;
        const bool first = id == (int)blockIdx.x, has_next = id + (int)gridDim.x < 4096;
        const int nid = has_next ? id + gridDim.x : id, nbh = ((nid >> 3) >> 6) * 8 + (nid & 7);
        const bf16_t* ngk0 = Kk + ((size_t)(nbh * 2 + 0) * TKV + krs) * 64 + kcs * 8;
        const bf16_t* ngk1 = ngk0 + (size_t)TKV * 64;
        const bf16_t* ngv = Vt + ((size_t)nbh * 128 + vrs) * TKV + vcs * 8;
        f32x4 O[2][8];
#pragma unroll
        for (int qt = 0; qt < 2; ++qt)
#pragma unroll
            for (int d = 0; d < 8; ++d) O[qt][d] = (f32x4){0.f, 0.f, 0.f, 0.f};
        float m[2], l[2] = {0.f, 0.f};
        const int slow = __syncthreads_or(!(mb[0] <= 60.0f && mb[1] <= 60.0f));
        if (!slow) { m[0] = mb[0]; m[1] = mb[1]; attn_kloop<true>(smem, sdst, gk0, gk1, gv, first, has_next, ngk0, ngk1, ngv, comp, krow0, ksw, l15, qd, qf, O, m, l); }
        else { m[0] = -INFINITY; m[1] = -INFINITY; attn_kloop<false>(smem, sdst, gk0, gk1, gv, first, has_next, ngk0, ngk1, ngv, comp, krow0, ksw, l15, qd, qf, O, m, l); }
        if (comp == 1) {
#pragma unroll
            for (int qt = 0; qt < 2; ++qt) {
                const float i1 = lam / l[qt];
#pragma unroll
                for (int d = 0; d < 8; ++d)
#pragma unroll
                    for (int i = 0; i < 4; ++i) xbuf[((qt * 8 + d) * 4 + i) * 64 + lane] = O[qt][d][i] * i1;
            }
        }
        __syncthreads();
        if (comp == 0) {
#pragma unroll
            for (int qt = 0; qt < 2; ++qt) {
                const float i0 = 1.0f / l[qt];
                float ss = 0.f;
#pragma unroll
                for (int d = 0; d < 8; ++d)
#pragma unroll
                    for (int i = 0; i < 4; ++i) { const float o = O[qt][d][i] * i0 - xbuf[((qt * 8 + d) * 4 + i) * 64 + lane]; O[qt][d][i] = o; ss += o * o; }
                ss = quad_sum(ss);
                const float rs = rsqrtf(ss * (1.0f / 128.0f) + EPS) * 0.8f;
                const int t = qti * 128 + g * 32 + 16 * qt + l15;
                bf16_t* dst = YDA + ((size_t)b * TLAT + t) * 1024 + h * 128;
#pragma unroll
                for (int d = 0; d < 8; ++d) {
                    const int dv = 16 * d + 4 * qd;
                    const f32x4 hn = *(const f32x4*)(p.da_hn + dv);
                    uint2 u; u.x = pk2(O[qt][d][0] * rs * hn.x, O[qt][d][1] * rs * hn.y); u.y = pk2(O[qt][d][2] * rs * hn.z, O[qt][d][3] * rs * hn.w);
                    *(uint2*)(dst + dv) = u;
                }
            }
        }
    }
}

DI void phase_gate(const Params& p, char* smem) {
    const int tid = get_tid();
    const float* glow = (const float*)(p.ws + OFF_GLOW);
    float* sg = (float*)smem;
    float wf[16], wb[16];
#pragma unroll
    for (int r = 0; r < 16; ++r) { wf[r] = p.w_gate_up[(size_t)r * 512 + tid]; wb[r] = p.w_gate_up[(size_t)(16 + r) * 512 + tid]; }
    const float biasf = p.b_gate_up[tid], biasb = p.b_gate_up[512 + tid];
    _Float16* BF = (_Float16*)(p.ws + R_BF);
    _Float16* BB = (_Float16*)(p.ws + R_BB);
    for (int ch = blockIdx.x; ch < 1056; ch += gridDim.x) {
        __syncthreads();
        *(f32x4*)(sg + tid * 4) = *(const f32x4*)(glow + (size_t)ch * 2048 + tid * 4);
        __syncthreads();
        float run = 0.f;
#pragma unroll 4
        for (int i = 0; i < 64; ++i) {
            const float* gl = sg + i * 32;
            float a = biasf;
#pragma unroll
            for (int r = 0; r < 16; ++r) a = fmaf(gl[r], wf[r], a);
            const float ls = fminf(a, 0.f) - __logf(1.0f + __expf(-fabsf(a)));
            run += ls * (1.4426950408889634f / 16.0f);
            BF[(size_t)(ch * 64 + i) * 512 + tid] = (_Float16)run;
        }
        run = 0.f;
#pragma unroll 4
        for (int i = 63; i >= 0; --i) {
            const float* gl = sg + i * 32 + 16;
            float a = biasb;
#pragma unroll
            for (int r = 0; r < 16; ++r) a = fmaf(gl[r], wb[r], a);
            const float ls = fminf(a, 0.f) - __logf(1.0f + __expf(-fabsf(a)));
            run += ls * (1.4426950408889634f / 16.0f);
            BB[(size_t)(ch * 64 + i) * 512 + tid] = (_Float16)run;
        }
    }
}

struct GlaRegs { uint2 k[2][2], q[2][2], bb[2][2], bl[2][2]; uint4 v[2]; };

DI void phase_gla(const Params& p, char* smem, int unit) {
    const int tid = get_tid(), lane = tid & 63, w = tid >> 6, l31 = lane & 31, hh = lane >> 5;
    const int dir = unit & 1, dvh = (unit >> 1) & 1, bh = unit >> 2, b = bh >> 2, h = bh & 3;
    const bf16_t* gq = (const bf16_t*)(p.ws + R_GQ);
    const bf16_t* gk = (const bf16_t*)(p.ws + R_GK);
    const bf16_t* gvT = (const bf16_t*)(p.ws + R_GVT) + (size_t)(bh * 256 + dvh * 128) * TKV;
    const _Float16* B16 = (const _Float16*)(p.ws + (dir ? R_BB : R_BF));
    bf16_t* Oo = (bf16_t*)(p.ws + (dir ? R_OB : R_OF));
    char* sQt = smem;
    char* sKt = smem + 16384;
    char* sKh = smem + 32768;
    char* sVT = smem + 49152;
    char* sA = smem + 81920;
    float* sD = (float*)(smem + 90112);
    f32x16 S[4];
#pragma unroll
    for (int k = 0; k < 4; ++k)
#pragma unroll
        for (int e = 0; e < 16; ++e) S[k][e] = 0.f;
    const int sw = (l31 >> 1) & 7;
    GlaRegs R;
    auto chunk_info = [&](int step, int& rowbase, int& tcol, bool& emit) {
        if (step < 4) { const int cc = dir ? 3 - step : step; rowbase = NLAT + b * 256 + cc * 64; tcol = TLAT + cc * 64; emit = false; }
        else { const int cc = dir ? 127 - (step - 4) : step - 4; rowbase = b * TLAT + cc * 64; tcol = cc * 64; emit = true; }
    };
    auto load_chunk = [&](int step) {
        int rowbase, tcol; bool emit; chunk_info(step, rowbase, tcol, emit);
        const int rl = rowbase + (dir ? 0 : 63);
#pragma unroll
        for (int i = 0; i < 2; ++i) {
            const int item = tid + NT * i, tok = item >> 4, c = item & 15, d0 = 16 * (c >> 1) + 4 * (c & 1);
            const size_t ro = (size_t)(rowbase + tok) * 512 + h * 128 + d0;
            R.k[i][0] = *(const uint2*)(gk + ro); R.k[i][1] = *(const uint2*)(gk + ro + 8);
            if (emit) { R.q[i][0] = *(const uint2*)(gq + ro); R.q[i][1] = *(const uint2*)(gq + ro + 8); }
            else { R.q[i][0] = make_uint2(0, 0); R.q[i][1] = make_uint2(0, 0); }
            R.bb[i][0] = *(const uint2*)(B16 + ro); R.bb[i][1] = *(const uint2*)(B16 + ro + 8);
            const size_t rlo = (size_t)rl * 512 + h * 128 + d0;
            R.bl[i][0] = *(const uint2*)(B16 + rlo); R.bl[i][1] = *(const uint2*)(B16 + rlo + 8);
        }
#pragma unroll
        for (int i = 0; i < 2; ++i) R.v[i] = *(const uint4*)(gvT + (size_t)((tid >> 3) + 64 * i) * TKV + tcol + (tid & 7) * 8);
    };
    auto stage_chunk = [&]() {
#pragma unroll
        for (int i = 0; i < 2; ++i) {
            const int item = tid + NT * i, tok = item >> 4, c = item & 15, d0 = 16 * (c >> 1) + 4 * (c & 1);
            float qo[8], ko[8];
#pragma unroll
            for (int g = 0; g < 2; ++g) {
                const h4_t bv = __builtin_bit_cast(h4_t, R.bb[i][g]), lv = __builtin_bit_cast(h4_t, R.bl[i][g]);
                const float kk[4] = {bflo(R.k[i][g].x), bfhi(R.k[i][g].x), bflo(R.k[i][g].y), bfhi(R.k[i][g].y)};
                const float qq[4] = {bflo(R.q[i][g].x), bfhi(R.q[i][g].x), bflo(R.q[i][g].y), bfhi(R.q[i][g].y)};
#pragma unroll
                for (int j = 0; j < 4; ++j) {
                    const float bb = (float)bv[j], bl = (float)lv[j];
                    qo[4 * g + j] = qq[j] * __builtin_amdgcn_exp2f(bb);
                    ko[4 * g + j] = kk[j] * __builtin_amdgcn_exp2f(-bb);
                    const float kh = kk[j] * __builtin_amdgcn_exp2f(bl - bb);
                    const int dk = d0 + 8 * g + j;
                    *(bf16_t*)(sKh + dk * 128 + ((((tok >> 3) ^ ((dk >> 1) & 7))) << 4) + (tok & 7) * 2) = bf1(kh);
                }
            }
            const int po = tok * 256 + ((c ^ (tok & 15)) << 4);
            uint4 uq, uk;
            uq.x = pk2(qo[0], qo[1]); uq.y = pk2(qo[2], qo[3]); uq.z = pk2(qo[4], qo[5]); uq.w = pk2(qo[6], qo[7]);
            uk.x = pk2(ko[0], ko[1]); uk.y = pk2(ko[2], ko[3]); uk.z = pk2(ko[4], ko[5]); uk.w = pk2(ko[6], ko[7]);
            *(uint4*)(sQt + po) = uq; *(uint4*)(sKt + po) = uk;
        }
#pragma unroll
        for (int i = 0; i < 2; ++i) {
            const int row = (tid >> 3) + 64 * i, scn = tid & 7;
            *(uint4*)(sVT + row * 128 + ((scn ^ ((row >> 1) & 7)) << 4)) = R.v[i];
        }
        if (tid < 16) {
            const int d0 = 16 * (tid >> 1) + 4 * (tid & 1);
#pragma unroll
            for (int g = 0; g < 2; ++g) {
                const h4_t lv = __builtin_bit_cast(h4_t, R.bl[0][g]);
#pragma unroll
                for (int j = 0; j < 4; ++j) sD[d0 + 8 * g + j] = __builtin_amdgcn_exp2f((float)lv[j]);
            }
        }
    };
    load_chunk(0);
    for (int step = 0; step < 132; ++step) {
        int rowbase, tcol; bool emit; chunk_info(step, rowbase, tcol, emit);
        stage_chunk();
        __syncthreads();
        if (step + 1 < 132) load_chunk(step + 1);
        const int dvb = 32 * (w & 3);
        f32x16 o[2];
        if (emit) {
            if (w >= 4) {
                const int ti = (w - 4) >> 1, tj = (w - 4) & 1;
                f32x16 a;
#pragma unroll
                for (int e = 0; e < 16; ++e) a[e] = 0.f;
                const bool dead = dir ? (tj < ti) : (tj > ti);
                if (!dead) {
#pragma unroll
                    for (int ks = 0; ks < 8; ++ks) {
                        const int ri = 32 * ti + l31, rj = 32 * tj + l31, c = 2 * ks + hh;
                        const bf16x8 af = *(const bf16x8*)(sQt + ri * 256 + ((c ^ (ri & 15)) << 4));
                        const bf16x8 bf = *(const bf16x8*)(sKt + rj * 256 + ((c ^ (rj & 15)) << 4));
                        a = MFMA32(af, bf, a);
                    }
                }
                const int jj = 32 * tj + l31;
#pragma unroll
                for (int e = 0; e < 16; ++e) {
                    const int ii = 32 * ti + (e & 3) + 8 * (e >> 2) + 4 * hh;
                    const bool keep = dir ? (jj >= ii) : (jj <= ii);
                    *(bf16_t*)(sA + ii * 128 + ((((jj >> 3) ^ ((ii >> 1) & 7))) << 4) + (jj & 7) * 2) = bf1(keep ? a[e] : 0.f);
                }
            } else {
#pragma unroll
            for (int mt = 0; mt < 2; ++mt)
#pragma unroll
                for (int e = 0; e < 16; ++e) o[mt][e] = 0.f;
#pragma unroll
            for (int kt = 0; kt < 4; ++kt)
#pragma unroll
                for (int s = 0; s < 2; ++s) {
                    typedef unsigned u32x4 __attribute__((ext_vector_type(4)));
                    u32x4 pu = {pk2(S[kt][8 * s], S[kt][8 * s + 1]), pk2(S[kt][8 * s + 2], S[kt][8 * s + 3]), pk2(S[kt][8 * s + 4], S[kt][8 * s + 5]), pk2(S[kt][8 * s + 6], S[kt][8 * s + 7])};
                    const bf16x8 sf = __builtin_bit_cast(bf16x8, pu);
#pragma unroll
                    for (int mt = 0; mt < 2; ++mt) {
                        const int ri = 32 * mt + l31, c = 4 * kt + 2 * s + hh;
                        const bf16x8 af = *(const bf16x8*)(sQt + ri * 256 + ((c ^ (ri & 15)) << 4));
                        o[mt] = MFMA32(af, sf, o[mt]);
                    }
                }
            }
            __syncthreads();
            if (w < 4) {
#pragma unroll
            for (int s2 = 0; s2 < 4; ++s2) {
                const int c = 2 * s2 + hh;
                const bf16x8 vf = *(const bf16x8*)(sVT + (dvb + l31) * 128 + ((c ^ sw) << 4));
#pragma unroll
                for (int mt = 0; mt < 2; ++mt) {
                    const bf16x8 af = *(const bf16x8*)(sA + (32 * mt + l31) * 128 + ((c ^ sw) << 4));
                    o[mt] = MFMA32(af, vf, o[mt]);
                }
            }
            bf16_t* od = Oo + (size_t)rowbase * 1024 + h * 256 + dvh * 128 + dvb + l31;
#pragma unroll
            for (int mt = 0; mt < 2; ++mt)
#pragma unroll
                for (int e = 0; e < 16; ++e) od[(size_t)(32 * mt + (e & 3) + 8 * (e >> 2) + 4 * hh) * 1024] = bf1(o[mt][e]);
            }
        }
        if (w < 4) {
#pragma unroll
        for (int kt = 0; kt < 4; ++kt)
#pragma unroll
            for (int g4 = 0; g4 < 4; ++g4) {
                const f32x4 dd = *(const f32x4*)(sD + 32 * kt + 8 * g4 + 4 * hh);
#pragma unroll
                for (int jq = 0; jq < 4; ++jq) S[kt][4 * g4 + jq] *= dd[jq];
            }
#pragma unroll
        for (int s2 = 0; s2 < 4; ++s2) {
            const int c = 2 * s2 + hh;
            const bf16x8 vf = *(const bf16x8*)(sVT + (dvb + l31) * 128 + ((c ^ sw) << 4));
#pragma unroll
            for (int kt = 0; kt < 4; ++kt) {
                const bf16x8 af = *(const bf16x8*)(sKh + (32 * kt + l31) * 128 + ((c ^ sw) << 4));
                S[kt] = MFMA32(af, vf, S[kt]);
            }
        }
        }
        __syncthreads();
    }
}

DI void phase_combine(const Params& p, int panel) {
    const int tid = get_tid(), lane = tid & 63, w = tid >> 6;
    const bf16_t* OF = (const bf16_t*)(p.ws + R_OF);
    const bf16_t* OB = (const bf16_t*)(p.ws + R_OB);
    const bf16_t* SG = (const bf16_t*)(p.ws + R_SG);
    bf16_t* Y = (bf16_t*)(p.ws + R_YGLA);
    for (int row2 = panel * 256 + w; row2 < panel * 256 + 256; row2 += 16)
#pragma unroll
    for (int rr = 0; rr < 2; ++rr) {
        const int row = row2 + 8 * rr;
        const size_t o = (size_t)row * 1024 + lane * 16;
        const uint4 a0 = *(const uint4*)(OF + o), a1 = *(const uint4*)(OF + o + 8);
        const uint4 b0 = *(const uint4*)(OB + o), b1 = *(const uint4*)(OB + o + 8);
        const uint4 g0 = *(const uint4*)(SG + o), g1 = *(const uint4*)(SG + o + 8);
        const unsigned au[8] = {a0.x, a0.y, a0.z, a0.w, a1.x, a1.y, a1.z, a1.w};
        const unsigned bu[8] = {b0.x, b0.y, b0.z, b0.w, b1.x, b1.y, b1.z, b1.w};
        const unsigned gu[8] = {g0.x, g0.y, g0.z, g0.w, g1.x, g1.y, g1.z, g1.w};
        float v[16]; float ss = 0.f;
#pragma unroll
        for (int e = 0; e < 8; ++e) { v[2 * e] = bflo(au[e]) + bflo(bu[e]); v[2 * e + 1] = bfhi(au[e]) + bfhi(bu[e]); ss += v[2 * e] * v[2 * e] + v[2 * e + 1] * v[2 * e + 1]; }
#pragma unroll
        for (int of = 8; of >= 1; of >>= 1) ss += __shfl_xor(ss, of);
        const float rs = rsqrtf(ss * (1.0f / 256.0f) + EPS);
        const float* gn = p.gla_hn + ((lane * 16) & 255);
        unsigned ou[8];
#pragma unroll
        for (int e = 0; e < 8; ++e) ou[e] = pk2(v[2 * e] * rs * gn[2 * e] * bflo(gu[e]), v[2 * e + 1] * rs * gn[2 * e + 1] * bfhi(gu[e]));
        *(uint4*)(Y + o) = make_uint4(ou[0], ou[1], ou[2], ou[3]);
        *(uint4*)(Y + o + 8) = make_uint4(ou[4], ou[5], ou[6], ou[7]);
    }
}

template <int MODE>
DI void phase_rows(const Params& p, char* smem, int panel) {
    float* md = (float*)smem;
    const int tid = get_tid(), lane = tid & 63, w = tid >> 6;
    const bf16_t* Yin = (const bf16_t*)(p.ws + (MODE == 0 ? R_Y2 : R_Y3));
    bf16_t* H2 = (bf16_t*)(p.ws + R_H2);
    const float* pn = MODE == 0 ? p.post_norm1 : p.post_norm2;
    const float* xsrc = MODE == 0 ? p.x : (const float*)p.out;
    const int r = panel >> 5;
    __syncthreads();
    if (MODE == 0) { load_mod(p, r, 2, md); load_mod(p, r, 3, md + 1024); load_mod(p, r, 4, md + 2048); }
    else load_mod(p, r, 5, md);
    __syncthreads();
    for (int i = 0; i < 16; ++i) {
        const int rows[2] = {panel * 256 + w * 32 + i, panel * 256 + w * 32 + 16 + i};
        uint2 yu[2][4]; f32x4 xv[2][4];
#pragma unroll
        for (int q = 0; q < 2; ++q)
#pragma unroll
            for (int j = 0; j < 4; ++j) {
                yu[q][j] = *(const uint2*)(Yin + (size_t)rows[q] * 1024 + lane * 4 + 256 * j);
                xv[q][j] = *(const f32x4*)(xsrc + (size_t)rows[q] * 1024 + lane * 4 + 256 * j);
            }
        float y[2][16], ss[2] = {0.f, 0.f};
#pragma unroll
        for (int q = 0; q < 2; ++q)
#pragma unroll
            for (int j = 0; j < 4; ++j) {
                y[q][4 * j] = bflo(yu[q][j].x); y[q][4 * j + 1] = bfhi(yu[q][j].x); y[q][4 * j + 2] = bflo(yu[q][j].y); y[q][4 * j + 3] = bfhi(yu[q][j].y);
#pragma unroll
                for (int e = 0; e < 4; ++e) ss[q] += y[q][4 * j + e] * y[q][4 * j + e];
            }
        ss[0] = wave_sum(ss[0]); ss[1] = wave_sum(ss[1]);
        float xn[2][16], s2[2] = {0.f, 0.f};
#pragma unroll
        for (int q = 0; q < 2; ++q) {
            const float rs = rsqrtf(ss[q] * (1.0f / 1024.0f) + EPS);
#pragma unroll
            for (int j = 0; j < 4; ++j) {
                const int col = lane * 4 + 256 * j;
                const f32x4 g = *(const f32x4*)(pn + col), gt = *(const f32x4*)(md + col);
#pragma unroll
                for (int e = 0; e < 4; ++e) { xn[q][4 * j + e] = xv[q][j][e] + gt[e] * (y[q][4 * j + e] * rs * g[e]); s2[q] += xn[q][4 * j + e] * xn[q][4 * j + e]; }
                f32x4 ov = {xn[q][4 * j], xn[q][4 * j + 1], xn[q][4 * j + 2], xn[q][4 * j + 3]};
                *(f32x4*)(p.out + (size_t)rows[q] * 1024 + col) = ov;
            }
        }
        if (MODE == 0) {
            s2[0] = wave_sum(s2[0]); s2[1] = wave_sum(s2[1]);
#pragma unroll
            for (int q = 0; q < 2; ++q) {
                const float rs2 = rsqrtf(s2[q] * (1.0f / 1024.0f) + EPS);
#pragma unroll
                for (int j = 0; j < 4; ++j) {
                    const int col = lane * 4 + 256 * j;
                    const f32x4 g = *(const f32x4*)(p.pre_norm2 + col), sh = *(const f32x4*)(md + 1024 + col), sc = *(const f32x4*)(md + 2048 + col);
                    float o[4];
#pragma unroll
                    for (int e = 0; e < 4; ++e) o[e] = xn[q][4 * j + e] * rs2 * g[e] * (1.f + sc[e]) + sh[e];
                    uint2 u; u.x = pk2(o[0], o[1]); u.y = pk2(o[2], o[3]);
                    *(uint2*)(H2 + (size_t)rows[q] * 1024 + col) = u;
                }
            }
        }
    }
}

DI void gsync(unsigned* bar, unsigned k) {
    __syncthreads();
    const unsigned epoch = k * gridDim.x;
    if (threadIdx.x == 0) {
        __threadfence();
        atomicAdd(bar, 1u);
        while (__hip_atomic_load(bar, __ATOMIC_RELAXED, __HIP_MEMORY_SCOPE_AGENT) < epoch) __builtin_amdgcn_s_sleep(16);
        __threadfence();
    }
    __syncthreads();
}

__global__ void __launch_bounds__(NT) fwd_megakernel(Params p) {
    __shared__ __attribute__((aligned(16))) char smem[131072 + 16384];
    cg::grid_group grid = cg::this_grid();
    char* ws = p.ws;
    unsigned* bar = (unsigned*)(ws + OFF_BAR);
    phase_prep(p, smem);
    grid.sync();
    phase_h(p, smem);
    gsync(bar, 1u);
    {
        EpiIn e; e.Q = (bf16_t*)(ws + R_Q); e.Kk = (bf16_t*)(ws + R_K); e.Vt = (bf16_t*)(ws + R_VT); e.gq = (bf16_t*)(ws + R_GQ); e.gk = (bf16_t*)(ws + R_GK);
        e.gvT = (bf16_t*)(ws + R_GVT); e.sg = (bf16_t*)(ws + R_SG); e.mg = (bf16_t*)p.out; e.glow = (float*)(ws + OFF_GLOW); e.kmax = (float*)(ws + OFF_KMAX); e.kacc0 = 0.f; e.kacc1 = 0.f;
        {
            const f32x4* src = (const f32x4*)(ws + OFF_ROPE); f32x4* dst = (f32x4*)(smem + 131072);
            for (int i = threadIdx.x; i < 1024; i += NT) dst[i] = src[i];
            __syncthreads();
            e.rope = (const float*)(smem + 131072);
        }
        gemm_phase_ex<true>((const bf16_t*)(ws + R_H), 1024, (const bf16_t*)(ws + OFF_WIN), 1024, 1024, 264, 33, smem, e, blockIdx.x, gridDim.x);
    }
    gsync(bar, 2u);
    phase_attn(p, smem);
    gsync(bar, 3u);
    phase_gate(p, smem);
    gsync(bar, 4u);
    const bool split = gridDim.x >= 192;
    const int nscan = split ? 128 : (int)gridDim.x, oth0 = split ? 128 : 0, noth = (int)gridDim.x - oth0;
    if ((int)blockIdx.x < nscan) { for (int unit = blockIdx.x; unit < 128; unit += nscan) { __syncthreads(); phase_gla(p, smem, unit); } }
    if ((int)blockIdx.x >= oth0) {
        EpiGate0 e0; e0.mg = (bf16_t*)p.out;
        gemm_phase_ex<false>((const bf16_t*)(ws + R_H), 1024, (const bf16_t*)(ws + OFF_WDA), 1024, 1024, 256, 4, smem, e0, blockIdx.x - oth0, noth);
        const long gsz2 = (long)noth * NT, gtid2 = (long)(blockIdx.x - oth0) * NT + get_tid();
        repack<0>(p.w_bgla, 1024, 1024, (bf16_t*)(ws + OFF_WGLA), 1024, gtid2, gsz2);
        repack<0>(p.w_out, 1024, 1024, (bf16_t*)(ws + OFF_WOUT), 1024, gtid2, gsz2);
        repack<0>(p.w_ff1, 1024, 4096, (bf16_t*)(ws + OFF_WFF1), 4096, gtid2, gsz2);
        repack<0>(p.w_ff2, 4096, 1024, (bf16_t*)(ws + OFF_WFF2), 1024, gtid2, gsz2);
    }
    gsync(bar, 5u);
    for (int panel = blockIdx.x; panel < 256; panel += gridDim.x) phase_combine(p, panel);
    gsync(bar, 6u);
    { EpiGate1 e1; e1.Y = (bf16_t*)(ws + R_Y); e1.mg = (const bf16_t*)p.out;
      gemm_phase((const bf16_t*)(ws + R_YGLA), 1024, (const bf16_t*)(ws + OFF_WGLA), 1024, 1024, 256, 4, smem, e1); }
    gsync(bar, 7u);
    { EpiStore<0> e; e.O = (bf16_t*)(ws + R_Y2); e.ldo = 1024;
      gemm_phase((const bf16_t*)(ws + R_Y), 1024, (const bf16_t*)(ws + OFF_WOUT), 1024, 1024, 256, 4, smem, e); }
    gsync(bar, 8u);
    for (int panel = blockIdx.x; panel < 256; panel += gridDim.x) phase_rows<0>(p, smem, panel);
    gsync(bar, 9u);
    { EpiStore<1> e; e.O = (bf16_t*)(ws + R_U); e.ldo = 4096;
      gemm_phase((const bf16_t*)(ws + R_H2), 1024, (const bf16_t*)(ws + OFF_WFF1), 1024, 1024, 256, 16, smem, e); }
    gsync(bar, 10u);
    { EpiStore<0> e; e.O = (bf16_t*)(ws + R_Y3); e.ldo = 1024;
      gemm_phase((const bf16_t*)(ws + R_U), 4096, (const bf16_t*)(ws + OFF_WFF2), 4096, 4096, 256, 4, smem, e); }
    gsync(bar, 11u);
    for (int panel = blockIdx.x; panel < 256; panel += gridDim.x) phase_rows<1>(p, smem, panel);
}

extern "C" void kernel_launch(void* const* d_in, const int* in_sizes, int n_in, void* d_out, int out_size, void* d_ws, size_t ws_size, hipStream_t stream) {
    static int grid_blocks = 0;
    if (!grid_blocks) {
        int dev = 0, cus = 0, per_cu = 0;
        hipGetDevice(&dev);
        hipDeviceGetAttribute(&cus, hipDeviceAttributeMultiprocessorCount, dev);
        hipOccupancyMaxActiveBlocksPerMultiprocessor(&per_cu, fwd_megakernel, NT, 0);
        if (per_cu < 1) per_cu = 1;
        grid_blocks = cus * per_cu;
        if (grid_blocks > 256) grid_blocks = 256;
    }
    Params p{};
    const float* const* in = (const float* const*)d_in;
    p.x = in[0]; p.c = in[1]; p.ctx = in[2]; p.c_ctx = in[3]; p.w_mod = in[4]; p.b_mod = in[5]; p.pre_norm1 = in[6]; p.w_in = in[7];
    p.w_gate_up = in[8]; p.b_gate_up = in[9]; p.lq1 = in[10]; p.lk1 = in[11]; p.lq2 = in[12]; p.lk2 = in[13]; p.da_hn = in[14]; p.gla_hn = in[15];
    p.w_bda = in[16]; p.w_bgla = in[17]; p.w_out = in[18]; p.post_norm1 = in[19]; p.pre_norm2 = in[20]; p.w_ff1 = in[21]; p.w_ff2 = in[22]; p.post_norm2 = in[23];
    p.out = (float*)d_out; p.ws = (char*)d_ws;
    hipMemsetAsync((char*)d_ws + OFF_BAR, 0, 256, stream);
    void* args[] = {&p};
    hipError_t e = hipLaunchCooperativeKernel((void*)fwd_megakernel, dim3(grid_blocks), dim3(NT), args, 0, stream);
    if (e != hipSuccess) fprintf(stderr, "cooperative launch failed: %s (grid %d)\n", hipGetErrorString(e), grid_blocks);
}
```

```cpp
#include <hip/hip_runtime.h>
#include <hip/hip_cooperative_groups.h>
#include <cstdio>
namespace cg = cooperative_groups;

typedef unsigned short bf16_t;
typedef short bf16x8 __attribute__((ext_vector_type(8)));
typedef float f32x16 __attribute__((ext_vector_type(16)));
typedef float f32x4 __attribute__((ext_vector_type(4)));
typedef float f32x2 __attribute__((ext_vector_type(2)));
typedef __bf16 bf2_t __attribute__((ext_vector_type(2)));
typedef _Float16 h4_t __attribute__((ext_vector_type(4)));

#define DI __device__ __forceinline__
#define MFMA32(a, b, c) __builtin_amdgcn_mfma_f32_32x32x16_bf16((a), (b), (c), 0, 0, 0)

constexpr int NT = 512;
constexpr int TLAT = 8192, NB = 8, NLAT = 65536, NROW = 67584, TKV = 8448;
constexpr float EPS = 1e-6f;
constexpr size_t MiB = 1048576;
constexpr size_t OFF_WIN = 0;
constexpr size_t OFF_WDA = OFF_WIN + 8448ull * 1024 * 2;
constexpr size_t OFF_WGLA = OFF_WDA + 2 * MiB;
constexpr size_t OFF_WOUT = OFF_WGLA + 2 * MiB;
constexpr size_t OFF_WFF1 = OFF_WOUT + 2 * MiB;
constexpr size_t OFF_WFF2 = OFF_WFF1 + 8 * MiB;
constexpr size_t OFF_MODP = OFF_WFF2 + 8 * MiB;
constexpr size_t OFF_ROPE = OFF_MODP + 16ull * 9 * 6144 * 4;
constexpr size_t OFF_GLOW = OFF_ROPE + 16384;
constexpr size_t OFF_KMAX = OFF_GLOW + 67584ull * 32 * 4;
constexpr int KMS = 32;
constexpr size_t OFF_BAR = OFF_KMAX + 256 * KMS * 4;
constexpr size_t R_H = 64 * MiB;
constexpr size_t R_Q = R_H + 132 * MiB;
constexpr size_t R_K = R_Q + 128 * MiB;
constexpr size_t R_VT = R_K + 132 * MiB;
constexpr size_t R_GQ = R_VT + 132 * MiB;
constexpr size_t R_GK = R_GQ + 64 * MiB;
constexpr size_t R_GVT = R_GK + 66 * MiB;
constexpr size_t R_SG = R_GVT + 132 * MiB;
constexpr size_t WS_END = R_SG + 128 * MiB;
static_assert(OFF_BAR + 1024 <= R_H, "small region overflow");
static_assert(WS_END <= 1024 * MiB, "workspace overflow");
constexpr size_t R_BF = R_Q;
constexpr size_t R_BB = R_Q + 66 * MiB;
constexpr size_t R_OF = R_K + 4 * MiB;
constexpr size_t R_OB = R_VT;
constexpr size_t R_YGLA = R_SG;
constexpr size_t R_Y = R_GVT;
constexpr size_t R_Y2 = R_SG;
constexpr size_t R_H2 = R_H;
constexpr size_t R_U = R_Q;
constexpr size_t R_Y3 = R_GVT;

struct Params {
    const float *x, *c, *ctx, *c_ctx, *w_mod, *b_mod, *pre_norm1, *w_in, *w_gate_up, *b_gate_up;
    const float *lq1, *lk1, *lq2, *lk2, *da_hn, *gla_hn, *w_bda, *w_bgla, *w_out, *post_norm1, *pre_norm2, *w_ff1, *w_ff2, *post_norm2;
    float* out;
    char* ws;
};

DI unsigned pk2(float a, float b) { f32x2 v = {a, b}; bf2_t r = __builtin_convertvector(v, bf2_t); return __builtin_bit_cast(unsigned, r); }
DI bf16_t bf1(float a) { __bf16 r = (__bf16)a; return __builtin_bit_cast(unsigned short, r); }
DI float bflo(unsigned v) { return __uint_as_float(v << 16); }
DI float bfhi(unsigned v) { return __uint_as_float(v & 0xffff0000u); }
DI float wave_sum(float v) {
#pragma unroll
    for (int o = 32; o >= 1; o >>= 1) v += __shfl_xor(v, o);
    return v;
}
DI int get_tid() { int t = threadIdx.x; asm volatile("" : "+v"(t)); return t; }
DI float sigmoidf_(float x) { return __builtin_amdgcn_rcpf(1.0f + __expf(-x)); }

template <int MODE>
DI void repack(const float* __restrict__ src, int K, int Nsrc, bf16_t* __restrict__ dst, int Nd, long gtid, long gsz) {
    const long total = (long)Nd * (K / 8);
    for (long it = gtid; it < total; it += gsz) {
        const int n = (int)(it % Nd), kc = (int)(it / Nd);
        int col = n; bool valid = true;
        if (MODE == 1) { if (n < 5120) col = n; else if (n < 8192) col = n + 32; else if (n < 8224) col = n - 8192 + 5120; else valid = false; }
        float v[8];
#pragma unroll
        for (int j = 0; j < 8; ++j) v[j] = valid ? src[(size_t)(kc * 8 + j) * Nsrc + col] : 0.f;
        uint4 o; o.x = pk2(v[0], v[1]); o.y = pk2(v[2], v[3]); o.z = pk2(v[4], v[5]); o.w = pk2(v[6], v[7]);
        *(uint4*)(dst + (size_t)n * K + kc * 8) = o;
    }
}

DI void sincos_acc(float a, float& s, float& c) {
    const float q = rintf(a * 0.63661977236758134f);
    float r = fmaf(-q, 1.5703125f, a); r = fmaf(-q, 4.837512969970703125e-4f, r); r = fmaf(-q, 7.54978995489188216e-8f, r);
    const float r2 = r * r;
    const float sp = r + r * r2 * (-1.6666666666e-1f + r2 * (8.3333333333e-3f + r2 * (-1.98412698e-4f + r2 * 2.7557319e-6f)));
    const float cp = 1.0f + r2 * (-0.5f + r2 * (4.16666666667e-2f + r2 * (-1.38888888889e-3f + r2 * (2.48015873e-5f + r2 * -2.75573192e-7f))));
    const int qi = ((int)q) & 3;
    s = (qi == 0) ? sp : (qi == 1) ? cp : (qi == 2) ? -sp : -cp;
    c = (qi == 0) ? cp : (qi == 1) ? -sp : (qi == 2) ? -cp : sp;
}

DI void phase_prep(const Params& p, char* smem) {
    const int tid = get_tid();
    const long gsz = (long)gridDim.x * NT, gtid = (long)blockIdx.x * NT + tid;
    char* ws = p.ws;
    repack<1>(p.w_in, 1024, 8224, (bf16_t*)(ws + OFF_WIN), 8448, gtid, gsz);
    repack<0>(p.w_bda, 1024, 1024, (bf16_t*)(ws + OFF_WDA), 1024, gtid, gsz);
    if (gtid < 256) ((float*)(ws + OFF_KMAX))[gtid * KMS] = 0.f;
    if (gtid < 2048) {
        const int pos = (int)gtid >> 4, f = (int)gtid & 15;
        const float inv = exp2f(-(float)f * (13.287712379549449f / 16.0f));
        float s, c; sincos_acc((float)pos * inv, s, c);
        float* rt = (float*)(ws + OFF_ROPE);
        rt[gtid] = c; rt[2048 + gtid] = s;
    }
    float* sil = (float*)smem;
    float* modp = (float*)(ws + OFF_MODP);
    for (int item = blockIdx.x; item < 192; item += gridDim.x) {
        const int cb = item % 12, ks = item / 12;
        __syncthreads();
        for (int i = tid; i < 9 * 64; i += NT) {
            const int r = i >> 6, kk = i & 63;
            const float v = (r < 8) ? p.c[r * 1024 + ks * 64 + kk] : p.c_ctx[ks * 64 + kk];
            sil[i] = v * sigmoidf_(v);
        }
        __syncthreads();
        const int n = cb * 512 + tid;
        float acc[9];
#pragma unroll
        for (int r = 0; r < 9; ++r) acc[r] = 0.f;
        for (int kk = 0; kk < 64; ++kk) {
            const float w = p.w_mod[(size_t)(ks * 64 + kk) * 6144 + n];
#pragma unroll
            for (int r = 0; r < 9; ++r) acc[r] = fmaf(sil[r * 64 + kk], w, acc[r]);
        }
#pragma unroll
        for (int r = 0; r < 9; ++r) modp[(size_t)(ks * 9 + r) * 6144 + n] = acc[r];
    }
}

DI void load_mod(const Params& p, int r, int which, float* dst) {
    const float* modp = (const float*)(p.ws + OFF_MODP);
    for (int n = threadIdx.x; n < 1024; n += NT) {
        float a = p.b_mod[which * 1024 + n];
#pragma unroll
        for (int ks = 0; ks < 16; ++ks) a += modp[(size_t)(ks * 9 + r) * 6144 + which * 1024 + n];
        dst[n] = a;
    }
}

DI void h_row2(const Params& p, const float* md, bf16_t* H, int rowA, int rowB, int lane) {
    const float* sa = rowA < NLAT ? p.x + (size_t)rowA * 1024 : p.ctx + (size_t)(rowA - NLAT) * 1024;
    const float* sbp = rowB < NLAT ? p.x + (size_t)rowB * 1024 : p.ctx + (size_t)(rowB - NLAT) * 1024;
    f32x4 va[4], vb[4]; float sa2 = 0.f, sb2 = 0.f;
#pragma unroll
    for (int j = 0; j < 4; ++j) { va[j] = *(const f32x4*)(sa + lane * 4 + 256 * j); vb[j] = *(const f32x4*)(sbp + lane * 4 + 256 * j); }
#pragma unroll
    for (int j = 0; j < 4; ++j) {
        sa2 += va[j].x * va[j].x + va[j].y * va[j].y + va[j].z * va[j].z + va[j].w * va[j].w;
        sb2 += vb[j].x * vb[j].x + vb[j].y * vb[j].y + vb[j].z * vb[j].z + vb[j].w * vb[j].w;
    }
    sa2 = wave_sum(sa2); sb2 = wave_sum(sb2);
    const float ra = rsqrtf(sa2 * (1.0f / 1024.0f) + EPS), rb = rsqrtf(sb2 * (1.0f / 1024.0f) + EPS);
#pragma unroll
    for (int j = 0; j < 4; ++j) {
        const int col = lane * 4 + 256 * j;
        const f32x4 g = *(const f32x4*)(p.pre_norm1 + col);
        const f32x4 sh = *(const f32x4*)(md + col), sc = *(const f32x4*)(md + 1024 + col);
        float oa[4], ob[4];
#pragma unroll
        for (int e = 0; e < 4; ++e) { const float gm = g[e] * (1.f + sc[e]); oa[e] = va[j][e] * ra * gm + sh[e]; ob[e] = vb[j][e] * rb * gm + sh[e]; }
        uint2 o; o.x = pk2(oa[0], oa[1]); o.y = pk2(oa[2], oa[3]);
        *(uint2*)(H + (size_t)rowA * 1024 + col) = o;
        o.x = pk2(ob[0], ob[1]); o.y = pk2(ob[2], ob[3]);
        *(uint2*)(H + (size_t)rowB * 1024 + col) = o;
    }
}

DI void phase_h(const Params& p, char* smem) {
    float* md = (float*)smem;
    const int tid = get_tid(), lane = tid & 63, w = tid >> 6;
    bf16_t* H = (bf16_t*)(p.ws + R_H);
    for (int tile = blockIdx.x; tile < 256; tile += gridDim.x) {
        __syncthreads();
        load_mod(p, tile >> 5, 0, md); load_mod(p, tile >> 5, 1, md + 1024);
        __syncthreads();
        for (int i = 0; i < 16; ++i) h_row2(p, md, H, tile * 256 + w * 32 + i, tile * 256 + w * 32 + 16 + i, lane);
    }
    __syncthreads();
    load_mod(p, 8, 0, md); load_mod(p, 8, 1, md + 1024);
    __syncthreads();
    for (int r2 = blockIdx.x * 8 + w; r2 < 1024; r2 += gridDim.x * 8) h_row2(p, md, H, NLAT + 2 * r2, NLAT + 2 * r2 + 1, lane);
}

typedef __attribute__((address_space(3))) unsigned lds_u32;
DI lds_u32* to_lds(const void* p) { return (lds_u32*)(unsigned)(size_t)p; }
#define GLDS16(src, dst) __builtin_amdgcn_global_load_lds((const unsigned*)(src), to_lds(dst), 16, 0, 0)

#define MFMA16(a, b, c) __builtin_amdgcn_mfma_f32_16x16x32_bf16((a), (b), (c), 0, 0, 0)
DI void stage_rc8(int b, int& R, int& C) { const int st = b >> 10, sb = b & 1023, swz = sb ^ (((sb >> 9) & 1) << 5); R = (st >> 1) * 16 + (swz >> 6); C = (st & 1) * 32 + ((swz & 63) >> 1); }
template <bool SWAP, class Epi>
DI void gemm_tile(const bf16_t* A, int lda, const bf16_t* B, int ldb, int K, int m0, int n0, bool, bool, int, int, char* smem, Epi& epi) {
    const int tid = get_tid(), lane = tid & 63, w = tid >> 6, wr = w >> 2, wc = w & 3, fr = lane & 15, fq = lane >> 4;
    f32x4 acc[2][2][4][2];
#pragma unroll
    for (int a = 0; a < 2; ++a)
#pragma unroll
        for (int b = 0; b < 2; ++b)
#pragma unroll
            for (int m = 0; m < 4; ++m)
#pragma unroll
                for (int n = 0; n < 2; ++n) acc[a][b][m][n] = (f32x4){0.f, 0.f, 0.f, 0.f};
    bf16x8 At[4][2], B0[2][2], B1[2][2];
    int R0, C0, R1, C1; stage_rc8(tid * 16, R0, C0); stage_rc8(tid * 16 + 8192, R1, C1);
    const char* Am = (const char*)(A + (size_t)m0 * lda); const char* Bn = (const char*)(B + (size_t)n0 * ldb);
    const unsigned a0 = 2u * (unsigned)(R0 * lda + C0), a1 = 2u * (unsigned)(R1 * lda + C1), b0 = 2u * (unsigned)(R0 * ldb + C0), b1 = 2u * (unsigned)(R1 * ldb + C1);
    const unsigned ahalf = 256u * (unsigned)lda, bhalf = 256u * (unsigned)ldb;
    char* sdst = smem + w * 1024;
    const int loff = (fr * 64 + fq * 16) ^ ((fr >> 3) << 5);
    const int aoff = wr * 8192 + loff, boff = wc * 4096 + loff;
#define SA8(b, h) (((b) * 2 + (h)) * 16384)
#define SB8(b, h) ((4 + (b) * 2 + (h)) * 16384)
#define STAGE_A(b, h, kt_) do { GLDS16(Am + (a0 + (h) * ahalf + (unsigned)(kt_) * 128u), sdst + SA8(b, h)); GLDS16(Am + (a1 + (h) * ahalf + (unsigned)(kt_) * 128u), sdst + SA8(b, h) + 8192); } while (0)
#define STAGE_B(b, h, kt_) do { GLDS16(Bn + (b0 + (h) * bhalf + (unsigned)(kt_) * 128u), sdst + SB8(b, h)); GLDS16(Bn + (b1 + (h) * bhalf + (unsigned)(kt_) * 128u), sdst + SB8(b, h) + 8192); } while (0)
#define LDA8(dst, b, h) do { _Pragma("unroll") for (int m = 0; m < 4; ++m) _Pragma("unroll") for (int k = 0; k < 2; ++k) \
        dst[m][k] = *(const bf16x8*)(smem + SA8(b, h) + aoff + (m * 2 + k) * 1024); } while (0)
#define LDB8(dst, b, h) do { _Pragma("unroll") for (int n = 0; n < 2; ++n) _Pragma("unroll") for (int k = 0; k < 2; ++k) \
        dst[n][k] = *(const bf16x8*)(smem + SB8(b, h) + boff + (n * 2 + k) * 1024); } while (0)
#define MMA8(ai, bj, Af, Bf) do { __builtin_amdgcn_s_setprio(1); \
        _Pragma("unroll") for (int m = 0; m < 4; ++m) _Pragma("unroll") for (int n = 0; n < 2; ++n) _Pragma("unroll") for (int k = 0; k < 2; ++k) \
            acc[ai][bj][m][n] = SWAP ? MFMA16(Af[m][k], Bf[n][k], acc[ai][bj][m][n]) : MFMA16(Bf[n][k], Af[m][k], acc[ai][bj][m][n]); \
        __builtin_amdgcn_s_setprio(0); } while (0)
#define WAIT_V(n) asm volatile("s_waitcnt vmcnt(" #n ")" ::: "memory")
#define WAIT_L(n) asm volatile("s_waitcnt lgkmcnt(" #n ")" ::: "memory")
#define BAR8 __builtin_amdgcn_s_barrier()
#define SCHED8 __builtin_amdgcn_sched_barrier(0)
    const int nt = K >> 6;
    WAIT_V(0);
    STAGE_B(0, 0, 0); STAGE_A(0, 0, 0); STAGE_B(0, 1, 0); STAGE_A(0, 1, 0);
    if (wr == 1) BAR8;
    WAIT_V(4); BAR8;
    STAGE_B(1, 0, 1); STAGE_A(1, 0, 1); STAGE_B(1, 1, 1);
    WAIT_V(6); BAR8;
    for (int t = 0; t < nt - 2; t += 2) {
        LDB8(B0, 0, 0); SCHED8; LDA8(At, 0, 0); STAGE_A(1, 1, t + 1);
        WAIT_L(8); BAR8; WAIT_L(0); MMA8(0, 0, At, B0); BAR8; SCHED8;
        LDB8(B1, 0, 1); STAGE_B(0, 0, t + 2);
        BAR8; WAIT_L(0); MMA8(0, 1, At, B1); BAR8;
        LDA8(At, 0, 1); STAGE_A(0, 0, t + 2);
        BAR8; WAIT_L(0); MMA8(1, 0, At, B0); BAR8; SCHED8;
        STAGE_B(0, 1, t + 2);
        WAIT_V(6); BAR8; MMA8(1, 1, At, B1); BAR8;
        LDB8(B0, 1, 0); SCHED8; LDA8(At, 1, 0); STAGE_A(0, 1, t + 2);
        WAIT_L(8); BAR8; WAIT_L(0); MMA8(0, 0, At, B0); BAR8; SCHED8;
        LDB8(B1, 1, 1); STAGE_B(1, 0, t + 3);
        BAR8; WAIT_L(0); MMA8(0, 1, At, B1); BAR8;
        LDA8(At, 1, 1); STAGE_A(1, 0, t + 3);
        BAR8; WAIT_L(0); MMA8(1, 0, At, B0); BAR8; SCHED8;
        STAGE_B(1, 1, t + 3);
        WAIT_V(6); BAR8; MMA8(1, 1, At, B1); BAR8;
    }
    {
        LDB8(B0, 0, 0); LDA8(At, 0, 0); STAGE_A(1, 1, nt - 1);
        BAR8; WAIT_L(0); MMA8(0, 0, At, B0); BAR8;
        LDB8(B1, 0, 1); BAR8; WAIT_L(0); MMA8(0, 1, At, B1); BAR8;
        LDA8(At, 0, 1); WAIT_V(4); BAR8; WAIT_L(0); MMA8(1, 0, At, B0); MMA8(1, 1, At, B1); BAR8;
    }
    {
        LDB8(B0, 1, 0); LDA8(At, 1, 0); WAIT_V(2); BAR8; WAIT_L(0); MMA8(0, 0, At, B0); BAR8;
        LDB8(B1, 1, 1); WAIT_V(0); BAR8; WAIT_L(0); MMA8(0, 1, At, B1); BAR8;
        LDA8(At, 1, 1); BAR8; WAIT_L(0); MMA8(1, 0, At, B0); MMA8(1, 1, At, B1); BAR8;
    }
    if (wr == 0) BAR8;
#undef SA8
#undef SB8
#undef STAGE_A
#undef STAGE_B
#undef LDA8
#undef LDB8
#undef MMA8
#undef WAIT_V
#undef WAIT_L
#undef BAR8
#undef SCHED8
    const int tid2 = get_tid(), wr2 = (tid2 >> 6) >> 2, wc2 = (tid2 >> 6) & 3, fr2 = tid2 & 15, fq2 = (tid2 & 63) >> 4;
    if constexpr (!SWAP) epi.begin();
#pragma unroll
    for (int ai = 0; ai < 2; ++ai)
#pragma unroll
        for (int bj = 0; bj < 2; ++bj) {
#pragma unroll
            for (int m = 0; m < 4; ++m) {
                if constexpr (SWAP) {
#pragma unroll
                    for (int n = 0; n < 2; ++n) {
                        const f32x4 v = acc[ai][bj][m][n];
                        uint2 u; u.x = pk2(v[0], v[1]); u.y = pk2(v[2], v[3]);
                        { const int r = wc2 * 32 + n * 16 + fr2, cbB = (wr2 * 64 + m * 16 + 4 * fq2) * 2; *(uint2*)(smem + r * 256 + ((((cbB >> 4) ^ (r & 15)) << 4) | (cbB & 8))) = u; }
                    }
                } else {
                    epi.xform(m0 + ai * 128 + wr2 * 64 + m * 16 + fr2, n0 + bj * 128 + wc2 * 32, acc[ai][bj][m], fq2);
#pragma unroll
                    for (int n = 0; n < 2; ++n) {
                        const f32x4 v = acc[ai][bj][m][n];
                        uint2 u; u.x = pk2(v[0], v[1]); u.y = pk2(v[2], v[3]);
                        { const int r = wr2 * 64 + m * 16 + fr2, cbB = (wc2 * 32 + n * 16 + 4 * fq2) * 2; *(uint2*)(smem + r * 256 + ((((cbB >> 4) ^ (r & 15)) << 4) | (cbB & 8))) = u; }
                    }
                }
                if (m & 1) asm volatile("" ::: "memory");
            }
            __syncthreads();
#pragma unroll
            for (int i = 0; i < 4; ++i) {
                const int c = tid2 + NT * i, r = c >> 4, c16 = c & 15;
                const uint4 d = *(const uint4*)(smem + r * 256 + ((c16 ^ (r & 15)) << 4));
                bf16_t* dst;
                if constexpr (SWAP) dst = epi.addrT(n0 + bj * 128 + r, m0 + ai * 128 + (c16 >> 3) * 64);
                else dst = epi.addr64(m0 + ai * 128 + r, n0 + bj * 128 + (c16 >> 3) * 64);
                if (dst) *(uint4*)(dst + (c16 & 7) * 8) = d;
            }
            __syncthreads();
        }
    if constexpr (!SWAP) epi.flush(m0, n0, wc2);
}

DI void tile_map(int id, int MT, int NTl, int& mt, int& nt) {
    const int x = id & 7, local = id >> 3, mtx = MT >> 3;
    const int full = mtx >> 2, per = 4 * NTl;
    int patch = local / per, wv = local - patch * per, pm = 4;
    if (patch >= full) { patch = full; wv = local - full * per; pm = mtx - full * 4; }
    const int mo = wv % pm; nt = wv / pm;
    mt = (patch * 4 + mo) * 8 + x;
}

DI void tile_map_in(int id, int& mt, int& nt) {
    if (id < 8448) { tile_map(id, 256, 33, mt, nt); return; }
    const int id2 = id - 8448, k = id2 >> 3;
    mt = 256 + (id2 & 7);
    nt = k < 8 ? 4 + k : k < 10 ? 14 + (k - 8) : k < 14 ? 16 + (k - 10) : 32;
}
template <bool VSWAP, class Epi>
DI void gemm_phase_ex(const bf16_t* A, int lda, const bf16_t* B, int ldb, int K, int MT, int NTl, char* smem, Epi& epi, int bid, int nblk) {
    const int total = VSWAP ? 8448 + 120 : MT * NTl;
    bool first = true;
    for (int id = bid; id < total; id += nblk) {
        int mt, nt, mt2 = 0, nt2 = 0;
        if (VSWAP) tile_map_in(id, mt, nt); else tile_map(id, MT, NTl, mt, nt);
        const bool has_next = id + nblk < total;
        if (has_next) { if (VSWAP) tile_map_in(id + nblk, mt2, nt2); else tile_map(id + nblk, MT, NTl, mt2, nt2); }
        if constexpr (VSWAP) { if (Epi::is_vt(nt)) { gemm_tile<true>(A, lda, B, ldb, K, mt * 256, nt * 256, first, has_next, mt2 * 256, nt2 * 256, smem, epi); first = false; continue; } }
        gemm_tile<false>(A, lda, B, ldb, K, mt * 256, nt * 256, first, has_next, mt2 * 256, nt2 * 256, smem, epi);
        first = false;
    }
}
template <class Epi>
DI void gemm_phase(const bf16_t* A, int lda, const bf16_t* B, int ldb, int K, int MT, int NTl, char* smem, Epi& epi) {
    gemm_phase_ex<false>(A, lda, B, ldb, K, MT, NTl, smem, epi, blockIdx.x, gridDim.x);
}

DI float xhalf_max(float v) {
    typedef unsigned u32x2 __attribute__((ext_vector_type(2)));
    const unsigned u = __float_as_uint(v);
    const u32x2 r = __builtin_amdgcn_permlane32_swap(u, u, false, false);
    return fmaxf(__uint_as_float(r[0]), __uint_as_float(r[1]));
}
DI float xhalf_sum(float v) {
    typedef unsigned u32x2 __attribute__((ext_vector_type(2)));
    const unsigned u = __float_as_uint(v);
    const u32x2 r = __builtin_amdgcn_permlane32_swap(u, u, false, false);
    return __uint_as_float(r[0]) + __uint_as_float(r[1]);
}
template <class Epi>
DI void gemm_panel(const bf16_t* A, int lda, const bf16_t* B, int ldb, int K, int panel, int NTl, char* smem, Epi& epi) {
    for (int nt = 0; nt < NTl; ++nt)
        gemm_tile<false>(A, lda, B, ldb, K, panel * 256, nt * 256, nt == 0, nt + 1 < NTl, panel * 256, (nt + 1) * 256, smem, epi);
}

DI float quad_sum(float v) { v += __shfl_xor(v, 16); v += __shfl_xor(v, 32); return v; }
struct EpiIn {
    bf16_t *Q, *Kk, *Vt, *gq, *gk, *gvT, *sg, *mg; float* glow; const float* rope; float* kmax;
    float kacc0, kacc1;
    static DI bool is_vt(int nt) { return (nt >= 8 && nt < 12) || (nt >= 16 && nt < 20); }
    DI bf16_t* addrT(int col, int row64) const {
        int b, t;
        if (row64 < NLAT) { b = row64 >> 13; t = row64 & 8191; } else { const int r2 = row64 - NLAT; b = r2 >> 8; t = TLAT + (r2 & 255); }
        if (col < 3072) { const int c = col - 2048; return Vt + (size_t)((b * 8 + (c >> 7)) * 128 + (c & 127)) * TKV + t; }
        const int c = col - 4096; return gvT + (size_t)((b * 4 + (c >> 8)) * 256 + (c & 255)) * TKV + t;
    }
    DI bf16_t* addr64(int row, int col64) const {
        const bool lat = row < NLAT;
        int b, t;
        if (lat) { b = row >> 13; t = row & 8191; } else { const int r2 = row - NLAT; b = r2 >> 8; t = TLAT + (r2 & 255); }
        if (col64 < 2048) {
            const bool isq = col64 < 1024;
            if (isq && !lat) return nullptr;
            const int c = col64 & 1023, head = c >> 7, comp = (c >> 6) & 1;
            return isq ? Q + ((size_t)((b * 8 + head) * 2 + comp) * TLAT + t) * 64 : Kk + ((size_t)((b * 8 + head) * 2 + comp) * TKV + t) * 64;
        }
        if (col64 < 3072) return nullptr;
        if (col64 < 4096) { const bool isq = col64 < 3584; if (isq && !lat) return nullptr; return (isq ? gq : gk) + (size_t)row * 512 + ((col64 - 3072) & 511); }
        if (col64 < 5120) return nullptr;
        if (col64 < 6144) return lat ? sg + (size_t)row * 1024 + (col64 - 5120) : nullptr;
        if (col64 < 8192) return lat ? mg + (size_t)row * 2048 + (col64 - 6144) : nullptr;
        return nullptr;
    }
    DI void flush(int m0, int n0, int wc) {
        if (n0 < 1024 || n0 >= 2048) return;
        const int b = m0 < NLAT ? (m0 >> 13) : ((m0 - NLAT) >> 8);
#pragma unroll
        for (int bj = 0; bj < 2; ++bj) {
            float v = bj ? kacc1 : kacc0;
#pragma unroll
            for (int of = 8; of >= 1; of >>= 1) v = fmaxf(v, __shfl_xor(v, of));
            const int c = (n0 + bj * 128 + wc * 32) & 1023, head = c >> 7, comp = (c >> 6) & 1, half = (c >> 5) & 1;
            if ((threadIdx.x & 63) == 0) atomicMax((unsigned*)(kmax + (((b * 8 + head) * 2 + comp) * 2 + half) * KMS), __float_as_uint(v));
        }
    }
    DI void begin() { kacc0 = 0.f; kacc1 = 0.f; }
    DI void xform(int row, int cb, f32x4 (&v)[2], int q) {
        if (cb >= 8224) return;
        const bool lat = row < NLAT;
        int b, t;
        if (lat) { b = row >> 13; t = row & 8191; } else { const int r2 = row - NLAT; b = r2 >> 8; t = TLAT + (r2 & 255); }
        if (cb < 2048) {
            const bool isq = cb < 1024;
            if (isq && !lat) return;
            const int c = cb & 1023, head = c >> 7, comp = (c >> 6) & 1, half = (c >> 5) & 1;
            f32x4 o[2];
            if (lat) {
                const int pos = half ? (t & 63) : (t >> 6);
                const f32x4 c4 = *(const f32x4*)(rope + pos * 16 + 4 * q), s4 = *(const f32x4*)(rope + 2048 + pos * 16 + 4 * q);
#pragma unroll
                for (int j = 0; j < 4; ++j) {
                    const float x1 = v[0][j], x2 = v[1][j];
                    o[0][j] = x1 * c4[j] - x2 * s4[j];
                    o[1][j] = x2 * c4[j] + x1 * s4[j];
                }
            } else { o[0] = v[0]; o[1] = v[1]; }
            if (!isq) {
                float ssq = 0.f;
#pragma unroll
                for (int j = 0; j < 4; ++j) ssq += o[0][j] * o[0][j] + o[1][j] * o[1][j];
                ssq = quad_sum(ssq);
                if ((cb >> 7) & 1) kacc1 = fmaxf(kacc1, ssq); else kacc0 = fmaxf(kacc0, ssq);
            }
            const float scl = isq ? 0.125f * 1.4426950408889634f : 1.0f;
#pragma unroll
            for (int n = 0; n < 2; ++n) v[n] = o[n] * scl;
        } else if (cb < 3072) {
        } else if (cb < 4096) {
            const bool isq = cb < 3584;
            if (isq && !lat) return;
            const int c = (cb - 3072) & 511;
            const float scl = isq ? 0.08838834764831845f : 1.0f;
            (void)c;
#pragma unroll
            for (int n = 0; n < 2; ++n) v[n] = v[n] * scl;
        } else if (cb < 5120) {
        } else if (cb < 6144) {
            if (!lat) return;
#pragma unroll
            for (int n = 0; n < 2; ++n)
#pragma unroll
                for (int j = 0; j < 4; ++j) { const float xx = v[n][j]; v[n][j] = xx * sigmoidf_(xx); }
        } else if (cb < 8192) {
            if (!lat) return;
#pragma unroll
            for (int n = 0; n < 2; ++n)
#pragma unroll
                for (int j = 0; j < 4; ++j) v[n][j] = sigmoidf_(v[n][j]);
        } else {
            float* dst = glow + (size_t)row * 32;
#pragma unroll
            for (int n = 0; n < 2; ++n) *(f32x4*)(dst + 16 * n + 4 * q) = v[n];
        }
    }
};

struct EpiGate0 {
    bf16_t* mg;
    DI void flush(int, int, int) {}
    DI void begin() {}
    DI bf16_t* addr64(int row, int col64) const { return mg + (size_t)row * 2048 + col64; }
    DI void xform(int row, int cb, f32x4 (&v)[2], int q) const {
#pragma unroll
        for (int n = 0; n < 2; ++n) {
            const int col = cb + 16 * n + 4 * q;
            const uint2 m = *(const uint2*)(mg + (size_t)row * 2048 + col);
            v[n][0] *= bflo(m.x); v[n][1] *= bfhi(m.x); v[n][2] *= bflo(m.y); v[n][3] *= bfhi(m.y);
        }
    }
};
struct EpiGate1 {
    bf16_t* Y; const bf16_t* mg;
    DI void flush(int, int, int) {}
    DI void begin() {}
    DI bf16_t* addr64(int row, int col64) const { return Y + (size_t)row * 1024 + col64; }
    DI void xform(int row, int cb, f32x4 (&v)[2], int q) const {
#pragma unroll
        for (int n = 0; n < 2; ++n) {
            const int col = cb + 16 * n + 4 * q;
            const uint2 m = *(const uint2*)(mg + (size_t)row * 2048 + 1024 + col);
            const uint2 pr = *(const uint2*)(mg + (size_t)row * 2048 + col);
            v[n][0] = bflo(pr.x) + v[n][0] * bflo(m.x); v[n][1] = bfhi(pr.x) + v[n][1] * bfhi(m.x);
            v[n][2] = bflo(pr.y) + v[n][2] * bflo(m.y); v[n][3] = bfhi(pr.y) + v[n][3] * bfhi(m.y);
        }
    }
};
template <int ACT>
struct EpiStore {
    bf16_t* O; int ldo;
    DI void flush(int, int, int) {}
    DI void begin() {}
    DI bf16_t* addr64(int row, int col64) const { return O + (size_t)row * ldo + col64; }
    DI void xform(int row, int cb, f32x4 (&v)[2], int q) const {
        if (ACT == 1) {
#pragma unroll
            for (int n = 0; n < 2; ++n)
#pragma unroll
                for (int j = 0; j < 4; ++j) { const float xx = fmaxf(v[n][j], 0.f); v[n][j] = xx * xx; }
        }
    }
};

DI float quad_max(float v) { v = fmaxf(v, __shfl_xor(v, 16)); v = fmaxf(v, __shfl_xor(v, 32)); return v; }
DI bf16x8 pack8(const f32x4& a, const f32x4& b) {
    typedef unsigned u32x4 __attribute__((ext_vector_type(4)));
    const u32x4 u = {pk2(a[0], a[1]), pk2(a[2], a[3]), pk2(b[0], b[1]), pk2(b[2], b[3])};
    return __builtin_bit_cast(bf16x8, u);
}

template <bool FAST>
DI void attn_kloop(char* smem, char* sdst, const bf16_t* gk0, const bf16_t* gk1, const bf16_t* gv, bool first, bool has_next, const bf16_t* ngk0, const bf16_t* ngk1, const bf16_t* ngv,
                   int comp, int krow0, int ksw, int l15, int qd, const bf16x8 (&qf)[2][2], f32x4 (&O)[2][8], float (&m)[2], float (&l)[2]) {
#define ATT_STAGE_P(pk0, pk1, pv, buf, kt_) do { _Pragma("unroll") for (int jj = 0; jj < 2; ++jj) { \
            GLDS16(pk0 + (size_t)((kt_) * 128 + 64 * jj) * 64, sdst + (buf) * 65536 + jj * 8192); \
            GLDS16(pk1 + (size_t)((kt_) * 128 + 64 * jj) * 64, sdst + (buf) * 65536 + 16384 + jj * 8192); } \
            _Pragma("unroll") for (int jj = 0; jj < 4; ++jj) GLDS16(pv + (size_t)(32 * jj) * TKV + (kt_) * 128, sdst + (buf) * 65536 + 32768 + jj * 8192); } while (0)
#define ATT_STAGE(buf, kt_) ATT_STAGE_P(gk0, gk1, gv, buf, kt_)
#define KFRAG(sub_, t_, kd_) (*(const bf16x8*)(skc + (32 * (sub_) + krow0 + 4 * (t_)) * 128 + (((4 * (kd_) + qd) ^ ksw) << 4)))
#define VFRAG(sub_, dt_) (*(const bf16x8*)(sb + 32768 + (16 * (dt_) + l15) * 256 + (((4 * (sub_) + qd) ^ l15) << 4)))
    if (first) {
        ATT_STAGE(0, 0);
        asm volatile("s_waitcnt vmcnt(0)" ::: "memory");
        __syncthreads();
    }
    const bool late = (threadIdx.x >> 8) != 0;
    f32x4 sinit[2], Ls[2];
#pragma unroll
    for (int qt = 0; qt < 2; ++qt) { const float v0 = FAST ? -m[qt] : 0.f; sinit[qt] = (f32x4){v0, v0, v0, v0}; Ls[qt] = (f32x4){0.f, 0.f, 0.f, 0.f}; }
    constexpr int NKT = TKV / 128;
    for (int kt = 0; kt < NKT; ++kt) {
        const int cur = kt & 1;
        if (kt + 1 < NKT) ATT_STAGE(cur ^ 1, kt + 1);
        else if (has_next) ATT_STAGE_P(ngk0, ngk1, ngv, cur ^ 1, 0);
        const char* sb = smem + cur * 65536;
        const char* skc = sb + comp * 16384;
        if (FAST) {
            bf16x8 kf[2][2];
#pragma unroll
            for (int t = 0; t < 2; ++t)
#pragma unroll
                for (int kd = 0; kd < 2; ++kd) kf[t][kd] = KFRAG(0, t, kd);
            f32x4 Sn[2][2];
#pragma unroll
            for (int qt = 0; qt < 2; ++qt)
#pragma unroll
                for (int t = 0; t < 2; ++t) { Sn[qt][t] = MFMA16(kf[t][0], qf[qt][0], sinit[qt]); Sn[qt][t] = MFMA16(kf[t][1], qf[qt][1], Sn[qt][t]); }
            const bf16x8 ones = {0x3F80, 0x3F80, 0x3F80, 0x3F80, 0x3F80, 0x3F80, 0x3F80, 0x3F80};
#pragma unroll
            for (int sub = 0; sub < 4; ++sub) {
                f32x4 Sc[2][2];
#pragma unroll
                for (int qt = 0; qt < 2; ++qt)
#pragma unroll
                    for (int t = 0; t < 2; ++t) Sc[qt][t] = Sn[qt][t];
                bf16x8 va[4], vb[4];
#pragma unroll
                for (int dt = 0; dt < 4; ++dt) va[dt] = VFRAG(sub, dt);
                if (sub < 3) {
#pragma unroll
                    for (int t = 0; t < 2; ++t)
#pragma unroll
                        for (int kd = 0; kd < 2; ++kd) kf[t][kd] = KFRAG(sub + 1, t, kd);
                }
                __builtin_amdgcn_sched_barrier(0);
                bf16x8 pb[2];
#pragma unroll
                for (int qt = 0; qt < 2; ++qt) {
                    f32x4 p0, p1;
#pragma unroll
                    for (int i = 0; i < 4; ++i) { p0[i] = __builtin_amdgcn_exp2f(Sc[qt][0][i]); p1[i] = __builtin_amdgcn_exp2f(Sc[qt][1][i]); }
                    pb[qt] = pack8(p0, p1);
                }
#pragma unroll
                for (int dt = 0; dt < 4; ++dt) vb[dt] = VFRAG(sub, 4 + dt);
                __builtin_amdgcn_sched_barrier(0);
                if (sub == 3 && late) {
                    asm volatile("s_waitcnt vmcnt(0) lgkmcnt(0)" ::: "memory"); __builtin_amdgcn_s_barrier(); asm volatile("" ::: "memory");
                }
#pragma unroll
                for (int dt = 0; dt < 4; ++dt) {
                    O[0][dt] = MFMA16(va[dt], pb[0], O[0][dt]);
                    O[1][dt] = MFMA16(va[dt], pb[1], O[1][dt]);
                    if (sub < 3) Sn[dt >> 1][dt & 1] = MFMA16(kf[dt & 1][0], qf[dt >> 1][0], sinit[dt >> 1]);
                }
#pragma unroll
                for (int dt = 0; dt < 4; ++dt) {
                    O[0][4 + dt] = MFMA16(vb[dt], pb[0], O[0][4 + dt]);
                    O[1][4 + dt] = MFMA16(vb[dt], pb[1], O[1][4 + dt]);
                    if (sub < 3) Sn[dt >> 1][dt & 1] = MFMA16(kf[dt & 1][1], qf[dt >> 1][1], Sn[dt >> 1][dt & 1]);
                }
                Ls[0] = MFMA16(ones, pb[0], Ls[0]);
                Ls[1] = MFMA16(ones, pb[1], Ls[1]);
            }
        } else {
#pragma unroll 1
            for (int sub = 0; sub < 4; ++sub) {
                f32x4 S[2][2];
#pragma unroll
                for (int qt = 0; qt < 2; ++qt)
#pragma unroll
                    for (int t = 0; t < 2; ++t) { S[qt][t] = MFMA16(KFRAG(sub, t, 0), qf[qt][0], sinit[qt]); S[qt][t] = MFMA16(KFRAG(sub, t, 1), qf[qt][1], S[qt][t]); }
                bf16x8 pb[2];
#pragma unroll
                for (int qt = 0; qt < 2; ++qt) {
                    float mt = fmaxf(fmaxf(fmaxf(S[qt][0][0], S[qt][0][1]), fmaxf(S[qt][0][2], S[qt][0][3])), fmaxf(fmaxf(S[qt][1][0], S[qt][1][1]), fmaxf(S[qt][1][2], S[qt][1][3])));
                    mt = quad_max(mt);
                    if (mt > m[qt]) {
                        const float al = __builtin_amdgcn_exp2f(m[qt] - mt);
                        l[qt] *= al;
#pragma unroll
                        for (int dt = 0; dt < 8; ++dt) O[qt][dt] *= al;
                        m[qt] = mt;
                    }
                    f32x4 p0, p1;
#pragma unroll
                    for (int i = 0; i < 4; ++i) { p0[i] = __builtin_amdgcn_exp2f(S[qt][0][i] - m[qt]); p1[i] = __builtin_amdgcn_exp2f(S[qt][1][i] - m[qt]); l[qt] += p0[i] + p1[i]; }
                    pb[qt] = pack8(p0, p1);
                }
#pragma unroll
                for (int dt = 0; dt < 8; ++dt) {
                    const bf16x8 vf = VFRAG(sub, dt);
                    O[0][dt] = MFMA16(vf, pb[0], O[0][dt]);
                    O[1][dt] = MFMA16(vf, pb[1], O[1][dt]);
                }
            }
        }
        if (!(FAST && late)) { asm volatile("s_waitcnt vmcnt(0) lgkmcnt(0)" ::: "memory"); __builtin_amdgcn_s_barrier(); asm volatile("" ::: "memory"); }
    }
#undef ATT_STAGE
#undef ATT_STAGE_P
#undef KFRAG
#undef VFRAG
    if (FAST) { l[0] = Ls[0][0]; l[1] = Ls[1][0]; }
    else { l[0] = quad_sum(l[0]); l[1] = quad_sum(l[1]); }
}

DI void phase_attn(const Params& p, char* smem) {
    const int tid = get_tid(), lane = tid & 63, w = tid >> 6, l15 = lane & 15, qd = lane >> 4;
    const int g = w >> 1, comp = w & 1;
    const bf16_t* Q = (const bf16_t*)(p.ws + R_Q);
    const bf16_t* Kk = (const bf16_t*)(p.ws + R_K);
    const bf16_t* Vt = (const bf16_t*)(p.ws + R_VT);
    const float* kmax = (const float*)(p.ws + OFF_KMAX);
    bf16_t* YDA = (bf16_t*)(p.ws + R_H);
    float d1 = 0.f, d2 = 0.f;
    for (int i = 0; i < 64; ++i) { d1 += p.lq1[i] * p.lk1[i]; d2 += p.lq2[i] * p.lk2[i]; }
    const float lam = __expf(d1) - __expf(d2) + 0.2f;
    const int krs = 8 * w + (lane >> 3), kcs = (lane & 7) ^ (((lane >> 4) & 1) | ((w & 3) << 1));
    const int vrs = 4 * w + (lane >> 4), vcs = (lane & 15) ^ ((4 * w + (lane >> 4)) & 15);
    const int krow0 = 8 * (l15 >> 2) + (l15 & 3);
    const int ksw = ((l15 >> 1) & 1) | (((l15 >> 2) & 3) << 1);
    float* xbuf = (float*)(smem + 65536) + g * 4096;
    char* sdst = smem + w * 1024;
    for (int id = blockIdx.x; id < 4096; id += gridDim.x) {
        const int x = id & 7, j = id >> 3, bh = (j >> 6) * 8 + x, qti = j & 63;
        const int b = bh >> 3, h = bh & 7;
        bf16x8 qf[2][2];
        float mb[2];
        const float kb = sqrtf(kmax[((bh * 2 + comp) * 2) * KMS] + kmax[((bh * 2 + comp) * 2 + 1) * KMS]);
#pragma unroll
        for (int qt = 0; qt < 2; ++qt) {
            const bf16_t* qp = Q + ((size_t)(bh * 2 + comp) * TLAT + qti * 128 + g * 32 + 16 * qt + l15) * 64 + qd * 8;
            qf[qt][0] = *(const bf16x8*)qp; qf[qt][1] = *(const bf16x8*)(qp + 32);
            float qn = 0.f;
#pragma unroll
            for (int kd = 0; kd < 2; ++kd)
#pragma unroll
                for (int e = 0; e < 8; ++e) { const float qv = __uint_as_float(((unsigned)(unsigned short)qf[qt][kd][e]) << 16); qn += qv * qv; }
            qn = quad_sum(qn);
            mb[qt] = sqrtf(qn) * kb * 1.01f + 1e-3f;
        }
        const bf16_t* gk0 = Kk + ((size_t)(bh * 2 + 0) * TKV + krs) * 64 + kcs * 8;
        const bf16_t* gk1 = gk0 + (size_t)TKV * 64;
        const bf16_t* gv = Vt + ((size_t)bh * 128 + vrs) * TKV + vcs * 8;
        const bool first = id == (int)blockIdx.x, has_next = id + (int)gridDim.x < 4096;
        const int nid = has_next ? id + gridDim.x : id, nbh = ((nid >> 3) >> 6) * 8 + (nid & 7);
        const bf16_t* ngk0 = Kk + ((size_t)(nbh * 2 + 0) * TKV + krs) * 64 + kcs * 8;
        const bf16_t* ngk1 = ngk0 + (size_t)TKV * 64;
        const bf16_t* ngv = Vt + ((size_t)nbh * 128 + vrs) * TKV + vcs * 8;
        f32x4 O[2][8];
#pragma unroll
        for (int qt = 0; qt < 2; ++qt)
#pragma unroll
            for (int d = 0; d < 8; ++d) O[qt][d] = (f32x4){0.f, 0.f, 0.f, 0.f};
        float m[2], l[2] = {0.f, 0.f};
        const int slow = __syncthreads_or(!(mb[0] <= 60.0f && mb[1] <= 60.0f));
        if (!slow) { m[0] = mb[0]; m[1] = mb[1]; attn_kloop<true>(smem, sdst, gk0, gk1, gv, first, has_next, ngk0, ngk1, ngv, comp, krow0, ksw, l15, qd, qf, O, m, l); }
        else { m[0] = -INFINITY; m[1] = -INFINITY; attn_kloop<false>(smem, sdst, gk0, gk1, gv, first, has_next, ngk0, ngk1, ngv, comp, krow0, ksw, l15, qd, qf, O, m, l); }
        if (comp == 1) {
#pragma unroll
            for (int qt = 0; qt < 2; ++qt) {
                const float i1 = lam / l[qt];
#pragma unroll
                for (int d = 0; d < 8; ++d)
#pragma unroll
                    for (int i = 0; i < 4; ++i) xbuf[((qt * 8 + d) * 4 + i) * 64 + lane] = O[qt][d][i] * i1;
            }
        }
        __syncthreads();
        if (comp == 0) {
#pragma unroll
            for (int qt = 0; qt < 2; ++qt) {
                const float i0 = 1.0f / l[qt];
                float ss = 0.f;
#pragma unroll
                for (int d = 0; d < 8; ++d)
#pragma unroll
                    for (int i = 0; i < 4; ++i) { const float o = O[qt][d][i] * i0 - xbuf[((qt * 8 + d) * 4 + i) * 64 + lane]; O[qt][d][i] = o; ss += o * o; }
                ss = quad_sum(ss);
                const float rs = rsqrtf(ss * (1.0f / 128.0f) + EPS) * 0.8f;
                const int t = qti * 128 + g * 32 + 16 * qt + l15;
                bf16_t* dst = YDA + ((size_t)b * TLAT + t) * 1024 + h * 128;
#pragma unroll
                for (int d = 0; d < 8; ++d) {
                    const int dv = 16 * d + 4 * qd;
                    const f32x4 hn = *(const f32x4*)(p.da_hn + dv);
                    uint2 u; u.x = pk2(O[qt][d][0] * rs * hn.x, O[qt][d][1] * rs * hn.y); u.y = pk2(O[qt][d][2] * rs * hn.z, O[qt][d][3] * rs * hn.w);
                    *(uint2*)(dst + dv) = u;
                }
            }
        }
    }
}

DI void phase_gate(const Params& p, char* smem) {
    const int tid = get_tid();
    const float* glow = (const float*)(p.ws + OFF_GLOW);
    float* sg = (float*)smem;
    float wf[16], wb[16];
#pragma unroll
    for (int r = 0; r < 16; ++r) { wf[r] = p.w_gate_up[(size_t)r * 512 + tid]; wb[r] = p.w_gate_up[(size_t)(16 + r) * 512 + tid]; }
    const float biasf = p.b_gate_up[tid], biasb = p.b_gate_up[512 + tid];
    _Float16* BF = (_Float16*)(p.ws + R_BF);
    _Float16* BB = (_Float16*)(p.ws + R_BB);
    for (int ch = blockIdx.x; ch < 1056; ch += gridDim.x) {
        __syncthreads();
        *(f32x4*)(sg + tid * 4) = *(const f32x4*)(glow + (size_t)ch * 2048 + tid * 4);
        __syncthreads();
        float run = 0.f;
#pragma unroll 4
        for (int i = 0; i < 64; ++i) {
            const float* gl = sg + i * 32;
            float a = biasf;
#pragma unroll
            for (int r = 0; r < 16; ++r) a = fmaf(gl[r], wf[r], a);
            const float ls = fminf(a, 0.f) - __logf(1.0f + __expf(-fabsf(a)));
            run += ls * (1.4426950408889634f / 16.0f);
            BF[(size_t)(ch * 64 + i) * 512 + tid] = (_Float16)run;
        }
        run = 0.f;
#pragma unroll 4
        for (int i = 63; i >= 0; --i) {
            const float* gl = sg + i * 32 + 16;
            float a = biasb;
#pragma unroll
            for (int r = 0; r < 16; ++r) a = fmaf(gl[r], wb[r], a);
            const float ls = fminf(a, 0.f) - __logf(1.0f + __expf(-fabsf(a)));
            run += ls * (1.4426950408889634f / 16.0f);
            BB[(size_t)(ch * 64 + i) * 512 + tid] = (_Float16)run;
        }
    }
}

struct GlaRegs { uint2 k[2][2], q[2][2], bb[2][2], bl[2][2]; uint4 v[2]; };

DI void phase_gla(const Params& p, char* smem, int unit) {
    const int tid = get_tid(), lane = tid & 63, w = tid >> 6, l31 = lane & 31, hh = lane >> 5;
    const int dir = unit & 1, dvh = (unit >> 1) & 1, bh = unit >> 2, b = bh >> 2, h = bh & 3;
    const bf16_t* gq = (const bf16_t*)(p.ws + R_GQ);
    const bf16_t* gk = (const bf16_t*)(p.ws + R_GK);
    const bf16_t* gvT = (const bf16_t*)(p.ws + R_GVT) + (size_t)(bh * 256 + dvh * 128) * TKV;
    const _Float16* B16 = (const _Float16*)(p.ws + (dir ? R_BB : R_BF));
    bf16_t* Oo = (bf16_t*)(p.ws + (dir ? R_OB : R_OF));
    char* sQt = smem;
    char* sKt = smem + 16384;
    char* sKh = smem + 32768;
    char* sVT = smem + 49152;
    char* sA = smem + 81920;
    float* sD = (float*)(smem + 90112);
    f32x16 S[4];
#pragma unroll
    for (int k = 0; k < 4; ++k)
#pragma unroll
        for (int e = 0; e < 16; ++e) S[k][e] = 0.f;
    const int sw = (l31 >> 1) & 7;
    GlaRegs R;
    auto chunk_info = [&](int step, int& rowbase, int& tcol, bool& emit) {
        if (step < 4) { const int cc = dir ? 3 - step : step; rowbase = NLAT + b * 256 + cc * 64; tcol = TLAT + cc * 64; emit = false; }
        else { const int cc = dir ? 127 - (step - 4) : step - 4; rowbase = b * TLAT + cc * 64; tcol = cc * 64; emit = true; }
    };
    auto load_chunk = [&](int step) {
        int rowbase, tcol; bool emit; chunk_info(step, rowbase, tcol, emit);
        const int rl = rowbase + (dir ? 0 : 63);
#pragma unroll
        for (int i = 0; i < 2; ++i) {
            const int item = tid + NT * i, tok = item >> 4, c = item & 15, d0 = 16 * (c >> 1) + 4 * (c & 1);
            const size_t ro = (size_t)(rowbase + tok) * 512 + h * 128 + d0;
            R.k[i][0] = *(const uint2*)(gk + ro); R.k[i][1] = *(const uint2*)(gk + ro + 8);
            if (emit) { R.q[i][0] = *(const uint2*)(gq + ro); R.q[i][1] = *(const uint2*)(gq + ro + 8); }
            else { R.q[i][0] = make_uint2(0, 0); R.q[i][1] = make_uint2(0, 0); }
            R.bb[i][0] = *(const uint2*)(B16 + ro); R.bb[i][1] = *(const uint2*)(B16 + ro + 8);
            const size_t rlo = (size_t)rl * 512 + h * 128 + d0;
            R.bl[i][0] = *(const uint2*)(B16 + rlo); R.bl[i][1] = *(const uint2*)(B16 + rlo + 8);
        }
#pragma unroll
        for (int i = 0; i < 2; ++i) R.v[i] = *(const uint4*)(gvT + (size_t)((tid >> 3) + 64 * i) * TKV + tcol + (tid & 7) * 8);
    };
    auto stage_chunk = [&]() {
#pragma unroll
        for (int i = 0; i < 2; ++i) {
            const int item = tid + NT * i, tok = item >> 4, c = item & 15, d0 = 16 * (c >> 1) + 4 * (c & 1);
            float qo[8], ko[8];
#pragma unroll
            for (int g = 0; g < 2; ++g) {
                const h4_t bv = __builtin_bit_cast(h4_t, R.bb[i][g]), lv = __builtin_bit_cast(h4_t, R.bl[i][g]);
                const float kk[4] = {bflo(R.k[i][g].x), bfhi(R.k[i][g].x), bflo(R.k[i][g].y), bfhi(R.k[i][g].y)};
                const float qq[4] = {bflo(R.q[i][g].x), bfhi(R.q[i][g].x), bflo(R.q[i][g].y), bfhi(R.q[i][g].y)};
#pragma unroll
                for (int j = 0; j < 4; ++j) {
                    const float bb = (float)bv[j], bl = (float)lv[j];
                    qo[4 * g + j] = qq[j] * __builtin_amdgcn_exp2f(bb);
                    ko[4 * g + j] = kk[j] * __builtin_amdgcn_exp2f(-bb);
                    const float kh = kk[j] * __builtin_amdgcn_exp2f(bl - bb);
                    const int dk = d0 + 8 * g + j;
                    *(bf16_t*)(sKh + dk * 128 + ((((tok >> 3) ^ ((dk >> 1) & 7))) << 4) + (tok & 7) * 2) = bf1(kh);
                }
            }
            const int po = tok * 256 + ((c ^ (tok & 15)) << 4);
            uint4 uq, uk;
            uq.x = pk2(qo[0], qo[1]); uq.y = pk2(qo[2], qo[3]); uq.z = pk2(qo[4], qo[5]); uq.w = pk2(qo[6], qo[7]);
            uk.x = pk2(ko[0], ko[1]); uk.y = pk2(ko[2], ko[3]); uk.z = pk2(ko[4], ko[5]); uk.w = pk2(ko[6], ko[7]);
            *(uint4*)(sQt + po) = uq; *(uint4*)(sKt + po) = uk;
        }
#pragma unroll
        for (int i = 0; i < 2; ++i) {
            const int row = (tid >> 3) + 64 * i, scn = tid & 7;
            *(uint4*)(sVT + row * 128 + ((scn ^ ((row >> 1) & 7)) << 4)) = R.v[i];
        }
        if (tid < 16) {
            const int d0 = 16 * (tid >> 1) + 4 * (tid & 1);
#pragma unroll
            for (int g = 0; g < 2; ++g) {
                const h4_t lv = __builtin_bit_cast(h4_t, R.bl[0][g]);
#pragma unroll
                for (int j = 0; j < 4; ++j) sD[d0 + 8 * g + j] = __builtin_amdgcn_exp2f((float)lv[j]);
            }
        }
    };
    load_chunk(0);
    for (int step = 0; step < 132; ++step) {
        int rowbase, tcol; bool emit; chunk_info(step, rowbase, tcol, emit);
        stage_chunk();
        __syncthreads();
        if (step + 1 < 132) load_chunk(step + 1);
        const int dvb = 32 * (w & 3);
        f32x16 o[2];
        if (emit) {
            if (w >= 4) {
                const int ti = (w - 4) >> 1, tj = (w - 4) & 1;
                f32x16 a;
#pragma unroll
                for (int e = 0; e < 16; ++e) a[e] = 0.f;
                const bool dead = dir ? (tj < ti) : (tj > ti);
                if (!dead) {
#pragma unroll
                    for (int ks = 0; ks < 8; ++ks) {
                        const int ri = 32 * ti + l31, rj = 32 * tj + l31, c = 2 * ks + hh;
                        const bf16x8 af = *(const bf16x8*)(sQt + ri * 256 + ((c ^ (ri & 15)) << 4));
                        const bf16x8 bf = *(const bf16x8*)(sKt + rj * 256 + ((c ^ (rj & 15)) << 4));
                        a = MFMA32(af, bf, a);
                    }
                }
                const int jj = 32 * tj + l31;
#pragma unroll
                for (int e = 0; e < 16; ++e) {
                    const int ii = 32 * ti + (e & 3) + 8 * (e >> 2) + 4 * hh;
                    const bool keep = dir ? (jj >= ii) : (jj <= ii);
                    *(bf16_t*)(sA + ii * 128 + ((((jj >> 3) ^ ((ii >> 1) & 7))) << 4) + (jj & 7) * 2) = bf1(keep ? a[e] : 0.f);
                }
            } else {
#pragma unroll
            for (int mt = 0; mt < 2; ++mt)
#pragma unroll
                for (int e = 0; e < 16; ++e) o[mt][e] = 0.f;
#pragma unroll
            for (int kt = 0; kt < 4; ++kt)
#pragma unroll
                for (int s = 0; s < 2; ++s) {
                    typedef unsigned u32x4 __attribute__((ext_vector_type(4)));
                    u32x4 pu = {pk2(S[kt][8 * s], S[kt][8 * s + 1]), pk2(S[kt][8 * s + 2], S[kt][8 * s + 3]), pk2(S[kt][8 * s + 4], S[kt][8 * s + 5]), pk2(S[kt][8 * s + 6], S[kt][8 * s + 7])};
                    const bf16x8 sf = __builtin_bit_cast(bf16x8, pu);
#pragma unroll
                    for (int mt = 0; mt < 2; ++mt) {
                        const int ri = 32 * mt + l31, c = 4 * kt + 2 * s + hh;
                        const bf16x8 af = *(const bf16x8*)(sQt + ri * 256 + ((c ^ (ri & 15)) << 4));
                        o[mt] = MFMA32(af, sf, o[mt]);
                    }
                }
            }
            __syncthreads();
            if (w < 4) {
#pragma unroll
            for (int s2 = 0; s2 < 4; ++s2) {
                const int c = 2 * s2 + hh;
                const bf16x8 vf = *(const bf16x8*)(sVT + (dvb + l31) * 128 + ((c ^ sw) << 4));
#pragma unroll
                for (int mt = 0; mt < 2; ++mt) {
                    const bf16x8 af = *(const bf16x8*)(sA + (32 * mt + l31) * 128 + ((c ^ sw) << 4));
                    o[mt] = MFMA32(af, vf, o[mt]);
                }
            }
            bf16_t* od = Oo + (size_t)rowbase * 1024 + h * 256 + dvh * 128 + dvb + l31;
#pragma unroll
            for (int mt = 0; mt < 2; ++mt)
#pragma unroll
                for (int e = 0; e < 16; ++e) od[(size_t)(32 * mt + (e & 3) + 8 * (e >> 2) + 4 * hh) * 1024] = bf1(o[mt][e]);
            }
        }
        if (w < 4) {
#pragma unroll
        for (int kt = 0; kt < 4; ++kt)
#pragma unroll
            for (int g4 = 0; g4 < 4; ++g4) {
                const f32x4 dd = *(const f32x4*)(sD + 32 * kt + 8 * g4 + 4 * hh);
#pragma unroll
                for (int jq = 0; jq < 4; ++jq) S[kt][4 * g4 + jq] *= dd[jq];
            }
#pragma unroll
        for (int s2 = 0; s2 < 4; ++s2) {
            const int c = 2 * s2 + hh;
            const bf16x8 vf = *(const bf16x8*)(sVT + (dvb + l31) * 128 + ((c ^ sw) << 4));
#pragma unroll
            for (int kt = 0; kt < 4; ++kt) {
                const bf16x8 af = *(const bf16x8*)(sKh + (32 * kt + l31) * 128 + ((c ^ sw) << 4));
                S[kt] = MFMA32(af, vf, S[kt]);
            }
        }
        }
        __syncthreads();
    }
}

DI void phase_combine(const Params& p, int panel) {
    const int tid = get_tid(), lane = tid & 63, w = tid >> 6;
    const bf16_t* OF = (const bf16_t*)(p.ws + R_OF);
    const bf16_t* OB = (const bf16_t*)(p.ws + R_OB);
    const bf16_t* SG = (const bf16_t*)(p.ws + R_SG);
    bf16_t* Y = (bf16_t*)(p.ws + R_YGLA);
    for (int row2 = panel * 256 + w; row2 < panel * 256 + 256; row2 += 16)
#pragma unroll
    for (int rr = 0; rr < 2; ++rr) {
        const int row = row2 + 8 * rr;
        const size_t o = (size_t)row * 1024 + lane * 16;
        const uint4 a0 = *(const uint4*)(OF + o), a1 = *(const uint4*)(OF + o + 8);
        const uint4 b0 = *(const uint4*)(OB + o), b1 = *(const uint4*)(OB + o + 8);
        const uint4 g0 = *(const uint4*)(SG + o), g1 = *(const uint4*)(SG + o + 8);
        const unsigned au[8] = {a0.x, a0.y, a0.z, a0.w, a1.x, a1.y, a1.z, a1.w};
        const unsigned bu[8] = {b0.x, b0.y, b0.z, b0.w, b1.x, b1.y, b1.z, b1.w};
        const unsigned gu[8] = {g0.x, g0.y, g0.z, g0.w, g1.x, g1.y, g1.z, g1.w};
        float v[16]; float ss = 0.f;
#pragma unroll
        for (int e = 0; e < 8; ++e) { v[2 * e] = bflo(au[e]) + bflo(bu[e]); v[2 * e + 1] = bfhi(au[e]) + bfhi(bu[e]); ss += v[2 * e] * v[2 * e] + v[2 * e + 1] * v[2 * e + 1]; }
#pragma unroll
        for (int of = 8; of >= 1; of >>= 1) ss += __shfl_xor(ss, of);
        const float rs = rsqrtf(ss * (1.0f / 256.0f) + EPS);
        const float* gn = p.gla_hn + ((lane * 16) & 255);
        unsigned ou[8];
#pragma unroll
        for (int e = 0; e < 8; ++e) ou[e] = pk2(v[2 * e] * rs * gn[2 * e] * bflo(gu[e]), v[2 * e + 1] * rs * gn[2 * e + 1] * bfhi(gu[e]));
        *(uint4*)(Y + o) = make_uint4(ou[0], ou[1], ou[2], ou[3]);
        *(uint4*)(Y + o + 8) = make_uint4(ou[4], ou[5], ou[6], ou[7]);
    }
}

template <int MODE>
DI void phase_rows(const Params& p, char* smem, int panel) {
    float* md = (float*)smem;
    const int tid = get_tid(), lane = tid & 63, w = tid >> 6;
    const bf16_t* Yin = (const bf16_t*)(p.ws + (MODE == 0 ? R_Y2 : R_Y3));
    bf16_t* H2 = (bf16_t*)(p.ws + R_H2);
    const float* pn = MODE == 0 ? p.post_norm1 : p.post_norm2;
    const float* xsrc = MODE == 0 ? p.x : (const float*)p.out;
    const int r = panel >> 5;
    __syncthreads();
    if (MODE == 0) { load_mod(p, r, 2, md); load_mod(p, r, 3, md + 1024); load_mod(p, r, 4, md + 2048); }
    else load_mod(p, r, 5, md);
    __syncthreads();
    for (int i = 0; i < 16; ++i) {
        const int rows[2] = {panel * 256 + w * 32 + i, panel * 256 + w * 32 + 16 + i};
        uint2 yu[2][4]; f32x4 xv[2][4];
#pragma unroll
        for (int q = 0; q < 2; ++q)
#pragma unroll
            for (int j = 0; j < 4; ++j) {
                yu[q][j] = *(const uint2*)(Yin + (size_t)rows[q] * 1024 + lane * 4 + 256 * j);
                xv[q][j] = *(const f32x4*)(xsrc + (size_t)rows[q] * 1024 + lane * 4 + 256 * j);
            }
        float y[2][16], ss[2] = {0.f, 0.f};
#pragma unroll
        for (int q = 0; q < 2; ++q)
#pragma unroll
            for (int j = 0; j < 4; ++j) {
                y[q][4 * j] = bflo(yu[q][j].x); y[q][4 * j + 1] = bfhi(yu[q][j].x); y[q][4 * j + 2] = bflo(yu[q][j].y); y[q][4 * j + 3] = bfhi(yu[q][j].y);
#pragma unroll
                for (int e = 0; e < 4; ++e) ss[q] += y[q][4 * j + e] * y[q][4 * j + e];
            }
        ss[0] = wave_sum(ss[0]); ss[1] = wave_sum(ss[1]);
        float xn[2][16], s2[2] = {0.f, 0.f};
#pragma unroll
        for (int q = 0; q < 2; ++q) {
            const float rs = rsqrtf(ss[q] * (1.0f / 1024.0f) + EPS);
#pragma unroll
            for (int j = 0; j < 4; ++j) {
                const int col = lane * 4 + 256 * j;
                const f32x4 g = *(const f32x4*)(pn + col), gt = *(const f32x4*)(md + col);
#pragma unroll
                for (int e = 0; e < 4; ++e) { xn[q][4 * j + e] = xv[q][j][e] + gt[e] * (y[q][4 * j + e] * rs * g[e]); s2[q] += xn[q][4 * j + e] * xn[q][4 * j + e]; }
                f32x4 ov = {xn[q][4 * j], xn[q][4 * j + 1], xn[q][4 * j + 2], xn[q][4 * j + 3]};
                *(f32x4*)(p.out + (size_t)rows[q] * 1024 + col) = ov;
            }
        }
        if (MODE == 0) {
            s2[0] = wave_sum(s2[0]); s2[1] = wave_sum(s2[1]);
#pragma unroll
            for (int q = 0; q < 2; ++q) {
                const float rs2 = rsqrtf(s2[q] * (1.0f / 1024.0f) + EPS);
#pragma unroll
                for (int j = 0; j < 4; ++j) {
                    const int col = lane * 4 + 256 * j;
                    const f32x4 g = *(const f32x4*)(p.pre_norm2 + col), sh = *(const f32x4*)(md + 1024 + col), sc = *(const f32x4*)(md + 2048 + col);
                    float o[4];
#pragma unroll
                    for (int e = 0; e < 4; ++e) o[e] = xn[q][4 * j + e] * rs2 * g[e] * (1.f + sc[e]) + sh[e];
                    uint2 u; u.x = pk2(o[0], o[1]); u.y = pk2(o[2], o[3]);
                    *(uint2*)(H2 + (size_t)rows[q] * 1024 + col) = u;
                }
            }
        }
    }
}

DI void gsync(unsigned* bar, unsigned k) {
    __syncthreads();
    const unsigned epoch = k * gridDim.x;
    if (threadIdx.x == 0) {
        __threadfence();
        atomicAdd(bar, 1u);
        while (__hip_atomic_load(bar, __ATOMIC_RELAXED, __HIP_MEMORY_SCOPE_AGENT) < epoch) __builtin_amdgcn_s_sleep(1);
        __threadfence();
    }
    __syncthreads();
}

__global__ void __launch_bounds__(NT) fwd_megakernel(Params p) {
    __shared__ __attribute__((aligned(16))) char smem[131072 + 16384];
    cg::grid_group grid = cg::this_grid();
    char* ws = p.ws;
    unsigned* bar = (unsigned*)(ws + OFF_BAR);
    phase_prep(p, smem);
    grid.sync();
    phase_h(p, smem);
    gsync(bar, 1u);
    {
        EpiIn e; e.Q = (bf16_t*)(ws + R_Q); e.Kk = (bf16_t*)(ws + R_K); e.Vt = (bf16_t*)(ws + R_VT); e.gq = (bf16_t*)(ws + R_GQ); e.gk = (bf16_t*)(ws + R_GK);
        e.gvT = (bf16_t*)(ws + R_GVT); e.sg = (bf16_t*)(ws + R_SG); e.mg = (bf16_t*)p.out; e.glow = (float*)(ws + OFF_GLOW); e.kmax = (float*)(ws + OFF_KMAX); e.kacc0 = 0.f; e.kacc1 = 0.f;
        {
            const f32x4* src = (const f32x4*)(ws + OFF_ROPE); f32x4* dst = (f32x4*)(smem + 131072);
            for (int i = threadIdx.x; i < 1024; i += NT) dst[i] = src[i];
            __syncthreads();
            e.rope = (const float*)(smem + 131072);
        }
        gemm_phase_ex<true>((const bf16_t*)(ws + R_H), 1024, (const bf16_t*)(ws + OFF_WIN), 1024, 1024, 264, 33, smem, e, blockIdx.x, gridDim.x);
    }
    gsync(bar, 2u);
    phase_attn(p, smem);
    gsync(bar, 3u);
    phase_gate(p, smem);
    gsync(bar, 4u);
    const bool split = gridDim.x >= 192;
    const int nscan = split ? 128 : (int)gridDim.x, oth0 = split ? 128 : 0, noth = (int)gridDim.x - oth0;
    if ((int)blockIdx.x < nscan) { for (int unit = blockIdx.x; unit < 128; unit += nscan) { __syncthreads(); phase_gla(p, smem, unit); } }
    if ((int)blockIdx.x >= oth0) {
        EpiGate0 e0; e0.mg = (bf16_t*)p.out;
        gemm_phase_ex<false>((const bf16_t*)(ws + R_H), 1024, (const bf16_t*)(ws + OFF_WDA), 1024, 1024, 256, 4, smem, e0, blockIdx.x - oth0, noth);
        const long gsz2 = (long)noth * NT, gtid2 = (long)(blockIdx.x - oth0) * NT + get_tid();
        repack<0>(p.w_bgla, 1024, 1024, (bf16_t*)(ws + OFF_WGLA), 1024, gtid2, gsz2);
        repack<0>(p.w_out, 1024, 1024, (bf16_t*)(ws + OFF_WOUT), 1024, gtid2, gsz2);
        repack<0>(p.w_ff1, 1024, 4096, (bf16_t*)(ws + OFF_WFF1), 4096, gtid2, gsz2);
        repack<0>(p.w_ff2, 4096, 1024, (bf16_t*)(ws + OFF_WFF2), 1024, gtid2, gsz2);
    }
    gsync(bar, 5u);
    for (int panel = blockIdx.x; panel < 256; panel += gridDim.x) phase_combine(p, panel);
    gsync(bar, 6u);
    { EpiGate1 e1; e1.Y = (bf16_t*)(ws + R_Y); e1.mg = (const bf16_t*)p.out;
      gemm_phase((const bf16_t*)(ws + R_YGLA), 1024, (const bf16_t*)(ws + OFF_WGLA), 1024, 1024, 256, 4, smem, e1); }
    gsync(bar, 7u);
    { EpiStore<0> e; e.O = (bf16_t*)(ws + R_Y2); e.ldo = 1024;
      gemm_phase((const bf16_t*)(ws + R_Y), 1024, (const bf16_t*)(ws + OFF_WOUT), 1024, 1024, 256, 4, smem, e); }
    gsync(bar, 8u);
    for (int panel = blockIdx.x; panel < 256; panel += gridDim.x) phase_rows<0>(p, smem, panel);
    gsync(bar, 9u);
    { EpiStore<1> e; e.O = (bf16_t*)(ws + R_U); e.ldo = 4096;
      gemm_phase((const bf16_t*)(ws + R_H2), 1024, (const bf16_t*)(ws + OFF_WFF1), 1024, 1024, 256, 16, smem, e); }
    gsync(bar, 10u);
    { EpiStore<0> e; e.O = (bf16_t*)(ws + R_Y3); e.ldo = 1024;
      gemm_phase((const bf16_t*)(ws + R_U), 4096, (const bf16_t*)(ws + OFF_WFF2), 4096, 4096, 256, 4, smem, e); }
    gsync(bar, 11u);
    for (int panel = blockIdx.x; panel < 256; panel += gridDim.x) phase_rows<1>(p, smem, panel);
}

extern "C" void kernel_launch(void* const* d_in, const int* in_sizes, int n_in, void* d_out, int out_size, void* d_ws, size_t ws_size, hipStream_t stream) {
    static int grid_blocks = 0;
    if (!grid_blocks) {
        int dev = 0, cus = 0, per_cu = 0;
        hipGetDevice(&dev);
        hipDeviceGetAttribute(&cus, hipDeviceAttributeMultiprocessorCount, dev);
        hipOccupancyMaxActiveBlocksPerMultiprocessor(&per_cu, fwd_megakernel, NT, 0);
        if (per_cu < 1) per_cu = 1;
        grid_blocks = cus * per_cu;
        if (grid_blocks > 256) grid_blocks = 256;
    }
    Params p{};
    const float* const* in = (const float* const*)d_in;
    p.x = in[0]; p.c = in[1]; p.ctx = in[2]; p.c_ctx = in[3]; p.w_mod = in[4]; p.b_mod = in[5]; p.pre_norm1 = in[6]; p.w_in = in[7];
    p.w_gate_up = in[8]; p.b_gate_up = in[9]; p.lq1 = in[10]; p.lk1 = in[11]; p.lq2 = in[12]; p.lk2 = in[13]; p.da_hn = in[14]; p.gla_hn = in[15];
    p.w_bda = in[16]; p.w_bgla = in[17]; p.w_out = in[18]; p.post_norm1 = in[19]; p.pre_norm2 = in[20]; p.w_ff1 = in[21]; p.w_ff2 = in[22]; p.post_norm2 = in[23];
    p.out = (float*)d_out; p.ws = (char*)d_ws;
    hipMemsetAsync((char*)d_ws + OFF_BAR, 0, 256, stream);
    void* args[] = {&p};
    hipError_t e = hipLaunchCooperativeKernel((void*)fwd_megakernel, dim3(grid_blocks), dim3(NT), args, 0, stream);
    if (e != hipSuccess) fprintf(stderr, "cooperative launch failed: %s (grid %d)\n", hipGetErrorString(e), grid_blocks);
}
```

```cpp
#include <hip/hip_runtime.h>
#include <hip/hip_cooperative_groups.h>
#include <cstdio>
namespace cg = cooperative_groups;

typedef unsigned short bf16_t;
typedef short bf16x8 __attribute__((ext_vector_type(8)));
typedef float f32x16 __attribute__((ext_vector_type(16)));
typedef float f32x4 __attribute__((ext_vector_type(4)));
typedef float f32x2 __attribute__((ext_vector_type(2)));
typedef __bf16 bf2_t __attribute__((ext_vector_type(2)));
typedef _Float16 h4_t __attribute__((ext_vector_type(4)));

#define DI __device__ __forceinline__
#define MFMA32(a, b, c) __builtin_amdgcn_mfma_f32_32x32x16_bf16((a), (b), (c), 0, 0, 0)

constexpr int NT = 512;
constexpr int TLAT = 8192, NB = 8, NLAT = 65536, NROW = 67584, TKV = 8448;
constexpr float EPS = 1e-6f;
constexpr size_t MiB = 1048576;
constexpr size_t OFF_WIN = 0;
constexpr size_t OFF_WDA = OFF_WIN + 8448ull * 1024 * 2;
constexpr size_t OFF_WGLA = OFF_WDA + 2 * MiB;
constexpr size_t OFF_WOUT = OFF_WGLA + 2 * MiB;
constexpr size_t OFF_WFF1 = OFF_WOUT + 2 * MiB;
constexpr size_t OFF_WFF2 = OFF_WFF1 + 8 * MiB;
constexpr size_t OFF_MODP = OFF_WFF2 + 8 * MiB;
constexpr size_t OFF_ROPE = OFF_MODP + 16ull * 9 * 6144 * 4;
constexpr size_t OFF_GLOW = OFF_ROPE + 16384;
constexpr size_t OFF_KMAX = OFF_GLOW + 67584ull * 32 * 4;
constexpr int KMS = 32;
constexpr size_t OFF_BAR = OFF_KMAX + 256 * KMS * 4;
constexpr size_t R_H = 64 * MiB;
constexpr size_t R_Q = R_H + 132 * MiB;
constexpr size_t R_K = R_Q + 128 * MiB;
constexpr size_t R_VT = R_K + 132 * MiB;
constexpr size_t R_GQ = R_VT + 132 * MiB;
constexpr size_t R_GK = R_GQ + 64 * MiB;
constexpr size_t R_GVT = R_GK + 66 * MiB;
constexpr size_t R_SG = R_GVT + 132 * MiB;
constexpr size_t WS_END = R_SG + 128 * MiB;
static_assert(OFF_BAR + 1024 <= R_H, "small region overflow");
static_assert(WS_END <= 1024 * MiB, "workspace overflow");
constexpr size_t R_BF = R_Q;
constexpr size_t R_BB = R_Q + 66 * MiB;
constexpr size_t R_OF = R_K + 4 * MiB;
constexpr size_t R_OB = R_VT;
constexpr size_t R_YGLA = R_SG;
constexpr size_t R_Y = R_GVT;
constexpr size_t R_Y2 = R_SG;
constexpr size_t R_H2 = R_H;
constexpr size_t R_U = R_Q;
constexpr size_t R_Y3 = R_GVT;

struct Params {
    const float *x, *c, *ctx, *c_ctx, *w_mod, *b_mod, *pre_norm1, *w_in, *w_gate_up, *b_gate_up;
    const float *lq1, *lk1, *lq2, *lk2, *da_hn, *gla_hn, *w_bda, *w_bgla, *w_out, *post_norm1, *pre_norm2, *w_ff1, *w_ff2, *post_norm2;
    float* out;
    char* ws;
};

DI unsigned pk2(float a, float b) { f32x2 v = {a, b}; bf2_t r = __builtin_convertvector(v, bf2_t); return __builtin_bit_cast(unsigned, r); }
DI bf16_t bf1(float a) { __bf16 r = (__bf16)a; return __builtin_bit_cast(unsigned short, r); }
DI float bflo(unsigned v) { return __uint_as_float(v << 16); }
DI float bfhi(unsigned v) { return __uint_as_float(v & 0xffff0000u); }
DI float wave_sum(float v) {
#pragma unroll
    for (int o = 32; o >= 1; o >>= 1) v += __shfl_xor(v, o);
    return v;
}
DI int get_tid() { int t = threadIdx.x; asm volatile("" : "+v"(t)); return t; }
DI float sigmoidf_(float x) { return __builtin_amdgcn_rcpf(1.0f + __expf(-x)); }

template <int MODE>
DI void repack(const float* __restrict__ src, int K, int Nsrc, bf16_t* __restrict__ dst, int Nd, long gtid, long gsz) {
    const long total = (long)Nd * (K / 8);
    for (long it = gtid; it < total; it += gsz) {
        const int n = (int)(it % Nd), kc = (int)(it / Nd);
        int col = n; bool valid = true;
        if (MODE == 1) { if (n < 5120) col = n; else if (n < 8192) col = n + 32; else if (n < 8224) col = n - 8192 + 5120; else valid = false; }
        float v[8];
#pragma unroll
        for (int j = 0; j < 8; ++j) v[j] = valid ? src[(size_t)(kc * 8 + j) * Nsrc + col] : 0.f;
        uint4 o; o.x = pk2(v[0], v[1]); o.y = pk2(v[2], v[3]); o.z = pk2(v[4], v[5]); o.w = pk2(v[6], v[7]);
        *(uint4*)(dst + (size_t)n * K + kc * 8) = o;
    }
}

DI void sincos_acc(float a, float& s, float& c) {
    const float q = rintf(a * 0.63661977236758134f);
    float r = fmaf(-q, 1.5703125f, a); r = fmaf(-q, 4.837512969970703125e-4f, r); r = fmaf(-q, 7.54978995489188216e-8f, r);
    const float r2 = r * r;
    const float sp = r + r * r2 * (-1.6666666666e-1f + r2 * (8.3333333333e-3f + r2 * (-1.98412698e-4f + r2 * 2.7557319e-6f)));
    const float cp = 1.0f + r2 * (-0.5f + r2 * (4.16666666667e-2f + r2 * (-1.38888888889e-3f + r2 * (2.48015873e-5f + r2 * -2.75573192e-7f))));
    const int qi = ((int)q) & 3;
    s = (qi == 0) ? sp : (qi == 1) ? cp : (qi == 2) ? -sp : -cp;
    c = (qi == 0) ? cp : (qi == 1) ? -sp : (qi == 2) ? -cp : sp;
}

DI void phase_prep(const Params& p, char* smem) {
    const int tid = get_tid();
    const long gsz = (long)gridDim.x * NT, gtid = (long)blockIdx.x * NT + tid;
    char* ws = p.ws;
    repack<1>(p.w_in, 1024, 8224, (bf16_t*)(ws + OFF_WIN), 8448, gtid, gsz);
    repack<0>(p.w_bda, 1024, 1024, (bf16_t*)(ws + OFF_WDA), 1024, gtid, gsz);
    if (gtid < 256) ((float*)(ws + OFF_KMAX))[gtid * KMS] = 0.f;
    if (gtid < 2048) {
        const int pos = (int)gtid >> 4, f = (int)gtid & 15;
        const float inv = exp2f(-(float)f * (13.287712379549449f / 16.0f));
        float s, c; sincos_acc((float)pos * inv, s, c);
        float* rt = (float*)(ws + OFF_ROPE);
        rt[gtid] = c; rt[2048 + gtid] = s;
    }
    float* sil = (float*)smem;
    float* modp = (float*)(ws + OFF_MODP);
    for (int item = blockIdx.x; item < 192; item += gridDim.x) {
        const int cb = item % 12, ks = item / 12;
        __syncthreads();
        for (int i = tid; i < 9 * 64; i += NT) {
            const int r = i >> 6, kk = i & 63;
            const float v = (r < 8) ? p.c[r * 1024 + ks * 64 + kk] : p.c_ctx[ks * 64 + kk];
            sil[i] = v * sigmoidf_(v);
        }
        __syncthreads();
        const int n = cb * 512 + tid;
        float acc[9];
#pragma unroll
        for (int r = 0; r < 9; ++r) acc[r] = 0.f;
        for (int kk = 0; kk < 64; ++kk) {
            const float w = p.w_mod[(size_t)(ks * 64 + kk) * 6144 + n];
#pragma unroll
            for (int r = 0; r < 9; ++r) acc[r] = fmaf(sil[r * 64 + kk], w, acc[r]);
        }
#pragma unroll
        for (int r = 0; r < 9; ++r) modp[(size_t)(ks * 9 + r) * 6144 + n] = acc[r];
    }
}

DI void load_mod(const Params& p, int r, int which, float* dst) {
    const float* modp = (const float*)(p.ws + OFF_MODP);
    for (int n = threadIdx.x; n < 1024; n += NT) {
        float a = p.b_mod[which * 1024 + n];
#pragma unroll
        for (int ks = 0; ks < 16; ++ks) a += modp[(size_t)(ks * 9 + r) * 6144 + which * 1024 + n];
        dst[n] = a;
    }
}

DI void h_row2(const Params& p, const float* md, bf16_t* H, int rowA, int rowB, int lane) {
    const float* sa = rowA < NLAT ? p.x + (size_t)rowA * 1024 : p.ctx + (size_t)(rowA - NLAT) * 1024;
    const float* sbp = rowB < NLAT ? p.x + (size_t)rowB * 1024 : p.ctx + (size_t)(rowB - NLAT) * 1024;
    f32x4 va[4], vb[4]; float sa2 = 0.f, sb2 = 0.f;
#pragma unroll
    for (int j = 0; j < 4; ++j) { va[j] = __builtin_nontemporal_load((const f32x4*)(sa + lane * 4 + 256 * j)); vb[j] = __builtin_nontemporal_load((const f32x4*)(sbp + lane * 4 + 256 * j)); }
#pragma unroll
    for (int j = 0; j < 4; ++j) {
        sa2 += va[j].x * va[j].x + va[j].y * va[j].y + va[j].z * va[j].z + va[j].w * va[j].w;
        sb2 += vb[j].x * vb[j].x + vb[j].y * vb[j].y + vb[j].z * vb[j].z + vb[j].w * vb[j].w;
    }
    sa2 = wave_sum(sa2); sb2 = wave_sum(sb2);
    const float ra = rsqrtf(sa2 * (1.0f / 1024.0f) + EPS), rb = rsqrtf(sb2 * (1.0f / 1024.0f) + EPS);
#pragma unroll
    for (int j = 0; j < 4; ++j) {
        const int col = lane * 4 + 256 * j;
        const f32x4 g = *(const f32x4*)(p.pre_norm1 + col);
        const f32x4 sh = *(const f32x4*)(md + col), sc = *(const f32x4*)(md + 1024 + col);
        float oa[4], ob[4];
#pragma unroll
        for (int e = 0; e < 4; ++e) { const float gm = g[e] * (1.f + sc[e]); oa[e] = va[j][e] * ra * gm + sh[e]; ob[e] = vb[j][e] * rb * gm + sh[e]; }
        uint2 o; o.x = pk2(oa[0], oa[1]); o.y = pk2(oa[2], oa[3]);
        *(uint2*)(H + (size_t)rowA * 1024 + col) = o;
        o.x = pk2(ob[0], ob[1]); o.y = pk2(ob[2], ob[3]);
        *(uint2*)(H + (size_t)rowB * 1024 + col) = o;
    }
}

DI void phase_h(const Params& p, char* smem) {
    float* md = (float*)smem;
    const int tid = get_tid(), lane = tid & 63, w = tid >> 6;
    bf16_t* H = (bf16_t*)(p.ws + R_H);
    for (int tile = blockIdx.x; tile < 256; tile += gridDim.x) {
        __syncthreads();
        load_mod(p, tile >> 5, 0, md); load_mod(p, tile >> 5, 1, md + 1024);
        __syncthreads();
        for (int i = 0; i < 16; ++i) h_row2(p, md, H, tile * 256 + w * 32 + i, tile * 256 + w * 32 + 16 + i, lane);
    }
    __syncthreads();
    load_mod(p, 8, 0, md); load_mod(p, 8, 1, md + 1024);
    __syncthreads();
    for (int r2 = blockIdx.x * 8 + w; r2 < 1024; r2 += gridDim.x * 8) h_row2(p, md, H, NLAT + 2 * r2, NLAT + 2 * r2 + 1, lane);
}

typedef __attribute__((address_space(3))) unsigned lds_u32;
DI lds_u32* to_lds(const void* p) { return (lds_u32*)(unsigned)(size_t)p; }
#define GLDS16(src, dst) __builtin_amdgcn_global_load_lds((const unsigned*)(src), to_lds(dst), 16, 0, 0)

#define MFMA16(a, b, c) __builtin_amdgcn_mfma_f32_16x16x32_bf16((a), (b), (c), 0, 0, 0)
DI void stage_rc8(int b, int& R, int& C) { const int st = b >> 10, sb = b & 1023, swz = sb ^ (((sb >> 9) & 1) << 5); R = (st >> 1) * 16 + (swz >> 6); C = (st & 1) * 32 + ((swz & 63) >> 1); }
template <bool SWAP, class Epi>
DI void gemm_tile(const bf16_t* A, int lda, const bf16_t* B, int ldb, int K, int m0, int n0, bool, bool, int, int, char* smem, Epi& epi) {
    const int tid = get_tid(), lane = tid & 63, w = tid >> 6, wr = w >> 2, wc = w & 3, fr = lane & 15, fq = lane >> 4;
    f32x4 acc[2][2][4][2];
#pragma unroll
    for (int a = 0; a < 2; ++a)
#pragma unroll
        for (int b = 0; b < 2; ++b)
#pragma unroll
            for (int m = 0; m < 4; ++m)
#pragma unroll
                for (int n = 0; n < 2; ++n) acc[a][b][m][n] = (f32x4){0.f, 0.f, 0.f, 0.f};
    bf16x8 At[4][2], B0[2][2], B1[2][2];
    int R0, C0, R1, C1; stage_rc8(tid * 16, R0, C0); stage_rc8(tid * 16 + 8192, R1, C1);
    const char* Am = (const char*)(A + (size_t)m0 * lda); const char* Bn = (const char*)(B + (size_t)n0 * ldb);
    const unsigned a0 = 2u * (unsigned)(R0 * lda + C0), a1 = 2u * (unsigned)(R1 * lda + C1), b0 = 2u * (unsigned)(R0 * ldb + C0), b1 = 2u * (unsigned)(R1 * ldb + C1);
    const unsigned ahalf = 256u * (unsigned)lda, bhalf = 256u * (unsigned)ldb;
    char* sdst = smem + w * 1024;
    const int loff = (fr * 64 + fq * 16) ^ ((fr >> 3) << 5);
    const int aoff = wr * 8192 + loff, boff = wc * 4096 + loff;
#define SA8(b, h) (((b) * 2 + (h)) * 16384)
#define SB8(b, h) ((4 + (b) * 2 + (h)) * 16384)
#define STAGE_A(b, h, kt_) do { GLDS16(Am + (a0 + (h) * ahalf + (unsigned)(kt_) * 128u), sdst + SA8(b, h)); GLDS16(Am + (a1 + (h) * ahalf + (unsigned)(kt_) * 128u), sdst + SA8(b, h) + 8192); } while (0)
#define STAGE_B(b, h, kt_) do { GLDS16(Bn + (b0 + (h) * bhalf + (unsigned)(kt_) * 128u), sdst + SB8(b, h)); GLDS16(Bn + (b1 + (h) * bhalf + (unsigned)(kt_) * 128u), sdst + SB8(b, h) + 8192); } while (0)
#define LDA8(dst, b, h) do { _Pragma("unroll") for (int m = 0; m < 4; ++m) _Pragma("unroll") for (int k = 0; k < 2; ++k) \
        dst[m][k] = *(const bf16x8*)(smem + SA8(b, h) + aoff + (m * 2 + k) * 1024); } while (0)
#define LDB8(dst, b, h) do { _Pragma("unroll") for (int n = 0; n < 2; ++n) _Pragma("unroll") for (int k = 0; k < 2; ++k) \
        dst[n][k] = *(const bf16x8*)(smem + SB8(b, h) + boff + (n * 2 + k) * 1024); } while (0)
#define MMA8(ai, bj, Af, Bf) do { __builtin_amdgcn_s_setprio(1); \
        _Pragma("unroll") for (int m = 0; m < 4; ++m) _Pragma("unroll") for (int n = 0; n < 2; ++n) _Pragma("unroll") for (int k = 0; k < 2; ++k) \
            acc[ai][bj][m][n] = SWAP ? MFMA16(Af[m][k], Bf[n][k], acc[ai][bj][m][n]) : MFMA16(Bf[n][k], Af[m][k], acc[ai][bj][m][n]); \
        __builtin_amdgcn_s_setprio(0); } while (0)
#define WAIT_V(n) asm volatile("s_waitcnt vmcnt(" #n ")" ::: "memory")
#define WAIT_L(n) asm volatile("s_waitcnt lgkmcnt(" #n ")" ::: "memory")
#define BAR8 __builtin_amdgcn_s_barrier()
#define SCHED8 __builtin_amdgcn_sched_barrier(0)
    const int nt = K >> 6;
    WAIT_V(0);
    STAGE_B(0, 0, 0); STAGE_A(0, 0, 0); STAGE_B(0, 1, 0); STAGE_A(0, 1, 0);
    if (wr == 1) BAR8;
    WAIT_V(4); BAR8;
    STAGE_B(1, 0, 1); STAGE_A(1, 0, 1); STAGE_B(1, 1, 1);
    WAIT_V(6); BAR8;
    for (int t = 0; t < nt - 2; t += 2) {
        LDB8(B0, 0, 0); SCHED8; LDA8(At, 0, 0); STAGE_A(1, 1, t + 1);
        WAIT_L(8); BAR8; WAIT_L(0); MMA8(0, 0, At, B0); BAR8; SCHED8;
        LDB8(B1, 0, 1); STAGE_B(0, 0, t + 2);
        BAR8; WAIT_L(0); MMA8(0, 1, At, B1); BAR8;
        LDA8(At, 0, 1); STAGE_A(0, 0, t + 2);
        BAR8; WAIT_L(0); MMA8(1, 0, At, B0); BAR8; SCHED8;
        STAGE_B(0, 1, t + 2);
        WAIT_V(6); BAR8; MMA8(1, 1, At, B1); BAR8;
        LDB8(B0, 1, 0); SCHED8; LDA8(At, 1, 0); STAGE_A(0, 1, t + 2);
        WAIT_L(8); BAR8; WAIT_L(0); MMA8(0, 0, At, B0); BAR8; SCHED8;
        LDB8(B1, 1, 1); STAGE_B(1, 0, t + 3);
        BAR8; WAIT_L(0); MMA8(0, 1, At, B1); BAR8;
        LDA8(At, 1, 1); STAGE_A(1, 0, t + 3);
        BAR8; WAIT_L(0); MMA8(1, 0, At, B0); BAR8; SCHED8;
        STAGE_B(1, 1, t + 3);
        WAIT_V(6); BAR8; MMA8(1, 1, At, B1); BAR8;
    }
    {
        LDB8(B0, 0, 0); LDA8(At, 0, 0); STAGE_A(1, 1, nt - 1);
        BAR8; WAIT_L(0); MMA8(0, 0, At, B0); BAR8;
        LDB8(B1, 0, 1); BAR8; WAIT_L(0); MMA8(0, 1, At, B1); BAR8;
        LDA8(At, 0, 1); WAIT_V(4); BAR8; WAIT_L(0); MMA8(1, 0, At, B0); MMA8(1, 1, At, B1); BAR8;
    }
    {
        LDB8(B0, 1, 0); LDA8(At, 1, 0); WAIT_V(2); BAR8; WAIT_L(0); MMA8(0, 0, At, B0); BAR8;
        LDB8(B1, 1, 1); WAIT_V(0); BAR8; WAIT_L(0); MMA8(0, 1, At, B1); BAR8;
        LDA8(At, 1, 1); BAR8; WAIT_L(0); MMA8(1, 0, At, B0); MMA8(1, 1, At, B1); BAR8;
    }
    if (wr == 0) BAR8;
#undef SA8
#undef SB8
#undef STAGE_A
#undef STAGE_B
#undef LDA8
#undef LDB8
#undef MMA8
#undef WAIT_V
#undef WAIT_L
#undef BAR8
#undef SCHED8
    const int tid2 = get_tid(), wr2 = (tid2 >> 6) >> 2, wc2 = (tid2 >> 6) & 3, fr2 = tid2 & 15, fq2 = (tid2 & 63) >> 4;
    if constexpr (!SWAP) epi.begin();
#pragma unroll
    for (int ai = 0; ai < 2; ++ai)
#pragma unroll
        for (int bj = 0; bj < 2; ++bj) {
#pragma unroll
            for (int m = 0; m < 4; ++m) {
                if constexpr (SWAP) {
#pragma unroll
                    for (int n = 0; n < 2; ++n) {
                        const f32x4 v = acc[ai][bj][m][n];
                        uint2 u; u.x = pk2(v[0], v[1]); u.y = pk2(v[2], v[3]);
                        { const int r = wc2 * 32 + n * 16 + fr2, cbB = (wr2 * 64 + m * 16 + 4 * fq2) * 2; *(uint2*)(smem + r * 256 + ((((cbB >> 4) ^ (r & 15)) << 4) | (cbB & 8))) = u; }
                    }
                } else {
                    epi.xform(m0 + ai * 128 + wr2 * 64 + m * 16 + fr2, n0 + bj * 128 + wc2 * 32, acc[ai][bj][m], fq2);
#pragma unroll
                    for (int n = 0; n < 2; ++n) {
                        const f32x4 v = acc[ai][bj][m][n];
                        uint2 u; u.x = pk2(v[0], v[1]); u.y = pk2(v[2], v[3]);
                        { const int r = wr2 * 64 + m * 16 + fr2, cbB = (wc2 * 32 + n * 16 + 4 * fq2) * 2; *(uint2*)(smem + r * 256 + ((((cbB >> 4) ^ (r & 15)) << 4) | (cbB & 8))) = u; }
                    }
                }
                if (m & 1) asm volatile("" ::: "memory");
            }
            __syncthreads();
#pragma unroll
            for (int i = 0; i < 4; ++i) {
                const int c = tid2 + NT * i, r = c >> 4, c16 = c & 15;
                const uint4 d = *(const uint4*)(smem + r * 256 + ((c16 ^ (r & 15)) << 4));
                bf16_t* dst;
                if constexpr (SWAP) dst = epi.addrT(n0 + bj * 128 + r, m0 + ai * 128 + (c16 >> 3) * 64);
                else dst = epi.addr64(m0 + ai * 128 + r, n0 + bj * 128 + (c16 >> 3) * 64);
                if (dst) *(uint4*)(dst + (c16 & 7) * 8) = d;
            }
            __syncthreads();
        }
    if constexpr (!SWAP) epi.flush(m0, n0, wc2);
}

DI void tile_map(int id, int MT, int NTl, int& mt, int& nt) {
    const int x = id & 7, local = id >> 3, mtx = MT >> 3;
    const int full = mtx >> 2, per = 4 * NTl;
    int patch = local / per, wv = local - patch * per, pm = 4;
    if (patch >= full) { patch = full; wv = local - full * per; pm = mtx - full * 4; }
    const int mo = wv % pm; nt = wv / pm;
    mt = (patch * 4 + mo) * 8 + x;
}

DI void tile_map_in(int id, int& mt, int& nt) {
    if (id < 8448) { tile_map(id, 256, 33, mt, nt); return; }
    const int id2 = id - 8448, k = id2 >> 3;
    mt = 256 + (id2 & 7);
    nt = k < 8 ? 4 + k : k < 10 ? 14 + (k - 8) : k < 14 ? 16 + (k - 10) : 32;
}
template <bool VSWAP, class Epi>
DI void gemm_phase_ex(const bf16_t* A, int lda, const bf16_t* B, int ldb, int K, int MT, int NTl, char* smem, Epi& epi, int bid, int nblk) {
    const int total = VSWAP ? 8448 + 120 : MT * NTl;
    bool first = true;
    for (int id = bid; id < total; id += nblk) {
        int mt, nt, mt2 = 0, nt2 = 0;
        if (VSWAP) tile_map_in(id, mt, nt); else tile_map(id, MT, NTl, mt, nt);
        const bool has_next = id + nblk < total;
        if (has_next) { if (VSWAP) tile_map_in(id + nblk, mt2, nt2); else tile_map(id + nblk, MT, NTl, mt2, nt2); }
        if constexpr (VSWAP) { if (Epi::is_vt(nt)) { gemm_tile<true>(A, lda, B, ldb, K, mt * 256, nt * 256, first, has_next, mt2 * 256, nt2 * 256, smem, epi); first = false; continue; } }
        gemm_tile<false>(A, lda, B, ldb, K, mt * 256, nt * 256, first, has_next, mt2 * 256, nt2 * 256, smem, epi);
        first = false;
    }
}
template <class Epi>
DI void gemm_phase(const bf16_t* A, int lda, const bf16_t* B, int ldb, int K, int MT, int NTl, char* smem, Epi& epi) {
    gemm_phase_ex<false>(A, lda, B, ldb, K, MT, NTl, smem, epi, blockIdx.x, gridDim.x);
}

DI float xhalf_max(float v) {
    typedef unsigned u32x2 __attribute__((ext_vector_type(2)));
    const unsigned u = __float_as_uint(v);
    const u32x2 r = __builtin_amdgcn_permlane32_swap(u, u, false, false);
    return fmaxf(__uint_as_float(r[0]), __uint_as_float(r[1]));
}
DI float xhalf_sum(float v) {
    typedef unsigned u32x2 __attribute__((ext_vector_type(2)));
    const unsigned u = __float_as_uint(v);
    const u32x2 r = __builtin_amdgcn_permlane32_swap(u, u, false, false);
    return __uint_as_float(r[0]) + __uint_as_float(r[1]);
}
template <class Epi>
DI void gemm_panel(const bf16_t* A, int lda, const bf16_t* B, int ldb, int K, int panel, int NTl, char* smem, Epi& epi) {
    for (int nt = 0; nt < NTl; ++nt)
        gemm_tile<false>(A, lda, B, ldb, K, panel * 256, nt * 256, nt == 0, nt + 1 < NTl, panel * 256, (nt + 1) * 256, smem, epi);
}

DI float quad_sum(float v) { v += __shfl_xor(v, 16); v += __shfl_xor(v, 32); return v; }
struct EpiIn {
    bf16_t *Q, *Kk, *Vt, *gq, *gk, *gvT, *sg, *mg; float* glow; const float* rope; float* kmax;
    float kacc0, kacc1;
    static DI bool is_vt(int nt) { return (nt >= 8 && nt < 12) || (nt >= 16 && nt < 20); }
    DI bf16_t* addrT(int col, int row64) const {
        int b, t;
        if (row64 < NLAT) { b = row64 >> 13; t = row64 & 8191; } else { const int r2 = row64 - NLAT; b = r2 >> 8; t = TLAT + (r2 & 255); }
        if (col < 3072) { const int c = col - 2048; return Vt + (size_t)((b * 8 + (c >> 7)) * 128 + (c & 127)) * TKV + t; }
        const int c = col - 4096; return gvT + (size_t)((b * 4 + (c >> 8)) * 256 + (c & 255)) * TKV + t;
    }
    DI bf16_t* addr64(int row, int col64) const {
        const bool lat = row < NLAT;
        int b, t;
        if (lat) { b = row >> 13; t = row & 8191; } else { const int r2 = row - NLAT; b = r2 >> 8; t = TLAT + (r2 & 255); }
        if (col64 < 2048) {
            const bool isq = col64 < 1024;
            if (isq && !lat) return nullptr;
            const int c = col64 & 1023, head = c >> 7, comp = (c >> 6) & 1;
            return isq ? Q + ((size_t)((b * 8 + head) * 2 + comp) * TLAT + t) * 64 : Kk + ((size_t)((b * 8 + head) * 2 + comp) * TKV + t) * 64;
        }
        if (col64 < 3072) return nullptr;
        if (col64 < 4096) { const bool isq = col64 < 3584; if (isq && !lat) return nullptr; return (isq ? gq : gk) + (size_t)row * 512 + ((col64 - 3072) & 511); }
        if (col64 < 5120) return nullptr;
        if (col64 < 6144) return lat ? sg + (size_t)row * 1024 + (col64 - 5120) : nullptr;
        if (col64 < 8192) return lat ? mg + (size_t)row * 2048 + (col64 - 6144) : nullptr;
        return nullptr;
    }
    DI void flush(int m0, int n0, int wc) {
        if (n0 < 1024 || n0 >= 2048) return;
        const int b = m0 < NLAT ? (m0 >> 13) : ((m0 - NLAT) >> 8);
#pragma unroll
        for (int bj = 0; bj < 2; ++bj) {
            float v = bj ? kacc1 : kacc0;
#pragma unroll
            for (int of = 8; of >= 1; of >>= 1) v = fmaxf(v, __shfl_xor(v, of));
            const int c = (n0 + bj * 128 + wc * 32) & 1023, head = c >> 7, comp = (c >> 6) & 1, half = (c >> 5) & 1;
            if ((threadIdx.x & 63) == 0) atomicMax((unsigned*)(kmax + (((b * 8 + head) * 2 + comp) * 2 + half) * KMS), __float_as_uint(v));
        }
    }
    DI void begin() { kacc0 = 0.f; kacc1 = 0.f; }
    DI void xform(int row, int cb, f32x4 (&v)[2], int q) {
        if (cb >= 8224) return;
        const bool lat = row < NLAT;
        int b, t;
        if (lat) { b = row >> 13; t = row & 8191; } else { const int r2 = row - NLAT; b = r2 >> 8; t = TLAT + (r2 & 255); }
        if (cb < 2048) {
            const bool isq = cb < 1024;
            if (isq && !lat) return;
            const int c = cb & 1023, head = c >> 7, comp = (c >> 6) & 1, half = (c >> 5) & 1;
            f32x4 o[2];
            if (lat) {
                const int pos = half ? (t & 63) : (t >> 6);
                const f32x4 c4 = *(const f32x4*)(rope + pos * 16 + 4 * q), s4 = *(const f32x4*)(rope + 2048 + pos * 16 + 4 * q);
#pragma unroll
                for (int j = 0; j < 4; ++j) {
                    const float x1 = v[0][j], x2 = v[1][j];
                    o[0][j] = x1 * c4[j] - x2 * s4[j];
                    o[1][j] = x2 * c4[j] + x1 * s4[j];
                }
            } else { o[0] = v[0]; o[1] = v[1]; }
            if (!isq) {
                float ssq = 0.f;
#pragma unroll
                for (int j = 0; j < 4; ++j) ssq += o[0][j] * o[0][j] + o[1][j] * o[1][j];
                ssq = quad_sum(ssq);
                if ((cb >> 7) & 1) kacc1 = fmaxf(kacc1, ssq); else kacc0 = fmaxf(kacc0, ssq);
            }
            const float scl = isq ? 0.125f * 1.4426950408889634f : 1.0f;
#pragma unroll
            for (int n = 0; n < 2; ++n) v[n] = o[n] * scl;
        } else if (cb < 3072) {
        } else if (cb < 4096) {
            const bool isq = cb < 3584;
            if (isq && !lat) return;
            const int c = (cb - 3072) & 511;
            const float scl = isq ? 0.08838834764831845f : 1.0f;
            (void)c;
#pragma unroll
            for (int n = 0; n < 2; ++n) v[n] = v[n] * scl;
        } else if (cb < 5120) {
        } else if (cb < 6144) {
            if (!lat) return;
#pragma unroll
            for (int n = 0; n < 2; ++n)
#pragma unroll
                for (int j = 0; j < 4; ++j) { const float xx = v[n][j]; v[n][j] = xx * sigmoidf_(xx); }
        } else if (cb < 8192) {
            if (!lat) return;
#pragma unroll
            for (int n = 0; n < 2; ++n)
#pragma unroll
                for (int j = 0; j < 4; ++j) v[n][j] = sigmoidf_(v[n][j]);
        } else {
            float* dst = glow + (size_t)row * 32;
#pragma unroll
            for (int n = 0; n < 2; ++n) *(f32x4*)(dst + 16 * n + 4 * q) = v[n];
        }
    }
};

struct EpiGate0 {
    bf16_t* mg;
    DI void flush(int, int, int) {}
    DI void begin() {}
    DI bf16_t* addr64(int row, int col64) const { return mg + (size_t)row * 2048 + col64; }
    DI void xform(int row, int cb, f32x4 (&v)[2], int q) const {
#pragma unroll
        for (int n = 0; n < 2; ++n) {
            const int col = cb + 16 * n + 4 * q;
            const uint2 m = *(const uint2*)(mg + (size_t)row * 2048 + col);
            v[n][0] *= bflo(m.x); v[n][1] *= bfhi(m.x); v[n][2] *= bflo(m.y); v[n][3] *= bfhi(m.y);
        }
    }
};
struct EpiGate1 {
    bf16_t* Y; const bf16_t* mg;
    DI void flush(int, int, int) {}
    DI void begin() {}
    DI bf16_t* addr64(int row, int col64) const { return Y + (size_t)row * 1024 + col64; }
    DI void xform(int row, int cb, f32x4 (&v)[2], int q) const {
#pragma unroll
        for (int n = 0; n < 2; ++n) {
            const int col = cb + 16 * n + 4 * q;
            const uint2 m = *(const uint2*)(mg + (size_t)row * 2048 + 1024 + col);
            const uint2 pr = *(const uint2*)(mg + (size_t)row * 2048 + col);
            v[n][0] = bflo(pr.x) + v[n][0] * bflo(m.x); v[n][1] = bfhi(pr.x) + v[n][1] * bfhi(m.x);
            v[n][2] = bflo(pr.y) + v[n][2] * bflo(m.y); v[n][3] = bfhi(pr.y) + v[n][3] * bfhi(m.y);
        }
    }
};
template <int ACT>
struct EpiStore {
    bf16_t* O; int ldo;
    DI void flush(int, int, int) {}
    DI void begin() {}
    DI bf16_t* addr64(int row, int col64) const { return O + (size_t)row * ldo + col64; }
    DI void xform(int row, int cb, f32x4 (&v)[2], int q) const {
        if (ACT == 1) {
#pragma unroll
            for (int n = 0; n < 2; ++n)
#pragma unroll
                for (int j = 0; j < 4; ++j) { const float xx = fmaxf(v[n][j], 0.f); v[n][j] = xx * xx; }
        }
    }
};

DI float quad_max(float v) { v = fmaxf(v, __shfl_xor(v, 16)); v = fmaxf(v, __shfl_xor(v, 32)); return v; }
DI bf16x8 pack8(const f32x4& a, const f32x4& b) {
    typedef unsigned u32x4 __attribute__((ext_vector_type(4)));
    const u32x4 u = {pk2(a[0], a[1]), pk2(a[2], a[3]), pk2(b[0], b[1]), pk2(b[2], b[3])};
    return __builtin_bit_cast(bf16x8, u);
}

template <bool FAST>
DI void attn_kloop(char* smem, char* sdst, const bf16_t* gk0, const bf16_t* gk1, const bf16_t* gv, bool first, bool has_next, const bf16_t* ngk0, const bf16_t* ngk1, const bf16_t* ngv,
                   int comp, int krow0, int ksw, int l15, int qd, const bf16x8 (&qf)[2][2], f32x4 (&O)[2][8], float (&m)[2], float (&l)[2]) {
#define ATT_STAGE_P(pk0, pk1, pv, buf, kt_) do { _Pragma("unroll") for (int jj = 0; jj < 2; ++jj) { \
            GLDS16(pk0 + (size_t)((kt_) * 128 + 64 * jj) * 64, sdst + (buf) * 65536 + jj * 8192); \
            GLDS16(pk1 + (size_t)((kt_) * 128 + 64 * jj) * 64, sdst + (buf) * 65536 + 16384 + jj * 8192); } \
            _Pragma("unroll") for (int jj = 0; jj < 4; ++jj) GLDS16(pv + (size_t)(32 * jj) * TKV + (kt_) * 128, sdst + (buf) * 65536 + 32768 + jj * 8192); } while (0)
#define ATT_STAGE(buf, kt_) ATT_STAGE_P(gk0, gk1, gv, buf, kt_)
#define KFRAG(sub_, t_, kd_) (*(const bf16x8*)(skc + (32 * (sub_) + krow0 + 4 * (t_)) * 128 + (((4 * (kd_) + qd) ^ ksw) << 4)))
#define VFRAG(sub_, dt_) (*(const bf16x8*)(sb + 32768 + (16 * (dt_) + l15) * 256 + (((4 * (sub_) + qd) ^ l15) << 4)))
    if (first) {
        ATT_STAGE(0, 0);
        asm volatile("s_waitcnt vmcnt(0)" ::: "memory");
        __syncthreads();
    }
    const bool late = (threadIdx.x >> 8) != 0;
    f32x4 sinit[2], Ls[2];
#pragma unroll
    for (int qt = 0; qt < 2; ++qt) { const float v0 = FAST ? -m[qt] : 0.f; sinit[qt] = (f32x4){v0, v0, v0, v0}; Ls[qt] = (f32x4){0.f, 0.f, 0.f, 0.f}; }
    constexpr int NKT = TKV / 128;
    for (int kt = 0; kt < NKT; ++kt) {
        const int cur = kt & 1;
        if (kt + 1 < NKT) ATT_STAGE(cur ^ 1, kt + 1);
        else if (has_next) ATT_STAGE_P(ngk0, ngk1, ngv, cur ^ 1, 0);
        const char* sb = smem + cur * 65536;
        const char* skc = sb + comp * 16384;
        if (FAST) {
            bf16x8 kf[2][2];
#pragma unroll
            for (int t = 0; t < 2; ++t)
#pragma unroll
                for (int kd = 0; kd < 2; ++kd) kf[t][kd] = KFRAG(0, t, kd);
            f32x4 Sn[2][2];
#pragma unroll
            for (int qt = 0; qt < 2; ++qt)
#pragma unroll
                for (int t = 0; t < 2; ++t) { Sn[qt][t] = MFMA16(kf[t][0], qf[qt][0], sinit[qt]); Sn[qt][t] = MFMA16(kf[t][1], qf[qt][1], Sn[qt][t]); }
            const bf16x8 ones = {0x3F80, 0x3F80, 0x3F80, 0x3F80, 0x3F80, 0x3F80, 0x3F80, 0x3F80};
#pragma unroll
            for (int sub = 0; sub < 4; ++sub) {
                f32x4 Sc[2][2];
#pragma unroll
                for (int qt = 0; qt < 2; ++qt)
#pragma unroll
                    for (int t = 0; t < 2; ++t) Sc[qt][t] = Sn[qt][t];
                bf16x8 va[4], vb[4];
#pragma unroll
                for (int dt = 0; dt < 4; ++dt) va[dt] = VFRAG(sub, dt);
                if (sub < 3) {
#pragma unroll
                    for (int t = 0; t < 2; ++t)
#pragma unroll
                        for (int kd = 0; kd < 2; ++kd) kf[t][kd] = KFRAG(sub + 1, t, kd);
                }
                __builtin_amdgcn_sched_barrier(0);
                bf16x8 pb[2];
#pragma unroll
                for (int qt = 0; qt < 2; ++qt) {
                    f32x4 p0, p1;
#pragma unroll
                    for (int i = 0; i < 4; ++i) { p0[i] = __builtin_amdgcn_exp2f(Sc[qt][0][i]); p1[i] = __builtin_amdgcn_exp2f(Sc[qt][1][i]); }
                    pb[qt] = pack8(p0, p1);
                }
#pragma unroll
                for (int dt = 0; dt < 4; ++dt) vb[dt] = VFRAG(sub, 4 + dt);
                __builtin_amdgcn_sched_barrier(0);
                if (sub == 3 && late) {
                    asm volatile("s_waitcnt vmcnt(0) lgkmcnt(0)" ::: "memory"); __builtin_amdgcn_s_barrier(); asm volatile("" ::: "memory");
                }
#pragma unroll
                for (int dt = 0; dt < 4; ++dt) {
                    O[0][dt] = MFMA16(va[dt], pb[0], O[0][dt]);
                    O[1][dt] = MFMA16(va[dt], pb[1], O[1][dt]);
                    if (sub < 3) Sn[dt >> 1][dt & 1] = MFMA16(kf[dt & 1][0], qf[dt >> 1][0], sinit[dt >> 1]);
                }
#pragma unroll
                for (int dt = 0; dt < 4; ++dt) {
                    O[0][4 + dt] = MFMA16(vb[dt], pb[0], O[0][4 + dt]);
                    O[1][4 + dt] = MFMA16(vb[dt], pb[1], O[1][4 + dt]);
                    if (sub < 3) Sn[dt >> 1][dt & 1] = MFMA16(kf[dt & 1][1], qf[dt >> 1][1], Sn[dt >> 1][dt & 1]);
                }
                Ls[0] = MFMA16(ones, pb[0], Ls[0]);
                Ls[1] = MFMA16(ones, pb[1], Ls[1]);
            }
        } else {
#pragma unroll 1
            for (int sub = 0; sub < 4; ++sub) {
                f32x4 S[2][2];
#pragma unroll
                for (int qt = 0; qt < 2; ++qt)
#pragma unroll
                    for (int t = 0; t < 2; ++t) { S[qt][t] = MFMA16(KFRAG(sub, t, 0), qf[qt][0], sinit[qt]); S[qt][t] = MFMA16(KFRAG(sub, t, 1), qf[qt][1], S[qt][t]); }
                bf16x8 pb[2];
#pragma unroll
                for (int qt = 0; qt < 2; ++qt) {
                    float mt = fmaxf(fmaxf(fmaxf(S[qt][0][0], S[qt][0][1]), fmaxf(S[qt][0][2], S[qt][0][3])), fmaxf(fmaxf(S[qt][1][0], S[qt][1][1]), fmaxf(S[qt][1][2], S[qt][1][3])));
                    mt = quad_max(mt);
                    if (mt > m[qt]) {
                        const float al = __builtin_amdgcn_exp2f(m[qt] - mt);
                        l[qt] *= al;
#pragma unroll
                        for (int dt = 0; dt < 8; ++dt) O[qt][dt] *= al;
                        m[qt] = mt;
                    }
                    f32x4 p0, p1;
#pragma unroll
                    for (int i = 0; i < 4; ++i) { p0[i] = __builtin_amdgcn_exp2f(S[qt][0][i] - m[qt]); p1[i] = __builtin_amdgcn_exp2f(S[qt][1][i] - m[qt]); l[qt] += p0[i] + p1[i]; }
                    pb[qt] = pack8(p0, p1);
                }
#pragma unroll
                for (int dt = 0; dt < 8; ++dt) {
                    const bf16x8 vf = VFRAG(sub, dt);
                    O[0][dt] = MFMA16(vf, pb[0], O[0][dt]);
                    O[1][dt] = MFMA16(vf, pb[1], O[1][dt]);
                }
            }
        }
        if (!(FAST && late)) { asm volatile("s_waitcnt vmcnt(0) lgkmcnt(0)" ::: "memory"); __builtin_amdgcn_s_barrier(); asm volatile("" ::: "memory"); }
    }
#undef ATT_STAGE
#undef ATT_STAGE_P
#undef KFRAG
#undef VFRAG
    if (FAST) { l[0] = Ls[0][0]; l[1] = Ls[1][0]; }
    else { l[0] = quad_sum(l[0]); l[1] = quad_sum(l[1]); }
}

DI void phase_attn(const Params& p, char* smem) {
    const int tid = get_tid(), lane = tid & 63, w = tid >> 6, l15 = lane & 15, qd = lane >> 4;
    const int g = w >> 1, comp = w & 1;
    const bf16_t* Q = (const bf16_t*)(p.ws + R_Q);
    const bf16_t* Kk = (const bf16_t*)(p.ws + R_K);
    const bf16_t* Vt = (const bf16_t*)(p.ws + R_VT);
    const float* kmax = (const float*)(p.ws + OFF_KMAX);
    bf16_t* YDA = (bf16_t*)(p.ws + R_H);
    float d1 = 0.f, d2 = 0.f;
    for (int i = 0; i < 64; ++i) { d1 += p.lq1[i] * p.lk1[i]; d2 += p.lq2[i] * p.lk2[i]; }
    const float lam = __expf(d1) - __expf(d2) + 0.2f;
    const int krs = 8 * w + (lane >> 3), kcs = (lane & 7) ^ (((lane >> 4) & 1) | ((w & 3) << 1));
    const int vrs = 4 * w + (lane >> 4), vcs = (lane & 15) ^ ((4 * w + (lane >> 4)) & 15);
    const int krow0 = 8 * (l15 >> 2) + (l15 & 3);
    const int ksw = ((l15 >> 1) & 1) | (((l15 >> 2) & 3) << 1);
    float* xbuf = (float*)(smem + 65536) + g * 4096;
    char* sdst = smem + w * 1024;
    for (int id = blockIdx.x; id < 4096; id += gridDim.x) {
        const int x = id & 7, j = id >> 3, bh = (j >> 6) * 8 + x, qti = j & 63;
        const int b = bh >> 3, h = bh & 7;
        bf16x8 qf[2][2];
        float mb[2];
        const float kb = sqrtf(kmax[((bh * 2 + comp) * 2) * KMS] + kmax[((bh * 2 + comp) * 2 + 1) * KMS]);
#pragma unroll
        for (int qt = 0; qt < 2; ++qt) {
            const bf16_t* qp = Q + ((size_t)(bh * 2 + comp) * TLAT + qti * 128 + g * 32 + 16 * qt + l15) * 64 + qd * 8;
            qf[qt][0] = *(const bf16x8*)qp; qf[qt][1] = *(const bf16x8*)(qp + 32);
            float qn = 0.f;
#pragma unroll
            for (int kd = 0; kd < 2; ++kd)
#pragma unroll
                for (int e = 0; e < 8; ++e) { const float qv = __uint_as_float(((unsigned)(unsigned short)qf[qt][kd][e]) << 16); qn += qv * qv; }
            qn = quad_sum(qn);
            mb[qt] = sqrtf(qn) * kb * 1.01f + 1e-3f;
        }
        const bf16_t* gk0 = Kk + ((size_t)(bh * 2 + 0) * TKV + krs) * 64 + kcs * 8;
        const bf16_t* gk1 = gk0 + (size_t)TKV * 64;
        const bf16_t* gv = Vt + ((size_t)bh * 128 + vrs) * TKV + vcs * 8;
        const bool first = id == (int)blockIdx.x, has_next = id + (int)gridDim.x < 4096;
        const int nid = has_next ? id + gridDim.x : id, nbh = ((nid >> 3) >> 6) * 8 + (nid & 7);
        const bf16_t* ngk0 = Kk + ((size_t)(nbh * 2 + 0) * TKV + krs) * 64 + kcs * 8;
        const bf16_t* ngk1 = ngk0 + (size_t)TKV * 64;
        const bf16_t* ngv = Vt + ((size_t)nbh * 128 + vrs) * TKV + vcs * 8;
        f32x4 O[2][8];
#pragma unroll
        for (int qt = 0; qt < 2; ++qt)
#pragma unroll
            for (int d = 0; d < 8; ++d) O[qt][d] = (f32x4){0.f, 0.f, 0.f, 0.f};
        float m[2], l[2] = {0.f, 0.f};
        const int slow = __syncthreads_or(!(mb[0] <= 60.0f && mb[1] <= 60.0f));
        if (!slow) { m[0] = mb[0]; m[1] = mb[1]; attn_kloop<true>(smem, sdst, gk0, gk1, gv, first, has_next, ngk0, ngk1, ngv, comp, krow0, ksw, l15, qd, qf, O, m, l); }
        else { m[0] = -INFINITY; m[1] = -INFINITY; attn_kloop<false>(smem, sdst, gk0, gk1, gv, first, has_next, ngk0, ngk1, ngv, comp, krow0, ksw, l15, qd, qf, O, m, l); }
        if (comp == 1) {
#pragma unroll
            for (int qt = 0; qt < 2; ++qt) {
                const float i1 = lam / l[qt];
#pragma unroll
                for (int d = 0; d < 8; ++d)
#pragma unroll
                    for (int i = 0; i < 4; ++i) xbuf[((qt * 8 + d) * 4 + i) * 64 + lane] = O[qt][d][i] * i1;
            }
        }
        __syncthreads();
        if (comp == 0) {
#pragma unroll
            for (int qt = 0; qt < 2; ++qt) {
                const float i0 = 1.0f / l[qt];
                float ss = 0.f;
#pragma unroll
                for (int d = 0; d < 8; ++d)
#pragma unroll
                    for (int i = 0; i < 4; ++i) { const float o = O[qt][d][i] * i0 - xbuf[((qt * 8 + d) * 4 + i) * 64 + lane]; O[qt][d][i] = o; ss += o * o; }
                ss = quad_sum(ss);
                const float rs = rsqrtf(ss * (1.0f / 128.0f) + EPS) * 0.8f;
                const int t = qti * 128 + g * 32 + 16 * qt + l15;
                bf16_t* dst = YDA + ((size_t)b * TLAT + t) * 1024 + h * 128;
#pragma unroll
                for (int d = 0; d < 8; ++d) {
                    const int dv = 16 * d + 4 * qd;
                    const f32x4 hn = *(const f32x4*)(p.da_hn + dv);
                    uint2 u; u.x = pk2(O[qt][d][0] * rs * hn.x, O[qt][d][1] * rs * hn.y); u.y = pk2(O[qt][d][2] * rs * hn.z, O[qt][d][3] * rs * hn.w);
                    *(uint2*)(dst + dv) = u;
                }
            }
        }
    }
}

DI void phase_gate(const Params& p, char* smem) {
    const int tid = get_tid();
    const float* glow = (const float*)(p.ws + OFF_GLOW);
    float* sg = (float*)smem;
    float wf[16], wb[16];
#pragma unroll
    for (int r = 0; r < 16; ++r) { wf[r] = p.w_gate_up[(size_t)r * 512 + tid]; wb[r] = p.w_gate_up[(size_t)(16 + r) * 512 + tid]; }
    const float biasf = p.b_gate_up[tid], biasb = p.b_gate_up[512 + tid];
    _Float16* BF = (_Float16*)(p.ws + R_BF);
    _Float16* BB = (_Float16*)(p.ws + R_BB);
    for (int ch = blockIdx.x; ch < 1056; ch += gridDim.x) {
        __syncthreads();
        *(f32x4*)(sg + tid * 4) = *(const f32x4*)(glow + (size_t)ch * 2048 + tid * 4);
        __syncthreads();
        float run = 0.f;
#pragma unroll 4
        for (int i = 0; i < 64; ++i) {
            const float* gl = sg + i * 32;
            float a = biasf;
#pragma unroll
            for (int r = 0; r < 16; ++r) a = fmaf(gl[r], wf[r], a);
            const float ls = fminf(a, 0.f) - __logf(1.0f + __expf(-fabsf(a)));
            run += ls * (1.4426950408889634f / 16.0f);
            BF[(size_t)(ch * 64 + i) * 512 + tid] = (_Float16)run;
        }
        run = 0.f;
#pragma unroll 4
        for (int i = 63; i >= 0; --i) {
            const float* gl = sg + i * 32 + 16;
            float a = biasb;
#pragma unroll
            for (int r = 0; r < 16; ++r) a = fmaf(gl[r], wb[r], a);
            const float ls = fminf(a, 0.f) - __logf(1.0f + __expf(-fabsf(a)));
            run += ls * (1.4426950408889634f / 16.0f);
            BB[(size_t)(ch * 64 + i) * 512 + tid] = (_Float16)run;
        }
    }
}

struct GlaRegs { uint2 k[2][2], q[2][2], bb[2][2], bl[2][2]; uint4 v[2]; };

DI void phase_gla(const Params& p, char* smem, int unit) {
    const int tid = get_tid(), lane = tid & 63, w = tid >> 6, l31 = lane & 31, hh = lane >> 5;
    const int dir = unit & 1, dvh = (unit >> 1) & 1, bh = unit >> 2, b = bh >> 2, h = bh & 3;
    const bf16_t* gq = (const bf16_t*)(p.ws + R_GQ);
    const bf16_t* gk = (const bf16_t*)(p.ws + R_GK);
    const bf16_t* gvT = (const bf16_t*)(p.ws + R_GVT) + (size_t)(bh * 256 + dvh * 128) * TKV;
    const _Float16* B16 = (const _Float16*)(p.ws + (dir ? R_BB : R_BF));
    bf16_t* Oo = (bf16_t*)(p.ws + (dir ? R_OB : R_OF));
    char* sQt = smem;
    char* sKt = smem + 16384;
    char* sKh = smem + 32768;
    char* sVT = smem + 49152;
    char* sA = smem + 81920;
    float* sD = (float*)(smem + 90112);
    f32x16 S[4];
#pragma unroll
    for (int k = 0; k < 4; ++k)
#pragma unroll
        for (int e = 0; e < 16; ++e) S[k][e] = 0.f;
    const int sw = (l31 >> 1) & 7;
    GlaRegs R;
    auto chunk_info = [&](int step, int& rowbase, int& tcol, bool& emit) {
        if (step < 4) { const int cc = dir ? 3 - step : step; rowbase = NLAT + b * 256 + cc * 64; tcol = TLAT + cc * 64; emit = false; }
        else { const int cc = dir ? 127 - (step - 4) : step - 4; rowbase = b * TLAT + cc * 64; tcol = cc * 64; emit = true; }
    };
    auto load_chunk = [&](int step) {
        int rowbase, tcol; bool emit; chunk_info(step, rowbase, tcol, emit);
        const int rl = rowbase + (dir ? 0 : 63);
#pragma unroll
        for (int i = 0; i < 2; ++i) {
            const int item = tid + NT * i, tok = item >> 4, c = item & 15, d0 = 16 * (c >> 1) + 4 * (c & 1);
            const size_t ro = (size_t)(rowbase + tok) * 512 + h * 128 + d0;
            R.k[i][0] = *(const uint2*)(gk + ro); R.k[i][1] = *(const uint2*)(gk + ro + 8);
            if (emit) { R.q[i][0] = *(const uint2*)(gq + ro); R.q[i][1] = *(const uint2*)(gq + ro + 8); }
            else { R.q[i][0] = make_uint2(0, 0); R.q[i][1] = make_uint2(0, 0); }
            R.bb[i][0] = *(const uint2*)(B16 + ro); R.bb[i][1] = *(const uint2*)(B16 + ro + 8);
            const size_t rlo = (size_t)rl * 512 + h * 128 + d0;
            R.bl[i][0] = *(const uint2*)(B16 + rlo); R.bl[i][1] = *(const uint2*)(B16 + rlo + 8);
        }
#pragma unroll
        for (int i = 0; i < 2; ++i) R.v[i] = *(const uint4*)(gvT + (size_t)((tid >> 3) + 64 * i) * TKV + tcol + (tid & 7) * 8);
    };
    auto stage_chunk = [&]() {
#pragma unroll
        for (int i = 0; i < 2; ++i) {
            const int item = tid + NT * i, tok = item >> 4, c = item & 15, d0 = 16 * (c >> 1) + 4 * (c & 1);
            float qo[8], ko[8];
#pragma unroll
            for (int g = 0; g < 2; ++g) {
                const h4_t bv = __builtin_bit_cast(h4_t, R.bb[i][g]), lv = __builtin_bit_cast(h4_t, R.bl[i][g]);
                const float kk[4] = {bflo(R.k[i][g].x), bfhi(R.k[i][g].x), bflo(R.k[i][g].y), bfhi(R.k[i][g].y)};
                const float qq[4] = {bflo(R.q[i][g].x), bfhi(R.q[i][g].x), bflo(R.q[i][g].y), bfhi(R.q[i][g].y)};
#pragma unroll
                for (int j = 0; j < 4; ++j) {
                    const float bb = (float)bv[j], bl = (float)lv[j];
                    qo[4 * g + j] = qq[j] * __builtin_amdgcn_exp2f(bb);
                    ko[4 * g + j] = kk[j] * __builtin_amdgcn_exp2f(-bb);
                    const float kh = kk[j] * __builtin_amdgcn_exp2f(bl - bb);
                    const int dk = d0 + 8 * g + j;
                    *(bf16_t*)(sKh + dk * 128 + ((((tok >> 3) ^ ((dk >> 1) & 7))) << 4) + (tok & 7) * 2) = bf1(kh);
                }
            }
            const int po = tok * 256 + ((c ^ (tok & 15)) << 4);
            uint4 uq, uk;
            uq.x = pk2(qo[0], qo[1]); uq.y = pk2(qo[2], qo[3]); uq.z = pk2(qo[4], qo[5]); uq.w = pk2(qo[6], qo[7]);
            uk.x = pk2(ko[0], ko[1]); uk.y = pk2(ko[2], ko[3]); uk.z = pk2(ko[4], ko[5]); uk.w = pk2(ko[6], ko[7]);
            *(uint4*)(sQt + po) = uq; *(uint4*)(sKt + po) = uk;
        }
#pragma unroll
        for (int i = 0; i < 2; ++i) {
            const int row = (tid >> 3) + 64 * i, scn = tid & 7;
            *(uint4*)(sVT + row * 128 + ((scn ^ ((row >> 1) & 7)) << 4)) = R.v[i];
        }
        if (tid < 16) {
            const int d0 = 16 * (tid >> 1) + 4 * (tid & 1);
#pragma unroll
            for (int g = 0; g < 2; ++g) {
                const h4_t lv = __builtin_bit_cast(h4_t, R.bl[0][g]);
#pragma unroll
                for (int j = 0; j < 4; ++j) sD[d0 + 8 * g + j] = __builtin_amdgcn_exp2f((float)lv[j]);
            }
        }
    };
    load_chunk(0);
    for (int step = 0; step < 132; ++step) {
        int rowbase, tcol; bool emit; chunk_info(step, rowbase, tcol, emit);
        stage_chunk();
        __syncthreads();
        if (step + 1 < 132) load_chunk(step + 1);
        const int dvb = 32 * (w & 3);
        f32x16 o[2];
        if (emit) {
            if (w >= 4) {
                const int ti = (w - 4) >> 1, tj = (w - 4) & 1;
                f32x16 a;
#pragma unroll
                for (int e = 0; e < 16; ++e) a[e] = 0.f;
                const bool dead = dir ? (tj < ti) : (tj > ti);
                if (!dead) {
#pragma unroll
                    for (int ks = 0; ks < 8; ++ks) {
                        const int ri = 32 * ti + l31, rj = 32 * tj + l31, c = 2 * ks + hh;
                        const bf16x8 af = *(const bf16x8*)(sQt + ri * 256 + ((c ^ (ri & 15)) << 4));
                        const bf16x8 bf = *(const bf16x8*)(sKt + rj * 256 + ((c ^ (rj & 15)) << 4));
                        a = MFMA32(af, bf, a);
                    }
                }
                const int jj = 32 * tj + l31;
#pragma unroll
                for (int e = 0; e < 16; ++e) {
                    const int ii = 32 * ti + (e & 3) + 8 * (e >> 2) + 4 * hh;
                    const bool keep = dir ? (jj >= ii) : (jj <= ii);
                    *(bf16_t*)(sA + ii * 128 + ((((jj >> 3) ^ ((ii >> 1) & 7))) << 4) + (jj & 7) * 2) = bf1(keep ? a[e] : 0.f);
                }
            } else {
#pragma unroll
            for (int mt = 0; mt < 2; ++mt)
#pragma unroll
                for (int e = 0; e < 16; ++e) o[mt][e] = 0.f;
#pragma unroll
            for (int kt = 0; kt < 4; ++kt)
#pragma unroll
                for (int s = 0; s < 2; ++s) {
                    typedef unsigned u32x4 __attribute__((ext_vector_type(4)));
                    u32x4 pu = {pk2(S[kt][8 * s], S[kt][8 * s + 1]), pk2(S[kt][8 * s + 2], S[kt][8 * s + 3]), pk2(S[kt][8 * s + 4], S[kt][8 * s + 5]), pk2(S[kt][8 * s + 6], S[kt][8 * s + 7])};
                    const bf16x8 sf = __builtin_bit_cast(bf16x8, pu);
#pragma unroll
                    for (int mt = 0; mt < 2; ++mt) {
                        const int ri = 32 * mt + l31, c = 4 * kt + 2 * s + hh;
                        const bf16x8 af = *(const bf16x8*)(sQt + ri * 256 + ((c ^ (ri & 15)) << 4));
                        o[mt] = MFMA32(af, sf, o[mt]);
                    }
                }
            }
            __syncthreads();
            if (w < 4) {
#pragma unroll
            for (int s2 = 0; s2 < 4; ++s2) {
                const int c = 2 * s2 + hh;
                const bf16x8 vf = *(const bf16x8*)(sVT + (dvb + l31) * 128 + ((c ^ sw) << 4));
#pragma unroll
                for (int mt = 0; mt < 2; ++mt) {
                    const bf16x8 af = *(const bf16x8*)(sA + (32 * mt + l31) * 128 + ((c ^ sw) << 4));
                    o[mt] = MFMA32(af, vf, o[mt]);
                }
            }
            bf16_t* od = Oo + (size_t)rowbase * 1024 + h * 256 + dvh * 128 + dvb + l31;
#pragma unroll
            for (int mt = 0; mt < 2; ++mt)
#pragma unroll
                for (int e = 0; e < 16; ++e) od[(size_t)(32 * mt + (e & 3) + 8 * (e >> 2) + 4 * hh) * 1024] = bf1(o[mt][e]);
            }
        }
        if (w < 4) {
#pragma unroll
        for (int kt = 0; kt < 4; ++kt)
#pragma unroll
            for (int g4 = 0; g4 < 4; ++g4) {
                const f32x4 dd = *(const f32x4*)(sD + 32 * kt + 8 * g4 + 4 * hh);
#pragma unroll
                for (int jq = 0; jq < 4; ++jq) S[kt][4 * g4 + jq] *= dd[jq];
            }
#pragma unroll
        for (int s2 = 0; s2 < 4; ++s2) {
            const int c = 2 * s2 + hh;
            const bf16x8 vf = *(const bf16x8*)(sVT + (dvb + l31) * 128 + ((c ^ sw) << 4));
#pragma unroll
            for (int kt = 0; kt < 4; ++kt) {
                const bf16x8 af = *(const bf16x8*)(sKh + (32 * kt + l31) * 128 + ((c ^ sw) << 4));
                S[kt] = MFMA32(af, vf, S[kt]);
            }
        }
        }
        __syncthreads();
    }
}

DI void phase_combine(const Params& p, int panel) {
    const int tid = get_tid(), lane = tid & 63, w = tid >> 6;
    const bf16_t* OF = (const bf16_t*)(p.ws + R_OF);
    const bf16_t* OB = (const bf16_t*)(p.ws + R_OB);
    const bf16_t* SG = (const bf16_t*)(p.ws + R_SG);
    bf16_t* Y = (bf16_t*)(p.ws + R_YGLA);
    for (int row2 = panel * 256 + w; row2 < panel * 256 + 256; row2 += 16)
#pragma unroll
    for (int rr = 0; rr < 2; ++rr) {
        const int row = row2 + 8 * rr;
        const size_t o = (size_t)row * 1024 + lane * 16;
        const uint4 a0 = *(const uint4*)(OF + o), a1 = *(const uint4*)(OF + o + 8);
        const uint4 b0 = *(const uint4*)(OB + o), b1 = *(const uint4*)(OB + o + 8);
        const uint4 g0 = *(const uint4*)(SG + o), g1 = *(const uint4*)(SG + o + 8);
        const unsigned au[8] = {a0.x, a0.y, a0.z, a0.w, a1.x, a1.y, a1.z, a1.w};
        const unsigned bu[8] = {b0.x, b0.y, b0.z, b0.w, b1.x, b1.y, b1.z, b1.w};
        const unsigned gu[8] = {g0.x, g0.y, g0.z, g0.w, g1.x, g1.y, g1.z, g1.w};
        float v[16]; float ss = 0.f;
#pragma unroll
        for (int e = 0; e < 8; ++e) { v[2 * e] = bflo(au[e]) + bflo(bu[e]); v[2 * e + 1] = bfhi(au[e]) + bfhi(bu[e]); ss += v[2 * e] * v[2 * e] + v[2 * e + 1] * v[2 * e + 1]; }
#pragma unroll
        for (int of = 8; of >= 1; of >>= 1) ss += __shfl_xor(ss, of);
        const float rs = rsqrtf(ss * (1.0f / 256.0f) + EPS);
        const float* gn = p.gla_hn + ((lane * 16) & 255);
        unsigned ou[8];
#pragma unroll
        for (int e = 0; e < 8; ++e) ou[e] = pk2(v[2 * e] * rs * gn[2 * e] * bflo(gu[e]), v[2 * e + 1] * rs * gn[2 * e + 1] * bfhi(gu[e]));
        *(uint4*)(Y + o) = make_uint4(ou[0], ou[1], ou[2], ou[3]);
        *(uint4*)(Y + o + 8) = make_uint4(ou[4], ou[5], ou[6], ou[7]);
    }
}

template <int MODE>
DI void phase_rows(const Params& p, char* smem, int panel) {
    float* md = (float*)smem;
    const int tid = get_tid(), lane = tid & 63, w = tid >> 6;
    const bf16_t* Yin = (const bf16_t*)(p.ws + (MODE == 0 ? R_Y2 : R_Y3));
    bf16_t* H2 = (bf16_t*)(p.ws + R_H2);
    const float* pn = MODE == 0 ? p.post_norm1 : p.post_norm2;
    const float* xsrc = MODE == 0 ? p.x : (const float*)p.out;
    const int r = panel >> 5;
    __syncthreads();
    if (MODE == 0) { load_mod(p, r, 2, md); load_mod(p, r, 3, md + 1024); load_mod(p, r, 4, md + 2048); }
    else load_mod(p, r, 5, md);
    __syncthreads();
    for (int i = 0; i < 16; ++i) {
        const int rows[2] = {panel * 256 + w * 32 + i, panel * 256 + w * 32 + 16 + i};
        uint2 yu[2][4]; f32x4 xv[2][4];
#pragma unroll
        for (int q = 0; q < 2; ++q)
#pragma unroll
            for (int j = 0; j < 4; ++j) {
                yu[q][j] = *(const uint2*)(Yin + (size_t)rows[q] * 1024 + lane * 4 + 256 * j);
                xv[q][j] = *(const f32x4*)(xsrc + (size_t)rows[q] * 1024 + lane * 4 + 256 * j);
            }
        float y[2][16], ss[2] = {0.f, 0.f};
#pragma unroll
        for (int q = 0; q < 2; ++q)
#pragma unroll
            for (int j = 0; j < 4; ++j) {
                y[q][4 * j] = bflo(yu[q][j].x); y[q][4 * j + 1] = bfhi(yu[q][j].x); y[q][4 * j + 2] = bflo(yu[q][j].y); y[q][4 * j + 3] = bfhi(yu[q][j].y);
#pragma unroll
                for (int e = 0; e < 4; ++e) ss[q] += y[q][4 * j + e] * y[q][4 * j + e];
            }
        ss[0] = wave_sum(ss[0]); ss[1] = wave_sum(ss[1]);
        float xn[2][16], s2[2] = {0.f, 0.f};
#pragma unroll
        for (int q = 0; q < 2; ++q) {
            const float rs = rsqrtf(ss[q] * (1.0f / 1024.0f) + EPS);
#pragma unroll
            for (int j = 0; j < 4; ++j) {
                const int col = lane * 4 + 256 * j;
                const f32x4 g = *(const f32x4*)(pn + col), gt = *(const f32x4*)(md + col);
#pragma unroll
                for (int e = 0; e < 4; ++e) { xn[q][4 * j + e] = xv[q][j][e] + gt[e] * (y[q][4 * j + e] * rs * g[e]); s2[q] += xn[q][4 * j + e] * xn[q][4 * j + e]; }
                f32x4 ov = {xn[q][4 * j], xn[q][4 * j + 1], xn[q][4 * j + 2], xn[q][4 * j + 3]};
                if (MODE == 1) __builtin_nontemporal_store(ov, (f32x4*)(p.out + (size_t)rows[q] * 1024 + col));
                else *(f32x4*)(p.out + (size_t)rows[q] * 1024 + col) = ov;
            }
        }
        if (MODE == 0) {
            s2[0] = wave_sum(s2[0]); s2[1] = wave_sum(s2[1]);
#pragma unroll
            for (int q = 0; q < 2; ++q) {
                const float rs2 = rsqrtf(s2[q] * (1.0f / 1024.0f) + EPS);
#pragma unroll
                for (int j = 0; j < 4; ++j) {
                    const int col = lane * 4 + 256 * j;
                    const f32x4 g = *(const f32x4*)(p.pre_norm2 + col), sh = *(const f32x4*)(md + 1024 + col), sc = *(const f32x4*)(md + 2048 + col);
                    float o[4];
#pragma unroll
                    for (int e = 0; e < 4; ++e) o[e] = xn[q][4 * j + e] * rs2 * g[e] * (1.f + sc[e]) + sh[e];
                    uint2 u; u.x = pk2(o[0], o[1]); u.y = pk2(o[2], o[3]);
                    *(uint2*)(H2 + (size_t)rows[q] * 1024 + col) = u;
                }
            }
        }
    }
}

DI void gsync(unsigned* bar, unsigned k) {
    __syncthreads();
    const unsigned epoch = k * gridDim.x;
    if (threadIdx.x == 0) {
        __threadfence();
        atomicAdd(bar, 1u);
        while (__hip_atomic_load(bar, __ATOMIC_RELAXED, __HIP_MEMORY_SCOPE_AGENT) < epoch) __builtin_amdgcn_s_sleep(1);
        __threadfence();
    }
    __syncthreads();
}

__global__ void __launch_bounds__(NT) fwd_megakernel(Params p) {
    __shared__ __attribute__((aligned(16))) char smem[131072 + 16384];
    cg::grid_group grid = cg::this_grid();
    char* ws = p.ws;
    unsigned* bar = (unsigned*)(ws + OFF_BAR);
    phase_prep(p, smem);
    grid.sync();
    phase_h(p, smem);
    gsync(bar, 1u);
    {
        EpiIn e; e.Q = (bf16_t*)(ws + R_Q); e.Kk = (bf16_t*)(ws + R_K); e.Vt = (bf16_t*)(ws + R_VT); e.gq = (bf16_t*)(ws + R_GQ); e.gk = (bf16_t*)(ws + R_GK);
        e.gvT = (bf16_t*)(ws + R_GVT); e.sg = (bf16_t*)(ws + R_SG); e.mg = (bf16_t*)p.out; e.glow = (float*)(ws + OFF_GLOW); e.kmax = (float*)(ws + OFF_KMAX); e.kacc0 = 0.f; e.kacc1 = 0.f;
        {
            const f32x4* src = (const f32x4*)(ws + OFF_ROPE); f32x4* dst = (f32x4*)(smem + 131072);
            for (int i = threadIdx.x; i < 1024; i += NT) dst[i] = src[i];
            __syncthreads();
            e.rope = (const float*)(smem + 131072);
        }
        gemm_phase_ex<true>((const bf16_t*)(ws + R_H), 1024, (const bf16_t*)(ws + OFF_WIN), 1024, 1024, 264, 33, smem, e, blockIdx.x, gridDim.x);
    }
    gsync(bar, 2u);
    phase_attn(p, smem);
    gsync(bar, 3u);
    phase_gate(p, smem);
    gsync(bar, 4u);
    const bool split = gridDim.x >= 192;
    const int nscan = split ? 128 : (int)gridDim.x, oth0 = split ? 128 : 0, noth = (int)gridDim.x - oth0;
    if ((int)blockIdx.x < nscan) { for (int unit = blockIdx.x; unit < 128; unit += nscan) { __syncthreads(); phase_gla(p, smem, unit); } }
    if ((int)blockIdx.x >= oth0) {
        EpiGate0 e0; e0.mg = (bf16_t*)p.out;
        gemm_phase_ex<false>((const bf16_t*)(ws + R_H), 1024, (const bf16_t*)(ws + OFF_WDA), 1024, 1024, 256, 4, smem, e0, blockIdx.x - oth0, noth);
        const long gsz2 = (long)noth * NT, gtid2 = (long)(blockIdx.x - oth0) * NT + get_tid();
        repack<0>(p.w_bgla, 1024, 1024, (bf16_t*)(ws + OFF_WGLA), 1024, gtid2, gsz2);
        repack<0>(p.w_out, 1024, 1024, (bf16_t*)(ws + OFF_WOUT), 1024, gtid2, gsz2);
        repack<0>(p.w_ff1, 1024, 4096, (bf16_t*)(ws + OFF_WFF1), 4096, gtid2, gsz2);
        repack<0>(p.w_ff2, 4096, 1024, (bf16_t*)(ws + OFF_WFF2), 1024, gtid2, gsz2);
    }
    gsync(bar, 5u);
    for (int panel = blockIdx.x; panel < 256; panel += gridDim.x) phase_combine(p, panel);
    gsync(bar, 6u);
    { EpiGate1 e1; e1.Y = (bf16_t*)(ws + R_Y); e1.mg = (const bf16_t*)p.out;
      gemm_phase((const bf16_t*)(ws + R_YGLA), 1024, (const bf16_t*)(ws + OFF_WGLA), 1024, 1024, 256, 4, smem, e1); }
    gsync(bar, 7u);
    { EpiStore<0> e; e.O = (bf16_t*)(ws + R_Y2); e.ldo = 1024;
      gemm_phase((const bf16_t*)(ws + R_Y), 1024, (const bf16_t*)(ws + OFF_WOUT), 1024, 1024, 256, 4, smem, e); }
    gsync(bar, 8u);
    for (int panel = blockIdx.x; panel < 256; panel += gridDim.x) phase_rows<0>(p, smem, panel);
    gsync(bar, 9u);
    { EpiStore<1> e; e.O = (bf16_t*)(ws + R_U); e.ldo = 4096;
      gemm_phase((const bf16_t*)(ws + R_H2), 1024, (const bf16_t*)(ws + OFF_WFF1), 1024, 1024, 256, 16, smem, e); }
    gsync(bar, 10u);
    { EpiStore<0> e; e.O = (bf16_t*)(ws + R_Y3); e.ldo = 1024;
      gemm_phase((const bf16_t*)(ws + R_U), 4096, (const bf16_t*)(ws + OFF_WFF2), 4096, 4096, 256, 4, smem, e); }
    gsync(bar, 11u);
    for (int panel = blockIdx.x; panel < 256; panel += gridDim.x) phase_rows<1>(p, smem, panel);
}

extern "C" void kernel_launch(void* const* d_in, const int* in_sizes, int n_in, void* d_out, int out_size, void* d_ws, size_t ws_size, hipStream_t stream) {
    static int grid_blocks = 0;
    if (!grid_blocks) {
        int dev = 0, cus = 0, per_cu = 0;
        hipGetDevice(&dev);
        hipDeviceGetAttribute(&cus, hipDeviceAttributeMultiprocessorCount, dev);
        hipOccupancyMaxActiveBlocksPerMultiprocessor(&per_cu, fwd_megakernel, NT, 0);
        if (per_cu < 1) per_cu = 1;
        grid_blocks = cus * per_cu;
        if (grid_blocks > 256) grid_blocks = 256;
    }
    Params p{};
    const float* const* in = (const float* const*)d_in;
    p.x = in[0]; p.c = in[1]; p.ctx = in[2]; p.c_ctx = in[3]; p.w_mod = in[4]; p.b_mod = in[5]; p.pre_norm1 = in[6]; p.w_in = in[7];
    p.w_gate_up = in[8]; p.b_gate_up = in[9]; p.lq1 = in[10]; p.lk1 = in[11]; p.lq2 = in[12]; p.lk2 = in[13]; p.da_hn = in[14]; p.gla_hn = in[15];
    p.w_bda = in[16]; p.w_bgla = in[17]; p.w_out = in[18]; p.post_norm1 = in[19]; p.pre_norm2 = in[20]; p.w_ff1 = in[21]; p.w_ff2 = in[22]; p.post_norm2 = in[23];
    p.out = (float*)d_out; p.ws = (char*)d_ws;
    hipMemsetAsync((char*)d_ws + OFF_BAR, 0, 256, stream);
    void* args[] = {&p};
    hipError_t e = hipLaunchCooperativeKernel((void*)fwd_megakernel, dim3(grid_blocks), dim3(NT), args, 0, stream);
    if (e != hipSuccess) fprintf(stderr, "cooperative launch failed: %s (grid %d)\n", hipGetErrorString(e), grid_blocks);
}
```
